# Optimizing an MI355X kernel written in HIP

```python
import math
import jax, jax.numpy as jnp
from jax import lax
import numpy as np

D_MODEL = 1024
BATCH = 4
SEQ = 8192
DEPTH = 1

N_META = 16
S5_GROUP = 16
S5_GROUPS = 32
S5_WIDTH = S5_GROUP * S5_GROUPS
S5_STATE = 64
DT_MIN = 0.001
DT_MAX = 0.1
HG_HEADS = 4
HG_HEAD_DIM = 128
HG_WIDTH = HG_HEADS * HG_HEAD_DIM
CHUNK = 64
N_BRANCH = 2
IN_WIDTH = S5_WIDTH + 4 * HG_WIDTH + N_BRANCH * D_MODEL
IN_SPLITS = (S5_WIDTH, S5_WIDTH + HG_WIDTH, S5_WIDTH + 2 * HG_WIDTH,
             S5_WIDTH + 3 * HG_WIDTH, S5_WIDTH + 4 * HG_WIDTH)
N_EXPERTS = 32
TOP_K = 4
D_EXPERT = D_MODEL
SWIGLU_ALPHA = 1.702
SWIGLU_LIMIT = 7.0
MOE_BLOCK = 256
EPS = 1e-6

kernel_name = "hybrid_s5_hgrn2_moe_meta"


def rmsnorm(x, gain):
    x32 = x.astype(jnp.float32)
    y = x32 * lax.rsqrt(jnp.mean(x32 * x32, axis=-1, keepdims=True) + EPS)
    return (y * gain.astype(jnp.float32)).astype(x.dtype)


def s5_mixer(u, lam_re, lam_im, log_dt, b_re, b_im, c_re, c_im, d_skip, w_glu):
    f32 = jnp.float32
    bsz, seq_len, _ = u.shape
    u32 = u.astype(f32).reshape(bsz, seq_len, S5_GROUPS, S5_GROUP)
    lam = lax.complex(lam_re.astype(f32), lam_im.astype(f32))
    dt = jnp.exp(log_dt.astype(f32))[:, None]
    lam_bar = jnp.exp(lam * dt)
    b_mat = lax.complex(b_re.astype(f32), b_im.astype(f32))
    b_bar = ((lam_bar - 1.0) / lam)[:, :, None] * b_mat
    bu = jnp.einsum('gph,blgh->blgp', b_bar, u32.astype(jnp.complex64))
    a = jnp.broadcast_to(lam_bar, bu.shape)

    def combine(left, right):
        a_l, b_l = left
        a_r, b_r = right
        return a_r * a_l, a_r * b_l + b_r

    _, states = lax.associative_scan(combine, (a, bu), axis=1)
    c_mat = lax.complex(c_re.astype(f32), c_im.astype(f32))
    y = jnp.real(jnp.einsum('ghp,blgp->blgh', c_mat, states)) + d_skip.astype(f32) * u32
    y = jax.nn.gelu(y.reshape(bsz, seq_len, S5_WIDTH))
    return y * jax.nn.sigmoid(y @ w_glu.astype(f32))


def hgrn2_mixer(q, fpre, v, g, lb, gn_gain):
    f32 = jnp.float32
    bsz, seq_len, _ = q.shape
    f = lb + (1.0 - lb) * jax.nn.sigmoid(fpre.astype(f32))
    logf = jnp.log(f)
    k = 1.0 - f
    q = jax.nn.silu(q.astype(f32))
    v = v.astype(f32)
    pad = CHUNK - N_META

    def to_chunks(t):
        t = jnp.pad(t, ((0, 0), (pad, 0), (0, 0)))
        n_chunks = t.shape[1] // CHUNK
        t = t.reshape(bsz, n_chunks, CHUNK, HG_HEADS, HG_HEAD_DIM)
        return t.transpose(1, 0, 3, 2, 4)

    qc, kc, vc, lc = to_chunks(q), to_chunks(k), to_chunks(v), to_chunks(logf)
    bc = jnp.cumsum(lc, axis=3)
    causal = jnp.tril(jnp.ones((CHUNK, CHUNK), dtype=bool))[:, :, None]

    def step(state, inp):
        qi, ki, vi, bi = inp
        diff = bi[:, :, :, None, :] - bi[:, :, None, :, :]
        decay = jnp.exp(jnp.where(causal, diff, -jnp.inf))
        scores = jnp.einsum('bhid,bhjd,bhijd->bhij', qi, ki, decay)
        o = scores @ vi + jnp.einsum('bhid,bhde->bhie', qi * jnp.exp(bi), state)
        b_last = bi[:, :, -1:, :]
        state = (jnp.exp(b_last[:, :, 0, :, None]) * state
                 + jnp.einsum('bhjd,bhje->bhde', ki * jnp.exp(b_last - bi), vi))
        return state, o

    s0 = jnp.zeros((bsz, HG_HEADS, HG_HEAD_DIM, HG_HEAD_DIM), f32)
    _, o = lax.scan(step, s0, (qc, kc, vc, bc))
    o = o.transpose(1, 0, 3, 2, 4).reshape(bsz, -1, HG_HEADS, HG_HEAD_DIM)[:, pad:]
    o = o * lax.rsqrt(jnp.mean(o * o, axis=-1, keepdims=True) + EPS)
    o = o.reshape(bsz, seq_len, HG_WIDTH) * gn_gain.astype(f32)
    return o * jax.nn.silu(g.astype(f32))


def moe(xn, w_router, b_router, w_gate_up, b_gate_up, w_down, b_down):
    f32 = jnp.float32
    bsz, seq_len, d = xn.shape
    tokens = xn.reshape(-1, d)
    n_tok = tokens.shape[0]
    logits = (tokens @ w_router + b_router).astype(f32)
    top_logits, top_idx = lax.top_k(logits, TOP_K)
    top_w = jax.nn.softmax(top_logits, axis=-1)

    n_assign = n_tok * TOP_K
    flat_e = top_idx.reshape(-1).astype(jnp.int32)
    flat_tok = jnp.repeat(jnp.arange(n_tok, dtype=jnp.int32), TOP_K)
    flat_w = top_w.reshape(-1)
    order = jnp.argsort(flat_e)
    sorted_e = flat_e[order]
    counts = jnp.bincount(flat_e, length=N_EXPERTS).astype(jnp.int32)
    padded = (counts + MOE_BLOCK - 1) // MOE_BLOCK * MOE_BLOCK
    padded_end = jnp.cumsum(padded)
    padded_start = padded_end - padded
    start = jnp.cumsum(counts) - counts
    rank = jnp.arange(n_assign, dtype=jnp.int32) - start[sorted_e]
    dest = padded_start[sorted_e] + rank
    n_blocks = -(-n_assign // MOE_BLOCK) + N_EXPERTS
    n_rows = n_blocks * MOE_BLOCK
    row_tok = jnp.full((n_rows,), n_tok, dtype=jnp.int32).at[dest].set(flat_tok[order])
    row_w = jnp.zeros((n_rows,), f32).at[dest].set(flat_w[order])
    block_start = jnp.arange(n_blocks, dtype=jnp.int32) * MOE_BLOCK
    block_e = jnp.minimum(jnp.searchsorted(padded_end, block_start, side='right'), N_EXPERTS - 1)
    tokens_pad = jnp.concatenate([tokens, jnp.zeros((1, d), tokens.dtype)], axis=0)
    x_rows = tokens_pad[row_tok].reshape(n_blocks, MOE_BLOCK, d)

    def expert_block(args):
        xb, e = args
        gu = xb @ w_gate_up[e] + b_gate_up[e]
        gate = jnp.minimum(gu[:, ::2], SWIGLU_LIMIT)
        up = jnp.clip(gu[:, 1::2], -SWIGLU_LIMIT, SWIGLU_LIMIT)
        glu = gate * jax.nn.sigmoid(gate * SWIGLU_ALPHA)
        return ((up + 1.0) * glu) @ w_down[e] + b_down[e]

    y_rows = lax.map(expert_block, (x_rows, block_e)).reshape(n_rows, d)
    y = jax.ops.segment_sum(y_rows * row_w[:, None].astype(y_rows.dtype), row_tok,
                            num_segments=n_tok + 1)[:n_tok]
    return y.reshape(bsz, seq_len, d).astype(xn.dtype)


def setup_inputs(seed: int = 0) -> dict:
    key = jax.random.key(seed)
    ks = jax.random.split(key, 32)
    f32 = jnp.float32
    nrm = lambda k, shape, scale: jax.random.normal(k, shape, f32) * scale
    L_ = DEPTH
    x = jax.random.normal(ks[0], (BATCH, SEQ, D_MODEL), f32)
    meta_tokens = nrm(ks[1], (N_META, D_MODEL), 1.0)
    norm1_gain = 1.0 + nrm(ks[2], (L_, D_MODEL), 0.02)
    w_in = nrm(ks[3], (L_, D_MODEL, IN_WIDTH), D_MODEL ** -0.5)
    s5_lambda_re = -0.5 * jnp.exp(nrm(ks[4], (L_, S5_GROUPS, S5_STATE), 0.01))
    s5_lambda_im = (jnp.pi * jnp.arange(S5_STATE, dtype=f32))[None, None, :] + nrm(ks[5], (L_, S5_GROUPS, S5_STATE), 0.01)
    s5_log_dt = jax.random.uniform(ks[6], (L_, S5_GROUPS), f32, math.log(DT_MIN), math.log(DT_MAX))
    s5_b_re = nrm(ks[7], (L_, S5_GROUPS, S5_STATE, S5_GROUP), (2 * S5_GROUP) ** -0.5)
    s5_b_im = nrm(ks[8], (L_, S5_GROUPS, S5_STATE, S5_GROUP), (2 * S5_GROUP) ** -0.5)
    s5_c_re = nrm(ks[9], (L_, S5_GROUPS, S5_GROUP, S5_STATE), (2 * S5_STATE) ** -0.5)
    s5_c_im = nrm(ks[10], (L_, S5_GROUPS, S5_GROUP, S5_STATE), (2 * S5_STATE) ** -0.5)
    s5_d = nrm(ks[11], (L_, S5_GROUPS, S5_GROUP), 1.0)
    s5_w_glu = nrm(ks[12], (L_, S5_WIDTH, S5_WIDTH), S5_WIDTH ** -0.5)
    hgrn_lb_logits = nrm(ks[13], (L_ + 1, HG_WIDTH), 0.1)
    hgrn_norm_gain = 1.0 + nrm(ks[14], (L_, HG_WIDTH), 0.02)
    w_branch_s5 = nrm(ks[15], (L_, S5_WIDTH, D_MODEL), S5_WIDTH ** -0.5)
    w_branch_hgrn = nrm(ks[16], (L_, HG_WIDTH, D_MODEL), HG_WIDTH ** -0.5)
    w_out = nrm(ks[17], (L_, D_MODEL, D_MODEL), D_MODEL ** -0.5)
    norm2_gain = 1.0 + nrm(ks[18], (L_, D_MODEL), 0.02)
    w_router = nrm(ks[19], (L_, D_MODEL, N_EXPERTS), D_MODEL ** -0.5)
    b_router = nrm(ks[20], (L_, N_EXPERTS), 0.01)
    w_gate_up = nrm(ks[21], (L_, N_EXPERTS, D_MODEL, 2 * D_EXPERT), D_MODEL ** -0.5)
    b_gate_up = nrm(ks[22], (L_, N_EXPERTS, 2 * D_EXPERT), 0.01)
    w_down = nrm(ks[23], (L_, N_EXPERTS, D_EXPERT, D_MODEL), D_EXPERT ** -0.5)
    b_down = nrm(ks[24], (L_, N_EXPERTS, D_MODEL), 0.01)
    final_norm_gain = 1.0 + nrm(ks[25], (D_MODEL,), 0.02)
    return {"x": x, "meta_tokens": meta_tokens, "norm1_gain": norm1_gain, "w_in": w_in,
            "s5_lambda_re": s5_lambda_re, "s5_lambda_im": s5_lambda_im, "s5_log_dt": s5_log_dt,
            "s5_b_re": s5_b_re, "s5_b_im": s5_b_im, "s5_c_re": s5_c_re, "s5_c_im": s5_c_im,
            "s5_d": s5_d, "s5_w_glu": s5_w_glu, "hgrn_lb_logits": hgrn_lb_logits,
            "hgrn_norm_gain": hgrn_norm_gain, "w_branch_s5": w_branch_s5, "w_branch_hgrn": w_branch_hgrn,
            "w_out": w_out, "norm2_gain": norm2_gain, "w_router": w_router, "b_router": b_router,
            "w_gate_up": w_gate_up, "b_gate_up": b_gate_up, "w_down": w_down, "b_down": b_down,
            "final_norm_gain": final_norm_gain}


def reference(x, meta_tokens, norm1_gain, w_in, s5_lambda_re, s5_lambda_im, s5_log_dt,
              s5_b_re, s5_b_im, s5_c_re, s5_c_im, s5_d, s5_w_glu, hgrn_lb_logits,
              hgrn_norm_gain, w_branch_s5, w_branch_hgrn, w_out, norm2_gain, w_router, b_router,
              w_gate_up, b_gate_up, w_down, b_down, final_norm_gain):
    f32 = jnp.float32
    bsz = x.shape[0]
    meta = jnp.broadcast_to(meta_tokens[None].astype(x.dtype), (bsz, N_META, D_MODEL))
    h = jnp.concatenate([meta, x], axis=1)
    lower_bounds = jnp.cumsum(jax.nn.softmax(hgrn_lb_logits.astype(f32), axis=0), axis=0)
    for l in range(DEPTH):
        xn = rmsnorm(h, norm1_gain[l])
        proj = xn @ w_in[l]
        u, q, fpre, v, og, gates = jnp.split(proj, IN_SPLITS, axis=-1)
        y_s5 = s5_mixer(u, s5_lambda_re[l], s5_lambda_im[l], s5_log_dt[l], s5_b_re[l], s5_b_im[l],
                        s5_c_re[l], s5_c_im[l], s5_d[l], s5_w_glu[l])
        y_hg = hgrn2_mixer(q, fpre, v, og, lower_bounds[l], hgrn_norm_gain[l])
        gate_s5, gate_hg = jnp.split(jax.nn.sigmoid(gates.astype(f32)), N_BRANCH, axis=-1)
        merged = (gate_s5 * (y_s5 @ w_branch_s5[l].astype(f32))
                  + gate_hg * (y_hg @ w_branch_hgrn[l].astype(f32)))
        h = h + merged.astype(h.dtype) @ w_out[l]
        h = h + moe(rmsnorm(h, norm2_gain[l]), w_router[l], b_router[l], w_gate_up[l],
                    b_gate_up[l], w_down[l], b_down[l])
    y = rmsnorm(h, final_norm_gain)[:, N_META:]
    return y
```

```cpp
#include <hip/hip_runtime.h>
#include <cstdio>
#include <cstdint>

#ifndef MK_PER_PHASE
#define MK_PER_PHASE 1
#endif

#define LAS __attribute__((address_space(3)))
#define GAS __attribute__((address_space(1)))
typedef unsigned short bf16_t;
typedef short bf16x8 __attribute__((ext_vector_type(8)));
typedef float f32x4 __attribute__((ext_vector_type(4)));
typedef float f32x2 __attribute__((ext_vector_type(2)));
typedef float f32x16 __attribute__((ext_vector_type(16)));
typedef unsigned u32x4 __attribute__((ext_vector_type(4)));
typedef unsigned u32x2 __attribute__((ext_vector_type(2)));

constexpr int T = 32768, D = 1024, NB = 4, SEQ = 8192, NCH = 128, CH = 64, NMETA = 16, INW = 4608;
constexpr int SG = 32, SH = 16, SP = 64;
constexpr int HH = 4, HD = 128, HW = 512;
constexpr int NE = 32, TOPK = 4, DF = 1024;
constexpr int UAK = 1152;
constexpr float EPS = 1e-6f;
constexpr int MAXTILES = 544;

constexpr size_t MiB = 1u << 20, KiB = 1024;
constexpr size_t WS_CTL = 0;
constexpr size_t WS_LBV = 1 * MiB, WS_LAMB = 1 * MiB + 4 * KiB, WS_LAMC = 1 * MiB + 20 * KiB, WS_XMETA = 1 * MiB + 36 * KiB;
constexpr size_t WS_BBAR = 1 * MiB + 64 * KiB, WS_WRT = 1 * MiB + 320 * KiB, WS_PMETA = 1 * MiB + 512 * KiB;
constexpr size_t WS_KCONV = 2 * MiB, WS_SMETA = 3 * MiB;
constexpr size_t WS_WIN = 4 * MiB, WS_WGLU = 13 * MiB, WS_WBS = 14 * MiB, WS_WBH = 15 * MiB, WS_WOUT = 16 * MiB, WS_WGU = 18 * MiB, WS_WD = 146 * MiB;
constexpr size_t WS_TZ = 210 * MiB, WS_WE = 282 * MiB, WS_XN = 298 * MiB, WS_UA = 362 * MiB, WS_Q = 398 * MiB, WS_LOGF = 430 * MiB, WS_V = 494 * MiB;
constexpr size_t WS_GS = 526 * MiB, WS_GATES = 558 * MiB, WS_KVT = 686 * MiB, WS_SPREV = 814 * MiB, WS_SE = 878 * MiB, WS_DEC = 886 * MiB;
constexpr size_t WS_Y1 = 888 * MiB, WS_YHG = 920 * MiB, WS_YS5 = 952 * MiB, WS_END = 984 * MiB;
constexpr size_t WS_MERGED = 686 * MiB, WS_XN2 = 210 * MiB, WS_H1 = 274 * MiB, WS_SSQ = 402 * MiB, WS_TOPE = 404 * MiB, WS_TOPW = 404 * MiB + 512 * KiB;
constexpr size_t WS_ROWTOK = 405 * MiB, WS_ROWSLOT = 406 * MiB, WS_TILEE = 407 * MiB, WS_A2 = 408 * MiB, WS_YS = 680 * MiB;
constexpr int CW_CNT = 64, CW_FILL = 128, CW_NTILES = 192, CW_BAR = 4096;

constexpr int RING_BYTES = 131072, MISC_OFF = RING_BYTES + 256, LDS_BYTES = 147456;

__device__ __forceinline__ unsigned f2bf(float f) { unsigned u = __builtin_bit_cast(unsigned, f); return (u + 0x7fffu + ((u >> 16) & 1u)) >> 16; }
__device__ __forceinline__ float bf2f(unsigned b) { return __builtin_bit_cast(float, b << 16); }
__device__ __forceinline__ unsigned pk2(float lo, float hi) { return f2bf(lo) | (f2bf(hi) << 16); }
__device__ __forceinline__ unsigned cvt_pk_bf16(float lo, float hi) { unsigned r; asm volatile("v_cvt_pk_bf16_f32 %0, %1, %2" : "=v"(r) : "v"(lo), "v"(hi)); return r; }
__device__ __forceinline__ float sigmoidf_(float x) { return 1.0f / (1.0f + __expf(-x)); }
__device__ __forceinline__ float wave_sum(float v) {
#pragma unroll
    for (int o = 1; o < 64; o <<= 1) v += __shfl_xor(v, o);
    return v;
}
#define LDS_WAIT() asm volatile("s_waitcnt lgkmcnt(0)" ::: "memory")
#define VM_WAIT() asm volatile("s_waitcnt vmcnt(0)" ::: "memory")

#define XB_TMO      128
#define XB_XCNT(j)  (256  + 64 * (j))
#define XB_XSUB(j)  (1280 + 64 * (j))
#define XB_XGEN(j)  (2304 + 64 * (j))
#define XB_TOP      3328
#define XB_TOPGEN   3392
#define XCD_BAR_WORDS 3456
#define XB_SPIN_CAP (1u << 22)
__device__ __forceinline__ unsigned xb_ld(unsigned* p)              { return __hip_atomic_load(p, __ATOMIC_RELAXED, __HIP_MEMORY_SCOPE_AGENT); }
__device__ __forceinline__ unsigned xb_add(unsigned* p, unsigned v) { return __hip_atomic_fetch_add(p, v, __ATOMIC_RELAXED, __HIP_MEMORY_SCOPE_AGENT); }
__device__ __forceinline__ unsigned xb_xcc_id() { return (unsigned)__builtin_amdgcn_s_getreg((3 << 11) | 20) & 0xFu; }
#define XB_SPIN(cond, bar) do { unsigned _sp = 0; while (cond) { __builtin_amdgcn_s_sleep(1); \
    if ((++_sp & 255u) == 0u) { if (xb_ld(&(bar)[XB_TMO])) break; if (_sp > XB_SPIN_CAP) { atomicAdd(&(bar)[XB_TMO], 1u); break; } } } } while (0)
struct XcdBarrier { unsigned* bar; unsigned x; volatile LAS unsigned* st; };
__device__ __forceinline__ XcdBarrier xcd_barrier_post(unsigned* bar, volatile LAS unsigned* st) {
    XcdBarrier b; b.bar = bar; b.x = xb_xcc_id(); b.st = st;
    if (threadIdx.x == 0) (void)xb_add(&bar[XB_XCNT(b.x)], 1u);
    return b;
}
__device__ __forceinline__ void xcd_barrier_complete(unsigned* bar, unsigned x, unsigned& nloc, unsigned& nx) {
    const unsigned G = gridDim.x * gridDim.y * gridDim.z;
    unsigned sum, cnt, mine, sp = 0u;
    for (;;) {
        sum = 0u; cnt = 0u; mine = 0u;
#pragma unroll
        for (unsigned j = 0; j < 16; ++j) { const unsigned c = xb_ld(&bar[XB_XCNT(j)]); sum += c; cnt += (c > 0u) ? 1u : 0u; mine = (j == x) ? c : mine; }
        if (sum == G) break;
        __builtin_amdgcn_s_sleep(1);
        if ((++sp & 255u) == 0u) { if (xb_ld(&bar[XB_TMO])) break; if (sp > XB_SPIN_CAP) { atomicAdd(&bar[XB_TMO], 1u); break; } }
    }
    nloc = mine > 0u ? mine : 1u; nx = cnt > 0u ? cnt : 1u;
}
__device__ __forceinline__ void xcd_barrier(const XcdBarrier& b) {
    asm volatile("s_waitcnt vmcnt(0)" ::: "memory");
    __syncthreads();
    if (threadIdx.x == 0) {
        unsigned* bar = b.bar;
        __builtin_amdgcn_s_waitcnt(0);
        unsigned nloc = b.st[0], nx = b.st[1];
        if (nloc == 0u) { xcd_barrier_complete(bar, b.x, nloc, nx); b.st[0] = nloc; b.st[1] = nx; }
        const unsigned old = xb_add(&bar[XB_XSUB(b.x)], 1u);
        const unsigned gen = old / nloc;
        if (old + 1u == (gen + 1u) * nloc) {
            __builtin_amdgcn_fence(__ATOMIC_RELEASE, "agent");
            asm volatile("s_waitcnt vmcnt(0)" ::: "memory");
            const unsigned og = xb_add(&bar[XB_TOP], 1u);
            const unsigned tg = og / nx;
            if (og + 1u == (tg + 1u) * nx) xb_add(&bar[XB_TOPGEN], 1u);
            else XB_SPIN(xb_ld(&bar[XB_TOPGEN]) == tg, bar);
            __builtin_amdgcn_fence(__ATOMIC_ACQUIRE, "agent");
            xb_add(&bar[XB_XGEN(b.x)], 1u);
            asm volatile("s_waitcnt vmcnt(0)" ::: "memory");
        } else {
            XB_SPIN(xb_ld(&bar[XB_XGEN(b.x)]) == gen, bar);
            __builtin_amdgcn_fence(__ATOMIC_ACQUIRE, "agent");
            asm volatile("s_waitcnt vmcnt(0)" ::: "memory");
        }
    }
    __syncthreads();
}

namespace pg8 {
constexpr int BM = 256, BK = 64, HALF = 128, HTB = HALF * BK * 2, STAGE_BYTES = 8 * HTB, NXCD = 8, WGM = 8;
__device__ __forceinline__ int lds_byte(int r, int c) { const int st = (r >> 4) * 2 + (c >> 5), rr = r & 15, cc = c & 31, ob = rr * 64 + cc * 2; return st * 1024 + (ob ^ (((ob >> 9) & 1) << 5)); }
__device__ __forceinline__ void stage_rc(int b, int& R, int& C) { const int st = b / 1024, sb = b % 1024, swz = sb ^ (((sb >> 9) & 1) << 5); R = (st >> 1) * 16 + swz / 64; C = (st & 1) * 32 + (swz % 64) / 2; }
__device__ __forceinline__ int perm32(int rho) { const int n = rho >> 4, i = rho & 15; return 8 * (i >> 2) + 4 * n + (i & 3); }

struct Unit { int pm, pn, aux; const char* a; const char* b; };

__device__ __forceinline__ bool static_tile(int L, int nM, int nN, int& pm, int& pn) {
    const int nwg = nM * nN; if (L >= nwg) return false;
    int wgid = L; { const int q = nwg / NXCD, r = nwg % NXCD, xcd = wgid % NXCD, off = wgid / NXCD; wgid = (xcd < r ? xcd * (q + 1) : r * (q + 1) + (xcd - r) * q) + off; }
    const int nig = WGM * nN, gid = wgid / nig, fm = gid * WGM, gsz = (nM - fm) < WGM ? (nM - fm) : WGM;
    pm = fm + ((wgid % nig) % gsz); pn = (wgid % nig) / gsz; return true;
}

template <class Epi, class Sched, bool GATHER>
__device__ __forceinline__ void gemm_phase(LAS unsigned char* lds, const int K, const int lda, const int ldb, const Sched& S, const Epi& E, const int* __restrict__ rowidx) {
    const int tid = threadIdx.x, wid = __builtin_amdgcn_readfirstlane(tid >> 6), lane = tid & 63, wr = wid >> 2, wc = wid & 3, fr = lane & 15, fq = lane >> 4;
    const int nt = K / BK;
    unsigned voffA[2], voffB[2]; int gR[2], gC[2];
#pragma unroll
    for (int i = 0; i < 2; ++i) { int R, C; stage_rc(tid * 16 + i * 8192, R, C); const int Rb = Epi::PERM ? ((R & ~31) + perm32(R & 31)) : R;
        voffA[i] = (unsigned)(R * lda + C) * 2u; voffB[i] = (unsigned)(Rb * ldb + C) * 2u; gR[i] = R; gC[i] = C * 2; }
    const size_t kstep = (size_t)(BK * 2);
    const size_t hstepA = (size_t)HALF * lda * 2, hstepB = (size_t)HALF * ldb * 2;
    const unsigned ldsw = (unsigned)wid * 1024u;
    const int aoff = lds_byte(wr * 64 + fr, fq * 8), boff = lds_byte(wc * 32 + fr, fq * 8);
#define PG8_SA(b, h) (((b) * 2 + (h)) * HTB)
#define PG8_SB(b, h) ((4 + (b) * 2 + (h)) * HTB)
#define PG8_GLDS(src, dstoff) __builtin_amdgcn_global_load_lds((const unsigned*)(src), (LAS unsigned*)(lds + (dstoff)), 16, 0, 0)
#define PG8_STAGEB(bufoff, gbase) do { PG8_GLDS((const char*)(gbase) + voffB[0], (bufoff) + ldsw); PG8_GLDS((const char*)(gbase) + voffB[1], (bufoff) + ldsw + 8192); } while (0)
#define PG8_STAGEA(bufoff, gbase, h, O) do { if constexpr (GATHER) { PG8_GLDS((const char*)(gbase) + O[h][0], (bufoff) + ldsw); PG8_GLDS((const char*)(gbase) + O[h][1], (bufoff) + ldsw + 8192); } \
        else { PG8_GLDS((const char*)(gbase) + (h) * hstepA + voffA[0], (bufoff) + ldsw); PG8_GLDS((const char*)(gbase) + (h) * hstepA + voffA[1], (bufoff) + ldsw + 8192); } } while (0)
#define PG8_LDA(dst, b, h) do { _Pragma("unroll") for (int m = 0; m < 4; ++m) _Pragma("unroll") for (int k = 0; k < 2; ++k) dst[m][k] = *(const LAS bf16x8*)(lds + PG8_SA(b, h) + aoff + m * 2048 + k * 1024); } while (0)
#define PG8_LDB(dst, b, h) do { _Pragma("unroll") for (int n = 0; n < 2; ++n) _Pragma("unroll") for (int k = 0; k < 2; ++k) dst[n][k] = *(const LAS bf16x8*)(lds + PG8_SB(b, h) + boff + n * 2048 + k * 1024); } while (0)
#define PG8_MMA(ai, bj, At, Bt) do { __builtin_amdgcn_s_setprio(1); _Pragma("unroll") for (int m = 0; m < 4; ++m) _Pragma("unroll") for (int n = 0; n < 2; ++n) _Pragma("unroll") for (int k = 0; k < 2; ++k) \
        acc[ai][bj][m][n] = __builtin_amdgcn_mfma_f32_16x16x32_bf16(Bt[n][k], At[m][k], acc[ai][bj][m][n], 0, 0, 0); __builtin_amdgcn_s_setprio(0); } while (0)
#define PG8_WAIT_V(n) asm volatile("s_waitcnt vmcnt(" #n ")" ::: "memory")
#define PG8_WAIT_L(n) asm volatile("s_waitcnt lgkmcnt(" #n ")" ::: "memory")
#define PG8_BAR __builtin_amdgcn_s_barrier()
#define PG8_SCHED __builtin_amdgcn_sched_barrier(0)
#define PG8_GOFFS(O, U) do { if constexpr (GATHER) { _Pragma("unroll") for (int h_ = 0; h_ < 2; ++h_) _Pragma("unroll") for (int i_ = 0; i_ < 2; ++i_) \
        O[h_][i_] = (unsigned)rowidx[(U).aux + h_ * HALF + gR[i_]] * (unsigned)(lda * 2) + (unsigned)gC[i_]; } } while (0)
    Unit cur, nxt; int ui = 0;
    if (!S.next(0, cur)) return;
    f32x4 acc[2][2][4][2];
#pragma unroll
    for (int a = 0; a < 2; ++a)
#pragma unroll
        for (int b = 0; b < 2; ++b)
#pragma unroll
            for (int m = 0; m < 4; ++m)
#pragma unroll
                for (int n = 0; n < 2; ++n) acc[a][b][m][n] = (f32x4){0.f, 0.f, 0.f, 0.f};
    bf16x8 At[4][2], B0[2][2], B1[2][2];
    unsigned co[2][2] = {{0u, 0u}, {0u, 0u}}, no[2][2] = {{0u, 0u}, {0u, 0u}};
    PG8_GOFFS(co, cur);
    const char* cA = cur.a; const char* cB = cur.b;
    PG8_STAGEB(PG8_SB(0, 0), cB); PG8_STAGEB(PG8_SB(0, 1), cB + hstepB); PG8_STAGEA(PG8_SA(0, 0), cA, 0, co); PG8_STAGEA(PG8_SA(0, 1), cA, 1, co);
    if (wr == 1) PG8_BAR;
    PG8_WAIT_V(2); PG8_BAR;
    PG8_STAGEB(PG8_SB(1, 0), cB + kstep); PG8_STAGEA(PG8_SA(1, 0), cA + kstep, 0, co); PG8_STAGEB(PG8_SB(1, 1), cB + hstepB + kstep);
    PG8_WAIT_V(6); PG8_BAR;
    for (;;) {
        const bool has_next = S.next(ui + 1, nxt);
        if (has_next) PG8_GOFFS(no, nxt);
        const char* nA = has_next ? nxt.a : cA; const char* nB = has_next ? nxt.b : cB;
        for (int t = 0; t < nt; t += 2) {
            const bool last = (t == nt - 2);
            const char* a1 = cA + (size_t)(t + 1) * kstep;
            const char* a2 = last ? nA : cA + (size_t)(t + 2) * kstep; const char* b2 = last ? nB : cB + (size_t)(t + 2) * kstep;
            const char* a3 = a2 + kstep; const char* b3 = b2 + kstep;
            unsigned o2[2][2];
#pragma unroll
            for (int h_ = 0; h_ < 2; ++h_)
#pragma unroll
                for (int i_ = 0; i_ < 2; ++i_) o2[h_][i_] = (last && has_next) ? no[h_][i_] : co[h_][i_];
            PG8_LDB(B0, 0, 0); PG8_LDB(B1, 0, 1); PG8_SCHED; PG8_LDA(At, 0, 0); PG8_STAGEA(PG8_SA(1, 1), a1, 1, co);
            PG8_WAIT_V(8); PG8_WAIT_L(0); PG8_BAR; PG8_MMA(0, 0, At, B0); PG8_MMA(0, 1, At, B1); PG8_BAR; PG8_SCHED;
            PG8_LDA(At, 0, 1); PG8_STAGEB(PG8_SB(0, 0), b2); PG8_STAGEB(PG8_SB(0, 1), b2 + hstepB); PG8_STAGEA(PG8_SA(0, 0), a2, 0, o2);
            PG8_WAIT_V(8); PG8_WAIT_L(0); PG8_BAR; PG8_MMA(1, 0, At, B0); PG8_MMA(1, 1, At, B1); PG8_BAR; PG8_SCHED;
            PG8_LDB(B0, 1, 0); PG8_LDB(B1, 1, 1); PG8_SCHED; PG8_LDA(At, 1, 0); PG8_STAGEA(PG8_SA(0, 1), a2, 1, o2);
            PG8_WAIT_V(8); PG8_WAIT_L(0); PG8_BAR; PG8_MMA(0, 0, At, B0); PG8_MMA(0, 1, At, B1); PG8_BAR; PG8_SCHED;
            PG8_LDA(At, 1, 1); PG8_STAGEB(PG8_SB(1, 0), b3); PG8_STAGEB(PG8_SB(1, 1), b3 + hstepB); PG8_STAGEA(PG8_SA(1, 0), a3, 0, o2);
            PG8_WAIT_V(8); PG8_WAIT_L(0); PG8_BAR; PG8_MMA(1, 0, At, B0); PG8_MMA(1, 1, At, B1); PG8_BAR; PG8_SCHED;
        }
        if (wr == 0) PG8_BAR;
        const bool keep = E(acc, cur, wr, wc, fr, fq);
        if (!has_next) break;
        if (!keep) {
#pragma unroll
            for (int a = 0; a < 2; ++a)
#pragma unroll
                for (int b = 0; b < 2; ++b)
#pragma unroll
                    for (int m = 0; m < 4; ++m)
#pragma unroll
                        for (int n = 0; n < 2; ++n) acc[a][b][m][n] = (f32x4){0.f, 0.f, 0.f, 0.f};
        }
        cur = nxt; cA = nA; cB = nB; ++ui;
#pragma unroll
        for (int h_ = 0; h_ < 2; ++h_)
#pragma unroll
            for (int i_ = 0; i_ < 2; ++i_) co[h_][i_] = no[h_][i_];
        if (wr == 1) PG8_BAR;
    }
    PG8_WAIT_V(0);
    PG8_BAR;
#undef PG8_SA
#undef PG8_SB
#undef PG8_GLDS
#undef PG8_STAGEA
#undef PG8_STAGEB
#undef PG8_LDA
#undef PG8_LDB
#undef PG8_MMA
#undef PG8_WAIT_V
#undef PG8_WAIT_L
#undef PG8_BAR
#undef PG8_SCHED
#undef PG8_GOFFS
}
}
using pg8::Unit;

struct Frame {
    LAS unsigned char* lds; volatile LAS unsigned* MISC; unsigned* ctl; unsigned char* ws;
    int tid, lane, wave, vcu, G, bx;
    const float* in[26]; float* out;
};
enum { I_X = 0, I_META, I_N1G, I_WIN, I_LRE, I_LIM, I_LDT, I_BRE, I_BIM, I_CRE, I_CIM, I_SD, I_WGLU, I_LBL, I_HNG, I_WBS, I_WBH, I_WOUT, I_N2G, I_WR, I_BR, I_WGU, I_BGU, I_WD, I_BD, I_FNG };

struct SchedStatic {
    const char* A; const char* B; int nM, nN, G, c; size_t ta, tb;
    __device__ __forceinline__ bool next(int i, Unit& u) const { int pm, pn; if (!pg8::static_tile(i * G + c, nM, nN, pm, pn)) return false; u.pm = pm; u.pn = pn; u.aux = 0; u.a = A + (size_t)pm * ta; u.b = B + (size_t)pn * tb; return true; }
};
struct SchedS5E {
    const char* UA; const char* WE; int c;
    __device__ __forceinline__ bool next(int i, Unit& u) const { if (i > 0 || c >= 64) return false; const int g = c >> 1, pm = c & 1; u.pm = pm; u.pn = 0; u.aux = g;
        u.a = UA + ((size_t)g * 512 + pm * 256) * UAK * 2; u.b = WE + (size_t)g * 256 * 1024 * 2; return true; }
};
struct SchedS5Y {
    const char* UA; const char* TZ; int c, G;
    __device__ __forceinline__ bool next(int i, Unit& u) const { const int L = i * G + c; if (L >= 256) return false; const int g = L >> 3, pm = (L >> 2) & 1, pn = L & 3; u.pm = pm; u.pn = pn; u.aux = g;
        u.a = UA + ((size_t)g * 512 + pm * 256) * UAK * 2; u.b = TZ + ((size_t)g * 1024 + pn * 256) * UAK * 2; return true; }
};
struct SchedBranch {
    const char* A0; const char* A1; const char* B0; const char* B1; int G, c;
    __device__ __forceinline__ bool next(int i, Unit& u) const { int pm, pn; if (!pg8::static_tile((i >> 1) * G + c, T / 256, 4, pm, pn)) return false; const int part = i & 1; u.pm = pm; u.pn = pn; u.aux = part;
        u.a = (part ? A1 : A0) + (size_t)pm * 256 * HW * 2; u.b = (part ? B1 : B0) + (size_t)pn * 256 * HW * 2; return true; }
};
struct SchedMoe {
    const char* A; const char* W; const int* tile_e; int ntiles, NN, G, c; size_t wexp, wtile; bool gather;
    __device__ __forceinline__ bool next(int i, Unit& u) const { const int L = i * G + c; const int ti = L / NN; if (ti >= ntiles) return false; const int pn = L - ti * NN; const int e = tile_e[ti];
        u.pm = ti; u.pn = pn; u.aux = gather ? ti * 256 : e; u.a = gather ? A : A + (size_t)ti * 256 * DF * 2; u.b = W + (size_t)e * wexp + (size_t)pn * wtile; return true; }
};

__device__ __forceinline__ u32x4 pack8(const f32x4& v0, const f32x4& v1) { u32x4 w; w.x = cvt_pk_bf16(v0[0], v0[1]); w.y = cvt_pk_bf16(v0[2], v0[3]); w.z = cvt_pk_bf16(v1[0], v1[1]); w.w = cvt_pk_bf16(v1[2], v1[3]); return w; }

struct EpiInProj {
    static constexpr bool PERM = true;
    bf16_t *UA, *Q, *V, *GS, *GATES; float* LOGF; const float* LBV;
    __device__ __forceinline__ bool operator()(f32x4 (&acc)[2][2][4][2], const Unit& u, int wr, int wc, int fr, int fq) const {
        const int kind = u.pn >> 1;
#pragma unroll
        for (int ai = 0; ai < 2; ++ai)
#pragma unroll
            for (int m = 0; m < 4; ++m) { const int tok = u.pm * 256 + ai * 128 + wr * 64 + m * 16 + fr;
#pragma unroll
                for (int bj = 0; bj < 2; ++bj) { const int col = u.pn * 256 + bj * 128 + wc * 32 + 8 * fq; f32x4 v0 = acc[ai][bj][m][0], v1 = acc[ai][bj][m][1];
                    if (kind == 0) { const int g = col >> 4, hh = col & 15; *(u32x4*)(UA + ((size_t)(g * 512 + (tok >> 6)) * UAK + (tok & 63) * 16 + hh)) = pack8(v0, v1); }
                    else if (kind == 1) {
#pragma unroll
                        for (int j = 0; j < 4; ++j) { v0[j] = v0[j] * sigmoidf_(v0[j]); v1[j] = v1[j] * sigmoidf_(v1[j]); }
                        *(u32x4*)(Q + (size_t)tok * HW + (col - 512)) = pack8(v0, v1); }
                    else if (kind == 2) { const int c2 = col - 1024; const f32x4 l0 = *(const f32x4*)(LBV + c2), l1 = *(const f32x4*)(LBV + c2 + 4);
#pragma unroll
                        for (int j = 0; j < 4; ++j) { v0[j] = __logf(l0[j] + (1.f - l0[j]) * sigmoidf_(v0[j])); v1[j] = __logf(l1[j] + (1.f - l1[j]) * sigmoidf_(v1[j])); }
                        *(f32x4*)(LOGF + (size_t)tok * HW + c2) = v0; *(f32x4*)(LOGF + (size_t)tok * HW + c2 + 4) = v1; }
                    else if (kind == 3) { *(u32x4*)(V + (size_t)tok * HW + (col - 1536)) = pack8(v0, v1); }
                    else if (kind == 4) {
#pragma unroll
                        for (int j = 0; j < 4; ++j) { v0[j] = v0[j] * sigmoidf_(v0[j]); v1[j] = v1[j] * sigmoidf_(v1[j]); }
                        *(u32x4*)(GS + (size_t)tok * HW + (col - 2048)) = pack8(v0, v1); }
                    else {
#pragma unroll
                        for (int j = 0; j < 4; ++j) { v0[j] = sigmoidf_(v0[j]); v1[j] = sigmoidf_(v1[j]); }
                        *(u32x4*)(GATES + (size_t)tok * 2048 + (col - 2560)) = pack8(v0, v1); }
                } }
        return false;
    }
};
struct EpiS5E {
    static constexpr bool PERM = false;
    float* SE;
    __device__ __forceinline__ bool operator()(f32x4 (&acc)[2][2][4][2], const Unit& u, int wr, int wc, int fr, int fq) const {
#pragma unroll
        for (int ai = 0; ai < 2; ++ai)
#pragma unroll
            for (int m = 0; m < 4; ++m) { const int r = u.pm * 256 + ai * 128 + wr * 64 + m * 16 + fr; float* rowp = SE + ((size_t)u.aux * 512 + r) * 128 + wc * 32 + 4 * fq;
#pragma unroll
                for (int n = 0; n < 2; ++n) *(f32x4*)(rowp + n * 16) = acc[ai][0][m][n]; }
        return false;
    }
};
struct EpiS5Y {
    static constexpr bool PERM = true;
    const bf16_t* UA; const float* SD; bf16_t* Y1;
    __device__ __forceinline__ bool operator()(f32x4 (&acc)[2][2][4][2], const Unit& u, int wr, int wc, int fr, int fq) const {
        const int g = u.aux;
#pragma unroll
        for (int ai = 0; ai < 2; ++ai)
#pragma unroll
            for (int m = 0; m < 4; ++m) { const int r = u.pm * 256 + ai * 128 + wr * 64 + m * 16 + fr; const int b = r >> 7, c = r & 127;
#pragma unroll
                for (int bj = 0; bj < 2; ++bj) { const int col = u.pn * 256 + bj * 128 + wc * 32 + 8 * fq; const int t = col >> 4, hh = col & 15;
                    const u32x4 uu = *(const u32x4*)(UA + ((size_t)(g * 512 + r) * UAK + col));
                    const f32x4 d0 = *(const f32x4*)(SD + g * 16 + hh), d1 = *(const f32x4*)(SD + g * 16 + hh + 4);
                    f32x4 v0 = acc[ai][bj][m][0], v1 = acc[ai][bj][m][1];
                    v0[0] += d0[0] * bf2f(uu.x & 0xffffu); v0[1] += d0[1] * bf2f(uu.x >> 16); v0[2] += d0[2] * bf2f(uu.y & 0xffffu); v0[3] += d0[3] * bf2f(uu.y >> 16);
                    v1[0] += d1[0] * bf2f(uu.z & 0xffffu); v1[1] += d1[1] * bf2f(uu.z >> 16); v1[2] += d1[2] * bf2f(uu.w & 0xffffu); v1[3] += d1[3] * bf2f(uu.w >> 16);
#pragma unroll
                    for (int j = 0; j < 4; ++j) { float x = v0[j]; v0[j] = x * sigmoidf_(1.5957691216f * (x + 0.044715f * x * x * x)); x = v1[j]; v1[j] = x * sigmoidf_(1.5957691216f * (x + 0.044715f * x * x * x)); }
                    const int tok = b * SEQ + c * 64 + t;
                    *(u32x4*)(Y1 + (size_t)tok * HW + g * 16 + hh) = pack8(v0, v1); } }
        return false;
    }
};
struct EpiGlu {
    static constexpr bool PERM = true;
    const bf16_t* Y1; bf16_t* YS5;
    __device__ __forceinline__ bool operator()(f32x4 (&acc)[2][2][4][2], const Unit& u, int wr, int wc, int fr, int fq) const {
#pragma unroll
        for (int ai = 0; ai < 2; ++ai)
#pragma unroll
            for (int m = 0; m < 4; ++m) { const int row = u.pm * 256 + ai * 128 + wr * 64 + m * 16 + fr;
#pragma unroll
                for (int bj = 0; bj < 2; ++bj) { const int col = u.pn * 256 + bj * 128 + wc * 32 + 8 * fq; const u32x4 y = *(const u32x4*)(Y1 + (size_t)row * HW + col);
                    f32x4 v0 = acc[ai][bj][m][0], v1 = acc[ai][bj][m][1];
                    v0[0] = bf2f(y.x & 0xffffu) * sigmoidf_(v0[0]); v0[1] = bf2f(y.x >> 16) * sigmoidf_(v0[1]); v0[2] = bf2f(y.y & 0xffffu) * sigmoidf_(v0[2]); v0[3] = bf2f(y.y >> 16) * sigmoidf_(v0[3]);
                    v1[0] = bf2f(y.z & 0xffffu) * sigmoidf_(v1[0]); v1[1] = bf2f(y.z >> 16) * sigmoidf_(v1[1]); v1[2] = bf2f(y.w & 0xffffu) * sigmoidf_(v1[2]); v1[3] = bf2f(y.w >> 16) * sigmoidf_(v1[3]);
                    *(u32x4*)(YS5 + (size_t)row * HW + col) = pack8(v0, v1); } }
        return false;
    }
};
struct EpiBranch {
    static constexpr bool PERM = true;
    const bf16_t* GATES; bf16_t* MERGED;
    __device__ __forceinline__ bool operator()(f32x4 (&acc)[2][2][4][2], const Unit& u, int wr, int wc, int fr, int fq) const {
        const int part = u.aux;
#pragma unroll
        for (int ai = 0; ai < 2; ++ai)
#pragma unroll
            for (int m = 0; m < 4; ++m) { const int row = u.pm * 256 + ai * 128 + wr * 64 + m * 16 + fr;
#pragma unroll
                for (int bj = 0; bj < 2; ++bj) { const int col = u.pn * 256 + bj * 128 + wc * 32 + 8 * fq;
                    const u32x4 g2 = *(const u32x4*)(GATES + (size_t)row * 2048 + 1024 + col);
                    float h[8] = {bf2f(g2.x & 0xffffu), bf2f(g2.x >> 16), bf2f(g2.y & 0xffffu), bf2f(g2.y >> 16), bf2f(g2.z & 0xffffu), bf2f(g2.z >> 16), bf2f(g2.w & 0xffffu), bf2f(g2.w >> 16)};
#pragma unroll
                    for (int j = 0; j < 8; ++j) h[j] = fmaxf(h[j], 1e-30f);
                    if (part == 0) { const u32x4 g1 = *(const u32x4*)(GATES + (size_t)row * 2048 + col);
                        const float s[8] = {bf2f(g1.x & 0xffffu), bf2f(g1.x >> 16), bf2f(g1.y & 0xffffu), bf2f(g1.y >> 16), bf2f(g1.z & 0xffffu), bf2f(g1.z >> 16), bf2f(g1.w & 0xffffu), bf2f(g1.w >> 16)};
#pragma unroll
                        for (int j = 0; j < 4; ++j) { acc[ai][bj][m][0][j] *= s[j] / h[j]; acc[ai][bj][m][1][j] *= s[4 + j] / h[4 + j]; } }
                    else { f32x4 v0 = acc[ai][bj][m][0], v1 = acc[ai][bj][m][1];
#pragma unroll
                        for (int j = 0; j < 4; ++j) { v0[j] *= h[j]; v1[j] *= h[4 + j]; }
                        *(u32x4*)(MERGED + (size_t)row * D + col) = pack8(v0, v1); } } }
        return part == 0;
    }
};
struct EpiOut {
    static constexpr bool PERM = false;
    const float* X; float* H1; float* SSQ;
    __device__ __forceinline__ bool operator()(f32x4 (&acc)[2][2][4][2], const Unit& u, int wr, int wc, int fr, int fq) const {
#pragma unroll
        for (int ai = 0; ai < 2; ++ai)
#pragma unroll
            for (int m = 0; m < 4; ++m) { const int row = u.pm * 256 + ai * 128 + wr * 64 + m * 16 + fr; const size_t off = (size_t)row * D + u.pn * 256 + wc * 32 + 4 * fq; float ss = 0.f;
#pragma unroll
                for (int bj = 0; bj < 2; ++bj)
#pragma unroll
                    for (int n = 0; n < 2; ++n) { const f32x4 xv = *(const f32x4*)(X + off + bj * 128 + n * 16); const f32x4 o = xv + acc[ai][bj][m][n];
                        *(f32x4*)(H1 + off + bj * 128 + n * 16) = o; ss += (o[0] * o[0] + o[1] * o[1]) + (o[2] * o[2] + o[3] * o[3]); }
                ss += __shfl_xor(ss, 16); ss += __shfl_xor(ss, 32);
                if (fq == 0) SSQ[(size_t)row * 16 + u.pn * 4 + wc] = ss; }
        return false;
    }
};
struct EpiMoe1 {
    static constexpr bool PERM = true;
    const float* BGU; const int* tile_e; bf16_t* A2;
    __device__ __forceinline__ bool operator()(f32x4 (&acc)[2][2][4][2], const Unit& u, int wr, int wc, int fr, int fq) const {
        const int e = tile_e[u.pm]; const int hid = u.pn * 128 + wc * 32 + 8 * fq; const float* bp = BGU + (size_t)e * 2048 + 2 * hid;
        const f32x4 b0 = *(const f32x4*)(bp), b1 = *(const f32x4*)(bp + 4), b2 = *(const f32x4*)(bp + 8), b3 = *(const f32x4*)(bp + 12);
        const float bg[8] = {b0[0], b0[2], b1[0], b1[2], b2[0], b2[2], b3[0], b3[2]}, bu[8] = {b0[1], b0[3], b1[1], b1[3], b2[1], b2[3], b3[1], b3[3]};
#pragma unroll
        for (int ai = 0; ai < 2; ++ai)
#pragma unroll
            for (int m = 0; m < 4; ++m) { const int prow = u.pm * 256 + ai * 128 + wr * 64 + m * 16 + fr; f32x4 o0, o1;
#pragma unroll
                for (int j = 0; j < 4; ++j) {
                    float gt = fminf(acc[ai][0][m][0][j] + bg[j], 7.0f), up = fminf(fmaxf(acc[ai][1][m][0][j] + bu[j], -7.0f), 7.0f); o0[j] = (up + 1.0f) * gt * sigmoidf_(1.702f * gt);
                    gt = fminf(acc[ai][0][m][1][j] + bg[4 + j], 7.0f); up = fminf(fmaxf(acc[ai][1][m][1][j] + bu[4 + j], -7.0f), 7.0f); o1[j] = (up + 1.0f) * gt * sigmoidf_(1.702f * gt); }
                *(u32x4*)(A2 + (size_t)prow * DF + hid) = pack8(o0, o1); }
        return false;
    }
};
struct EpiMoe2 {
    static constexpr bool PERM = true;
    const float* BD; const int* tile_e; const int* rowslot; bf16_t* YS;
    __device__ __forceinline__ bool operator()(f32x4 (&acc)[2][2][4][2], const Unit& u, int wr, int wc, int fr, int fq) const {
        const int e = tile_e[u.pm];
#pragma unroll
        for (int ai = 0; ai < 2; ++ai)
#pragma unroll
            for (int m = 0; m < 4; ++m) { const int prow = u.pm * 256 + ai * 128 + wr * 64 + m * 16 + fr; const int slot = rowslot[prow];
                if (slot >= 0) {
#pragma unroll
                    for (int bj = 0; bj < 2; ++bj) { const int col = u.pn * 256 + bj * 128 + wc * 32 + 8 * fq; const f32x4 c0 = *(const f32x4*)(BD + (size_t)e * D + col), c1 = *(const f32x4*)(BD + (size_t)e * D + col + 4);
                        *(u32x4*)(YS + (size_t)slot * D + col) = pack8(acc[ai][bj][m][0] + c0, acc[ai][bj][m][1] + c1); } } }
        return false;
    }
};

template <int MODE  > __device__ __forceinline__ void p0_transpose_item(const float* W, int K, int N, bf16_t* WT, LAS float* scr, int item, int lane) {
    const int nblk = N / 32, kb = item / nblk, nb = item % nblk, k0 = 64 * kb, n0 = 32 * nb;
#pragma unroll 8
    for (int i = 0; i < 32; ++i) { const int kk = 2 * i + (lane >> 5); scr[kk * 33 + (lane & 31)] = W[(size_t)(k0 + kk) * N + n0 + (lane & 31)]; }
    LDS_WAIT(); asm volatile("" ::: "memory");
    const int c = lane & 7;
#pragma unroll
    for (int j = 0; j < 4; ++j) { const int n = (lane >> 3) + 8 * j; const LAS float* s = scr + (8 * c) * 33 + n;
        u32x4 o; o.x = pk2(s[0 * 33], s[1 * 33]); o.y = pk2(s[2 * 33], s[3 * 33]); o.z = pk2(s[4 * 33], s[5 * 33]); o.w = pk2(s[6 * 33], s[7 * 33]);
        int nn = n0 + n; if (MODE == 1) { const int hid = nn >> 1, part = nn & 1; nn = 256 * (hid >> 7) + 128 * part + (hid & 127); }
        *(u32x4*)(WT + (size_t)nn * K + k0 + 8 * c) = o; }
    LDS_WAIT(); asm volatile("" ::: "memory");
}
struct C2 { double re, im; };
__device__ __forceinline__ C2 cmul(C2 a, C2 b) { return C2{a.re * b.re - a.im * b.im, a.re * b.im + a.im * b.re}; }
__device__ __forceinline__ C2 s5_pow(const Frame& F, int g, int p, int k) {
    const double lre = (double)F.in[I_LRE][g * SP + p], lim = (double)F.in[I_LIM][g * SP + p], dt = exp((double)F.in[I_LDT][g]);
    const double mag = exp((double)k * lre * dt); double s, c; sincos((double)k * lim * dt, &s, &c); return C2{mag * c, mag * s};
}
__device__ __forceinline__ C2 s5_coef(const Frame& F, int g, int p) {
    const double lre = (double)F.in[I_LRE][g * SP + p], lim = (double)F.in[I_LIM][g * SP + p]; const C2 lb = s5_pow(F, g, p, 1);
    const double nr = lb.re - 1.0, ni = lb.im, den = lre * lre + lim * lim; return C2{(nr * lre + ni * lim) / den, (ni * lre - nr * lim) / den};
}

__device__ __forceinline__ void p0_prologue(Frame& F) {
    LAS float* scr = (LAS float*)(F.lds + F.wave * 16384);
    const int gw = F.vcu * 8 + F.wave, NGW = F.G * 8, lane = F.lane;
    unsigned char* ws = F.ws;
    constexpr int I_GU = NE * 16 * 64, I_DN = NE * 16 * 32, I_IN = 16 * 144, I_GL = 8 * 16, I_BS = 8 * 32, I_BH = 8 * 32, I_OU = 16 * 32;
    constexpr int R0 = I_GU, R1 = R0 + I_DN, R2 = R1 + I_IN, R3 = R2 + I_GL, R4 = R3 + I_BS, R5 = R4 + I_BH, R6 = R5 + I_OU;
    constexpr int R7 = R6 + 2048  , R8 = R7 + 2048  , R9 = R8 + 2048  , R10 = R9 + 32  , R11 = R10 + 96  , R12 = R11 + 16  , R13 = R12 + 1  ;
    constexpr int R14 = R13 + 2048  ;
    for (int it = gw; it < R14; it += NGW) {
        if (it < R0) { const int e = it / (16 * 64), r = it % (16 * 64); p0_transpose_item<1>(F.in[I_WGU] + (size_t)e * D * 2048, D, 2048, (bf16_t*)(ws + WS_WGU) + (size_t)e * 2048 * D, scr, r, lane); }
        else if (it < R1) { const int q = it - R0, e = q / (16 * 32), r = q % (16 * 32); p0_transpose_item<0>(F.in[I_WD] + (size_t)e * DF * D, DF, D, (bf16_t*)(ws + WS_WD) + (size_t)e * D * DF, scr, r, lane); }
        else if (it < R2) p0_transpose_item<0>(F.in[I_WIN], D, INW, (bf16_t*)(ws + WS_WIN), scr, it - R1, lane);
        else if (it < R3) p0_transpose_item<0>(F.in[I_WGLU], HW, HW, (bf16_t*)(ws + WS_WGLU), scr, it - R2, lane);
        else if (it < R4) p0_transpose_item<0>(F.in[I_WBS], HW, D, (bf16_t*)(ws + WS_WBS), scr, it - R3, lane);
        else if (it < R5) p0_transpose_item<0>(F.in[I_WBH], HW, D, (bf16_t*)(ws + WS_WBH), scr, it - R4, lane);
        else if (it < R6) p0_transpose_item<0>(F.in[I_WOUT], D, D, (bf16_t*)(ws + WS_WOUT), scr, it - R5, lane);
        else if (it < R7) {
            const int q = it - R6, g = q >> 6, k = q & 63, p = lane;
            const C2 pw = s5_pow(F, g, p, k), cf = s5_coef(F, g, p);
            LAS float* CLre = scr; LAS float* CLim = scr + 1024; LAS float* BBre = scr + 2048; LAS float* BBim = scr + 3072;
#pragma unroll 4
            for (int h = 0; h < 16; ++h) { const C2 cc = cmul(C2{(double)F.in[I_CRE][(g * 16 + h) * SP + p], (double)F.in[I_CIM][(g * 16 + h) * SP + p]}, pw); CLre[h * 64 + p] = (float)cc.re; CLim[h * 64 + p] = (float)cc.im;
                const C2 bb = cmul(cf, C2{(double)F.in[I_BRE][(g * SP + p) * 16 + h], (double)F.in[I_BIM][(g * SP + p) * 16 + h]}); BBre[p * 16 + h] = (float)bb.re; BBim[p * 16 + h] = (float)bb.im; }
            LDS_WAIT(); asm volatile("" ::: "memory");
            float o[4];
#pragma unroll
            for (int qq = 0; qq < 4; ++qq) { const int idx = lane * 4 + qq, h = idx >> 4, h2 = idx & 15; float s = 0.f;
                for (int pp = 0; pp < 64; ++pp) s += CLre[h * 64 + pp] * BBre[pp * 16 + h2] - CLim[h * 64 + pp] * BBim[pp * 16 + h2];
                o[qq] = s; }
            u32x2 w; w.x = pk2(o[0], o[1]); w.y = pk2(o[2], o[3]);
            *(u32x2*)((bf16_t*)(ws + WS_KCONV) + (size_t)q * 256 + lane * 4) = w;
            LDS_WAIT(); asm volatile("" ::: "memory");
        }
        else if (it < R8) {
            const int q = it - R7, g = q >> 6, s = q & 63, p = lane; const C2 pw = cmul(s5_pow(F, g, p, 63 - s), s5_coef(F, g, p));
            float re[16], im[16];
#pragma unroll
            for (int h = 0; h < 16; ++h) { const C2 w = cmul(pw, C2{(double)F.in[I_BRE][(g * SP + p) * 16 + h], (double)F.in[I_BIM][(g * SP + p) * 16 + h]}); re[h] = (float)w.re; im[h] = (float)w.im; }
            bf16_t* o0 = (bf16_t*)(ws + WS_WE) + ((size_t)(g * 256 + p) * 1024 + s * 16); bf16_t* o1 = o0 + (size_t)64 * 1024;
            u32x4 a, b; a.x = pk2(re[0], re[1]); a.y = pk2(re[2], re[3]); a.z = pk2(re[4], re[5]); a.w = pk2(re[6], re[7]); b.x = pk2(re[8], re[9]); b.y = pk2(re[10], re[11]); b.z = pk2(re[12], re[13]); b.w = pk2(re[14], re[15]);
            *(u32x4*)o0 = a; *(u32x4*)(o0 + 8) = b;
            a.x = pk2(im[0], im[1]); a.y = pk2(im[2], im[3]); a.z = pk2(im[4], im[5]); a.w = pk2(im[6], im[7]); b.x = pk2(im[8], im[9]); b.y = pk2(im[10], im[11]); b.z = pk2(im[12], im[13]); b.w = pk2(im[14], im[15]);
            *(u32x4*)o1 = a; *(u32x4*)(o1 + 8) = b;
        }
        else if (it < R9) {
            const int q = it - R8, g = q >> 6, t = q & 63, p = lane; const C2 pw = s5_pow(F, g, p, t + 1);
            for (int h = 0; h < 16; ++h) { const C2 cc = cmul(C2{(double)F.in[I_CRE][(g * 16 + h) * SP + p], (double)F.in[I_CIM][(g * 16 + h) * SP + p]}, pw);
                bf16_t* o = (bf16_t*)(ws + WS_TZ) + ((size_t)(g * 1024 + t * 16 + h) * UAK + 1024 + p); o[0] = (bf16_t)f2bf((float)cc.re); o[64] = (bf16_t)f2bf((float)(-cc.im)); }
        }
        else if (it < R10) {
            const int g = it - R9, p = lane; const C2 l1 = s5_pow(F, g, p, 1), l64 = s5_pow(F, g, p, 64), cf = s5_coef(F, g, p);
            ((f32x2*)(ws + WS_LAMB))[g * SP + p] = (f32x2){(float)l1.re, (float)l1.im}; ((f32x2*)(ws + WS_LAMC))[g * SP + p] = (f32x2){(float)l64.re, (float)l64.im};
            for (int h = 0; h < 16; ++h) { const C2 bb = cmul(cf, C2{(double)F.in[I_BRE][(g * SP + p) * 16 + h], (double)F.in[I_BIM][(g * SP + p) * 16 + h]}); ((f32x2*)(ws + WS_BBAR))[(g * SP + p) * 16 + h] = (f32x2){(float)bb.re, (float)bb.im}; }
        }
        else if (it < R11) {
            const int q = it - R10, cg = q >> 2, kq = q & 3; const int wcol = (cg < 8 ? cg * 64 : (cg < 16 ? 1024 + (cg - 8) * 64 : 1536 + (cg - 16) * 64)) + lane;
            const float* meta = F.in[I_META]; const float* g1 = F.in[I_N1G];
            for (int r = 0; r < 16; ++r) { float s = 0.f;
#pragma unroll
                for (int j = 0; j < 16; ++j) { const float v = meta[r * D + lane + 64 * j]; s += v * v; }
                const float rstd = 1.0f / sqrtf(wave_sum(s) * (1.0f / D) + EPS);
#pragma unroll
                for (int j = 0; j < 4; ++j) { const int kk = lane + 64 * j, k = kq * 256 + kk; scr[kk * 16 + r] = meta[r * D + k] * rstd * g1[k]; } }
            LDS_WAIT(); asm volatile("" ::: "memory");
            float a[16];
#pragma unroll
            for (int r = 0; r < 16; ++r) a[r] = 0.f;
            const float* wp = F.in[I_WIN] + (size_t)(kq * 256) * INW + wcol;
#pragma unroll 4
            for (int kk = 0; kk < 256; ++kk) { const float w = wp[(size_t)kk * INW]; const LAS f32x4* xs = (const LAS f32x4*)(scr + kk * 16);
                const f32x4 x0 = xs[0], x1 = xs[1], x2 = xs[2], x3 = xs[3];
                a[0] += w * x0[0]; a[1] += w * x0[1]; a[2] += w * x0[2]; a[3] += w * x0[3]; a[4] += w * x1[0]; a[5] += w * x1[1]; a[6] += w * x1[2]; a[7] += w * x1[3];
                a[8] += w * x2[0]; a[9] += w * x2[1]; a[10] += w * x2[2]; a[11] += w * x2[3]; a[12] += w * x3[0]; a[13] += w * x3[1]; a[14] += w * x3[2]; a[15] += w * x3[3]; }
            float* pm = (float*)(ws + WS_PMETA);
#pragma unroll
            for (int r = 0; r < 16; ++r) pm[(size_t)(kq * 16 + r) * 1536 + cg * 64 + lane] = a[r];
            LDS_WAIT(); asm volatile("" ::: "memory");
        }
        else if (it < R12) {
            const int k = (it - R11) * 64 + lane; bf16_t* hi = (bf16_t*)(ws + WS_WRT); bf16_t* lo = hi + NE * D;
            for (int e = 0; e < NE; ++e) { const float w = F.in[I_WR][k * NE + e]; const unsigned h = f2bf(w); hi[e * D + k] = (bf16_t)h; lo[e * D + k] = (bf16_t)f2bf(w - bf2f(h)); }
        }
        else if (it < R13) {
            for (int d = lane; d < HW; d += 64) ((float*)(ws + WS_LBV))[d] = sigmoidf_(F.in[I_LBL][d] - F.in[I_LBL][HW + d]);
        }
        else {
            const int q = it - R13, g = q >> 6, r0 = 128 + (q & 63) * 2; u32x4* o = (u32x4*)((bf16_t*)(ws + WS_WE) + (size_t)(g * 256 + r0) * 1024);
#pragma unroll
            for (int j = 0; j < 4; ++j) o[lane + 64 * j] = (u32x4){0u, 0u, 0u, 0u};
        }
    }
    const float* g1 = F.in[I_N1G];
    for (int m = gw; m < T; m += NGW) {
        const f32x4* xr = (const f32x4*)(F.in[I_X] + (size_t)m * D) + lane; f32x4 v[4]; float s = 0.f;
#pragma unroll
        for (int j = 0; j < 4; ++j) { v[j] = xr[64 * j]; s += (v[j].x * v[j].x + v[j].y * v[j].y) + (v[j].z * v[j].z + v[j].w * v[j].w); }
        const float rstd = 1.0f / sqrtf(wave_sum(s) * (1.0f / D) + EPS);
        u32x2* o8 = (u32x2*)((bf16_t*)(ws + WS_XN) + (size_t)m * D) + lane;
#pragma unroll
        for (int j = 0; j < 4; ++j) { const f32x4 gg = ((const f32x4*)g1)[lane + 64 * j]; u32x2 w; w.x = pk2(v[j].x * rstd * gg.x, v[j].y * rstd * gg.y); w.y = pk2(v[j].z * rstd * gg.z, v[j].w * rstd * gg.w); o8[64 * j] = w; }
    }
}
__device__ __forceinline__ void p1_toeplitz(Frame& F) {
    const int gw = F.vcu * 8 + F.wave, NGW = F.G * 8, lane = F.lane; const bf16_t* kc = (const bf16_t*)(F.ws + WS_KCONV); bf16_t* tz = (bf16_t*)(F.ws + WS_TZ);
    for (int row = gw; row < SG * 1024; row += NGW) { const int g = row >> 10, t = (row >> 4) & 63, h = row & 15;
#pragma unroll
        for (int j = 0; j < 2; ++j) { const int q = lane + 64 * j, s = q >> 1, half = q & 1; u32x4 v = (u32x4){0u, 0u, 0u, 0u};
            if (s <= t) v = *(const u32x4*)(kc + ((size_t)((g * 64 + (t - s)) * 16 + h) * 16 + half * 8));
            *(u32x4*)(tz + (size_t)row * UAK + s * 16 + half * 8) = v; } }
}

constexpr int ST64 = 144, ST128 = 272;
__device__ __forceinline__ void mma_nt32(f32x16& acc, const LAS unsigned char* A, int sa, const LAS unsigned char* B, int sb, int K, int lane) {
    const LAS unsigned char* pa = A + (lane & 31) * sa + (lane >> 5) * 16; const LAS unsigned char* pb = B + (lane & 31) * sb + (lane >> 5) * 16;
    for (int k = 0; k < K; k += 16) { const bf16x8 a = *(const LAS bf16x8*)(pa + k * 2), b = *(const LAS bf16x8*)(pb + k * 2); acc = __builtin_amdgcn_mfma_f32_32x32x16_bf16(a, b, acc, 0, 0, 0); }
}
__device__ __forceinline__ void hg_cumsum(LAS float* segtot, const float* LOGF, int tok0, int col, int d, int seg, float (&lf)[16], float (&cs)[16], float& total, float& bmid) {
#pragma unroll
    for (int j = 0; j < 16; ++j) lf[j] = LOGF[(size_t)(tok0 + seg * 16 + j) * HW + col];
    float run = 0.f;
#pragma unroll
    for (int j = 0; j < 16; ++j) { run += lf[j]; cs[j] = run; }
    segtot[seg * 128 + d] = run;
    __syncthreads();
    const float t0 = segtot[d], t1 = segtot[128 + d], t2 = segtot[256 + d], t3 = segtot[384 + d];
    const float pre = seg == 0 ? 0.f : (seg == 1 ? t0 : (seg == 2 ? t0 + t1 : t0 + t1 + t2));
#pragma unroll
    for (int j = 0; j < 16; ++j) cs[j] += pre;
    total = (t0 + t1) + (t2 + t3); bmid = t0 + t1;
}
__device__ __forceinline__ void hg_load_vt(LAS unsigned char* VT, const bf16_t* V, int tok0, int hcol, int tid) {
    const int j = tid & 63;
#pragma unroll
    for (int i = 0; i < 2; ++i) { const int e0 = ((tid >> 6) + 8 * i) * 8; const u32x4 v = *(const u32x4*)(V + (size_t)(tok0 + j) * HW + hcol + e0);
        LAS bf16_t* o = (LAS bf16_t*)(VT + e0 * ST64 + j * 2);
        o[0 * (ST64 / 2)] = (bf16_t)(v.x & 0xffffu); o[1 * (ST64 / 2)] = (bf16_t)(v.x >> 16); o[2 * (ST64 / 2)] = (bf16_t)(v.y & 0xffffu); o[3 * (ST64 / 2)] = (bf16_t)(v.y >> 16);
        o[4 * (ST64 / 2)] = (bf16_t)(v.z & 0xffffu); o[5 * (ST64 / 2)] = (bf16_t)(v.z >> 16); o[6 * (ST64 / 2)] = (bf16_t)(v.w & 0xffffu); o[7 * (ST64 / 2)] = (bf16_t)(v.w >> 16); }
}
__device__ __forceinline__ void hgrn_a_unit(Frame& F, int unit) {
    const int tid = F.tid, lane = F.lane, wave = F.wave; const int bh = unit >> 7, c = unit & 127, b = bh >> 2, h = bh & 3, tok0 = b * SEQ + c * CH, hcol = h * HD;
    LAS unsigned char* KT = F.lds; LAS unsigned char* VT = F.lds + 128 * ST64; LAS float* segtot = (LAS float*)(F.lds + 2 * 128 * ST64);
    const int d = tid & 127, seg = tid >> 7; float lf[16], cs[16], total, bmid;
    hg_load_vt(VT, (const bf16_t*)(F.ws + WS_V), tok0, hcol, tid);
    hg_cumsum(segtot, (const float*)(F.ws + WS_LOGF), tok0, hcol + d, d, seg, lf, cs, total, bmid);
    float kk[16];
#pragma unroll
    for (int j = 0; j < 16; ++j) kk[j] = (1.0f - __expf(lf[j])) * __expf(total - cs[j]);
    u32x4 w0, w1; w0.x = pk2(kk[0], kk[1]); w0.y = pk2(kk[2], kk[3]); w0.z = pk2(kk[4], kk[5]); w0.w = pk2(kk[6], kk[7]); w1.x = pk2(kk[8], kk[9]); w1.y = pk2(kk[10], kk[11]); w1.z = pk2(kk[12], kk[13]); w1.w = pk2(kk[14], kk[15]);
    *(LAS u32x4*)(KT + d * ST64 + seg * 32) = w0; *(LAS u32x4*)(KT + d * ST64 + seg * 32 + 16) = w1;
    if (seg == 0) ((float*)(F.ws + WS_DEC))[(size_t)unit * HD + d] = __expf(total);
    __syncthreads();
    float* kvt = (float*)(F.ws + WS_KVT) + (size_t)unit * HD * HD;
#pragma unroll
    for (int i = 0; i < 2; ++i) { const int tile = wave * 2 + i, et = tile >> 2, dt = tile & 3; f32x16 acc;
#pragma unroll
        for (int r = 0; r < 16; ++r) acc[r] = 0.f;
        mma_nt32(acc, VT + et * 32 * ST64, ST64, KT + dt * 32 * ST64, ST64, 64, lane);
#pragma unroll
        for (int r = 0; r < 16; ++r) { const int e = et * 32 + (r & 3) + 8 * (r >> 2) + 4 * (lane >> 5); kvt[(size_t)e * HD + dt * 32 + (lane & 31)] = acc[r]; } }
    __syncthreads();
}
__device__ __forceinline__ void hgrn_c_unit(Frame& F, int unit) {
    const int tid = F.tid, lane = F.lane, wave = F.wave; const int bh = unit >> 7, c = unit & 127, b = bh >> 2, h = bh & 3, tok0 = b * SEQ + c * CH, hcol = h * HD;
    LAS unsigned char* Q1 = F.lds; LAS unsigned char* K1 = Q1 + 64 * ST128; LAS unsigned char* Q2 = K1 + 64 * ST128; LAS unsigned char* VT = Q2 + 64 * ST128;
    LAS unsigned char* PP = VT + 128 * ST64; LAS unsigned char* SPL = PP + 64 * ST64; LAS float* segtot = (LAS float*)(SPL + 128 * ST128); LAS float* RS = segtot + 512;
    const int d = tid & 127, seg = tid >> 7; float lf[16], cs[16], total, bmid;
    hg_load_vt(VT, (const bf16_t*)(F.ws + WS_V), tok0, hcol, tid);
    { const bf16_t* sp = (const bf16_t*)(F.ws + WS_SPREV) + (size_t)unit * HD * HD;
#pragma unroll
      for (int i = 0; i < 4; ++i) { const int p = tid + 512 * i, e = p >> 4, d0 = (p & 15) * 8; *(LAS u32x4*)(SPL + e * ST128 + d0 * 2) = *(const u32x4*)(sp + (size_t)e * HD + d0); } }
    hg_cumsum(segtot, (const float*)(F.ws + WS_LOGF), tok0, hcol + d, d, seg, lf, cs, total, bmid);
    { const bf16_t* qg = (const bf16_t*)(F.ws + WS_Q);
#pragma unroll
      for (int j = 0; j < 16; ++j) { const int jj = seg * 16 + j; const float q = bf2f(qg[(size_t)(tok0 + jj) * HW + hcol + d]); const float kx = 1.0f - __expf(lf[j]);
          ((LAS bf16_t*)(Q1 + jj * ST128))[d] = (bf16_t)f2bf(q * __expf(cs[j] - bmid)); ((LAS bf16_t*)(K1 + jj * ST128))[d] = (bf16_t)f2bf(kx * __expf(bmid - cs[j])); ((LAS bf16_t*)(Q2 + jj * ST128))[d] = (bf16_t)f2bf(q * __expf(cs[j])); } }
    __syncthreads();
    if (wave < 4) { const int it = wave >> 1, jt = wave & 1; f32x16 acc;
#pragma unroll
        for (int r = 0; r < 16; ++r) acc[r] = 0.f;
        if (!(it == 0 && jt == 1)) mma_nt32(acc, Q1 + it * 32 * ST128, ST128, K1 + jt * 32 * ST128, ST128, 128, lane);
#pragma unroll
        for (int r = 0; r < 16; ++r) { const int i = it * 32 + (r & 3) + 8 * (r >> 2) + 4 * (lane >> 5), j = jt * 32 + (lane & 31); ((LAS bf16_t*)(PP + i * ST64))[j] = (bf16_t)f2bf(j <= i ? acc[r] : 0.f); } }
    __syncthreads();
    const int it = wave >> 2, et = wave & 3; f32x16 acc;
#pragma unroll
    for (int r = 0; r < 16; ++r) acc[r] = 0.f;
    mma_nt32(acc, PP + it * 32 * ST64, ST64, VT + et * 32 * ST64, ST64, 64, lane);
    mma_nt32(acc, Q2 + it * 32 * ST128, ST128, SPL + et * 32 * ST128, ST128, 128, lane);
#pragma unroll
    for (int r = 0; r < 16; ++r) { float s = acc[r] * acc[r]; s += __shfl_xor(s, 1); s += __shfl_xor(s, 2); s += __shfl_xor(s, 4); s += __shfl_xor(s, 8); s += __shfl_xor(s, 16);
        if ((lane & 31) == 0) RS[et * 64 + it * 32 + (r & 3) + 8 * (r >> 2) + 4 * (lane >> 5)] = s; }
    __syncthreads();
    { const int e = et * 32 + (lane & 31); const float gn = F.in[I_HNG][hcol + e]; const bf16_t* gs = (const bf16_t*)(F.ws + WS_GS); bf16_t* yo = (bf16_t*)(F.ws + WS_YHG);
#pragma unroll
      for (int r = 0; r < 16; ++r) { const int i = it * 32 + (r & 3) + 8 * (r >> 2) + 4 * (lane >> 5); const float ss = (RS[i] + RS[64 + i]) + (RS[128 + i] + RS[192 + i]);
          const float rstd = 1.0f / sqrtf(ss * (1.0f / HD) + EPS); const size_t o = (size_t)(tok0 + i) * HW + hcol + e; yo[o] = (bf16_t)f2bf(acc[r] * rstd * gn * bf2f(gs[o])); } }
    __syncthreads();
}

struct Args { const float* in[26]; float* out; unsigned char* ws; int ph_lo, ph_hi; };
constexpr int NPHASE = 13;

__global__ void __launch_bounds__(512, 2) mk_fwd(Args args) {
    extern __shared__ __attribute__((aligned(16))) unsigned char lds[];
    Frame F;
    F.lds = (LAS unsigned char*)lds; F.MISC = (volatile LAS unsigned*)(F.lds + MISC_OFF);
    F.tid = threadIdx.x; F.lane = F.tid & 63; F.wave = __builtin_amdgcn_readfirstlane(F.tid >> 6);
    F.G = gridDim.x; F.bx = blockIdx.x; F.vcu = (F.G % 8 == 0) ? (F.bx % 8) * (F.G / 8) + F.bx / 8 : F.bx;
    F.ws = args.ws; F.ctl = (unsigned*)(args.ws + WS_CTL); F.out = args.out;
#pragma unroll
    for (int i = 0; i < 26; ++i) F.in[i] = args.in[i];
    for (int u = F.tid; u < 64; u += 512) F.MISC[u] = 0u;
    __syncthreads();
    unsigned char* ws = F.ws;
    XcdBarrier bar; bar.bar = F.ctl + CW_BAR; bar.x = 0; bar.st = nullptr;
    if (!MK_PER_PHASE) bar = xcd_barrier_post(F.ctl + CW_BAR, F.MISC + 8);
    const int lo = args.ph_lo, hi = args.ph_hi;
#define IN(k) (lo <= (k) && (k) < hi)
#define SEAM(k) do { if (IN(k) && IN((k) + 1)) xcd_barrier(bar); } while (0)

    if (IN(0)) { p0_prologue(F); }
    SEAM(0);
    if (IN(1)) {
        p1_toeplitz(F);
        SchedStatic S{(const char*)(ws + WS_XN), (const char*)(ws + WS_WIN), T / 256, INW / 256, F.G, F.bx, (size_t)256 * D * 2, (size_t)256 * D * 2};
        EpiInProj E{(bf16_t*)(ws + WS_UA), (bf16_t*)(ws + WS_Q), (bf16_t*)(ws + WS_V), (bf16_t*)(ws + WS_GS), (bf16_t*)(ws + WS_GATES), (float*)(ws + WS_LOGF), (const float*)(ws + WS_LBV)};
        pg8::gemm_phase<EpiInProj, SchedStatic, false>(F.lds, D, D, D, S, E, nullptr);
    }
    SEAM(1);
    if (IN(2)) {
        { SchedS5E S{(const char*)(ws + WS_UA), (const char*)(ws + WS_WE), F.bx}; EpiS5E E{(float*)(ws + WS_SE)};
          pg8::gemm_phase<EpiS5E, SchedS5E, false>(F.lds, 1024, UAK, 1024, S, E, nullptr); }
        __syncthreads();
        const float* pm = (const float*)(ws + WS_PMETA);
        if (F.bx >= 64 && F.bx < 68) {
            const int g = (F.bx - 64) * 8 + (F.tid >> 6), p = F.tid & 63; const f32x2 lb = ((const f32x2*)(ws + WS_LAMB))[g * SP + p]; float xr = 0.f, xi = 0.f;
            for (int s = 0; s < NMETA; ++s) { float ar = 0.f, ai = 0.f;
#pragma unroll
                for (int h = 0; h < 16; ++h) { const int col = g * 16 + h; const float uu = (pm[(size_t)(0 * 16 + s) * 1536 + col] + pm[(size_t)(1 * 16 + s) * 1536 + col]) + (pm[(size_t)(2 * 16 + s) * 1536 + col] + pm[(size_t)(3 * 16 + s) * 1536 + col]);
                    const f32x2 bb = ((const f32x2*)(ws + WS_BBAR))[(g * SP + p) * 16 + h]; ar += bb.x * uu; ai += bb.y * uu; }
                const float nr = lb.x * xr - lb.y * xi + ar, ni = lb.x * xi + lb.y * xr + ai; xr = nr; xi = ni; }
            float* xm = (float*)(ws + WS_XMETA); xm[g * 128 + p] = xr; xm[g * 128 + 64 + p] = xi;
        }
        if (F.bx >= 68 && F.bx < 196) {
            const int idx = (F.bx - 68) * 512 + F.tid, h = idx >> 14, e = (idx >> 7) & 127, d = idx & 127; const float lbv = ((const float*)(ws + WS_LBV))[h * HD + d]; float S = 0.f;
            for (int s = 0; s < NMETA; ++s) { const int cf = 512 + h * HD + d, cv = 1024 + h * HD + e;
                const float fp = (pm[(size_t)(0 * 16 + s) * 1536 + cf] + pm[(size_t)(1 * 16 + s) * 1536 + cf]) + (pm[(size_t)(2 * 16 + s) * 1536 + cf] + pm[(size_t)(3 * 16 + s) * 1536 + cf]);
                const float vv = (pm[(size_t)(0 * 16 + s) * 1536 + cv] + pm[(size_t)(1 * 16 + s) * 1536 + cv]) + (pm[(size_t)(2 * 16 + s) * 1536 + cv] + pm[(size_t)(3 * 16 + s) * 1536 + cv]);
                const float f = lbv + (1.0f - lbv) * sigmoidf_(fp); S = f * S + (1.0f - f) * vv; }
            ((float*)(ws + WS_SMETA))[idx] = S;
        }
        if (F.bx >= 64) for (int u = F.bx - 64; u < 16 * NCH; u += F.G - 64) hgrn_a_unit(F, u);
    }
    SEAM(2);
    if (IN(3)) {
        {
            const int bh = F.bx >> 4, e = (F.bx & 15) * 8 + (F.tid >> 6), d = (F.tid & 63) * 2, h = bh & 3;
            f32x2 S = *(const f32x2*)((const float*)(ws + WS_SMETA) + (size_t)(h * HD + e) * HD + d);
            const float* kv = (const float*)(ws + WS_KVT) + (size_t)bh * NCH * HD * HD + (size_t)e * HD + d; const float* dc = (const float*)(ws + WS_DEC) + (size_t)bh * NCH * HD + d;
            unsigned* sp = (unsigned*)((bf16_t*)(ws + WS_SPREV) + (size_t)bh * NCH * HD * HD + (size_t)e * HD + d);
            for (int c0 = 0; c0 < NCH; c0 += 8) { f32x2 kvv[8], dv[8];
#pragma unroll
                for (int j = 0; j < 8; ++j) { kvv[j] = *(const f32x2*)(kv + (size_t)(c0 + j) * HD * HD); dv[j] = *(const f32x2*)(dc + (size_t)(c0 + j) * HD); }
#pragma unroll
                for (int j = 0; j < 8; ++j) { sp[(size_t)(c0 + j) * (HD * HD / 2)] = pk2(S.x, S.y); S.x = S.x * dv[j].x + kvv[j].x; S.y = S.y * dv[j].y + kvv[j].y; } }
        }
        if (F.bx < 16) {
            const int b = F.bx >> 2, g = (F.bx & 3) * 8 + (F.tid >> 6), p = F.tid & 63; const f32x2 lc = ((const f32x2*)(ws + WS_LAMC))[g * SP + p];
            const float* xm = (const float*)(ws + WS_XMETA); float xr = xm[g * 128 + p], xi = xm[g * 128 + 64 + p];
            const float* se = (const float*)(ws + WS_SE) + ((size_t)g * 512 + b * 128) * 128 + p; bf16_t* ua = (bf16_t*)(ws + WS_UA) + ((size_t)g * 512 + b * 128) * UAK + 1024 + p;
            for (int c0 = 0; c0 < NCH; c0 += 8) { float er[8], ei[8];
#pragma unroll
                for (int j = 0; j < 8; ++j) { er[j] = se[(size_t)(c0 + j) * 128]; ei[j] = se[(size_t)(c0 + j) * 128 + 64]; }
#pragma unroll
                for (int j = 0; j < 8; ++j) { bf16_t* o = ua + (size_t)(c0 + j) * UAK; o[0] = (bf16_t)f2bf(xr); o[64] = (bf16_t)f2bf(xi);
                    const float nr = lc.x * xr - lc.y * xi + er[j], ni = lc.x * xi + lc.y * xr + ei[j]; xr = nr; xi = ni; } }
        }
    }
    SEAM(3);
    if (IN(4)) {
        { SchedS5Y S{(const char*)(ws + WS_UA), (const char*)(ws + WS_TZ), F.bx, F.G}; EpiS5Y E{(const bf16_t*)(ws + WS_UA), F.in[I_SD], (bf16_t*)(ws + WS_Y1)};
          pg8::gemm_phase<EpiS5Y, SchedS5Y, false>(F.lds, UAK, UAK, UAK, S, E, nullptr); }
        __syncthreads();
        for (int u = F.bx; u < 16 * NCH; u += F.G) hgrn_c_unit(F, u);
    }
    SEAM(4);
    if (IN(5)) {
        SchedStatic S{(const char*)(ws + WS_Y1), (const char*)(ws + WS_WGLU), T / 256, HW / 256, F.G, F.bx, (size_t)256 * HW * 2, (size_t)256 * HW * 2};
        EpiGlu E{(const bf16_t*)(ws + WS_Y1), (bf16_t*)(ws + WS_YS5)};
        pg8::gemm_phase<EpiGlu, SchedStatic, false>(F.lds, HW, HW, HW, S, E, nullptr);
    }
    SEAM(5);
    if (IN(6)) {
        SchedBranch S{(const char*)(ws + WS_YS5), (const char*)(ws + WS_YHG), (const char*)(ws + WS_WBS), (const char*)(ws + WS_WBH), F.G, F.bx};
        EpiBranch E{(const bf16_t*)(ws + WS_GATES), (bf16_t*)(ws + WS_MERGED)};
        pg8::gemm_phase<EpiBranch, SchedBranch, false>(F.lds, HW, HW, HW, S, E, nullptr);
    }
    SEAM(6);
    if (IN(7)) {
        SchedStatic S{(const char*)(ws + WS_MERGED), (const char*)(ws + WS_WOUT), T / 256, D / 256, F.G, F.bx, (size_t)256 * D * 2, (size_t)256 * D * 2};
        EpiOut E{F.in[I_X], (float*)(ws + WS_H1), (float*)(ws + WS_SSQ)};
        pg8::gemm_phase<EpiOut, SchedStatic, false>(F.lds, D, D, D, S, E, nullptr);
    }
    SEAM(7);
    if (IN(8)) {
        volatile LAS unsigned* hist = F.MISC + 16;
        if (F.tid < 32) hist[F.tid] = 0u;
        __syncthreads();
        const int lane = F.lane, tl = lane & 15, kg = lane >> 4; const float* g2 = F.in[I_N2G]; const bf16_t* wh = (const bf16_t*)(ws + WS_WRT); const bf16_t* wl = wh + NE * D;
        for (int tile = F.vcu * 8 + F.wave; tile < T / 16; tile += F.G * 8) {
            const int tok = tile * 16 + tl; const float* hrow = (const float*)(ws + WS_H1) + (size_t)tok * D; const f32x4* sq = (const f32x4*)((const float*)(ws + WS_SSQ) + (size_t)tok * 16);
            const f32x4 s0 = sq[0], s1 = sq[1], s2 = sq[2], s3 = sq[3];
            const float ss = ((s0[0] + s0[1]) + (s0[2] + s0[3])) + ((s1[0] + s1[1]) + (s1[2] + s1[3])) + ((s2[0] + s2[1]) + (s2[2] + s2[3])) + ((s3[0] + s3[1]) + (s3[2] + s3[3]));
            const float rstd = 1.0f / sqrtf(ss * (1.0f / D) + EPS);
            f32x4 a0 = (f32x4){0.f, 0.f, 0.f, 0.f}, a1 = a0; bf16_t* xo = (bf16_t*)(ws + WS_XN2) + (size_t)tok * D;
#pragma unroll 2
            for (int ks = 0; ks < 32; ++ks) { const int k = ks * 32 + kg * 8; const f32x4 h0 = *(const f32x4*)(hrow + k), h1 = *(const f32x4*)(hrow + k + 4), ga = *(const f32x4*)(g2 + k), gb = *(const f32x4*)(g2 + k + 4);
                float x[8] = {h0[0] * rstd * ga[0], h0[1] * rstd * ga[1], h0[2] * rstd * ga[2], h0[3] * rstd * ga[3], h1[0] * rstd * gb[0], h1[1] * rstd * gb[1], h1[2] * rstd * gb[2], h1[3] * rstd * gb[3]};
                unsigned hb[8]; float lr[8];
#pragma unroll
                for (int j = 0; j < 8; ++j) { hb[j] = f2bf(x[j]); lr[j] = x[j] - bf2f(hb[j]); }
                u32x4 hi4; hi4.x = hb[0] | (hb[1] << 16); hi4.y = hb[2] | (hb[3] << 16); hi4.z = hb[4] | (hb[5] << 16); hi4.w = hb[6] | (hb[7] << 16);
                u32x4 lo4; lo4.x = pk2(lr[0], lr[1]); lo4.y = pk2(lr[2], lr[3]); lo4.z = pk2(lr[4], lr[5]); lo4.w = pk2(lr[6], lr[7]);
                *(u32x4*)(xo + k) = hi4;
                const bf16x8 xh = __builtin_bit_cast(bf16x8, hi4), xl = __builtin_bit_cast(bf16x8, lo4);
                const bf16x8 wh0 = *(const bf16x8*)(wh + (size_t)tl * D + k), wh1 = *(const bf16x8*)(wh + (size_t)(16 + tl) * D + k), wl0 = *(const bf16x8*)(wl + (size_t)tl * D + k), wl1 = *(const bf16x8*)(wl + (size_t)(16 + tl) * D + k);
                a0 = __builtin_amdgcn_mfma_f32_16x16x32_bf16(wh0, xh, a0, 0, 0, 0); a0 = __builtin_amdgcn_mfma_f32_16x16x32_bf16(wh0, xl, a0, 0, 0, 0); a0 = __builtin_amdgcn_mfma_f32_16x16x32_bf16(wl0, xh, a0, 0, 0, 0);
                a1 = __builtin_amdgcn_mfma_f32_16x16x32_bf16(wh1, xh, a1, 0, 0, 0); a1 = __builtin_amdgcn_mfma_f32_16x16x32_bf16(wh1, xl, a1, 0, 0, 0); a1 = __builtin_amdgcn_mfma_f32_16x16x32_bf16(wl1, xh, a1, 0, 0, 0); }
            float lg[8]; int le[8]; const float* br = F.in[I_BR];
#pragma unroll
            for (int j = 0; j < 4; ++j) { le[j] = 4 * kg + j; le[4 + j] = 16 + 4 * kg + j; lg[j] = a0[j] + br[le[j]]; lg[4 + j] = a1[j] + br[le[4 + j]]; }
            float tv[4]; int te[4];
#pragma unroll
            for (int r = 0; r < 4; ++r) { float bv = -3.0e38f; int be = 1 << 20;
#pragma unroll
                for (int j = 0; j < 8; ++j) if (lg[j] > bv || (lg[j] == bv && le[j] < be)) { bv = lg[j]; be = le[j]; }
#pragma unroll
                for (int o = 16; o <= 32; o <<= 1) { const float ov = __shfl_xor(bv, o); const int oe = __shfl_xor(be, o); if (ov > bv || (ov == bv && oe < be)) { bv = ov; be = oe; } }
                tv[r] = bv; te[r] = be;
#pragma unroll
                for (int j = 0; j < 8; ++j) if (le[j] == be) lg[j] = -3.0e38f; }
            if (kg == 0) { const float e1 = __expf(tv[1] - tv[0]), e2 = __expf(tv[2] - tv[0]), e3 = __expf(tv[3] - tv[0]); const float inv = 1.0f / (1.0f + e1 + e2 + e3);
                *(f32x4*)((float*)(ws + WS_TOPW) + (size_t)tok * 4) = (f32x4){inv, e1 * inv, e2 * inv, e3 * inv};
                int* tp = (int*)(ws + WS_TOPE) + (size_t)tok * 4; tp[0] = te[0]; tp[1] = te[1]; tp[2] = te[2]; tp[3] = te[3];
#pragma unroll
                for (int r = 0; r < 4; ++r) __hip_atomic_fetch_add((LAS unsigned*)(hist + te[r]), 1u, __ATOMIC_RELAXED, __HIP_MEMORY_SCOPE_WORKGROUP); }
        }
        __syncthreads();
        if (F.tid < 32) __hip_atomic_fetch_add(F.ctl + CW_CNT + F.tid, hist[F.tid], __ATOMIC_RELAXED, __HIP_MEMORY_SCOPE_AGENT);
    }
    SEAM(8);
    if (IN(9)) {
        volatile LAS unsigned* sb = F.MISC + 16;
        LAS unsigned* base = (LAS unsigned*)F.lds; LAS unsigned* lcnt = base + 64; LAS unsigned* gb = base + 128; (void)sb;
        if (F.tid < 32) { lcnt[F.tid] = 0u; }
        if (F.tid == 0) { unsigned run = 0; for (int e = 0; e < NE; ++e) { const unsigned c = __hip_atomic_load(F.ctl + CW_CNT + e, __ATOMIC_RELAXED, __HIP_MEMORY_SCOPE_AGENT); base[e] = run * 256u; base[32 + e] = c; run += (c + 255u) >> 8; }
            base[96] = run; if (F.bx == 0) F.ctl[CW_NTILES] = run; }
        __syncthreads();
        if (F.bx == 0) { for (int e = 0; e < NE; ++e) { const unsigned t0 = base[e] >> 8, nt_ = (base[32 + e] + 255u) >> 8; for (unsigned t = F.tid; t < nt_; t += 512) ((int*)(ws + WS_TILEE))[t0 + t] = e; } }
        if (F.bx < NE) { const int e = F.bx; const unsigned c = base[32 + e], pe = ((c + 255u) >> 8) << 8; for (unsigned r = c + F.tid; r < pe; r += 512) { ((int*)(ws + WS_ROWTOK))[base[e] + r] = 0; ((int*)(ws + WS_ROWSLOT))[base[e] + r] = -1; } }
        for (int vb = F.bx; vb < T / 128; vb += F.G) {
            const int tok = vb * 128 + (F.tid >> 2), k = F.tid & 3; const int e = ((const int*)(ws + WS_TOPE))[(size_t)tok * 4 + k];
            const unsigned lr = __hip_atomic_fetch_add(lcnt + e, 1u, __ATOMIC_RELAXED, __HIP_MEMORY_SCOPE_WORKGROUP);
            __syncthreads();
            if (F.tid < 32) { gb[F.tid] = __hip_atomic_fetch_add(F.ctl + CW_FILL + F.tid, lcnt[F.tid], __ATOMIC_RELAXED, __HIP_MEMORY_SCOPE_AGENT); lcnt[F.tid] = 0u; }
            __syncthreads();
            const unsigned prow = base[e] + gb[e] + lr; ((int*)(ws + WS_ROWTOK))[prow] = tok; ((int*)(ws + WS_ROWSLOT))[prow] = tok * 4 + k;
            __syncthreads();
        }
    }
    SEAM(9);
    if (IN(10)) {
        const int ntiles = (int)__hip_atomic_load(F.ctl + CW_NTILES, __ATOMIC_RELAXED, __HIP_MEMORY_SCOPE_AGENT);
        SchedMoe S{(const char*)(ws + WS_XN2), (const char*)(ws + WS_WGU), (const int*)(ws + WS_TILEE), ntiles, 8, F.G, F.bx, (size_t)2048 * D * 2, (size_t)256 * D * 2, true};
        EpiMoe1 E{F.in[I_BGU], (const int*)(ws + WS_TILEE), (bf16_t*)(ws + WS_A2)};
        pg8::gemm_phase<EpiMoe1, SchedMoe, true>(F.lds, D, D, D, S, E, (const int*)(ws + WS_ROWTOK));
    }
    SEAM(10);
    if (IN(11)) {
        const int ntiles = (int)__hip_atomic_load(F.ctl + CW_NTILES, __ATOMIC_RELAXED, __HIP_MEMORY_SCOPE_AGENT);
        SchedMoe S{(const char*)(ws + WS_A2), (const char*)(ws + WS_WD), (const int*)(ws + WS_TILEE), ntiles, 4, F.G, F.bx, (size_t)D * DF * 2, (size_t)256 * DF * 2, false};
        EpiMoe2 E{F.in[I_BD], (const int*)(ws + WS_TILEE), (const int*)(ws + WS_ROWSLOT), (bf16_t*)(ws + WS_YS)};
        pg8::gemm_phase<EpiMoe2, SchedMoe, false>(F.lds, DF, DF, DF, S, E, nullptr);
    }
    SEAM(11);
    if (IN(12)) {
        const int lane = F.lane; const float* fg = F.in[I_FNG];
        for (int tok = F.vcu * 8 + F.wave; tok < T; tok += F.G * 8) {
            const f32x4 w = *(const f32x4*)((const float*)(ws + WS_TOPW) + (size_t)tok * 4); const float wk[4] = {w[0], w[1], w[2], w[3]};
            const f32x4* hr = (const f32x4*)((const float*)(ws + WS_H1) + (size_t)tok * D) + lane; f32x4 v[4]; float s = 0.f;
#pragma unroll
            for (int j = 0; j < 4; ++j) { v[j] = hr[64 * j];
#pragma unroll
                for (int k = 0; k < 4; ++k) { const u32x2 y = *((const u32x2*)((const bf16_t*)(ws + WS_YS) + ((size_t)tok * 4 + k) * D) + lane + 64 * j);
                    v[j].x += wk[k] * bf2f(y.x & 0xffffu); v[j].y += wk[k] * bf2f(y.x >> 16); v[j].z += wk[k] * bf2f(y.y & 0xffffu); v[j].w += wk[k] * bf2f(y.y >> 16); }
                s += (v[j].x * v[j].x + v[j].y * v[j].y) + (v[j].z * v[j].z + v[j].w * v[j].w); }
            const float rstd = 1.0f / sqrtf(wave_sum(s) * (1.0f / D) + EPS);
            f32x4* o = (f32x4*)(F.out + (size_t)tok * D) + lane;
#pragma unroll
            for (int j = 0; j < 4; ++j) { const f32x4 gg = ((const f32x4*)fg)[lane + 64 * j]; o[64 * j] = (f32x4){v[j].x * rstd * gg.x, v[j].y * rstd * gg.y, v[j].z * rstd * gg.z, v[j].w * rstd * gg.w}; }
        }
    }
#undef IN
#undef SEAM
}

extern "C" void kernel_launch(void* const* d_in, const int* in_sizes, int n_in, void* d_out, int out_size, void* d_ws, size_t ws_size, hipStream_t stream) {
    static int grid = 0;
    if (grid == 0) {
        if (n_in != 26 || in_sizes[0] != T * D || out_size != T * D || ws_size < WS_END) { fprintf(stderr, "kernel_launch: unexpected shapes (n_in %d, in0 %d, out %d, ws %zu < %zu)\n", n_in, n_in > 0 ? in_sizes[0] : -1, out_size, ws_size, (size_t)WS_END); grid = -1; return; }
        int dev = 0, cus = 0, per_cu = 0;
        if (hipGetDevice(&dev) != hipSuccess || hipDeviceGetAttribute(&cus, hipDeviceAttributeMultiprocessorCount, dev) != hipSuccess) { grid = -1; return; }
        if (hipFuncSetAttribute((const void*)mk_fwd, hipFuncAttributeMaxDynamicSharedMemorySize, LDS_BYTES) != hipSuccess) { fprintf(stderr, "kernel_launch: hipFuncSetAttribute failed\n"); grid = -1; return; }
        if (hipOccupancyMaxActiveBlocksPerMultiprocessor(&per_cu, (const void*)mk_fwd, 512, LDS_BYTES) != hipSuccess || per_cu < 1) fprintf(stderr, "kernel_launch: occupancy query reports %d\n", per_cu);
        (void)hipGetLastError();
        grid = cus;
        if (grid != 256) fprintf(stderr, "kernel_launch: %d CUs (built for 256)\n", grid);
    }
    if (grid < 0) return;
    (void)hipMemsetAsync((char*)d_ws + WS_CTL, 0, 1 * MiB, stream);
    Args a{};
    for (int i = 0; i < 26; ++i) a.in[i] = (const float*)d_in[i];
    a.out = (float*)d_out; a.ws = (unsigned char*)d_ws;
#if MK_PER_PHASE
    for (int p = 0; p < NPHASE; ++p) { a.ph_lo = p; a.ph_hi = p + 1; hipLaunchKernelGGL(mk_fwd, dim3(grid), dim3(512), LDS_BYTES, stream, a); }
#else
    a.ph_lo = 0; a.ph_hi = NPHASE; hipLaunchKernelGGL(mk_fwd, dim3(grid), dim3(512), LDS_BYTES, stream, a);
#endif
}
```

```cpp
#include <hip/hip_runtime.h>
#include <cstdio>
#include <cstdint>

#ifndef MK_PER_PHASE
#define MK_PER_PHASE 0
#endif

#define LAS __attribute__((address_space(3)))
#define GAS __attribute__((address_space(1)))
typedef unsigned short bf16_t;
typedef short bf16x8 __attribute__((ext_vector_type(8)));
typedef float f32x4 __attribute__((ext_vector_type(4)));
typedef float f32x2 __attribute__((ext_vector_type(2)));
typedef float f32x16 __attribute__((ext_vector_type(16)));
typedef unsigned u32x4 __attribute__((ext_vector_type(4)));
typedef unsigned u32x2 __attribute__((ext_vector_type(2)));

constexpr int T = 32768, D = 1024, NB = 4, SEQ = 8192, NCH = 128, CH = 64, NMETA = 16, INW = 4608;
constexpr int SG = 32, SH = 16, SP = 64;
constexpr int HH = 4, HD = 128, HW = 512;
constexpr int NE = 32, TOPK = 4, DF = 1024;
constexpr int UAK = 1152;
constexpr float EPS = 1e-6f;
constexpr int MAXTILES = 544;

constexpr size_t MiB = 1u << 20, KiB = 1024;
constexpr size_t WS_CTL = 0;
constexpr size_t WS_LBV = 1 * MiB, WS_LAMB = 1 * MiB + 4 * KiB, WS_LAMC = 1 * MiB + 20 * KiB, WS_XMETA = 1 * MiB + 36 * KiB;
constexpr size_t WS_BBAR = 1 * MiB + 64 * KiB, WS_WRT = 1 * MiB + 320 * KiB, WS_PMETA = 1 * MiB + 512 * KiB;
constexpr size_t WS_KCONV = 2 * MiB, WS_SMETA = 3 * MiB;
constexpr size_t WS_WIN = 4 * MiB, WS_WGLU = 13 * MiB, WS_WBS = 14 * MiB, WS_WBH = 15 * MiB, WS_WOUT = 16 * MiB, WS_WGU = 18 * MiB, WS_WD = 146 * MiB;
constexpr size_t WS_TZ = 210 * MiB, WS_WE = 282 * MiB, WS_XN = 298 * MiB, WS_UA = 362 * MiB, WS_Q = 398 * MiB, WS_LOGF = 430 * MiB, WS_V = 494 * MiB;
constexpr size_t WS_GS = 526 * MiB, WS_GATES = 558 * MiB, WS_KVT = 686 * MiB, WS_SPREV = 814 * MiB, WS_SE = 878 * MiB, WS_DEC = 886 * MiB;
constexpr size_t WS_Y1 = 888 * MiB, WS_YHG = 920 * MiB, WS_YS5 = 952 * MiB, WS_END = 984 * MiB;
constexpr size_t WS_MERGED = 686 * MiB, WS_XN2 = 210 * MiB, WS_H1 = 274 * MiB, WS_SSQ = 402 * MiB, WS_TOPE = 404 * MiB, WS_TOPW = 404 * MiB + 512 * KiB;
constexpr size_t WS_ROWTOK = 405 * MiB, WS_ROWSLOT = 406 * MiB, WS_TILEE = 407 * MiB, WS_A2 = 408 * MiB, WS_YS = 680 * MiB;
constexpr int CW_CNT = 64, CW_FILL = 128, CW_NTILES = 192, CW_BAR = 4096;

constexpr int RING_BYTES = 131072, MISC_OFF = RING_BYTES + 256, LDS_BYTES = 147456;

__device__ __forceinline__ unsigned f2bf(float f) { unsigned u = __builtin_bit_cast(unsigned, f); return (u + 0x7fffu + ((u >> 16) & 1u)) >> 16; }
__device__ __forceinline__ float bf2f(unsigned b) { return __builtin_bit_cast(float, b << 16); }
__device__ __forceinline__ unsigned pk2(float lo, float hi) { return f2bf(lo) | (f2bf(hi) << 16); }
__device__ __forceinline__ unsigned cvt_pk_bf16(float lo, float hi) { unsigned r; asm volatile("v_cvt_pk_bf16_f32 %0, %1, %2" : "=v"(r) : "v"(lo), "v"(hi)); return r; }
__device__ __forceinline__ float sigmoidf_(float x) { return 1.0f / (1.0f + __expf(-x)); }
__device__ __forceinline__ float wave_sum(float v) {
#pragma unroll
    for (int o = 1; o < 64; o <<= 1) v += __shfl_xor(v, o);
    return v;
}
#define LDS_WAIT() asm volatile("s_waitcnt lgkmcnt(0)" ::: "memory")
#define VM_WAIT() asm volatile("s_waitcnt vmcnt(0)" ::: "memory")

#define XB_TMO      128
#define XB_XCNT(j)  (256  + 64 * (j))
#define XB_XSUB(j)  (1280 + 64 * (j))
#define XB_XGEN(j)  (2304 + 64 * (j))
#define XB_TOP      3328
#define XB_TOPGEN   3392
#define XCD_BAR_WORDS 3456
#define XB_SPIN_CAP (1u << 22)
__device__ __forceinline__ unsigned xb_ld(unsigned* p)              { return __hip_atomic_load(p, __ATOMIC_RELAXED, __HIP_MEMORY_SCOPE_AGENT); }
__device__ __forceinline__ unsigned xb_add(unsigned* p, unsigned v) { return __hip_atomic_fetch_add(p, v, __ATOMIC_RELAXED, __HIP_MEMORY_SCOPE_AGENT); }
__device__ __forceinline__ unsigned xb_xcc_id() { return (unsigned)__builtin_amdgcn_s_getreg((3 << 11) | 20) & 0xFu; }
#define XB_SPIN(cond, bar) do { unsigned _sp = 0; while (cond) { __builtin_amdgcn_s_sleep(1); \
    if ((++_sp & 255u) == 0u) { if (xb_ld(&(bar)[XB_TMO])) break; if (_sp > XB_SPIN_CAP) { atomicAdd(&(bar)[XB_TMO], 1u); break; } } } } while (0)
struct XcdBarrier { unsigned* bar; unsigned x; volatile LAS unsigned* st; };
__device__ __forceinline__ XcdBarrier xcd_barrier_post(unsigned* bar, volatile LAS unsigned* st) {
    XcdBarrier b; b.bar = bar; b.x = xb_xcc_id(); b.st = st;
    if (threadIdx.x == 0) (void)xb_add(&bar[XB_XCNT(b.x)], 1u);
    return b;
}
__device__ __forceinline__ void xcd_barrier_complete(unsigned* bar, unsigned x, unsigned& nloc, unsigned& nx) {
    const unsigned G = gridDim.x * gridDim.y * gridDim.z;
    unsigned sum, cnt, mine, sp = 0u;
    for (;;) {
        sum = 0u; cnt = 0u; mine = 0u;
#pragma unroll
        for (unsigned j = 0; j < 16; ++j) { const unsigned c = xb_ld(&bar[XB_XCNT(j)]); sum += c; cnt += (c > 0u) ? 1u : 0u; mine = (j == x) ? c : mine; }
        if (sum == G) break;
        __builtin_amdgcn_s_sleep(1);
        if ((++sp & 255u) == 0u) { if (xb_ld(&bar[XB_TMO])) break; if (sp > XB_SPIN_CAP) { atomicAdd(&bar[XB_TMO], 1u); break; } }
    }
    nloc = mine > 0u ? mine : 1u; nx = cnt > 0u ? cnt : 1u;
}
__device__ __forceinline__ void xcd_barrier(const XcdBarrier& b) {
    asm volatile("s_waitcnt vmcnt(0)" ::: "memory");
    __syncthreads();
    if (threadIdx.x == 0) {
        unsigned* bar = b.bar;
        __builtin_amdgcn_s_waitcnt(0);
        unsigned nloc = b.st[0], nx = b.st[1];
        if (nloc == 0u) { xcd_barrier_complete(bar, b.x, nloc, nx); b.st[0] = nloc; b.st[1] = nx; }
        const unsigned old = xb_add(&bar[XB_XSUB(b.x)], 1u);
        const unsigned gen = old / nloc;
        if (old + 1u == (gen + 1u) * nloc) {
            __builtin_amdgcn_fence(__ATOMIC_RELEASE, "agent");
            asm volatile("s_waitcnt vmcnt(0)" ::: "memory");
            const unsigned og = xb_add(&bar[XB_TOP], 1u);
            const unsigned tg = og / nx;
            if (og + 1u == (tg + 1u) * nx) xb_add(&bar[XB_TOPGEN], 1u);
            else XB_SPIN(xb_ld(&bar[XB_TOPGEN]) == tg, bar);
            __builtin_amdgcn_fence(__ATOMIC_ACQUIRE, "agent");
            xb_add(&bar[XB_XGEN(b.x)], 1u);
            asm volatile("s_waitcnt vmcnt(0)" ::: "memory");
        } else {
            XB_SPIN(xb_ld(&bar[XB_XGEN(b.x)]) == gen, bar);
            __builtin_amdgcn_fence(__ATOMIC_ACQUIRE, "agent");
            asm volatile("s_waitcnt vmcnt(0)" ::: "memory");
        }
    }
    __syncthreads();
}

namespace pg8 {
constexpr int BM = 256, BK = 64, HALF = 128, HTB = HALF * BK * 2, STAGE_BYTES = 8 * HTB, NXCD = 8, WGM = 8;
__device__ __forceinline__ int lds_byte(int r, int c) { const int st = (r >> 4) * 2 + (c >> 5), rr = r & 15, cc = c & 31, ob = rr * 64 + cc * 2; return st * 1024 + (ob ^ (((ob >> 9) & 1) << 5)); }
__device__ __forceinline__ void stage_rc(int b, int& R, int& C) { const int st = b / 1024, sb = b % 1024, swz = sb ^ (((sb >> 9) & 1) << 5); R = (st >> 1) * 16 + swz / 64; C = (st & 1) * 32 + (swz % 64) / 2; }
__device__ __forceinline__ int perm32(int rho) { const int n = rho >> 4, i = rho & 15; return 8 * (i >> 2) + 4 * n + (i & 3); }

struct Unit { int pm, pn, aux; const char* a; const char* b; };

__device__ __forceinline__ bool static_tile(int L, int nM, int nN, int& pm, int& pn) {
    const int nwg = nM * nN; if (L >= nwg) return false;
    int wgid = L; { const int q = nwg / NXCD, r = nwg % NXCD, xcd = wgid % NXCD, off = wgid / NXCD; wgid = (xcd < r ? xcd * (q + 1) : r * (q + 1) + (xcd - r) * q) + off; }
    const int nig = WGM * nN, gid = wgid / nig, fm = gid * WGM, gsz = (nM - fm) < WGM ? (nM - fm) : WGM;
    pm = fm + ((wgid % nig) % gsz); pn = (wgid % nig) / gsz; return true;
}

template <class Epi, class Sched, bool GATHER>
__device__ __forceinline__ void gemm_phase(LAS unsigned char* lds, const int K, const int lda, const int ldb, const Sched& S, const Epi& E, const int* __restrict__ rowidx) {
    const int tid = threadIdx.x, wid = __builtin_amdgcn_readfirstlane(tid >> 6), lane = tid & 63, wr = wid >> 2, wc = wid & 3, fr = lane & 15, fq = lane >> 4;
    const int nt = K / BK;
    unsigned voffA[2], voffB[2]; int gR[2], gC[2];
#pragma unroll
    for (int i = 0; i < 2; ++i) { int R, C; stage_rc(tid * 16 + i * 8192, R, C); const int Rb = Epi::PERM ? ((R & ~31) + perm32(R & 31)) : R;
        voffA[i] = (unsigned)(R * lda + C) * 2u; voffB[i] = (unsigned)(Rb * ldb + C) * 2u; gR[i] = R; gC[i] = C * 2; }
    const size_t kstep = (size_t)(BK * 2);
    const size_t hstepA = (size_t)HALF * lda * 2, hstepB = (size_t)HALF * ldb * 2;
    const unsigned ldsw = (unsigned)wid * 1024u;
    const int aoff = lds_byte(wr * 64 + fr, fq * 8), boff = lds_byte(wc * 32 + fr, fq * 8);
#define PG8_SA(b, h) (((b) * 2 + (h)) * HTB)
#define PG8_SB(b, h) ((4 + (b) * 2 + (h)) * HTB)
#define PG8_GLDS(src, dstoff) __builtin_amdgcn_global_load_lds((const unsigned*)(src), (LAS unsigned*)(lds + (dstoff)), 16, 0, 0)
#define PG8_STAGEB(bufoff, gbase) do { PG8_GLDS((const char*)(gbase) + voffB[0], (bufoff) + ldsw); PG8_GLDS((const char*)(gbase) + voffB[1], (bufoff) + ldsw + 8192); } while (0)
#define PG8_STAGEA(bufoff, gbase, h, O) do { if constexpr (GATHER) { PG8_GLDS((const char*)(gbase) + O[h][0], (bufoff) + ldsw); PG8_GLDS((const char*)(gbase) + O[h][1], (bufoff) + ldsw + 8192); } \
        else { PG8_GLDS((const char*)(gbase) + (h) * hstepA + voffA[0], (bufoff) + ldsw); PG8_GLDS((const char*)(gbase) + (h) * hstepA + voffA[1], (bufoff) + ldsw + 8192); } } while (0)
#define PG8_LDA(dst, b, h) do { _Pragma("unroll") for (int m = 0; m < 4; ++m) _Pragma("unroll") for (int k = 0; k < 2; ++k) dst[m][k] = *(const LAS bf16x8*)(lds + PG8_SA(b, h) + aoff + m * 2048 + k * 1024); } while (0)
#define PG8_LDB(dst, b, h) do { _Pragma("unroll") for (int n = 0; n < 2; ++n) _Pragma("unroll") for (int k = 0; k < 2; ++k) dst[n][k] = *(const LAS bf16x8*)(lds + PG8_SB(b, h) + boff + n * 2048 + k * 1024); } while (0)
#define PG8_MMA(ai, bj, At, Bt) do { __builtin_amdgcn_s_setprio(1); _Pragma("unroll") for (int m = 0; m < 4; ++m) _Pragma("unroll") for (int n = 0; n < 2; ++n) _Pragma("unroll") for (int k = 0; k < 2; ++k) \
        acc[ai][bj][m][n] = __builtin_amdgcn_mfma_f32_16x16x32_bf16(Bt[n][k], At[m][k], acc[ai][bj][m][n], 0, 0, 0); __builtin_amdgcn_s_setprio(0); } while (0)
#define PG8_WAIT_V(n) asm volatile("s_waitcnt vmcnt(" #n ")" ::: "memory")
#define PG8_WAIT_L(n) asm volatile("s_waitcnt lgkmcnt(" #n ")" ::: "memory")
#define PG8_BAR __builtin_amdgcn_s_barrier()
#define PG8_SCHED __builtin_amdgcn_sched_barrier(0)
#define PG8_GOFFS(O, U) do { if constexpr (GATHER) { _Pragma("unroll") for (int h_ = 0; h_ < 2; ++h_) _Pragma("unroll") for (int i_ = 0; i_ < 2; ++i_) \
        O[h_][i_] = (unsigned)rowidx[(U).aux + h_ * HALF + gR[i_]] * (unsigned)(lda * 2) + (unsigned)gC[i_]; } } while (0)
    Unit cur, nxt; int ui = 0;
    if (!S.next(0, cur)) return;
    f32x4 acc[2][2][4][2];
#pragma unroll
    for (int a = 0; a < 2; ++a)
#pragma unroll
        for (int b = 0; b < 2; ++b)
#pragma unroll
            for (int m = 0; m < 4; ++m)
#pragma unroll
                for (int n = 0; n < 2; ++n) acc[a][b][m][n] = (f32x4){0.f, 0.f, 0.f, 0.f};
    bf16x8 At[4][2], B0[2][2], B1[2][2];
    unsigned co[2][2] = {{0u, 0u}, {0u, 0u}}, no[2][2] = {{0u, 0u}, {0u, 0u}};
    PG8_GOFFS(co, cur);
    const char* cA = cur.a; const char* cB = cur.b;
    PG8_STAGEB(PG8_SB(0, 0), cB); PG8_STAGEB(PG8_SB(0, 1), cB + hstepB); PG8_STAGEA(PG8_SA(0, 0), cA, 0, co); PG8_STAGEA(PG8_SA(0, 1), cA, 1, co);
    if (wr == 1) PG8_BAR;
    PG8_WAIT_V(2); PG8_BAR;
    PG8_STAGEB(PG8_SB(1, 0), cB + kstep); PG8_STAGEA(PG8_SA(1, 0), cA + kstep, 0, co); PG8_STAGEB(PG8_SB(1, 1), cB + hstepB + kstep);
    PG8_WAIT_V(6); PG8_BAR;
    for (;;) {
        const bool has_next = S.next(ui + 1, nxt);
        if (has_next) PG8_GOFFS(no, nxt);
        const char* nA = has_next ? nxt.a : cA; const char* nB = has_next ? nxt.b : cB;
        for (int t = 0; t < nt; t += 2) {
            const bool last = (t == nt - 2);
            const char* a1 = cA + (size_t)(t + 1) * kstep;
            const char* a2 = last ? nA : cA + (size_t)(t + 2) * kstep; const char* b2 = last ? nB : cB + (size_t)(t + 2) * kstep;
            const char* a3 = a2 + kstep; const char* b3 = b2 + kstep;
            unsigned o2[2][2];
#pragma unroll
            for (int h_ = 0; h_ < 2; ++h_)
#pragma unroll
                for (int i_ = 0; i_ < 2; ++i_) o2[h_][i_] = (last && has_next) ? no[h_][i_] : co[h_][i_];
            PG8_LDB(B0, 0, 0); PG8_LDB(B1, 0, 1); PG8_SCHED; PG8_LDA(At, 0, 0); PG8_STAGEA(PG8_SA(1, 1), a1, 1, co);
            PG8_WAIT_V(8); PG8_WAIT_L(0); PG8_BAR; PG8_MMA(0, 0, At, B0); PG8_MMA(0, 1, At, B1); PG8_BAR; PG8_SCHED;
            PG8_LDA(At, 0, 1); PG8_STAGEB(PG8_SB(0, 0), b2); PG8_STAGEB(PG8_SB(0, 1), b2 + hstepB); PG8_STAGEA(PG8_SA(0, 0), a2, 0, o2);
            PG8_WAIT_V(8); PG8_WAIT_L(0); PG8_BAR; PG8_MMA(1, 0, At, B0); PG8_MMA(1, 1, At, B1); PG8_BAR; PG8_SCHED;
            PG8_LDB(B0, 1, 0); PG8_LDB(B1, 1, 1); PG8_SCHED; PG8_LDA(At, 1, 0); PG8_STAGEA(PG8_SA(0, 1), a2, 1, o2);
            PG8_WAIT_V(8); PG8_WAIT_L(0); PG8_BAR; PG8_MMA(0, 0, At, B0); PG8_MMA(0, 1, At, B1); PG8_BAR; PG8_SCHED;
            PG8_LDA(At, 1, 1); PG8_STAGEB(PG8_SB(1, 0), b3); PG8_STAGEB(PG8_SB(1, 1), b3 + hstepB); PG8_STAGEA(PG8_SA(1, 0), a3, 0, o2);
            PG8_WAIT_V(8); PG8_WAIT_L(0); PG8_BAR; PG8_MMA(1, 0, At, B0); PG8_MMA(1, 1, At, B1); PG8_BAR; PG8_SCHED;
        }
        if (wr == 0) PG8_BAR;
        const bool keep = E(acc, cur, wr, wc, fr, fq);
        if (!has_next) break;
        if (!keep) {
#pragma unroll
            for (int a = 0; a < 2; ++a)
#pragma unroll
                for (int b = 0; b < 2; ++b)
#pragma unroll
                    for (int m = 0; m < 4; ++m)
#pragma unroll
                        for (int n = 0; n < 2; ++n) acc[a][b][m][n] = (f32x4){0.f, 0.f, 0.f, 0.f};
        }
        cur = nxt; cA = nA; cB = nB; ++ui;
#pragma unroll
        for (int h_ = 0; h_ < 2; ++h_)
#pragma unroll
            for (int i_ = 0; i_ < 2; ++i_) co[h_][i_] = no[h_][i_];
        if (wr == 1) PG8_BAR;
    }
    PG8_WAIT_V(0);
    PG8_BAR;
#undef PG8_SA
#undef PG8_SB
#undef PG8_GLDS
#undef PG8_STAGEA
#undef PG8_STAGEB
#undef PG8_LDA
#undef PG8_LDB
#undef PG8_MMA
#undef PG8_WAIT_V
#undef PG8_WAIT_L
#undef PG8_BAR
#undef PG8_SCHED
#undef PG8_GOFFS
}
}
using pg8::Unit;

struct Frame {
    LAS unsigned char* lds; volatile LAS unsigned* MISC; unsigned* ctl; unsigned char* ws;
    int tid, lane, wave, vcu, G, bx;
    const float* in[26]; float* out;
};
enum { I_X = 0, I_META, I_N1G, I_WIN, I_LRE, I_LIM, I_LDT, I_BRE, I_BIM, I_CRE, I_CIM, I_SD, I_WGLU, I_LBL, I_HNG, I_WBS, I_WBH, I_WOUT, I_N2G, I_WR, I_BR, I_WGU, I_BGU, I_WD, I_BD, I_FNG };

struct SchedStatic {
    const char* A; const char* B; int nM, nN, G, c; size_t ta, tb;
    __device__ __forceinline__ bool next(int i, Unit& u) const { int pm, pn; if (!pg8::static_tile(i * G + c, nM, nN, pm, pn)) return false; u.pm = pm; u.pn = pn; u.aux = 0; u.a = A + (size_t)pm * ta; u.b = B + (size_t)pn * tb; return true; }
};
struct SchedS5E {
    const char* UA; const char* WE; int c;
    __device__ __forceinline__ bool next(int i, Unit& u) const { if (i > 0 || c >= 64) return false; const int g = c >> 1, pm = c & 1; u.pm = pm; u.pn = 0; u.aux = g;
        u.a = UA + ((size_t)g * 512 + pm * 256) * UAK * 2; u.b = WE + (size_t)g * 256 * 1024 * 2; return true; }
};
struct SchedS5Y {
    const char* UA; const char* TZ; int c, G;
    __device__ __forceinline__ bool next(int i, Unit& u) const { const int L = i * G + c; if (L >= 256) return false; const int g = L >> 3, pm = (L >> 2) & 1, pn = L & 3; u.pm = pm; u.pn = pn; u.aux = g;
        u.a = UA + ((size_t)g * 512 + pm * 256) * UAK * 2; u.b = TZ + ((size_t)g * 1024 + pn * 256) * UAK * 2; return true; }
};
struct SchedBranch {
    const char* A0; const char* A1; const char* B0; const char* B1; int G, c;
    __device__ __forceinline__ bool next(int i, Unit& u) const { int pm, pn; if (!pg8::static_tile((i >> 1) * G + c, T / 256, 4, pm, pn)) return false; const int part = i & 1; u.pm = pm; u.pn = pn; u.aux = part;
        u.a = (part ? A1 : A0) + (size_t)pm * 256 * HW * 2; u.b = (part ? B1 : B0) + (size_t)pn * 256 * HW * 2; return true; }
};
struct SchedMoe {
    const char* A; const char* W; const int* tile_e; int ntiles, NN, G, c; size_t wexp, wtile; bool gather;
    __device__ __forceinline__ bool next(int i, Unit& u) const { const int L = i * G + c; const int ti = L / NN; if (ti >= ntiles) return false; const int pn = L - ti * NN; const int e = tile_e[ti];
        u.pm = ti; u.pn = pn; u.aux = gather ? ti * 256 : e; u.a = gather ? A : A + (size_t)ti * 256 * DF * 2; u.b = W + (size_t)e * wexp + (size_t)pn * wtile; return true; }
};

__device__ __forceinline__ u32x4 pack8(const f32x4& v0, const f32x4& v1) { u32x4 w; w.x = cvt_pk_bf16(v0[0], v0[1]); w.y = cvt_pk_bf16(v0[2], v0[3]); w.z = cvt_pk_bf16(v1[0], v1[1]); w.w = cvt_pk_bf16(v1[2], v1[3]); return w; }

struct EpiInProj {
    static constexpr bool PERM = true;
    bf16_t *UA, *Q, *V, *GS, *GATES; float* LOGF; const float* LBV;
    __device__ __forceinline__ bool operator()(f32x4 (&acc)[2][2][4][2], const Unit& u, int wr, int wc, int fr, int fq) const {
        const int kind = u.pn >> 1;
#pragma unroll
        for (int ai = 0; ai < 2; ++ai)
#pragma unroll
            for (int m = 0; m < 4; ++m) { const int tok = u.pm * 256 + ai * 128 + wr * 64 + m * 16 + fr;
#pragma unroll
                for (int bj = 0; bj < 2; ++bj) { const int col = u.pn * 256 + bj * 128 + wc * 32 + 8 * fq; f32x4 v0 = acc[ai][bj][m][0], v1 = acc[ai][bj][m][1];
                    if (kind == 0) { const int g = col >> 4, hh = col & 15; *(u32x4*)(UA + ((size_t)(g * 512 + (tok >> 6)) * UAK + (tok & 63) * 16 + hh)) = pack8(v0, v1); }
                    else if (kind == 1) {
#pragma unroll
                        for (int j = 0; j < 4; ++j) { v0[j] = v0[j] * sigmoidf_(v0[j]); v1[j] = v1[j] * sigmoidf_(v1[j]); }
                        *(u32x4*)(Q + (size_t)tok * HW + (col - 512)) = pack8(v0, v1); }
                    else if (kind == 2) { const int c2 = col - 1024; const f32x4 l0 = *(const f32x4*)(LBV + c2), l1 = *(const f32x4*)(LBV + c2 + 4);
#pragma unroll
                        for (int j = 0; j < 4; ++j) { v0[j] = __logf(l0[j] + (1.f - l0[j]) * sigmoidf_(v0[j])); v1[j] = __logf(l1[j] + (1.f - l1[j]) * sigmoidf_(v1[j])); }
                        *(f32x4*)(LOGF + (size_t)tok * HW + c2) = v0; *(f32x4*)(LOGF + (size_t)tok * HW + c2 + 4) = v1; }
                    else if (kind == 3) { *(u32x4*)(V + (size_t)tok * HW + (col - 1536)) = pack8(v0, v1); }
                    else if (kind == 4) {
#pragma unroll
                        for (int j = 0; j < 4; ++j) { v0[j] = v0[j] * sigmoidf_(v0[j]); v1[j] = v1[j] * sigmoidf_(v1[j]); }
                        *(u32x4*)(GS + (size_t)tok * HW + (col - 2048)) = pack8(v0, v1); }
                    else {
#pragma unroll
                        for (int j = 0; j < 4; ++j) { v0[j] = sigmoidf_(v0[j]); v1[j] = sigmoidf_(v1[j]); }
                        *(u32x4*)(GATES + (size_t)tok * 2048 + (col - 2560)) = pack8(v0, v1); }
                } }
        return false;
    }
};
struct EpiS5E {
    static constexpr bool PERM = false;
    float* SE;
    __device__ __forceinline__ bool operator()(f32x4 (&acc)[2][2][4][2], const Unit& u, int wr, int wc, int fr, int fq) const {
#pragma unroll
        for (int ai = 0; ai < 2; ++ai)
#pragma unroll
            for (int m = 0; m < 4; ++m) { const int r = u.pm * 256 + ai * 128 + wr * 64 + m * 16 + fr; float* rowp = SE + ((size_t)u.aux * 512 + r) * 128 + wc * 32 + 4 * fq;
#pragma unroll
                for (int n = 0; n < 2; ++n) *(f32x4*)(rowp + n * 16) = acc[ai][0][m][n]; }
        return false;
    }
};
struct EpiS5Y {
    static constexpr bool PERM = true;
    const bf16_t* UA; const float* SD; bf16_t* Y1;
    __device__ __forceinline__ bool operator()(f32x4 (&acc)[2][2][4][2], const Unit& u, int wr, int wc, int fr, int fq) const {
        const int g = u.aux;
#pragma unroll
        for (int ai = 0; ai < 2; ++ai)
#pragma unroll
            for (int m = 0; m < 4; ++m) { const int r = u.pm * 256 + ai * 128 + wr * 64 + m * 16 + fr; const int b = r >> 7, c = r & 127;
#pragma unroll
                for (int bj = 0; bj < 2; ++bj) { const int col = u.pn * 256 + bj * 128 + wc * 32 + 8 * fq; const int t = col >> 4, hh = col & 15;
                    const u32x4 uu = *(const u32x4*)(UA + ((size_t)(g * 512 + r) * UAK + col));
                    const f32x4 d0 = *(const f32x4*)(SD + g * 16 + hh), d1 = *(const f32x4*)(SD + g * 16 + hh + 4);
                    f32x4 v0 = acc[ai][bj][m][0], v1 = acc[ai][bj][m][1];
                    v0[0] += d0[0] * bf2f(uu.x & 0xffffu); v0[1] += d0[1] * bf2f(uu.x >> 16); v0[2] += d0[2] * bf2f(uu.y & 0xffffu); v0[3] += d0[3] * bf2f(uu.y >> 16);
                    v1[0] += d1[0] * bf2f(uu.z & 0xffffu); v1[1] += d1[1] * bf2f(uu.z >> 16); v1[2] += d1[2] * bf2f(uu.w & 0xffffu); v1[3] += d1[3] * bf2f(uu.w >> 16);
#pragma unroll
                    for (int j = 0; j < 4; ++j) { float x = v0[j]; v0[j] = x * sigmoidf_(1.5957691216f * (x + 0.044715f * x * x * x)); x = v1[j]; v1[j] = x * sigmoidf_(1.5957691216f * (x + 0.044715f * x * x * x)); }
                    const int tok = b * SEQ + c * 64 + t;
                    *(u32x4*)(Y1 + (size_t)tok * HW + g * 16 + hh) = pack8(v0, v1); } }
        return false;
    }
};
struct EpiGlu {
    static constexpr bool PERM = true;
    const bf16_t* Y1; bf16_t* YS5;
    __device__ __forceinline__ bool operator()(f32x4 (&acc)[2][2][4][2], const Unit& u, int wr, int wc, int fr, int fq) const {
#pragma unroll
        for (int ai = 0; ai < 2; ++ai)
#pragma unroll
            for (int m = 0; m < 4; ++m) { const int row = u.pm * 256 + ai * 128 + wr * 64 + m * 16 + fr;
#pragma unroll
                for (int bj = 0; bj < 2; ++bj) { const int col = u.pn * 256 + bj * 128 + wc * 32 + 8 * fq; const u32x4 y = *(const u32x4*)(Y1 + (size_t)row * HW + col);
                    f32x4 v0 = acc[ai][bj][m][0], v1 = acc[ai][bj][m][1];
                    v0[0] = bf2f(y.x & 0xffffu) * sigmoidf_(v0[0]); v0[1] = bf2f(y.x >> 16) * sigmoidf_(v0[1]); v0[2] = bf2f(y.y & 0xffffu) * sigmoidf_(v0[2]); v0[3] = bf2f(y.y >> 16) * sigmoidf_(v0[3]);
                    v1[0] = bf2f(y.z & 0xffffu) * sigmoidf_(v1[0]); v1[1] = bf2f(y.z >> 16) * sigmoidf_(v1[1]); v1[2] = bf2f(y.w & 0xffffu) * sigmoidf_(v1[2]); v1[3] = bf2f(y.w >> 16) * sigmoidf_(v1[3]);
                    *(u32x4*)(YS5 + (size_t)row * HW + col) = pack8(v0, v1); } }
        return false;
    }
};
struct EpiBranch {
    static constexpr bool PERM = true;
    const bf16_t* GATES; bf16_t* MERGED;
    __device__ __forceinline__ bool operator()(f32x4 (&acc)[2][2][4][2], const Unit& u, int wr, int wc, int fr, int fq) const {
        const int part = u.aux;
#pragma unroll
        for (int ai = 0; ai < 2; ++ai)
#pragma unroll
            for (int m = 0; m < 4; ++m) { const int row = u.pm * 256 + ai * 128 + wr * 64 + m * 16 + fr;
#pragma unroll
                for (int bj = 0; bj < 2; ++bj) { const int col = u.pn * 256 + bj * 128 + wc * 32 + 8 * fq;
                    const u32x4 g2 = *(const u32x4*)(GATES + (size_t)row * 2048 + 1024 + col);
                    float h[8] = {bf2f(g2.x & 0xffffu), bf2f(g2.x >> 16), bf2f(g2.y & 0xffffu), bf2f(g2.y >> 16), bf2f(g2.z & 0xffffu), bf2f(g2.z >> 16), bf2f(g2.w & 0xffffu), bf2f(g2.w >> 16)};
#pragma unroll
                    for (int j = 0; j < 8; ++j) h[j] = fmaxf(h[j], 1e-30f);
                    if (part == 0) { const u32x4 g1 = *(const u32x4*)(GATES + (size_t)row * 2048 + col);
                        const float s[8] = {bf2f(g1.x & 0xffffu), bf2f(g1.x >> 16), bf2f(g1.y & 0xffffu), bf2f(g1.y >> 16), bf2f(g1.z & 0xffffu), bf2f(g1.z >> 16), bf2f(g1.w & 0xffffu), bf2f(g1.w >> 16)};
#pragma unroll
                        for (int j = 0; j < 4; ++j) { acc[ai][bj][m][0][j] *= s[j] / h[j]; acc[ai][bj][m][1][j] *= s[4 + j] / h[4 + j]; } }
                    else { f32x4 v0 = acc[ai][bj][m][0], v1 = acc[ai][bj][m][1];
#pragma unroll
                        for (int j = 0; j < 4; ++j) { v0[j] *= h[j]; v1[j] *= h[4 + j]; }
                        *(u32x4*)(MERGED + (size_t)row * D + col) = pack8(v0, v1); } } }
        return part == 0;
    }
};
struct EpiOut {
    static constexpr bool PERM = false;
    const float* X; float* H1; float* SSQ;
    __device__ __forceinline__ bool operator()(f32x4 (&acc)[2][2][4][2], const Unit& u, int wr, int wc, int fr, int fq) const {
#pragma unroll
        for (int ai = 0; ai < 2; ++ai)
#pragma unroll
            for (int m = 0; m < 4; ++m) { const int row = u.pm * 256 + ai * 128 + wr * 64 + m * 16 + fr; const size_t off = (size_t)row * D + u.pn * 256 + wc * 32 + 4 * fq; float ss = 0.f;
#pragma unroll
                for (int bj = 0; bj < 2; ++bj)
#pragma unroll
                    for (int n = 0; n < 2; ++n) { const f32x4 xv = *(const f32x4*)(X + off + bj * 128 + n * 16); const f32x4 o = xv + acc[ai][bj][m][n];
                        *(f32x4*)(H1 + off + bj * 128 + n * 16) = o; ss += (o[0] * o[0] + o[1] * o[1]) + (o[2] * o[2] + o[3] * o[3]); }
                ss += __shfl_xor(ss, 16); ss += __shfl_xor(ss, 32);
                if (fq == 0) SSQ[(size_t)row * 16 + u.pn * 4 + wc] = ss; }
        return false;
    }
};
struct EpiMoe1 {
    static constexpr bool PERM = true;
    const float* BGU; const int* tile_e; bf16_t* A2;
    __device__ __forceinline__ bool operator()(f32x4 (&acc)[2][2][4][2], const Unit& u, int wr, int wc, int fr, int fq) const {
        const int e = tile_e[u.pm]; const int hid = u.pn * 128 + wc * 32 + 8 * fq; const float* bp = BGU + (size_t)e * 2048 + 2 * hid;
        const f32x4 b0 = *(const f32x4*)(bp), b1 = *(const f32x4*)(bp + 4), b2 = *(const f32x4*)(bp + 8), b3 = *(const f32x4*)(bp + 12);
        const float bg[8] = {b0[0], b0[2], b1[0], b1[2], b2[0], b2[2], b3[0], b3[2]}, bu[8] = {b0[1], b0[3], b1[1], b1[3], b2[1], b2[3], b3[1], b3[3]};
#pragma unroll
        for (int ai = 0; ai < 2; ++ai)
#pragma unroll
            for (int m = 0; m < 4; ++m) { const int prow = u.pm * 256 + ai * 128 + wr * 64 + m * 16 + fr; f32x4 o0, o1;
#pragma unroll
                for (int j = 0; j < 4; ++j) {
                    float gt = fminf(acc[ai][0][m][0][j] + bg[j], 7.0f), up = fminf(fmaxf(acc[ai][1][m][0][j] + bu[j], -7.0f), 7.0f); o0[j] = (up + 1.0f) * gt * sigmoidf_(1.702f * gt);
                    gt = fminf(acc[ai][0][m][1][j] + bg[4 + j], 7.0f); up = fminf(fmaxf(acc[ai][1][m][1][j] + bu[4 + j], -7.0f), 7.0f); o1[j] = (up + 1.0f) * gt * sigmoidf_(1.702f * gt); }
                *(u32x4*)(A2 + (size_t)prow * DF + hid) = pack8(o0, o1); }
        return false;
    }
};
struct EpiMoe2 {
    static constexpr bool PERM = true;
    const float* BD; const int* tile_e; const int* rowslot; bf16_t* YS;
    __device__ __forceinline__ bool operator()(f32x4 (&acc)[2][2][4][2], const Unit& u, int wr, int wc, int fr, int fq) const {
        const int e = tile_e[u.pm];
#pragma unroll
        for (int ai = 0; ai < 2; ++ai)
#pragma unroll
            for (int m = 0; m < 4; ++m) { const int prow = u.pm * 256 + ai * 128 + wr * 64 + m * 16 + fr; const int slot = rowslot[prow];
                if (slot >= 0) {
#pragma unroll
                    for (int bj = 0; bj < 2; ++bj) { const int col = u.pn * 256 + bj * 128 + wc * 32 + 8 * fq; const f32x4 c0 = *(const f32x4*)(BD + (size_t)e * D + col), c1 = *(const f32x4*)(BD + (size_t)e * D + col + 4);
                        *(u32x4*)(YS + (size_t)slot * D + col) = pack8(acc[ai][bj][m][0] + c0, acc[ai][bj][m][1] + c1); } } }
        return false;
    }
};

template <int MODE  > __device__ __forceinline__ void p0_transpose_item(const float* W, int K, int N, bf16_t* WT, LAS float* scr, int item, int lane) {
    const int nblk = N / 32, kb = item / nblk, nb = item % nblk, k0 = 64 * kb, n0 = 32 * nb;
#pragma unroll 8
    for (int i = 0; i < 32; ++i) { const int kk = 2 * i + (lane >> 5); scr[kk * 33 + (lane & 31)] = W[(size_t)(k0 + kk) * N + n0 + (lane & 31)]; }
    LDS_WAIT(); asm volatile("" ::: "memory");
    const int c = lane & 7;
#pragma unroll
    for (int j = 0; j < 4; ++j) { const int n = (lane >> 3) + 8 * j; const LAS float* s = scr + (8 * c) * 33 + n;
        u32x4 o; o.x = pk2(s[0 * 33], s[1 * 33]); o.y = pk2(s[2 * 33], s[3 * 33]); o.z = pk2(s[4 * 33], s[5 * 33]); o.w = pk2(s[6 * 33], s[7 * 33]);
        int nn = n0 + n; if (MODE == 1) { const int hid = nn >> 1, part = nn & 1; nn = 256 * (hid >> 7) + 128 * part + (hid & 127); }
        *(u32x4*)(WT + (size_t)nn * K + k0 + 8 * c) = o; }
    LDS_WAIT(); asm volatile("" ::: "memory");
}
struct C2 { double re, im; };
__device__ __forceinline__ C2 cmul(C2 a, C2 b) { return C2{a.re * b.re - a.im * b.im, a.re * b.im + a.im * b.re}; }
__device__ __forceinline__ C2 s5_pow(const Frame& F, int g, int p, int k) {
    const double lre = (double)F.in[I_LRE][g * SP + p], lim = (double)F.in[I_LIM][g * SP + p], dt = exp((double)F.in[I_LDT][g]);
    const double mag = exp((double)k * lre * dt); double s, c; sincos((double)k * lim * dt, &s, &c); return C2{mag * c, mag * s};
}
__device__ __forceinline__ C2 s5_coef(const Frame& F, int g, int p) {
    const double lre = (double)F.in[I_LRE][g * SP + p], lim = (double)F.in[I_LIM][g * SP + p]; const C2 lb = s5_pow(F, g, p, 1);
    const double nr = lb.re - 1.0, ni = lb.im, den = lre * lre + lim * lim; return C2{(nr * lre + ni * lim) / den, (ni * lre - nr * lim) / den};
}

__device__ __forceinline__ void p0_prologue(Frame& F) {
    LAS float* scr = (LAS float*)(F.lds + F.wave * 16384);
    const int gw = F.vcu * 8 + F.wave, NGW = F.G * 8, lane = F.lane;
    unsigned char* ws = F.ws;
    constexpr int I_GU = NE * 16 * 64, I_DN = NE * 16 * 32, I_IN = 16 * 144, I_GL = 8 * 16, I_BS = 8 * 32, I_BH = 8 * 32, I_OU = 16 * 32;
    constexpr int R0 = I_GU, R1 = R0 + I_DN, R2 = R1 + I_IN, R3 = R2 + I_GL, R4 = R3 + I_BS, R5 = R4 + I_BH, R6 = R5 + I_OU;
    constexpr int R7 = R6 + 2048  , R8 = R7 + 2048  , R9 = R8 + 2048  , R10 = R9 + 32  , R11 = R10 + 96  , R12 = R11 + 16  , R13 = R12 + 1  ;
    constexpr int R14 = R13 + 2048  ;
    for (int it = gw; it < R14; it += NGW) {
        if (it < R0) { const int e = it / (16 * 64), r = it % (16 * 64); p0_transpose_item<1>(F.in[I_WGU] + (size_t)e * D * 2048, D, 2048, (bf16_t*)(ws + WS_WGU) + (size_t)e * 2048 * D, scr, r, lane); }
        else if (it < R1) { const int q = it - R0, e = q / (16 * 32), r = q % (16 * 32); p0_transpose_item<0>(F.in[I_WD] + (size_t)e * DF * D, DF, D, (bf16_t*)(ws + WS_WD) + (size_t)e * D * DF, scr, r, lane); }
        else if (it < R2) p0_transpose_item<0>(F.in[I_WIN], D, INW, (bf16_t*)(ws + WS_WIN), scr, it - R1, lane);
        else if (it < R3) p0_transpose_item<0>(F.in[I_WGLU], HW, HW, (bf16_t*)(ws + WS_WGLU), scr, it - R2, lane);
        else if (it < R4) p0_transpose_item<0>(F.in[I_WBS], HW, D, (bf16_t*)(ws + WS_WBS), scr, it - R3, lane);
        else if (it < R5) p0_transpose_item<0>(F.in[I_WBH], HW, D, (bf16_t*)(ws + WS_WBH), scr, it - R4, lane);
        else if (it < R6) p0_transpose_item<0>(F.in[I_WOUT], D, D, (bf16_t*)(ws + WS_WOUT), scr, it - R5, lane);
        else if (it < R7) {
            const int q = it - R6, g = q >> 6, k = q & 63, p = lane;
            const C2 pw = s5_pow(F, g, p, k), cf = s5_coef(F, g, p);
            LAS float* CLre = scr; LAS float* CLim = scr + 1024; LAS float* BBre = scr + 2048; LAS float* BBim = scr + 3072;
#pragma unroll 4
            for (int h = 0; h < 16; ++h) { const C2 cc = cmul(C2{(double)F.in[I_CRE][(g * 16 + h) * SP + p], (double)F.in[I_CIM][(g * 16 + h) * SP + p]}, pw); CLre[h * 64 + p] = (float)cc.re; CLim[h * 64 + p] = (float)cc.im;
                const C2 bb = cmul(cf, C2{(double)F.in[I_BRE][(g * SP + p) * 16 + h], (double)F.in[I_BIM][(g * SP + p) * 16 + h]}); BBre[p * 16 + h] = (float)bb.re; BBim[p * 16 + h] = (float)bb.im; }
            LDS_WAIT(); asm volatile("" ::: "memory");
            float o[4];
#pragma unroll
            for (int qq = 0; qq < 4; ++qq) { const int idx = lane * 4 + qq, h = idx >> 4, h2 = idx & 15; float s = 0.f;
                for (int pp = 0; pp < 64; ++pp) s += CLre[h * 64 + pp] * BBre[pp * 16 + h2] - CLim[h * 64 + pp] * BBim[pp * 16 + h2];
                o[qq] = s; }
            u32x2 w; w.x = pk2(o[0], o[1]); w.y = pk2(o[2], o[3]);
            *(u32x2*)((bf16_t*)(ws + WS_KCONV) + (size_t)q * 256 + lane * 4) = w;
            LDS_WAIT(); asm volatile("" ::: "memory");
        }
        else if (it < R8) {
            const int q = it - R7, g = q >> 6, s = q & 63, p = lane; const C2 pw = cmul(s5_pow(F, g, p, 63 - s), s5_coef(F, g, p));
            float re[16], im[16];
#pragma unroll
            for (int h = 0; h < 16; ++h) { const C2 w = cmul(pw, C2{(double)F.in[I_BRE][(g * SP + p) * 16 + h], (double)F.in[I_BIM][(g * SP + p) * 16 + h]}); re[h] = (float)w.re; im[h] = (float)w.im; }
            bf16_t* o0 = (bf16_t*)(ws + WS_WE) + ((size_t)(g * 256 + p) * 1024 + s * 16); bf16_t* o1 = o0 + (size_t)64 * 1024;
            u32x4 a, b; a.x = pk2(re[0], re[1]); a.y = pk2(re[2], re[3]); a.z = pk2(re[4], re[5]); a.w = pk2(re[6], re[7]); b.x = pk2(re[8], re[9]); b.y = pk2(re[10], re[11]); b.z = pk2(re[12], re[13]); b.w = pk2(re[14], re[15]);
            *(u32x4*)o0 = a; *(u32x4*)(o0 + 8) = b;
            a.x = pk2(im[0], im[1]); a.y = pk2(im[2], im[3]); a.z = pk2(im[4], im[5]); a.w = pk2(im[6], im[7]); b.x = pk2(im[8], im[9]); b.y = pk2(im[10], im[11]); b.z = pk2(im[12], im[13]); b.w = pk2(im[14], im[15]);
            *(u32x4*)o1 = a; *(u32x4*)(o1 + 8) = b;
        }
        else if (it < R9) {
            const int q = it - R8, g = q >> 6, t = q & 63, p = lane; const C2 pw = s5_pow(F, g, p, t + 1);
            for (int h = 0; h < 16; ++h) { const C2 cc = cmul(C2{(double)F.in[I_CRE][(g * 16 + h) * SP + p], (double)F.in[I_CIM][(g * 16 + h) * SP + p]}, pw);
                bf16_t* o = (bf16_t*)(ws + WS_TZ) + ((size_t)(g * 1024 + t * 16 + h) * UAK + 1024 + p); o[0] = (bf16_t)f2bf((float)cc.re); o[64] = (bf16_t)f2bf((float)(-cc.im)); }
        }
        else if (it < R10) {
            const int g = it - R9, p = lane; const C2 l1 = s5_pow(F, g, p, 1), l64 = s5_pow(F, g, p, 64), cf = s5_coef(F, g, p);
            ((f32x2*)(ws + WS_LAMB))[g * SP + p] = (f32x2){(float)l1.re, (float)l1.im}; ((f32x2*)(ws + WS_LAMC))[g * SP + p] = (f32x2){(float)l64.re, (float)l64.im};
            for (int h = 0; h < 16; ++h) { const C2 bb = cmul(cf, C2{(double)F.in[I_BRE][(g * SP + p) * 16 + h], (double)F.in[I_BIM][(g * SP + p) * 16 + h]}); ((f32x2*)(ws + WS_BBAR))[(g * SP + p) * 16 + h] = (f32x2){(float)bb.re, (float)bb.im}; }
        }
        else if (it < R11) {
            const int q = it - R10, cg = q >> 2, kq = q & 3; const int wcol = (cg < 8 ? cg * 64 : (cg < 16 ? 1024 + (cg - 8) * 64 : 1536 + (cg - 16) * 64)) + lane;
            const float* meta = F.in[I_META]; const float* g1 = F.in[I_N1G];
            for (int r = 0; r < 16; ++r) { float s = 0.f;
#pragma unroll
                for (int j = 0; j < 16; ++j) { const float v = meta[r * D + lane + 64 * j]; s += v * v; }
                const float rstd = 1.0f / sqrtf(wave_sum(s) * (1.0f / D) + EPS);
#pragma unroll
                for (int j = 0; j < 4; ++j) { const int kk = lane + 64 * j, k = kq * 256 + kk; scr[kk * 16 + r] = meta[r * D + k] * rstd * g1[k]; } }
            LDS_WAIT(); asm volatile("" ::: "memory");
            float a[16];
#pragma unroll
            for (int r = 0; r < 16; ++r) a[r] = 0.f;
            const float* wp = F.in[I_WIN] + (size_t)(kq * 256) * INW + wcol;
#pragma unroll 4
            for (int kk = 0; kk < 256; ++kk) { const float w = wp[(size_t)kk * INW]; const LAS f32x4* xs = (const LAS f32x4*)(scr + kk * 16);
                const f32x4 x0 = xs[0], x1 = xs[1], x2 = xs[2], x3 = xs[3];
                a[0] += w * x0[0]; a[1] += w * x0[1]; a[2] += w * x0[2]; a[3] += w * x0[3]; a[4] += w * x1[0]; a[5] += w * x1[1]; a[6] += w * x1[2]; a[7] += w * x1[3];
                a[8] += w * x2[0]; a[9] += w * x2[1]; a[10] += w * x2[2]; a[11] += w * x2[3]; a[12] += w * x3[0]; a[13] += w * x3[1]; a[14] += w * x3[2]; a[15] += w * x3[3]; }
            float* pm = (float*)(ws + WS_PMETA);
#pragma unroll
            for (int r = 0; r < 16; ++r) pm[(size_t)(kq * 16 + r) * 1536 + cg * 64 + lane] = a[r];
            LDS_WAIT(); asm volatile("" ::: "memory");
        }
        else if (it < R12) {
            const int k = (it - R11) * 64 + lane; bf16_t* hi = (bf16_t*)(ws + WS_WRT); bf16_t* lo = hi + NE * D;
            for (int e = 0; e < NE; ++e) { const float w = F.in[I_WR][k * NE + e]; const unsigned h = f2bf(w); hi[e * D + k] = (bf16_t)h; lo[e * D + k] = (bf16_t)f2bf(w - bf2f(h)); }
        }
        else if (it < R13) {
            for (int d = lane; d < HW; d += 64) ((float*)(ws + WS_LBV))[d] = sigmoidf_(F.in[I_LBL][d] - F.in[I_LBL][HW + d]);
        }
        else {
            const int q = it - R13, g = q >> 6, r0 = 128 + (q & 63) * 2; u32x4* o = (u32x4*)((bf16_t*)(ws + WS_WE) + (size_t)(g * 256 + r0) * 1024);
#pragma unroll
            for (int j = 0; j < 4; ++j) o[lane + 64 * j] = (u32x4){0u, 0u, 0u, 0u};
        }
    }
    const float* g1 = F.in[I_N1G];
    for (int m = gw; m < T; m += NGW) {
        const f32x4* xr = (const f32x4*)(F.in[I_X] + (size_t)m * D) + lane; f32x4 v[4]; float s = 0.f;
#pragma unroll
        for (int j = 0; j < 4; ++j) { v[j] = xr[64 * j]; s += (v[j].x * v[j].x + v[j].y * v[j].y) + (v[j].z * v[j].z + v[j].w * v[j].w); }
        const float rstd = 1.0f / sqrtf(wave_sum(s) * (1.0f / D) + EPS);
        u32x2* o8 = (u32x2*)((bf16_t*)(ws + WS_XN) + (size_t)m * D) + lane;
#pragma unroll
        for (int j = 0; j < 4; ++j) { const f32x4 gg = ((const f32x4*)g1)[lane + 64 * j]; u32x2 w; w.x = pk2(v[j].x * rstd * gg.x, v[j].y * rstd * gg.y); w.y = pk2(v[j].z * rstd * gg.z, v[j].w * rstd * gg.w); o8[64 * j] = w; }
    }
}
__device__ __forceinline__ void p1_toeplitz(Frame& F) {
    const int gw = F.vcu * 8 + F.wave, NGW = F.G * 8, lane = F.lane; const bf16_t* kc = (const bf16_t*)(F.ws + WS_KCONV); bf16_t* tz = (bf16_t*)(F.ws + WS_TZ);
    for (int row = gw; row < SG * 1024; row += NGW) { const int g = row >> 10, t = (row >> 4) & 63, h = row & 15;
#pragma unroll
        for (int j = 0; j < 2; ++j) { const int q = lane + 64 * j, s = q >> 1, half = q & 1; u32x4 v = (u32x4){0u, 0u, 0u, 0u};
            if (s <= t) v = *(const u32x4*)(kc + ((size_t)((g * 64 + (t - s)) * 16 + h) * 16 + half * 8));
            *(u32x4*)(tz + (size_t)row * UAK + s * 16 + half * 8) = v; } }
}

constexpr int ST64 = 144, ST128 = 272;
__device__ __forceinline__ void mma_nt32(f32x16& acc, const LAS unsigned char* A, int sa, const LAS unsigned char* B, int sb, int K, int lane) {
    const LAS unsigned char* pa = A + (lane & 31) * sa + (lane >> 5) * 16; const LAS unsigned char* pb = B + (lane & 31) * sb + (lane >> 5) * 16;
    for (int k = 0; k < K; k += 16) { const bf16x8 a = *(const LAS bf16x8*)(pa + k * 2), b = *(const LAS bf16x8*)(pb + k * 2); acc = __builtin_amdgcn_mfma_f32_32x32x16_bf16(a, b, acc, 0, 0, 0); }
}
__device__ __forceinline__ void hg_cumsum(LAS float* segtot, const float* LOGF, int tok0, int col, int d, int seg, float (&lf)[16], float (&cs)[16], float& total, float& bmid) {
#pragma unroll
    for (int j = 0; j < 16; ++j) lf[j] = LOGF[(size_t)(tok0 + seg * 16 + j) * HW + col];
    float run = 0.f;
#pragma unroll
    for (int j = 0; j < 16; ++j) { run += lf[j]; cs[j] = run; }
    segtot[seg * 128 + d] = run;
    __syncthreads();
    const float t0 = segtot[d], t1 = segtot[128 + d], t2 = segtot[256 + d], t3 = segtot[384 + d];
    const float pre = seg == 0 ? 0.f : (seg == 1 ? t0 : (seg == 2 ? t0 + t1 : t0 + t1 + t2));
#pragma unroll
    for (int j = 0; j < 16; ++j) cs[j] += pre;
    total = (t0 + t1) + (t2 + t3); bmid = t0 + t1;
}
__device__ __forceinline__ void hg_load_vt(LAS unsigned char* VT, const bf16_t* V, int tok0, int hcol, int tid) {
    const int j = tid & 63;
#pragma unroll
    for (int i = 0; i < 2; ++i) { const int e0 = ((tid >> 6) + 8 * i) * 8; const u32x4 v = *(const u32x4*)(V + (size_t)(tok0 + j) * HW + hcol + e0);
        LAS bf16_t* o = (LAS bf16_t*)(VT + e0 * ST64 + j * 2);
        o[0 * (ST64 / 2)] = (bf16_t)(v.x & 0xffffu); o[1 * (ST64 / 2)] = (bf16_t)(v.x >> 16); o[2 * (ST64 / 2)] = (bf16_t)(v.y & 0xffffu); o[3 * (ST64 / 2)] = (bf16_t)(v.y >> 16);
        o[4 * (ST64 / 2)] = (bf16_t)(v.z & 0xffffu); o[5 * (ST64 / 2)] = (bf16_t)(v.z >> 16); o[6 * (ST64 / 2)] = (bf16_t)(v.w & 0xffffu); o[7 * (ST64 / 2)] = (bf16_t)(v.w >> 16); }
}
__device__ __forceinline__ void hgrn_a_unit(Frame& F, int unit) {
    const int tid = F.tid, lane = F.lane, wave = F.wave; const int bh = unit >> 7, c = unit & 127, b = bh >> 2, h = bh & 3, tok0 = b * SEQ + c * CH, hcol = h * HD;
    LAS unsigned char* KT = F.lds; LAS unsigned char* VT = F.lds + 128 * ST64; LAS float* segtot = (LAS float*)(F.lds + 2 * 128 * ST64);
    const int d = tid & 127, seg = tid >> 7; float lf[16], cs[16], total, bmid;
    hg_load_vt(VT, (const bf16_t*)(F.ws + WS_V), tok0, hcol, tid);
    hg_cumsum(segtot, (const float*)(F.ws + WS_LOGF), tok0, hcol + d, d, seg, lf, cs, total, bmid);
    float kk[16];
#pragma unroll
    for (int j = 0; j < 16; ++j) kk[j] = (1.0f - __expf(lf[j])) * __expf(total - cs[j]);
    u32x4 w0, w1; w0.x = pk2(kk[0], kk[1]); w0.y = pk2(kk[2], kk[3]); w0.z = pk2(kk[4], kk[5]); w0.w = pk2(kk[6], kk[7]); w1.x = pk2(kk[8], kk[9]); w1.y = pk2(kk[10], kk[11]); w1.z = pk2(kk[12], kk[13]); w1.w = pk2(kk[14], kk[15]);
    *(LAS u32x4*)(KT + d * ST64 + seg * 32) = w0; *(LAS u32x4*)(KT + d * ST64 + seg * 32 + 16) = w1;
    if (seg == 0) ((float*)(F.ws + WS_DEC))[(size_t)unit * HD + d] = __expf(total);
    __syncthreads();
    float* kvt = (float*)(F.ws + WS_KVT) + (size_t)unit * HD * HD;
#pragma unroll
    for (int i = 0; i < 2; ++i) { const int tile = wave * 2 + i, et = tile >> 2, dt = tile & 3; f32x16 acc;
#pragma unroll
        for (int r = 0; r < 16; ++r) acc[r] = 0.f;
        mma_nt32(acc, VT + et * 32 * ST64, ST64, KT + dt * 32 * ST64, ST64, 64, lane);
#pragma unroll
        for (int r = 0; r < 16; ++r) { const int e = et * 32 + (r & 3) + 8 * (r >> 2) + 4 * (lane >> 5); kvt[(size_t)e * HD + dt * 32 + (lane & 31)] = acc[r]; } }
    __syncthreads();
}
__device__ __forceinline__ void hgrn_c_unit(Frame& F, int unit) {
    const int tid = F.tid, lane = F.lane, wave = F.wave; const int bh = unit >> 7, c = unit & 127, b = bh >> 2, h = bh & 3, tok0 = b * SEQ + c * CH, hcol = h * HD;
    LAS unsigned char* Q1 = F.lds; LAS unsigned char* K1 = Q1 + 64 * ST128; LAS unsigned char* Q2 = K1 + 64 * ST128; LAS unsigned char* VT = Q2 + 64 * ST128;
    LAS unsigned char* PP = VT + 128 * ST64; LAS unsigned char* SPL = PP + 64 * ST64; LAS float* segtot = (LAS float*)(SPL + 128 * ST128); LAS float* RS = segtot + 512;
    const int d = tid & 127, seg = tid >> 7; float lf[16], cs[16], total, bmid;
    hg_load_vt(VT, (const bf16_t*)(F.ws + WS_V), tok0, hcol, tid);
    { const bf16_t* sp = (const bf16_t*)(F.ws + WS_SPREV) + (size_t)unit * HD * HD;
#pragma unroll
      for (int i = 0; i < 4; ++i) { const int p = tid + 512 * i, e = p >> 4, d0 = (p & 15) * 8; *(LAS u32x4*)(SPL + e * ST128 + d0 * 2) = *(const u32x4*)(sp + (size_t)e * HD + d0); } }
    hg_cumsum(segtot, (const float*)(F.ws + WS_LOGF), tok0, hcol + d, d, seg, lf, cs, total, bmid);
    { const bf16_t* qg = (const bf16_t*)(F.ws + WS_Q);
#pragma unroll
      for (int j = 0; j < 16; ++j) { const int jj = seg * 16 + j; const float q = bf2f(qg[(size_t)(tok0 + jj) * HW + hcol + d]); const float kx = 1.0f - __expf(lf[j]);
          ((LAS bf16_t*)(Q1 + jj * ST128))[d] = (bf16_t)f2bf(q * __expf(cs[j] - bmid)); ((LAS bf16_t*)(K1 + jj * ST128))[d] = (bf16_t)f2bf(kx * __expf(bmid - cs[j])); ((LAS bf16_t*)(Q2 + jj * ST128))[d] = (bf16_t)f2bf(q * __expf(cs[j])); } }
    __syncthreads();
    if (wave < 4) { const int it = wave >> 1, jt = wave & 1; f32x16 acc;
#pragma unroll
        for (int r = 0; r < 16; ++r) acc[r] = 0.f;
        if (!(it == 0 && jt == 1)) mma_nt32(acc, Q1 + it * 32 * ST128, ST128, K1 + jt * 32 * ST128, ST128, 128, lane);
#pragma unroll
        for (int r = 0; r < 16; ++r) { const int i = it * 32 + (r & 3) + 8 * (r >> 2) + 4 * (lane >> 5), j = jt * 32 + (lane & 31); ((LAS bf16_t*)(PP + i * ST64))[j] = (bf16_t)f2bf(j <= i ? acc[r] : 0.f); } }
    __syncthreads();
    const int it = wave >> 2, et = wave & 3; f32x16 acc;
#pragma unroll
    for (int r = 0; r < 16; ++r) acc[r] = 0.f;
    mma_nt32(acc, PP + it * 32 * ST64, ST64, VT + et * 32 * ST64, ST64, 64, lane);
    mma_nt32(acc, Q2 + it * 32 * ST128, ST128, SPL + et * 32 * ST128, ST128, 128, lane);
#pragma unroll
    for (int r = 0; r < 16; ++r) { float s = acc[r] * acc[r]; s += __shfl_xor(s, 1); s += __shfl_xor(s, 2); s += __shfl_xor(s, 4); s += __shfl_xor(s, 8); s += __shfl_xor(s, 16);
        if ((lane & 31) == 0) RS[et * 64 + it * 32 + (r & 3) + 8 * (r >> 2) + 4 * (lane >> 5)] = s; }
    __syncthreads();
    { const int e = et * 32 + (lane & 31); const float gn = F.in[I_HNG][hcol + e]; const bf16_t* gs = (const bf16_t*)(F.ws + WS_GS); bf16_t* yo = (bf16_t*)(F.ws + WS_YHG);
#pragma unroll
      for (int r = 0; r < 16; ++r) { const int i = it * 32 + (r & 3) + 8 * (r >> 2) + 4 * (lane >> 5); const float ss = (RS[i] + RS[64 + i]) + (RS[128 + i] + RS[192 + i]);
          const float rstd = 1.0f / sqrtf(ss * (1.0f / HD) + EPS); const size_t o = (size_t)(tok0 + i) * HW + hcol + e; yo[o] = (bf16_t)f2bf(acc[r] * rstd * gn * bf2f(gs[o])); } }
    __syncthreads();
}

struct Args { const float* in[26]; float* out; unsigned char* ws; int ph_lo, ph_hi; };
constexpr int NPHASE = 13;

__global__ void __launch_bounds__(512, 2) mk_fwd(Args args) {
    extern __shared__ __attribute__((aligned(16))) unsigned char lds[];
    Frame F;
    F.lds = (LAS unsigned char*)lds; F.MISC = (volatile LAS unsigned*)(F.lds + MISC_OFF);
    F.tid = threadIdx.x; F.lane = F.tid & 63; F.wave = __builtin_amdgcn_readfirstlane(F.tid >> 6);
    F.G = gridDim.x; F.bx = blockIdx.x; F.vcu = (F.G % 8 == 0) ? (F.bx % 8) * (F.G / 8) + F.bx / 8 : F.bx;
    F.ws = args.ws; F.ctl = (unsigned*)(args.ws + WS_CTL); F.out = args.out;
#pragma unroll
    for (int i = 0; i < 26; ++i) F.in[i] = args.in[i];
    for (int u = F.tid; u < 64; u += 512) F.MISC[u] = 0u;
    __syncthreads();
    unsigned char* ws = F.ws;
    XcdBarrier bar; bar.bar = F.ctl + CW_BAR; bar.x = 0; bar.st = nullptr;
    if (!MK_PER_PHASE) bar = xcd_barrier_post(F.ctl + CW_BAR, F.MISC + 8);
    const int lo = args.ph_lo, hi = args.ph_hi;
#define IN(k) (lo <= (k) && (k) < hi)
#define SEAM(k) do { if (IN(k) && IN((k) + 1)) xcd_barrier(bar); } while (0)

    if (IN(0)) { p0_prologue(F); }
    SEAM(0);
    if (IN(1)) {
        p1_toeplitz(F);
        SchedStatic S{(const char*)(ws + WS_XN), (const char*)(ws + WS_WIN), T / 256, INW / 256, F.G, F.bx, (size_t)256 * D * 2, (size_t)256 * D * 2};
        EpiInProj E{(bf16_t*)(ws + WS_UA), (bf16_t*)(ws + WS_Q), (bf16_t*)(ws + WS_V), (bf16_t*)(ws + WS_GS), (bf16_t*)(ws + WS_GATES), (float*)(ws + WS_LOGF), (const float*)(ws + WS_LBV)};
        pg8::gemm_phase<EpiInProj, SchedStatic, false>(F.lds, D, D, D, S, E, nullptr);
    }
    SEAM(1);
    if (IN(2)) {
        { SchedS5E S{(const char*)(ws + WS_UA), (const char*)(ws + WS_WE), F.bx}; EpiS5E E{(float*)(ws + WS_SE)};
          pg8::gemm_phase<EpiS5E, SchedS5E, false>(F.lds, 1024, UAK, 1024, S, E, nullptr); }
        __syncthreads();
        const float* pm = (const float*)(ws + WS_PMETA);
        if (F.bx >= 64 && F.bx < 68) {
            const int g = (F.bx - 64) * 8 + (F.tid >> 6), p = F.tid & 63; const f32x2 lb = ((const f32x2*)(ws + WS_LAMB))[g * SP + p]; float xr = 0.f, xi = 0.f;
            for (int s = 0; s < NMETA; ++s) { float ar = 0.f, ai = 0.f;
#pragma unroll
                for (int h = 0; h < 16; ++h) { const int col = g * 16 + h; const float uu = (pm[(size_t)(0 * 16 + s) * 1536 + col] + pm[(size_t)(1 * 16 + s) * 1536 + col]) + (pm[(size_t)(2 * 16 + s) * 1536 + col] + pm[(size_t)(3 * 16 + s) * 1536 + col]);
                    const f32x2 bb = ((const f32x2*)(ws + WS_BBAR))[(g * SP + p) * 16 + h]; ar += bb.x * uu; ai += bb.y * uu; }
                const float nr = lb.x * xr - lb.y * xi + ar, ni = lb.x * xi + lb.y * xr + ai; xr = nr; xi = ni; }
            float* xm = (float*)(ws + WS_XMETA); xm[g * 128 + p] = xr; xm[g * 128 + 64 + p] = xi;
        }
        if (F.bx >= 68 && F.bx < 196) {
            const int idx = (F.bx - 68) * 512 + F.tid, h = idx >> 14, e = (idx >> 7) & 127, d = idx & 127; const float lbv = ((const float*)(ws + WS_LBV))[h * HD + d]; float S = 0.f;
            for (int s = 0; s < NMETA; ++s) { const int cf = 512 + h * HD + d, cv = 1024 + h * HD + e;
                const float fp = (pm[(size_t)(0 * 16 + s) * 1536 + cf] + pm[(size_t)(1 * 16 + s) * 1536 + cf]) + (pm[(size_t)(2 * 16 + s) * 1536 + cf] + pm[(size_t)(3 * 16 + s) * 1536 + cf]);
                const float vv = (pm[(size_t)(0 * 16 + s) * 1536 + cv] + pm[(size_t)(1 * 16 + s) * 1536 + cv]) + (pm[(size_t)(2 * 16 + s) * 1536 + cv] + pm[(size_t)(3 * 16 + s) * 1536 + cv]);
                const float f = lbv + (1.0f - lbv) * sigmoidf_(fp); S = f * S + (1.0f - f) * vv; }
            ((float*)(ws + WS_SMETA))[idx] = S;
        }
        if (F.bx >= 64) for (int u = F.bx - 64; u < 16 * NCH; u += F.G - 64) hgrn_a_unit(F, u);
    }
    SEAM(2);
    if (IN(3)) {
        {
            const int bh = F.bx >> 4, e = (F.bx & 15) * 8 + (F.tid >> 6), d = (F.tid & 63) * 2, h = bh & 3;
            f32x2 S = *(const f32x2*)((const float*)(ws + WS_SMETA) + (size_t)(h * HD + e) * HD + d);
            const float* kv = (const float*)(ws + WS_KVT) + (size_t)bh * NCH * HD * HD + (size_t)e * HD + d; const float* dc = (const float*)(ws + WS_DEC) + (size_t)bh * NCH * HD + d;
            unsigned* sp = (unsigned*)((bf16_t*)(ws + WS_SPREV) + (size_t)bh * NCH * HD * HD + (size_t)e * HD + d);
            for (int c0 = 0; c0 < NCH; c0 += 8) { f32x2 kvv[8], dv[8];
#pragma unroll
                for (int j = 0; j < 8; ++j) { kvv[j] = *(const f32x2*)(kv + (size_t)(c0 + j) * HD * HD); dv[j] = *(const f32x2*)(dc + (size_t)(c0 + j) * HD); }
#pragma unroll
                for (int j = 0; j < 8; ++j) { sp[(size_t)(c0 + j) * (HD * HD / 2)] = pk2(S.x, S.y); S.x = S.x * dv[j].x + kvv[j].x; S.y = S.y * dv[j].y + kvv[j].y; } }
        }
        if (F.bx < 16) {
            const int b = F.bx >> 2, g = (F.bx & 3) * 8 + (F.tid >> 6), p = F.tid & 63; const f32x2 lc = ((const f32x2*)(ws + WS_LAMC))[g * SP + p];
            const float* xm = (const float*)(ws + WS_XMETA); float xr = xm[g * 128 + p], xi = xm[g * 128 + 64 + p];
            const float* se = (const float*)(ws + WS_SE) + ((size_t)g * 512 + b * 128) * 128 + p; bf16_t* ua = (bf16_t*)(ws + WS_UA) + ((size_t)g * 512 + b * 128) * UAK + 1024 + p;
            for (int c0 = 0; c0 < NCH; c0 += 8) { float er[8], ei[8];
#pragma unroll
                for (int j = 0; j < 8; ++j) { er[j] = se[(size_t)(c0 + j) * 128]; ei[j] = se[(size_t)(c0 + j) * 128 + 64]; }
#pragma unroll
                for (int j = 0; j < 8; ++j) { bf16_t* o = ua + (size_t)(c0 + j) * UAK; o[0] = (bf16_t)f2bf(xr); o[64] = (bf16_t)f2bf(xi);
                    const float nr = lc.x * xr - lc.y * xi + er[j], ni = lc.x * xi + lc.y * xr + ei[j]; xr = nr; xi = ni; } }
        }
    }
    SEAM(3);
    if (IN(4)) {
        { SchedS5Y S{(const char*)(ws + WS_UA), (const char*)(ws + WS_TZ), F.bx, F.G}; EpiS5Y E{(const bf16_t*)(ws + WS_UA), F.in[I_SD], (bf16_t*)(ws + WS_Y1)};
          pg8::gemm_phase<EpiS5Y, SchedS5Y, false>(F.lds, UAK, UAK, UAK, S, E, nullptr); }
        __syncthreads();
        for (int u = F.bx; u < 16 * NCH; u += F.G) hgrn_c_unit(F, u);
    }
    SEAM(4);
    if (IN(5)) {
        SchedStatic S{(const char*)(ws + WS_Y1), (const char*)(ws + WS_WGLU), T / 256, HW / 256, F.G, F.bx, (size_t)256 * HW * 2, (size_t)256 * HW * 2};
        EpiGlu E{(const bf16_t*)(ws + WS_Y1), (bf16_t*)(ws + WS_YS5)};
        pg8::gemm_phase<EpiGlu, SchedStatic, false>(F.lds, HW, HW, HW, S, E, nullptr);
    }
    SEAM(5);
    if (IN(6)) {
        SchedBranch S{(const char*)(ws + WS_YS5), (const char*)(ws + WS_YHG), (const char*)(ws + WS_WBS), (const char*)(ws + WS_WBH), F.G, F.bx};
        EpiBranch E{(const bf16_t*)(ws + WS_GATES), (bf16_t*)(ws + WS_MERGED)};
        pg8::gemm_phase<EpiBranch, SchedBranch, false>(F.lds, HW, HW, HW, S, E, nullptr);
    }
    SEAM(6);
    if (IN(7)) {
        SchedStatic S{(const char*)(ws + WS_MERGED), (const char*)(ws + WS_WOUT), T / 256, D / 256, F.G, F.bx, (size_t)256 * D * 2, (size_t)256 * D * 2};
        EpiOut E{F.in[I_X], (float*)(ws + WS_H1), (float*)(ws + WS_SSQ)};
        pg8::gemm_phase<EpiOut, SchedStatic, false>(F.lds, D, D, D, S, E, nullptr);
    }
    SEAM(7);
    if (IN(8)) {
        volatile LAS unsigned* hist = F.MISC + 16;
        if (F.tid < 32) hist[F.tid] = 0u;
        __syncthreads();
        const int lane = F.lane, tl = lane & 15, kg = lane >> 4; const float* g2 = F.in[I_N2G]; const bf16_t* wh = (const bf16_t*)(ws + WS_WRT); const bf16_t* wl = wh + NE * D;
        for (int tile = F.vcu * 8 + F.wave; tile < T / 16; tile += F.G * 8) {
            const int tok = tile * 16 + tl; const float* hrow = (const float*)(ws + WS_H1) + (size_t)tok * D; const f32x4* sq = (const f32x4*)((const float*)(ws + WS_SSQ) + (size_t)tok * 16);
            const f32x4 s0 = sq[0], s1 = sq[1], s2 = sq[2], s3 = sq[3];
            const float ss = ((s0[0] + s0[1]) + (s0[2] + s0[3])) + ((s1[0] + s1[1]) + (s1[2] + s1[3])) + ((s2[0] + s2[1]) + (s2[2] + s2[3])) + ((s3[0] + s3[1]) + (s3[2] + s3[3]));
            const float rstd = 1.0f / sqrtf(ss * (1.0f / D) + EPS);
            f32x4 a0 = (f32x4){0.f, 0.f, 0.f, 0.f}, a1 = a0; bf16_t* xo = (bf16_t*)(ws + WS_XN2) + (size_t)tok * D;
#pragma unroll 2
            for (int ks = 0; ks < 32; ++ks) { const int k = ks * 32 + kg * 8; const f32x4 h0 = *(const f32x4*)(hrow + k), h1 = *(const f32x4*)(hrow + k + 4), ga = *(const f32x4*)(g2 + k), gb = *(const f32x4*)(g2 + k + 4);
                float x[8] = {h0[0] * rstd * ga[0], h0[1] * rstd * ga[1], h0[2] * rstd * ga[2], h0[3] * rstd * ga[3], h1[0] * rstd * gb[0], h1[1] * rstd * gb[1], h1[2] * rstd * gb[2], h1[3] * rstd * gb[3]};
                unsigned hb[8]; float lr[8];
#pragma unroll
                for (int j = 0; j < 8; ++j) { hb[j] = f2bf(x[j]); lr[j] = x[j] - bf2f(hb[j]); }
                u32x4 hi4; hi4.x = hb[0] | (hb[1] << 16); hi4.y = hb[2] | (hb[3] << 16); hi4.z = hb[4] | (hb[5] << 16); hi4.w = hb[6] | (hb[7] << 16);
                u32x4 lo4; lo4.x = pk2(lr[0], lr[1]); lo4.y = pk2(lr[2], lr[3]); lo4.z = pk2(lr[4], lr[5]); lo4.w = pk2(lr[6], lr[7]);
                *(u32x4*)(xo + k) = hi4;
                const bf16x8 xh = __builtin_bit_cast(bf16x8, hi4), xl = __builtin_bit_cast(bf16x8, lo4);
                const bf16x8 wh0 = *(const bf16x8*)(wh + (size_t)tl * D + k), wh1 = *(const bf16x8*)(wh + (size_t)(16 + tl) * D + k), wl0 = *(const bf16x8*)(wl + (size_t)tl * D + k), wl1 = *(const bf16x8*)(wl + (size_t)(16 + tl) * D + k);
                a0 = __builtin_amdgcn_mfma_f32_16x16x32_bf16(wh0, xh, a0, 0, 0, 0); a0 = __builtin_amdgcn_mfma_f32_16x16x32_bf16(wh0, xl, a0, 0, 0, 0); a0 = __builtin_amdgcn_mfma_f32_16x16x32_bf16(wl0, xh, a0, 0, 0, 0);
                a1 = __builtin_amdgcn_mfma_f32_16x16x32_bf16(wh1, xh, a1, 0, 0, 0); a1 = __builtin_amdgcn_mfma_f32_16x16x32_bf16(wh1, xl, a1, 0, 0, 0); a1 = __builtin_amdgcn_mfma_f32_16x16x32_bf16(wl1, xh, a1, 0, 0, 0); }
            float lg[8]; int le[8]; const float* br = F.in[I_BR];
#pragma unroll
            for (int j = 0; j < 4; ++j) { le[j] = 4 * kg + j; le[4 + j] = 16 + 4 * kg + j; lg[j] = a0[j] + br[le[j]]; lg[4 + j] = a1[j] + br[le[4 + j]]; }
            float tv[4]; int te[4];
#pragma unroll
            for (int r = 0; r < 4; ++r) { float bv = -3.0e38f; int be = 1 << 20;
#pragma unroll
                for (int j = 0; j < 8; ++j) if (lg[j] > bv || (lg[j] == bv && le[j] < be)) { bv = lg[j]; be = le[j]; }
#pragma unroll
                for (int o = 16; o <= 32; o <<= 1) { const float ov = __shfl_xor(bv, o); const int oe = __shfl_xor(be, o); if (ov > bv || (ov == bv && oe < be)) { bv = ov; be = oe; } }
                tv[r] = bv; te[r] = be;
#pragma unroll
                for (int j = 0; j < 8; ++j) if (le[j] == be) lg[j] = -3.0e38f; }
            if (kg == 0) { const float e1 = __expf(tv[1] - tv[0]), e2 = __expf(tv[2] - tv[0]), e3 = __expf(tv[3] - tv[0]); const float inv = 1.0f / (1.0f + e1 + e2 + e3);
                *(f32x4*)((float*)(ws + WS_TOPW) + (size_t)tok * 4) = (f32x4){inv, e1 * inv, e2 * inv, e3 * inv};
                int* tp = (int*)(ws + WS_TOPE) + (size_t)tok * 4; tp[0] = te[0]; tp[1] = te[1]; tp[2] = te[2]; tp[3] = te[3];
#pragma unroll
                for (int r = 0; r < 4; ++r) __hip_atomic_fetch_add((LAS unsigned*)(hist + te[r]), 1u, __ATOMIC_RELAXED, __HIP_MEMORY_SCOPE_WORKGROUP); }
        }
        __syncthreads();
        if (F.tid < 32) __hip_atomic_fetch_add(F.ctl + CW_CNT + F.tid, hist[F.tid], __ATOMIC_RELAXED, __HIP_MEMORY_SCOPE_AGENT);
    }
    SEAM(8);
    if (IN(9)) {
        volatile LAS unsigned* sb = F.MISC + 16;
        LAS unsigned* base = (LAS unsigned*)F.lds; LAS unsigned* lcnt = base + 64; LAS unsigned* gb = base + 128; (void)sb;
        if (F.tid < 32) { lcnt[F.tid] = 0u; }
        if (F.tid == 0) { unsigned run = 0; for (int e = 0; e < NE; ++e) { const unsigned c = __hip_atomic_load(F.ctl + CW_CNT + e, __ATOMIC_RELAXED, __HIP_MEMORY_SCOPE_AGENT); base[e] = run * 256u; base[32 + e] = c; run += (c + 255u) >> 8; }
            base[96] = run; if (F.bx == 0) F.ctl[CW_NTILES] = run; }
        __syncthreads();
        if (F.bx == 0) { for (int e = 0; e < NE; ++e) { const unsigned t0 = base[e] >> 8, nt_ = (base[32 + e] + 255u) >> 8; for (unsigned t = F.tid; t < nt_; t += 512) ((int*)(ws + WS_TILEE))[t0 + t] = e; } }
        if (F.bx < NE) { const int e = F.bx; const unsigned c = base[32 + e], pe = ((c + 255u) >> 8) << 8; for (unsigned r = c + F.tid; r < pe; r += 512) { ((int*)(ws + WS_ROWTOK))[base[e] + r] = 0; ((int*)(ws + WS_ROWSLOT))[base[e] + r] = -1; } }
        for (int vb = F.bx; vb < T / 128; vb += F.G) {
            const int tok = vb * 128 + (F.tid >> 2), k = F.tid & 3; const int e = ((const int*)(ws + WS_TOPE))[(size_t)tok * 4 + k];
            const unsigned lr = __hip_atomic_fetch_add(lcnt + e, 1u, __ATOMIC_RELAXED, __HIP_MEMORY_SCOPE_WORKGROUP);
            __syncthreads();
            if (F.tid < 32) { gb[F.tid] = __hip_atomic_fetch_add(F.ctl + CW_FILL + F.tid, lcnt[F.tid], __ATOMIC_RELAXED, __HIP_MEMORY_SCOPE_AGENT); lcnt[F.tid] = 0u; }
            __syncthreads();
            const unsigned prow = base[e] + gb[e] + lr; ((int*)(ws + WS_ROWTOK))[prow] = tok; ((int*)(ws + WS_ROWSLOT))[prow] = tok * 4 + k;
            __syncthreads();
        }
    }
    SEAM(9);
    if (IN(10)) {
        const int ntiles = (int)__hip_atomic_load(F.ctl + CW_NTILES, __ATOMIC_RELAXED, __HIP_MEMORY_SCOPE_AGENT);
        SchedMoe S{(const char*)(ws + WS_XN2), (const char*)(ws + WS_WGU), (const int*)(ws + WS_TILEE), ntiles, 8, F.G, F.bx, (size_t)2048 * D * 2, (size_t)256 * D * 2, true};
        EpiMoe1 E{F.in[I_BGU], (const int*)(ws + WS_TILEE), (bf16_t*)(ws + WS_A2)};
        pg8::gemm_phase<EpiMoe1, SchedMoe, true>(F.lds, D, D, D, S, E, (const int*)(ws + WS_ROWTOK));
    }
    SEAM(10);
    if (IN(11)) {
        const int ntiles = (int)__hip_atomic_load(F.ctl + CW_NTILES, __ATOMIC_RELAXED, __HIP_MEMORY_SCOPE_AGENT);
        SchedMoe S{(const char*)(ws + WS_A2), (const char*)(ws + WS_WD), (const int*)(ws + WS_TILEE), ntiles, 4, F.G, F.bx, (size_t)D * DF * 2, (size_t)256 * DF * 2, false};
        EpiMoe2 E{F.in[I_BD], (const int*)(ws + WS_TILEE), (const int*)(ws + WS_ROWSLOT), (bf16_t*)(ws + WS_YS)};
        pg8::gemm_phase<EpiMoe2, SchedMoe, false>(F.lds, DF, DF, DF, S, E, nullptr);
    }
    SEAM(11);
    if (IN(12)) {
        const int lane = F.lane; const float* fg = F.in[I_FNG];
        for (int tok = F.vcu * 8 + F.wave; tok < T; tok += F.G * 8) {
            const f32x4 w = *(const f32x4*)((const float*)(ws + WS_TOPW) + (size_t)tok * 4); const float wk[4] = {w[0], w[1], w[2], w[3]};
            const f32x4* hr = (const f32x4*)((const float*)(ws + WS_H1) + (size_t)tok * D) + lane; f32x4 v[4]; float s = 0.f;
#pragma unroll
            for (int j = 0; j < 4; ++j) { v[j] = hr[64 * j];
#pragma unroll
                for (int k = 0; k < 4; ++k) { const u32x2 y = *((const u32x2*)((const bf16_t*)(ws + WS_YS) + ((size_t)tok * 4 + k) * D) + lane + 64 * j);
                    v[j].x += wk[k] * bf2f(y.x & 0xffffu); v[j].y += wk[k] * bf2f(y.x >> 16); v[j].z += wk[k] * bf2f(y.y & 0xffffu); v[j].w += wk[k] * bf2f(y.y >> 16); }
                s += (v[j].x * v[j].x + v[j].y * v[j].y) + (v[j].z * v[j].z + v[j].w * v[j].w); }
            const float rstd = 1.0f / sqrtf(wave_sum(s) * (1.0f / D) + EPS);
            f32x4* o = (f32x4*)(F.out + (size_t)tok * D) + lane;
#pragma unroll
            for (int j = 0; j < 4; ++j) { const f32x4 gg = ((const f32x4*)fg)[lane + 64 * j]; o[64 * j] = (f32x4){v[j].x * rstd * gg.x, v[j].y * rstd * gg.y, v[j].z * rstd * gg.z, v[j].w * rstd * gg.w}; }
        }
    }
#undef IN
#undef SEAM
}

extern "C" void kernel_launch(void* const* d_in, const int* in_sizes, int n_in, void* d_out, int out_size, void* d_ws, size_t ws_size, hipStream_t stream) {
    static int grid = 0;
    if (grid == 0) {
        if (n_in != 26 || in_sizes[0] != T * D || out_size != T * D || ws_size < WS_END) { fprintf(stderr, "kernel_launch: unexpected shapes (n_in %d, in0 %d, out %d, ws %zu < %zu)\n", n_in, n_in > 0 ? in_sizes[0] : -1, out_size, ws_size, (size_t)WS_END); grid = -1; return; }
        int dev = 0, cus = 0, per_cu = 0;
        if (hipGetDevice(&dev) != hipSuccess || hipDeviceGetAttribute(&cus, hipDeviceAttributeMultiprocessorCount, dev) != hipSuccess) { grid = -1; return; }
        if (hipFuncSetAttribute((const void*)mk_fwd, hipFuncAttributeMaxDynamicSharedMemorySize, LDS_BYTES) != hipSuccess) { fprintf(stderr, "kernel_launch: hipFuncSetAttribute failed\n"); grid = -1; return; }
        if (hipOccupancyMaxActiveBlocksPerMultiprocessor(&per_cu, (const void*)mk_fwd, 512, LDS_BYTES) != hipSuccess || per_cu < 1) fprintf(stderr, "kernel_launch: occupancy query reports %d\n", per_cu);
        (void)hipGetLastError();
        grid = cus;
        if (grid != 256) fprintf(stderr, "kernel_launch: %d CUs (built for 256)\n", grid);
    }
    if (grid < 0) return;
    (void)hipMemsetAsync((char*)d_ws + WS_CTL, 0, 1 * MiB, stream);
    Args a{};
    for (int i = 0; i < 26; ++i) a.in[i] = (const float*)d_in[i];
    a.out = (float*)d_out; a.ws = (unsigned char*)d_ws;
#if MK_PER_PHASE
    for (int p = 0; p < NPHASE; ++p) { a.ph_lo = p; a.ph_hi = p + 1; hipLaunchKernelGGL(mk_fwd, dim3(grid), dim3(512), LDS_BYTES, stream, a); }
#else
    a.ph_lo = 0; a.ph_hi = NPHASE; hipLaunchKernelGGL(mk_fwd, dim3(grid), dim3(512), LDS_BYTES, stream, a);
#endif
}
```

```cpp
#include <hip/hip_runtime.h>
#include <cstdio>
#include <cstdint>

#ifndef MK_PER_PHASE
#define MK_PER_PHASE 0
#endif

#ifndef MK_REP_MASK
#define MK_REP_MASK 0
#endif

#ifndef MK_STAMP
#define MK_STAMP -1
#endif
#define MK_STAMP_SCALE 1e-5f
#ifndef MK_VARIANT
#define MK_VARIANT 0
#endif

#define LAS __attribute__((address_space(3)))
#define GAS __attribute__((address_space(1)))
typedef unsigned short bf16_t;
typedef short bf16x8 __attribute__((ext_vector_type(8)));
typedef float f32x4 __attribute__((ext_vector_type(4)));
typedef float f32x2 __attribute__((ext_vector_type(2)));
typedef float f32x16 __attribute__((ext_vector_type(16)));
typedef unsigned u32x4 __attribute__((ext_vector_type(4)));
typedef unsigned u32x2 __attribute__((ext_vector_type(2)));
typedef int i32x4 __attribute__((ext_vector_type(4)));
typedef int i32x8 __attribute__((ext_vector_type(8)));

constexpr int T = 32768, D = 1024, NB = 4, SEQ = 8192, NCH = 128, CH = 64, NMETA = 16, INW = 4608;
constexpr int SG = 32, SH = 16, SP = 64;
constexpr int HH = 4, HD = 128, HW = 512;
constexpr int NE = 32, TOPK = 4, DF = 1024;
constexpr int UAK = 1152;
constexpr float EPS = 1e-6f;
constexpr int MAXTILES = 544;

constexpr size_t MiB = 1u << 20, KiB = 1024;
constexpr size_t WS_CTL = 0;
constexpr size_t WS_LBV = 1 * MiB, WS_LAMB = 1 * MiB + 4 * KiB, WS_LAMC = 1 * MiB + 20 * KiB, WS_XMETA = 1 * MiB + 36 * KiB;
constexpr size_t WS_BBAR = 1 * MiB + 64 * KiB, WS_WRT = 1 * MiB + 320 * KiB, WS_PMR = 1 * MiB + 512 * KiB  ;
constexpr size_t WS_KCONV = 2 * MiB, WS_SMETA = 3 * MiB;
constexpr size_t WS_WIN = 4 * MiB, WS_WGLU = 13 * MiB, WS_WBS = 14 * MiB, WS_WBH = 15 * MiB, WS_WOUT = 16 * MiB, WS_WGU = 18 * MiB, WS_WD = 146 * MiB;
constexpr size_t WS_TZ = 210 * MiB, WS_WE = 282 * MiB, WS_XN = 298 * MiB, WS_UA = 362 * MiB, WS_Q = 398 * MiB, WS_LOGF = 430 * MiB, WS_V = 494 * MiB;
constexpr size_t WS_GS = 526 * MiB, WS_GATES = 558 * MiB, WS_KVT = 686 * MiB, WS_SPREV = 814 * MiB, WS_SE = 878 * MiB, WS_DEC = 886 * MiB;
constexpr size_t WS_Y1 = 888 * MiB, WS_YHG = 920 * MiB, WS_YS5 = 952 * MiB, WS_PMETA = 984 * MiB  , WS_END = 986 * MiB;
constexpr size_t WS_BCUM = 298 * MiB;
constexpr size_t WS_MERGED = 686 * MiB, WS_XN2 = 210 * MiB, WS_H1 = 274 * MiB, WS_SSQ = 402 * MiB, WS_TOPE = 404 * MiB, WS_TOPW = 404 * MiB + 512 * KiB;
constexpr size_t WS_ROWTOK = 405 * MiB, WS_ROWSLOT = 406 * MiB, WS_TILEE = 407 * MiB, WS_A2 = 408 * MiB, WS_YS = 680 * MiB;
constexpr int CW_CNT = 64, CW_FILL = 128, CW_NTILES = 192, CW_BAR = 4096;

constexpr int RING_BYTES = 131072, GOFF_LDS = RING_BYTES, MISC_OFF = RING_BYTES + 16384 + 256, LDS_BYTES = 155648;

__device__ __forceinline__ unsigned f2bf(float f) { unsigned u = __builtin_bit_cast(unsigned, f); return (u + 0x7fffu + ((u >> 16) & 1u)) >> 16; }
__device__ __forceinline__ float bf2f(unsigned b) { return __builtin_bit_cast(float, b << 16); }
__device__ __forceinline__ unsigned pk2(float lo, float hi) { return f2bf(lo) | (f2bf(hi) << 16); }
__device__ __forceinline__ unsigned cvt_pk_bf16(float lo, float hi) { unsigned r; asm volatile("v_cvt_pk_bf16_f32 %0, %1, %2" : "=v"(r) : "v"(lo), "v"(hi)); return r; }
__device__ __forceinline__ unsigned pk4_fp8(float a, float b, float c, float d) {
    a = fminf(fmaxf(a, -448.f), 448.f); b = fminf(fmaxf(b, -448.f), 448.f); c = fminf(fmaxf(c, -448.f), 448.f); d = fminf(fmaxf(d, -448.f), 448.f);
    int w = 0; w = __builtin_amdgcn_cvt_pk_fp8_f32(a, b, w, false); w = __builtin_amdgcn_cvt_pk_fp8_f32(c, d, w, true); return (unsigned)w; }
__device__ __forceinline__ float sigmoidf_(float x) { return 1.0f / (1.0f + __expf(-x)); }
__device__ __forceinline__ float wave_sum(float v) {
#pragma unroll
    for (int o = 1; o < 64; o <<= 1) v += __shfl_xor(v, o);
    return v;
}
#define LDS_WAIT() asm volatile("s_waitcnt lgkmcnt(0)" ::: "memory")
#define VM_WAIT() asm volatile("s_waitcnt vmcnt(0)" ::: "memory")

#define XB_TMO      128
#define XB_XCNT(j)  (256  + 64 * (j))
#define XB_XSUB(j)  (1280 + 64 * (j))
#define XB_XGEN(j)  (2304 + 64 * (j))
#define XB_TOP      3328
#define XB_TOPGEN   3392
#define XCD_BAR_WORDS 3456
#define XB_SPIN_CAP (1u << 22)
__device__ __forceinline__ unsigned xb_ld(unsigned* p)              { return __hip_atomic_load(p, __ATOMIC_RELAXED, __HIP_MEMORY_SCOPE_AGENT); }
__device__ __forceinline__ unsigned xb_add(unsigned* p, unsigned v) { return __hip_atomic_fetch_add(p, v, __ATOMIC_RELAXED, __HIP_MEMORY_SCOPE_AGENT); }
__device__ __forceinline__ unsigned xb_xcc_id() { return (unsigned)__builtin_amdgcn_s_getreg((3 << 11) | 20) & 0xFu; }
#define XB_SPIN(cond, bar) do { unsigned _sp = 0; while (cond) { __builtin_amdgcn_s_sleep(1); \
    if ((++_sp & 255u) == 0u) { if (xb_ld(&(bar)[XB_TMO])) break; if (_sp > XB_SPIN_CAP) { atomicAdd(&(bar)[XB_TMO], 1u); break; } } } } while (0)
struct XcdBarrier { unsigned* bar; unsigned x; volatile LAS unsigned* st; };
__device__ __forceinline__ XcdBarrier xcd_barrier_post(unsigned* bar, volatile LAS unsigned* st) {
    XcdBarrier b; b.bar = bar; b.x = xb_xcc_id(); b.st = st;
    if (threadIdx.x == 0) (void)xb_add(&bar[XB_XCNT(b.x)], 1u);
    return b;
}
__device__ __forceinline__ void xcd_barrier_complete(unsigned* bar, unsigned x, unsigned& nloc, unsigned& nx) {
    const unsigned G = gridDim.x * gridDim.y * gridDim.z;
    unsigned sum, cnt, mine, sp = 0u;
    for (;;) {
        sum = 0u; cnt = 0u; mine = 0u;
#pragma unroll
        for (unsigned j = 0; j < 16; ++j) { const unsigned c = xb_ld(&bar[XB_XCNT(j)]); sum += c; cnt += (c > 0u) ? 1u : 0u; mine = (j == x) ? c : mine; }
        if (sum == G) break;
        __builtin_amdgcn_s_sleep(1);
        if ((++sp & 255u) == 0u) { if (xb_ld(&bar[XB_TMO])) break; if (sp > XB_SPIN_CAP) { atomicAdd(&bar[XB_TMO], 1u); break; } }
    }
    nloc = mine > 0u ? mine : 1u; nx = cnt > 0u ? cnt : 1u;
}
__device__ __forceinline__ void xcd_barrier(const XcdBarrier& b) {
    asm volatile("s_waitcnt vmcnt(0)" ::: "memory");
    __syncthreads();
    if (threadIdx.x == 0) {
        unsigned* bar = b.bar;
        __builtin_amdgcn_s_waitcnt(0);
        unsigned nloc = b.st[0], nx = b.st[1];
        if (nloc == 0u) { xcd_barrier_complete(bar, b.x, nloc, nx); b.st[0] = nloc; b.st[1] = nx; }
        const unsigned old = xb_add(&bar[XB_XSUB(b.x)], 1u);
        const unsigned gen = old / nloc;
        if (old + 1u == (gen + 1u) * nloc) {
            __builtin_amdgcn_fence(__ATOMIC_RELEASE, "agent");
            asm volatile("s_waitcnt vmcnt(0)" ::: "memory");
            const unsigned og = xb_add(&bar[XB_TOP], 1u);
            const unsigned tg = og / nx;
            if (og + 1u == (tg + 1u) * nx) xb_add(&bar[XB_TOPGEN], 1u);
            else XB_SPIN(xb_ld(&bar[XB_TOPGEN]) == tg, bar);
            __builtin_amdgcn_fence(__ATOMIC_ACQUIRE, "agent");
            xb_add(&bar[XB_XGEN(b.x)], 1u);
            asm volatile("s_waitcnt vmcnt(0)" ::: "memory");
        } else {
            XB_SPIN(xb_ld(&bar[XB_XGEN(b.x)]) == gen, bar);
            __builtin_amdgcn_fence(__ATOMIC_ACQUIRE, "agent");
            asm volatile("s_waitcnt vmcnt(0)" ::: "memory");
        }
    }
    __syncthreads();
}

namespace pg8 {
constexpr int BM = 256, BK = 64, HALF = 128, HTB = HALF * BK * 2, STAGE_BYTES = 8 * HTB, NXCD = 8, WGM = 8;
__device__ __forceinline__ int lds_byte(int r, int c) { const int st = (r >> 4) * 2 + (c >> 5), rr = r & 15, cc = c & 31, ob = rr * 64 + cc * 2; return st * 1024 + (ob ^ (((ob >> 9) & 1) << 5)); }
__device__ __forceinline__ void stage_rc(int b, int& R, int& C) { const int st = b / 1024, sb = b % 1024, swz = sb ^ (((sb >> 9) & 1) << 5); R = (st >> 1) * 16 + swz / 64; C = (st & 1) * 32 + (swz % 64) / 2; }
__device__ __forceinline__ int perm32(int rho) { const int n = rho >> 4, i = rho & 15; return 8 * (i >> 2) + 4 * n + (i & 3); }

struct Unit { int pm, pn, aux; const char* a; const char* b; };

__device__ __forceinline__ bool static_tile(int L, int nM, int nN, int& pm, int& pn) {
    const int nwg = nM * nN; if (L >= nwg) return false;
    int wgid = L; { const int q = nwg / NXCD, r = nwg % NXCD, xcd = wgid % NXCD, off = wgid / NXCD; wgid = (xcd < r ? xcd * (q + 1) : r * (q + 1) + (xcd - r) * q) + off; }
    const int nig = WGM * nN, gid = wgid / nig, fm = gid * WGM, gsz = (nM - fm) < WGM ? (nM - fm) : WGM;
    pm = fm + ((wgid % nig) % gsz); pn = (wgid % nig) / gsz; return true;
}

constexpr int F8_WSH = 6;
template <class Epi, class Sched, bool GATHER, bool F8 = false>
__device__ __forceinline__ void gemm_phase(LAS unsigned char* lds, const int K, const int lda, const int ldb, const Sched& S, const Epi& E, const int* __restrict__ rowidx, const int pv = 0) {
    const int tid = threadIdx.x, wid = __builtin_amdgcn_readfirstlane(tid >> 6), lane = tid & 63, wr = wid >> 2, wc = wid & 3, fr = lane & 15, fq = lane >> 4;
    constexpr int ES = F8 ? 1 : 2;
    const int nt = K / (F8 ? 128 : BK);
#define PG8_SW(r) ((((r) >> 1) & 7) ^ (((((r) >> 2) ^ ((r) >> 3)) & 1) * (F8 ? 2 : 1)))
    unsigned voffA[2], voffB[2]; int gR[2], gC[2];
#pragma unroll
    for (int i = 0; i < 2; ++i) { const int q = tid * 16 + i * 8192, r = (q >> 7) & 15; const int R = (q >> 11) * 16 + r, C = (((q >> 4) & 7) ^ PG8_SW(r)) * 16;
        const int Rb = Epi::PERM ? ((R & ~31) + perm32(R & 31)) : R;
        voffA[i] = (unsigned)(R * lda * ES + C); voffB[i] = (unsigned)(Rb * ldb * ES + C); gR[i] = R; gC[i] = C; }
    const size_t kstep = (size_t)(BK * 2);
    const size_t hstepA = (size_t)HALF * lda * ES, hstepB = (size_t)HALF * ldb * ES;
    const unsigned ldsw = (unsigned)wid * 1024u;
    const int sx = PG8_SW(fr), ck0 = F8 ? 2 * fq : fq, ck1 = F8 ? 2 * fq + 1 : 4 + fq;
    const int aoff0 = wr * 8192 + fr * 128 + 16 * (ck0 ^ sx), aoff1 = wr * 8192 + fr * 128 + 16 * (ck1 ^ sx), boff0 = wc * 4096 + fr * 128 + 16 * (ck0 ^ sx), boff1 = wc * 4096 + fr * 128 + 16 * (ck1 ^ sx);
#define PG8_SA(b, h) (((b) * 2 + (h)) * HTB)
#define PG8_SB(b, h) ((4 + (b) * 2 + (h)) * HTB)
#define PG8_GLDS(src, dstoff) do { if (!(pv & 32)) __builtin_amdgcn_global_load_lds((const unsigned*)(src), (LAS unsigned*)(lds + (dstoff)), 16, 0, 0); } while (0)
#define PG8_STAGEB(bufoff, gbase) do { PG8_GLDS((const char*)(gbase) + voffB[0], (bufoff) + ldsw); PG8_GLDS((const char*)(gbase) + voffB[1], (bufoff) + ldsw + 8192); } while (0)
#define PG8_STAGEA(bufoff, gbase, h, SET) do { if constexpr (GATHER) { const u32x2 o_ = *(const LAS u32x2*)(lds + GOFF_LDS + ((SET) * 2 + (h)) * 4096 + tid * 8); \
        PG8_GLDS((const char*)(gbase) + o_.x, (bufoff) + ldsw); PG8_GLDS((const char*)(gbase) + o_.y, (bufoff) + ldsw + 8192); } \
        else { PG8_GLDS((const char*)(gbase) + (h) * hstepA + voffA[0], (bufoff) + ldsw); PG8_GLDS((const char*)(gbase) + (h) * hstepA + voffA[1], (bufoff) + ldsw + 8192); } } while (0)
#define PG8_LDA(dst, b, h) do { _Pragma("unroll") for (int m = 0; m < 4; ++m) { dst[m][0] = *(const LAS bf16x8*)(lds + PG8_SA(b, h) + aoff0 + m * 2048); dst[m][1] = *(const LAS bf16x8*)(lds + PG8_SA(b, h) + aoff1 + m * 2048); } } while (0)
#define PG8_LDB(dst, b, h) do { _Pragma("unroll") for (int n = 0; n < 2; ++n) { dst[n][0] = *(const LAS bf16x8*)(lds + PG8_SB(b, h) + boff0 + n * 2048); dst[n][1] = *(const LAS bf16x8*)(lds + PG8_SB(b, h) + boff1 + n * 2048); } } while (0)
#define PG8_CAT(lo, hi) __builtin_shufflevector(__builtin_bit_cast(i32x4, lo), __builtin_bit_cast(i32x4, hi), 0, 1, 2, 3, 4, 5, 6, 7)
#define PG8_MMA(ai, bj, At, Bt) do { if (pv & 16) { asm volatile("" :: "v"(At[0][0]), "v"(At[1][0]), "v"(At[2][0]), "v"(At[3][0]), "v"(At[0][1]), "v"(At[1][1]), "v"(At[2][1]), "v"(At[3][1]), "v"(Bt[0][0]), "v"(Bt[0][1]), "v"(Bt[1][0]), "v"(Bt[1][1])); break; } __builtin_amdgcn_s_setprio(1); _Pragma("unroll") for (int m = 0; m < 4; ++m) _Pragma("unroll") for (int n = 0; n < 2; ++n) { \
        if constexpr (F8) { const i32x8 b8_ = PG8_CAT(Bt[n][0], Bt[n][1]), a8_ = PG8_CAT(At[m][0], At[m][1]); \
            asm volatile("v_mfma_scale_f32_16x16x128_f8f6f4 %0, %1, %2, %0, %3, %4 op_sel_hi:[0,0,0]" : "+v"(acc[ai][bj][m][n]) : "v"(b8_), "v"(a8_), "v"(sc_w), "v"(sc_x)); } \
        else { _Pragma("unroll") for (int k = 0; k < 2; ++k) acc[ai][bj][m][n] = __builtin_amdgcn_mfma_f32_16x16x32_bf16(Bt[n][k], At[m][k], acc[ai][bj][m][n], 0, 0, 0); } } __builtin_amdgcn_s_setprio(0); } while (0)
#define PG8_WAIT_V(n) asm volatile("s_waitcnt vmcnt(" #n ")" ::: "memory")
#define PG8_WAIT_L(n) asm volatile("s_waitcnt lgkmcnt(" #n ")" ::: "memory")
#define PG8_BAR __builtin_amdgcn_s_barrier()
#define PG8_SCHED __builtin_amdgcn_sched_barrier(0)
#define PG8_GOFFS(SET, U) do { if constexpr (GATHER) { _Pragma("unroll") for (int h_ = 0; h_ < 2; ++h_) { u32x2 o_; \
        o_.x = (unsigned)rowidx[(U).aux + h_ * HALF + gR[0]] * (unsigned)(lda * ES) + (unsigned)gC[0]; o_.y = (unsigned)rowidx[(U).aux + h_ * HALF + gR[1]] * (unsigned)(lda * ES) + (unsigned)gC[1]; \
        *(LAS u32x2*)(lds + GOFF_LDS + ((SET) * 2 + h_) * 4096 + tid * 8) = o_; } } } while (0)
    const int sc_w = 127 - F8_WSH, sc_x = 127; (void)sc_w; (void)sc_x;
    Unit cur, nxt; int ui = 0;
    if (!S.next(0, cur)) return;
    f32x4 acc[2][2][4][2];
#pragma unroll
    for (int a = 0; a < 2; ++a)
#pragma unroll
        for (int b = 0; b < 2; ++b)
#pragma unroll
            for (int m = 0; m < 4; ++m)
#pragma unroll
                for (int n = 0; n < 2; ++n) acc[a][b][m][n] = (f32x4){0.f, 0.f, 0.f, 0.f};
    bf16x8 At[4][2], B0[2][2], B1[2][2];
    PG8_GOFFS(0, cur);
    const char* cA = cur.a; const char* cB = cur.b;
    PG8_STAGEB(PG8_SB(0, 0), cB); PG8_STAGEB(PG8_SB(0, 1), cB + hstepB); PG8_STAGEA(PG8_SA(0, 0), cA, 0, 0); PG8_STAGEA(PG8_SA(0, 1), cA, 1, 0);
    if (wr == 1) PG8_BAR;
    PG8_WAIT_V(2); PG8_BAR;
    PG8_STAGEB(PG8_SB(1, 0), cB + kstep); PG8_STAGEA(PG8_SA(1, 0), cA + kstep, 0, 0); PG8_STAGEB(PG8_SB(1, 1), cB + hstepB + kstep);
    PG8_WAIT_V(6); PG8_BAR;
    for (;;) {
        const bool has_next = S.next(ui + 1, nxt);
        const int cs = ui & 1; if (has_next) PG8_GOFFS(cs ^ 1, nxt);
        const char* nA = has_next ? nxt.a : cA; const char* nB = has_next ? nxt.b : cB;
#pragma unroll 1
        for (int t = 0; t < nt; t += 2) {
            const bool last = (t == nt - 2);
            const char* a1 = cA + (size_t)(t + 1) * kstep;
            const char* a2 = last ? nA : cA + (size_t)(t + 2) * kstep; const char* b2 = last ? nB : cB + (size_t)(t + 2) * kstep;
            const char* a3 = a2 + kstep; const char* b3 = b2 + kstep;
            const int s2 = (last && has_next) ? (cs ^ 1) : cs;
            PG8_LDB(B0, 0, 0); PG8_LDB(B1, 0, 1); PG8_SCHED; PG8_LDA(At, 0, 0); PG8_STAGEA(PG8_SA(1, 1), a1, 1, cs);
            PG8_WAIT_V(8); PG8_WAIT_L(0); PG8_BAR; PG8_MMA(0, 0, At, B0); PG8_MMA(0, 1, At, B1); PG8_BAR; PG8_SCHED;
            PG8_LDA(At, 0, 1); PG8_STAGEB(PG8_SB(0, 0), b2); PG8_STAGEB(PG8_SB(0, 1), b2 + hstepB); PG8_STAGEA(PG8_SA(0, 0), a2, 0, s2);
            PG8_WAIT_V(8); PG8_WAIT_L(0); PG8_BAR; PG8_MMA(1, 0, At, B0); PG8_MMA(1, 1, At, B1); PG8_BAR; PG8_SCHED;
            PG8_LDB(B0, 1, 0); PG8_LDB(B1, 1, 1); PG8_SCHED; PG8_LDA(At, 1, 0); PG8_STAGEA(PG8_SA(0, 1), a2, 1, s2);
            PG8_WAIT_V(8); PG8_WAIT_L(0); PG8_BAR; PG8_MMA(0, 0, At, B0); PG8_MMA(0, 1, At, B1); PG8_BAR; PG8_SCHED;
            PG8_LDA(At, 1, 1); PG8_STAGEB(PG8_SB(1, 0), b3); PG8_STAGEB(PG8_SB(1, 1), b3 + hstepB); PG8_STAGEA(PG8_SA(1, 0), a3, 0, s2);
            PG8_WAIT_V(8); PG8_WAIT_L(0); PG8_BAR; PG8_MMA(1, 0, At, B0); PG8_MMA(1, 1, At, B1); PG8_BAR; PG8_SCHED;
        }
        if constexpr (F8) asm volatile("s_nop 15\n\ts_nop 15" ::: "memory");
        if (wr == 0) PG8_BAR;
        int fr_e = fr, fq_e = fq; asm volatile("" : "+v"(fr_e), "+v"(fq_e));
        const bool keep = E(acc, cur, wr, wc, fr_e, fq_e);
        if (!has_next) break;
        if (!keep) {
#pragma unroll
            for (int a = 0; a < 2; ++a)
#pragma unroll
                for (int b = 0; b < 2; ++b)
#pragma unroll
                    for (int m = 0; m < 4; ++m)
#pragma unroll
                        for (int n = 0; n < 2; ++n) acc[a][b][m][n] = (f32x4){0.f, 0.f, 0.f, 0.f};
        }
        cur = nxt; cA = nA; cB = nB; ++ui;
        if (wr == 1) PG8_BAR;
    }
    PG8_WAIT_V(0);
    PG8_BAR;
#undef PG8_SW
#undef PG8_SA
#undef PG8_SB
#undef PG8_GLDS
#undef PG8_STAGEA
#undef PG8_STAGEB
#undef PG8_LDA
#undef PG8_LDB
#undef PG8_MMA
#undef PG8_CAT
#undef PG8_WAIT_V
#undef PG8_WAIT_L
#undef PG8_BAR
#undef PG8_SCHED
#undef PG8_GOFFS
}
}
using pg8::Unit;

struct Frame {
    LAS unsigned char* lds; volatile LAS unsigned* MISC; unsigned* ctl; unsigned char* ws;
    int tid, lane, wave, vcu, G, bx;
    const float* in[26]; float* out;
};
enum { I_X = 0, I_META, I_N1G, I_WIN, I_LRE, I_LIM, I_LDT, I_BRE, I_BIM, I_CRE, I_CIM, I_SD, I_WGLU, I_LBL, I_HNG, I_WBS, I_WBH, I_WOUT, I_N2G, I_WR, I_BR, I_WGU, I_BGU, I_WD, I_BD, I_FNG };

struct SchedStatic {
    const char* A; const char* B; int nM, nN, G, c; size_t ta, tb; int var = 0;
    __device__ __forceinline__ bool next(int i, Unit& u) const { int pm, pn; if (!pg8::static_tile(i * G + c, nM, nN, pm, pn)) return false; u.pm = pm; u.pn = pn; u.aux = 0; u.a = A + (size_t)pm * ta; u.b = B + (size_t)pn * tb; if (var & 8) { u.a = A; u.b = B; } return true; }
};
struct SchedS5E {
    const char* UA; const char* WE; int c;
    __device__ __forceinline__ bool next(int i, Unit& u) const { if (i > 0 || c >= 64) return false; const int x = c & 7, r = c >> 3, g = x * 4 + (r >> 1), pm = r & 1; u.pm = pm; u.pn = 0; u.aux = g;
        u.a = UA + ((size_t)g * 512 + pm * 256) * UAK * 2; u.b = WE + (size_t)g * 256 * 1024 * 2; return true; }
};
struct SchedS5Y {
    const char* UA; const char* TZ; int c, G;
    __device__ __forceinline__ bool next(int i, Unit& u) const { if (i > 0 || G != 256) { const int L = i * G + c; if (G == 256 || L >= 256) return false; const int g = L >> 3; u.pm = (L >> 2) & 1; u.pn = L & 3; u.aux = g;
            u.a = UA + ((size_t)g * 512 + u.pm * 256) * UAK * 2; u.b = TZ + ((size_t)g * 1024 + u.pn * 256) * UAK * 2; return true; }
        const int x = c & 7, r = c >> 3, g = x + 8 * (r >> 3), pm = (r >> 2) & 1, pn = r & 3; u.pm = pm; u.pn = pn; u.aux = g;
        u.a = UA + ((size_t)g * 512 + pm * 256) * UAK * 2; u.b = TZ + ((size_t)g * 1024 + pn * 256) * UAK * 2; return true; }
};
struct SchedBranch {
    const char* A0; const char* A1; const char* B0; const char* B1; int G, c;
    __device__ __forceinline__ bool next(int i, Unit& u) const { int pm, pn; if (!pg8::static_tile((i >> 1) * G + c, T / 256, 4, pm, pn)) return false; const int part = i & 1; u.pm = pm; u.pn = pn; u.aux = part;
        u.a = (part ? A1 : A0) + (size_t)pm * 256 * HW * 2; u.b = (part ? B1 : B0) + (size_t)pn * 256 * HW * 2; return true; }
};
struct SchedMoe {
    const char* A; const char* W; const int* tile_e; int ntiles, NN, G, c; size_t wexp, wtile; bool gather; int var;
    __device__ __forceinline__ bool next(int i, Unit& u) const { int ti, pn;
        if ((G & 7) == 0) { const int x = c & 7, j = i * (G >> 3) + (c >> 3), ml = j / NN; pn = j - ml * NN; ti = ml * 8 + x; }
        else { const int L = i * G + c; ti = L / NN; pn = L - ti * NN; }
        if (ti >= ntiles) return false; const int e = tile_e[ti];
        u.pm = ti; u.pn = pn; u.aux = gather ? ti * 256 : e; u.a = gather ? A : A + (size_t)ti * 256 * DF; u.b = W + (size_t)e * wexp + (size_t)pn * wtile;
        if (var & 8) { u.a = A; u.b = W; if (gather) u.aux = 0; } return true; }
};

__device__ __forceinline__ u32x4 pack8(const f32x4& v0, const f32x4& v1) { u32x4 w; w.x = cvt_pk_bf16(v0[0], v0[1]); w.y = cvt_pk_bf16(v0[2], v0[3]); w.z = cvt_pk_bf16(v1[0], v1[1]); w.w = cvt_pk_bf16(v1[2], v1[3]); return w; }

struct EpiInProj {
    static constexpr bool PERM = true;
    bf16_t *UA, *Q, *V, *GS, *GATES; float* LOGF; const float* LBV;
    __device__ __forceinline__ bool operator()(f32x4 (&acc)[2][2][4][2], const Unit& u, int wr, int wc, int fr, int fq) const {
        const int kind = u.pn >> 1;
#pragma unroll
        for (int ai = 0; ai < 2; ++ai)
#pragma unroll
            for (int m = 0; m < 4; ++m) { const int tok = u.pm * 256 + ai * 128 + wr * 64 + m * 16 + fr;
#pragma unroll
                for (int bj = 0; bj < 2; ++bj) { const int col = u.pn * 256 + bj * 128 + wc * 32 + 8 * fq; f32x4 v0 = acc[ai][bj][m][0], v1 = acc[ai][bj][m][1];
                    if (kind == 0) { const int g = col >> 4, hh = col & 15; *(u32x4*)(UA + ((size_t)(g * 512 + (tok >> 6)) * UAK + (tok & 63) * 16 + hh)) = pack8(v0, v1); }
                    else if (kind == 1) {
#pragma unroll
                        for (int j = 0; j < 4; ++j) { v0[j] = v0[j] * sigmoidf_(v0[j]); v1[j] = v1[j] * sigmoidf_(v1[j]); }
                        *(u32x4*)(Q + (size_t)tok * HW + (col - 512)) = pack8(v0, v1); }
                    else if (kind == 2) { const int c2 = col - 1024; const f32x4 l0 = *(const f32x4*)(LBV + c2), l1 = *(const f32x4*)(LBV + c2 + 4);
#pragma unroll
                        for (int j = 0; j < 4; ++j) { v0[j] = __logf(l0[j] + (1.f - l0[j]) * sigmoidf_(v0[j])); v1[j] = __logf(l1[j] + (1.f - l1[j]) * sigmoidf_(v1[j])); }
                        *(f32x4*)(LOGF + (size_t)tok * HW + c2) = v0; *(f32x4*)(LOGF + (size_t)tok * HW + c2 + 4) = v1; }
                    else if (kind == 3) { *(u32x4*)(V + (size_t)tok * HW + (col - 1536)) = pack8(v0, v1); }
                    else if (kind == 4) {
#pragma unroll
                        for (int j = 0; j < 4; ++j) { v0[j] = v0[j] * sigmoidf_(v0[j]); v1[j] = v1[j] * sigmoidf_(v1[j]); }
                        *(u32x4*)(GS + (size_t)tok * HW + (col - 2048)) = pack8(v0, v1); }
                    else {
#pragma unroll
                        for (int j = 0; j < 4; ++j) { v0[j] = sigmoidf_(v0[j]); v1[j] = sigmoidf_(v1[j]); }
                        *(u32x4*)(GATES + (size_t)tok * 2048 + (col - 2560)) = pack8(v0, v1); }
                } }
        return false;
    }
};
struct EpiS5E {
    static constexpr bool PERM = false;
    float* SE;
    __device__ __forceinline__ bool operator()(f32x4 (&acc)[2][2][4][2], const Unit& u, int wr, int wc, int fr, int fq) const {
#pragma unroll
        for (int ai = 0; ai < 2; ++ai)
#pragma unroll
            for (int m = 0; m < 4; ++m) { const int r = u.pm * 256 + ai * 128 + wr * 64 + m * 16 + fr; float* rowp = SE + ((size_t)u.aux * 512 + r) * 128 + wc * 32 + 4 * fq;
#pragma unroll
                for (int n = 0; n < 2; ++n) *(f32x4*)(rowp + n * 16) = acc[ai][0][m][n]; }
        return false;
    }
};
struct EpiS5Y {
    static constexpr bool PERM = true;
    const bf16_t* UA; const float* SD; bf16_t* Y1;
    __device__ __forceinline__ bool operator()(f32x4 (&acc)[2][2][4][2], const Unit& u, int wr, int wc, int fr, int fq) const {
        const int g = u.aux;
#pragma unroll
        for (int ai = 0; ai < 2; ++ai)
#pragma unroll
            for (int m = 0; m < 4; ++m) { const int r = u.pm * 256 + ai * 128 + wr * 64 + m * 16 + fr; const int b = r >> 7, c = r & 127;
#pragma unroll
                for (int bj = 0; bj < 2; ++bj) { const int col = u.pn * 256 + bj * 128 + wc * 32 + 8 * fq; const int t = col >> 4, hh = col & 15;
                    const u32x4 uu = *(const u32x4*)(UA + ((size_t)(g * 512 + r) * UAK + col));
                    const f32x4 d0 = *(const f32x4*)(SD + g * 16 + hh), d1 = *(const f32x4*)(SD + g * 16 + hh + 4);
                    f32x4 v0 = acc[ai][bj][m][0], v1 = acc[ai][bj][m][1];
                    v0[0] += d0[0] * bf2f(uu.x & 0xffffu); v0[1] += d0[1] * bf2f(uu.x >> 16); v0[2] += d0[2] * bf2f(uu.y & 0xffffu); v0[3] += d0[3] * bf2f(uu.y >> 16);
                    v1[0] += d1[0] * bf2f(uu.z & 0xffffu); v1[1] += d1[1] * bf2f(uu.z >> 16); v1[2] += d1[2] * bf2f(uu.w & 0xffffu); v1[3] += d1[3] * bf2f(uu.w >> 16);
#pragma unroll
                    for (int j = 0; j < 4; ++j) { float x = v0[j]; v0[j] = x * sigmoidf_(1.5957691216f * (x + 0.044715f * x * x * x)); x = v1[j]; v1[j] = x * sigmoidf_(1.5957691216f * (x + 0.044715f * x * x * x)); }
                    const int tok = b * SEQ + c * 64 + t;
                    *(u32x4*)(Y1 + (size_t)tok * HW + g * 16 + hh) = pack8(v0, v1); } }
        return false;
    }
};
struct EpiGlu {
    static constexpr bool PERM = true;
    const bf16_t* Y1; bf16_t* YS5;
    __device__ __forceinline__ bool operator()(f32x4 (&acc)[2][2][4][2], const Unit& u, int wr, int wc, int fr, int fq) const {
#pragma unroll
        for (int ai = 0; ai < 2; ++ai)
#pragma unroll
            for (int m = 0; m < 4; ++m) { const int row = u.pm * 256 + ai * 128 + wr * 64 + m * 16 + fr;
#pragma unroll
                for (int bj = 0; bj < 2; ++bj) { const int col = u.pn * 256 + bj * 128 + wc * 32 + 8 * fq; const u32x4 y = *(const u32x4*)(Y1 + (size_t)row * HW + col);
                    f32x4 v0 = acc[ai][bj][m][0], v1 = acc[ai][bj][m][1];
                    v0[0] = bf2f(y.x & 0xffffu) * sigmoidf_(v0[0]); v0[1] = bf2f(y.x >> 16) * sigmoidf_(v0[1]); v0[2] = bf2f(y.y & 0xffffu) * sigmoidf_(v0[2]); v0[3] = bf2f(y.y >> 16) * sigmoidf_(v0[3]);
                    v1[0] = bf2f(y.z & 0xffffu) * sigmoidf_(v1[0]); v1[1] = bf2f(y.z >> 16) * sigmoidf_(v1[1]); v1[2] = bf2f(y.w & 0xffffu) * sigmoidf_(v1[2]); v1[3] = bf2f(y.w >> 16) * sigmoidf_(v1[3]);
                    *(u32x4*)(YS5 + (size_t)row * HW + col) = pack8(v0, v1); } }
        return false;
    }
};
struct EpiBranch {
    static constexpr bool PERM = true;
    const bf16_t* GATES; bf16_t* MERGED;
    __device__ __forceinline__ bool operator()(f32x4 (&acc)[2][2][4][2], const Unit& u, int wr, int wc, int fr, int fq) const {
        const int part = u.aux;
#pragma unroll
        for (int ai = 0; ai < 2; ++ai)
#pragma unroll
            for (int m = 0; m < 4; ++m) { const int row = u.pm * 256 + ai * 128 + wr * 64 + m * 16 + fr;
#pragma unroll
                for (int bj = 0; bj < 2; ++bj) { const int col = u.pn * 256 + bj * 128 + wc * 32 + 8 * fq;
                    const u32x4 g2 = *(const u32x4*)(GATES + (size_t)row * 2048 + 1024 + col);
                    float h[8] = {bf2f(g2.x & 0xffffu), bf2f(g2.x >> 16), bf2f(g2.y & 0xffffu), bf2f(g2.y >> 16), bf2f(g2.z & 0xffffu), bf2f(g2.z >> 16), bf2f(g2.w & 0xffffu), bf2f(g2.w >> 16)};
#pragma unroll
                    for (int j = 0; j < 8; ++j) h[j] = fmaxf(h[j], 1e-30f);
                    if (part == 0) { const u32x4 g1 = *(const u32x4*)(GATES + (size_t)row * 2048 + col);
                        const float s[8] = {bf2f(g1.x & 0xffffu), bf2f(g1.x >> 16), bf2f(g1.y & 0xffffu), bf2f(g1.y >> 16), bf2f(g1.z & 0xffffu), bf2f(g1.z >> 16), bf2f(g1.w & 0xffffu), bf2f(g1.w >> 16)};
#pragma unroll
                        for (int j = 0; j < 4; ++j) { acc[ai][bj][m][0][j] *= s[j] / h[j]; acc[ai][bj][m][1][j] *= s[4 + j] / h[4 + j]; } }
                    else { f32x4 v0 = acc[ai][bj][m][0], v1 = acc[ai][bj][m][1];
#pragma unroll
                        for (int j = 0; j < 4; ++j) { v0[j] *= h[j]; v1[j] *= h[4 + j]; }
                        *(u32x4*)(MERGED + (size_t)row * D + col) = pack8(v0, v1); } } }
        return part == 0;
    }
};
struct EpiOut {
    static constexpr bool PERM = false;
    const float* X; float* H1; float* SSQ; int var = 0;
    __device__ __forceinline__ bool operator()(f32x4 (&acc)[2][2][4][2], const Unit& u, int wr, int wc, int fr, int fq) const {
#pragma unroll
        for (int ai = 0; ai < 2; ++ai)
#pragma unroll
            for (int m = 0; m < 4; ++m) { const int row = u.pm * 256 + ai * 128 + wr * 64 + m * 16 + fr; const size_t off = (size_t)row * D + u.pn * 256 + wc * 32 + 4 * fq; float ss = 0.f;
                if (var & 4) { asm volatile("" :: "v"(acc[ai][0][m][0]), "v"(acc[ai][0][m][1]), "v"(acc[ai][1][m][0]), "v"(acc[ai][1][m][1])); continue; }
#pragma unroll
                for (int bj = 0; bj < 2; ++bj)
#pragma unroll
                    for (int n = 0; n < 2; ++n) { const f32x4 xv = *(const f32x4*)(X + off + bj * 128 + n * 16); const f32x4 o = xv + acc[ai][bj][m][n];
                        *(f32x4*)(H1 + off + bj * 128 + n * 16) = o; ss += (o[0] * o[0] + o[1] * o[1]) + (o[2] * o[2] + o[3] * o[3]); }
                ss += __shfl_xor(ss, 16); ss += __shfl_xor(ss, 32);
                if (fq == 0) SSQ[(size_t)row * 16 + u.pn * 4 + wc] = ss; }
        return false;
    }
};
struct EpiMoe1 {
    static constexpr bool PERM = true;
    const float* BGU; const int* tile_e; unsigned char* A2; int var;
    __device__ __forceinline__ bool operator()(f32x4 (&acc)[2][2][4][2], const Unit& u, int wr, int wc, int fr, int fq) const {
        const int e = tile_e[u.pm]; const int hid = u.pn * 128 + wc * 32 + 8 * fq; const float* bp = BGU + (size_t)e * 2048 + 2 * hid;
        const f32x4 b0 = *(const f32x4*)(bp), b1 = *(const f32x4*)(bp + 4), b2 = *(const f32x4*)(bp + 8), b3 = *(const f32x4*)(bp + 12);
        const float bg[8] = {b0[0], b0[2], b1[0], b1[2], b2[0], b2[2], b3[0], b3[2]}, bu[8] = {b0[1], b0[3], b1[1], b1[3], b2[1], b2[3], b3[1], b3[3]};
#pragma unroll
        for (int ai = 0; ai < 2; ++ai)
#pragma unroll
            for (int m = 0; m < 4; ++m) { const int prow = u.pm * 256 + ai * 128 + wr * 64 + m * 16 + fr; f32x4 o0, o1;
                if (var & 4) { asm volatile("" :: "v"(acc[ai][0][m][0]), "v"(acc[ai][0][m][1]), "v"(acc[ai][1][m][0]), "v"(acc[ai][1][m][1])); continue; }
#pragma unroll
                for (int j = 0; j < 4; ++j) {
                    float gt = fminf(acc[ai][0][m][0][j] + bg[j], 7.0f), up = fminf(fmaxf(acc[ai][1][m][0][j] + bu[j], -7.0f), 7.0f); o0[j] = (up + 1.0f) * gt * sigmoidf_(1.702f * gt);
                    gt = fminf(acc[ai][0][m][1][j] + bg[4 + j], 7.0f); up = fminf(fmaxf(acc[ai][1][m][1][j] + bu[4 + j], -7.0f), 7.0f); o1[j] = (up + 1.0f) * gt * sigmoidf_(1.702f * gt); }
                u32x2 q8; q8.x = pk4_fp8(o0[0], o0[1], o0[2], o0[3]); q8.y = pk4_fp8(o1[0], o1[1], o1[2], o1[3]);
                if (var & 1) asm volatile("" :: "v"(q8)); else *(u32x2*)(A2 + (size_t)prow * DF + hid) = q8; }
        return false;
    }
};
struct EpiMoe2 {
    static constexpr bool PERM = true;
    const float* BD; const int* tile_e; const int* rowslot; bf16_t* YS; int var;
    __device__ __forceinline__ bool operator()(f32x4 (&acc)[2][2][4][2], const Unit& u, int wr, int wc, int fr, int fq) const {
        const int e = tile_e[u.pm];
#pragma unroll
        for (int ai = 0; ai < 2; ++ai)
#pragma unroll
            for (int m = 0; m < 4; ++m) { const int prow = u.pm * 256 + ai * 128 + wr * 64 + m * 16 + fr; const int slot = rowslot[prow];
                if (var & 4) { asm volatile("" :: "v"(acc[ai][0][m][0]), "v"(acc[ai][0][m][1]), "v"(acc[ai][1][m][0]), "v"(acc[ai][1][m][1])); continue; }
                if (var & 1) { const f32x4 c0 = *(const f32x4*)(BD + (size_t)e * D + u.pn * 256 + wc * 32 + 8 * fq); const f32x4 t0 = acc[ai][0][m][0] + c0, t1 = acc[ai][1][m][1] + c0; asm volatile("" :: "v"(t0), "v"(t1), "v"(slot)); continue; }
                if (slot >= 0) {
#pragma unroll
                    for (int bj = 0; bj < 2; ++bj) { const int col = u.pn * 256 + bj * 128 + wc * 32 + 8 * fq; const f32x4 c0 = *(const f32x4*)(BD + (size_t)e * D + col), c1 = *(const f32x4*)(BD + (size_t)e * D + col + 4);
                        *(u32x4*)(YS + (size_t)slot * D + col) = pack8(acc[ai][bj][m][0] + c0, acc[ai][bj][m][1] + c1); } } }
        return false;
    }
};

template <int MODE  > __device__ __forceinline__ void p0_transpose_item(const float* W, int K, int N, bf16_t* WT, LAS float* scr, int item, int lane) {
    const int nblk = N / 32, kb = item / nblk, nb = item % nblk, k0 = 64 * kb, n0 = 32 * nb;
#pragma unroll 8
    for (int i = 0; i < 32; ++i) { const int kk = 2 * i + (lane >> 5); scr[kk * 33 + (lane & 31)] = W[(size_t)(k0 + kk) * N + n0 + (lane & 31)]; }
    LDS_WAIT(); asm volatile("" ::: "memory");
    const int c = lane & 7;
#pragma unroll
    for (int j = 0; j < 4; ++j) { const int n = (lane >> 3) + 8 * j; const LAS float* s = scr + (8 * c) * 33 + n;
        u32x4 o; o.x = pk2(s[0 * 33], s[1 * 33]); o.y = pk2(s[2 * 33], s[3 * 33]); o.z = pk2(s[4 * 33], s[5 * 33]); o.w = pk2(s[6 * 33], s[7 * 33]);
        int nn = n0 + n; if (MODE == 1) { const int hid = nn >> 1, part = nn & 1; nn = 256 * (hid >> 7) + 128 * part + (hid & 127); }
        *(u32x4*)(WT + (size_t)nn * K + k0 + 8 * c) = o; }
    LDS_WAIT(); asm volatile("" ::: "memory");
}
template <int MODE> __device__ __forceinline__ void p0_transpose_item8(const float* W, int K, int N, unsigned char* WT, LAS float* scr, int item, int lane) {
    const int nblk = N / 32, kb = item / nblk, nb = item % nblk, k0 = 64 * kb, n0 = 32 * nb;
#pragma unroll 8
    for (int i = 0; i < 32; ++i) { const int kk = 2 * i + (lane >> 5); scr[kk * 33 + (lane & 31)] = W[(size_t)(k0 + kk) * N + n0 + (lane & 31)]; }
    LDS_WAIT(); asm volatile("" ::: "memory");
    const int c = lane & 3; const float sc = (float)(1 << pg8::F8_WSH);
#pragma unroll
    for (int j = 0; j < 2; ++j) { const int n = (lane >> 2) + 16 * j; const LAS float* s = scr + (16 * c) * 33 + n;
        u32x4 o; o.x = pk4_fp8(s[0 * 33] * sc, s[1 * 33] * sc, s[2 * 33] * sc, s[3 * 33] * sc); o.y = pk4_fp8(s[4 * 33] * sc, s[5 * 33] * sc, s[6 * 33] * sc, s[7 * 33] * sc);
        o.z = pk4_fp8(s[8 * 33] * sc, s[9 * 33] * sc, s[10 * 33] * sc, s[11 * 33] * sc); o.w = pk4_fp8(s[12 * 33] * sc, s[13 * 33] * sc, s[14 * 33] * sc, s[15 * 33] * sc);
        int nn = n0 + n; if (MODE == 1) { const int hid = nn >> 1, part = nn & 1; nn = 256 * (hid >> 7) + 128 * part + (hid & 127); }
        *(u32x4*)(WT + (size_t)nn * K + k0 + 16 * c) = o; }
    LDS_WAIT(); asm volatile("" ::: "memory");
}
struct TDesc { const float* W; unsigned char* WT; int K, N, k0, n0, mode, out8; };
__device__ __forceinline__ TDesc p0_decode(const Frame& F, int t) {
    TDesc d; unsigned char* ws = F.ws;
    if (t < 16384) { const int e = t >> 9, r = t & 511; d.W = F.in[I_WGU] + (size_t)e * D * 2048; d.WT = ws + WS_WGU + (size_t)e * 2048 * D; d.K = D; d.N = 2048; d.k0 = (r >> 5) * 64; d.n0 = (r & 31) * 64; d.mode = 1; d.out8 = 1; return d; }
    t -= 16384;
    if (t < 8192) { const int e = t >> 8, r = t & 255; d.W = F.in[I_WD] + (size_t)e * DF * D; d.WT = ws + WS_WD + (size_t)e * D * DF; d.K = DF; d.N = D; d.k0 = (r >> 4) * 64; d.n0 = (r & 15) * 64; d.mode = 0; d.out8 = 1; return d; }
    t -= 8192; d.mode = 0; d.out8 = 0;
    if (t < 1152) { d.W = F.in[I_WIN]; d.WT = ws + WS_WIN; d.K = D; d.N = INW; d.k0 = (t / 72) * 64; d.n0 = (t % 72) * 64; return d; }
    t -= 1152;
    if (t < 64) { d.W = F.in[I_WGLU]; d.WT = ws + WS_WGLU; d.K = HW; d.N = HW; d.k0 = (t >> 3) * 64; d.n0 = (t & 7) * 64; return d; }
    t -= 64;
    if (t < 128) { d.W = F.in[I_WBS]; d.WT = ws + WS_WBS; d.K = HW; d.N = D; d.k0 = (t >> 4) * 64; d.n0 = (t & 15) * 64; return d; }
    t -= 128;
    if (t < 128) { d.W = F.in[I_WBH]; d.WT = ws + WS_WBH; d.K = HW; d.N = D; d.k0 = (t >> 4) * 64; d.n0 = (t & 15) * 64; return d; }
    t -= 128;
    d.W = F.in[I_WOUT]; d.WT = ws + WS_WOUT; d.K = D; d.N = D; d.k0 = (t >> 4) * 64; d.n0 = (t & 15) * 64; return d;
}
constexpr int P0_NTILES = 16384 + 8192 + 1152 + 64 + 128 + 128 + 256;
__device__ __forceinline__ void p0_tile_load(const TDesc& d, f32x4 (&r)[16], int lane) {
    const float* p = d.W + (size_t)(d.k0 + (lane >> 4)) * d.N + d.n0 + (lane & 15) * 4;
#pragma unroll
    for (int i = 0; i < 16; ++i) r[i] = *(const f32x4*)(p + (size_t)(4 * i) * d.N);
}
__device__ __forceinline__ void p0_tile_to_lds(LAS float* scr, const f32x4 (&r)[16], int lane) {
#pragma unroll
    for (int i = 0; i < 16; ++i) { const int k = (lane >> 4) + 4 * i; *(LAS f32x4*)(scr + k * 64 + (((lane & 15) * 4) ^ (4 * ((k >> 3) & 7)))) = r[i]; }
}
__device__ __forceinline__ void p0_tile_store(const TDesc& d, const LAS float* scr, int lane) {
    if (d.out8) { const int c = lane & 3; const float sc = (float)(1 << pg8::F8_WSH);
#pragma unroll
        for (int j = 0; j < 4; ++j) { const int n = (lane >> 2) + 16 * j; float v[16];
#pragma unroll
            for (int t = 0; t < 16; ++t) { const int k = 16 * c + t; v[t] = scr[k * 64 + (n ^ (4 * ((k >> 3) & 7)))] * sc; }
            u32x4 o;
            { int w = 0; w = __builtin_amdgcn_cvt_pk_fp8_f32(v[0], v[1], w, false); w = __builtin_amdgcn_cvt_pk_fp8_f32(v[2], v[3], w, true); o.x = (unsigned)w; }
            { int w = 0; w = __builtin_amdgcn_cvt_pk_fp8_f32(v[4], v[5], w, false); w = __builtin_amdgcn_cvt_pk_fp8_f32(v[6], v[7], w, true); o.y = (unsigned)w; }
            { int w = 0; w = __builtin_amdgcn_cvt_pk_fp8_f32(v[8], v[9], w, false); w = __builtin_amdgcn_cvt_pk_fp8_f32(v[10], v[11], w, true); o.z = (unsigned)w; }
            { int w = 0; w = __builtin_amdgcn_cvt_pk_fp8_f32(v[12], v[13], w, false); w = __builtin_amdgcn_cvt_pk_fp8_f32(v[14], v[15], w, true); o.w = (unsigned)w; }
            int nn = d.n0 + n; if (d.mode == 1) { const int hid = nn >> 1, part = nn & 1; nn = 256 * (hid >> 7) + 128 * part + (hid & 127); }
            *(u32x4*)(d.WT + (size_t)nn * d.K + d.k0 + 16 * c) = o; } }
    else { const int c = lane & 7;
#pragma unroll
        for (int j = 0; j < 8; ++j) { const int n = (lane >> 3) + 8 * j; float v[8];
#pragma unroll
            for (int t = 0; t < 8; ++t) { const int k = 8 * c + t; v[t] = scr[k * 64 + (n ^ (4 * (c & 7)))]; }
            u32x4 o; o.x = cvt_pk_bf16(v[0], v[1]); o.y = cvt_pk_bf16(v[2], v[3]); o.z = cvt_pk_bf16(v[4], v[5]); o.w = cvt_pk_bf16(v[6], v[7]);
            *(u32x4*)((bf16_t*)d.WT + (size_t)(d.n0 + n) * d.K + d.k0 + 8 * c) = o; } }
}
struct C2 { double re, im; };
__device__ __forceinline__ C2 cmul(C2 a, C2 b) { return C2{a.re * b.re - a.im * b.im, a.re * b.im + a.im * b.re}; }
__device__ __forceinline__ C2 s5_pow(const Frame& F, int g, int p, int k) {
    const double lre = (double)F.in[I_LRE][g * SP + p], lim = (double)F.in[I_LIM][g * SP + p], dt = exp((double)F.in[I_LDT][g]);
    const double mag = exp((double)k * lre * dt); double s, c; sincos((double)k * lim * dt, &s, &c); return C2{mag * c, mag * s};
}
__device__ __forceinline__ C2 s5_coef(const Frame& F, int g, int p) {
    const double lre = (double)F.in[I_LRE][g * SP + p], lim = (double)F.in[I_LIM][g * SP + p]; const C2 lb = s5_pow(F, g, p, 1);
    const double nr = lb.re - 1.0, ni = lb.im, den = lre * lre + lim * lim; return C2{(nr * lre + ni * lim) / den, (ni * lre - nr * lim) / den};
}

struct C2f { float re, im; };
__device__ __forceinline__ C2f cmulf(C2f a, C2f b) { return C2f{a.re * b.re - a.im * b.im, a.re * b.im + a.im * b.re}; }
__device__ __forceinline__ void s5_fast(const Frame& F, int g, int p, C2f& lb, C2f& cf) {
    const float lre = F.in[I_LRE][g * SP + p], lim = F.in[I_LIM][g * SP + p], dt = expf(F.in[I_LDT][g]); const float a = lre * dt, th = lim * dt;
    float sn, cs; sincosf(th, &sn, &cs); const float ea = expf(a); lb = C2f{ea * cs, ea * sn};
    const float sh = sinf(0.5f * th); const float nr = expm1f(a) * cs - 2.0f * sh * sh, ni = ea * sn, den = lre * lre + lim * lim;
    cf = C2f{(nr * lre + ni * lim) / den, (ni * lre - nr * lim) / den};
}
__device__ __forceinline__ C2f cpowf_(C2f b, int k) { C2f r{1.f, 0.f};
#pragma unroll
    for (int i = 0; i < 7; ++i) { if (k & 1) r = cmulf(r, b); b = cmulf(b, b); k >>= 1; } return r; }
__device__ __forceinline__ void p0_prologue(Frame& F, const int var = 0) {
    LAS float* scr = (LAS float*)(F.lds + F.wave * 16384);
    const int gw = F.vcu * 8 + F.wave, NGW = F.G * 8, lane = F.lane;
    unsigned char* ws = F.ws;
    { f32x4 rr[16]; int t = gw;
      if (t < P0_NTILES && !(var & 256)) { TDesc dc = p0_decode(F, t); p0_tile_load(dc, rr, lane);
        for (;;) { p0_tile_to_lds(scr, rr, lane);
            const int tn = t + NGW; TDesc dn = dc; const bool more = tn < P0_NTILES;
            if (more) { dn = p0_decode(F, tn); p0_tile_load(dn, rr, lane); }
            LDS_WAIT(); asm volatile("" ::: "memory");
            p0_tile_store(dc, scr, lane);
            LDS_WAIT(); asm volatile("" ::: "memory");
            if (!more) break; dc = dn; t = tn; } } }
    constexpr int R6 = 0;
    constexpr int R7 = R6 + 2048  , R8 = R7 + 2048  , R9 = R8 + 2048  , R10 = R9 + 32  , R11 = R10 + 384  , R12 = R11 + 16  , R13 = R12 + 1  ;
    constexpr int R14 = R13 + 2048  ;
    for (int it = gw; it < ((var & 512) ? 0 : R14); it += NGW) {
        if (it < R7) {
            const int q = it - R6, g = q >> 6, k = q & 63, p = lane;
            C2f lb, cf; s5_fast(F, g, p, lb, cf); const C2f pw = cpowf_(lb, k);
            LAS float* CLre = scr; LAS float* CLim = scr + 1024; LAS float* BBre = scr + 2048; LAS float* BBim = scr + 3072;
#pragma unroll 4
            for (int h = 0; h < 16; ++h) { const C2f cc = cmulf(C2f{F.in[I_CRE][(g * 16 + h) * SP + p], F.in[I_CIM][(g * 16 + h) * SP + p]}, pw); CLre[h * 64 + p] = cc.re; CLim[h * 64 + p] = cc.im;
                const C2f bb = cmulf(cf, C2f{F.in[I_BRE][(g * SP + p) * 16 + h], F.in[I_BIM][(g * SP + p) * 16 + h]}); BBre[p * 16 + h] = bb.re; BBim[p * 16 + h] = bb.im; }
            LDS_WAIT(); asm volatile("" ::: "memory");
            float o[4];
#pragma unroll
            for (int qq = 0; qq < 4; ++qq) { const int idx = lane * 4 + qq, h = idx >> 4, h2 = idx & 15; float s = 0.f;
                for (int pp = 0; pp < 64; ++pp) s += CLre[h * 64 + pp] * BBre[pp * 16 + h2] - CLim[h * 64 + pp] * BBim[pp * 16 + h2];
                o[qq] = s; }
            u32x2 w; w.x = pk2(o[0], o[1]); w.y = pk2(o[2], o[3]);
            *(u32x2*)((bf16_t*)(ws + WS_KCONV) + (size_t)q * 256 + lane * 4) = w;
            LDS_WAIT(); asm volatile("" ::: "memory");
        }
        else if (it < R8) {
            const int q = it - R7, g = q >> 6, s = q & 63, p = lane; C2f lb, cf; s5_fast(F, g, p, lb, cf); const C2f pw = cmulf(cpowf_(lb, 63 - s), cf);
            float re[16], im[16];
#pragma unroll
            for (int h = 0; h < 16; ++h) { const C2f w = cmulf(pw, C2f{F.in[I_BRE][(g * SP + p) * 16 + h], F.in[I_BIM][(g * SP + p) * 16 + h]}); re[h] = w.re; im[h] = w.im; }
            bf16_t* o0 = (bf16_t*)(ws + WS_WE) + ((size_t)(g * 256 + p) * 1024 + s * 16); bf16_t* o1 = o0 + (size_t)64 * 1024;
            u32x4 a, b; a.x = pk2(re[0], re[1]); a.y = pk2(re[2], re[3]); a.z = pk2(re[4], re[5]); a.w = pk2(re[6], re[7]); b.x = pk2(re[8], re[9]); b.y = pk2(re[10], re[11]); b.z = pk2(re[12], re[13]); b.w = pk2(re[14], re[15]);
            *(u32x4*)o0 = a; *(u32x4*)(o0 + 8) = b;
            a.x = pk2(im[0], im[1]); a.y = pk2(im[2], im[3]); a.z = pk2(im[4], im[5]); a.w = pk2(im[6], im[7]); b.x = pk2(im[8], im[9]); b.y = pk2(im[10], im[11]); b.z = pk2(im[12], im[13]); b.w = pk2(im[14], im[15]);
            *(u32x4*)o1 = a; *(u32x4*)(o1 + 8) = b;
        }
        else if (it < R9) {
            const int q = it - R8, g = q >> 6, t = q & 63, p = lane; C2f lb, cf; s5_fast(F, g, p, lb, cf); const C2f pw = cpowf_(lb, t + 1);
            for (int h = 0; h < 16; ++h) { const C2f cc = cmulf(C2f{F.in[I_CRE][(g * 16 + h) * SP + p], F.in[I_CIM][(g * 16 + h) * SP + p]}, pw);
                bf16_t* o = (bf16_t*)(ws + WS_TZ) + ((size_t)(g * 1024 + t * 16 + h) * UAK + 1024 + p); o[0] = (bf16_t)f2bf(cc.re); o[64] = (bf16_t)f2bf(-cc.im); }
        }
        else if (it < R10) {
            const int g = it - R9, p = lane; const C2 l1 = s5_pow(F, g, p, 1), cf = s5_coef(F, g, p); C2 l64 = l1;
#pragma unroll
            for (int q2 = 0; q2 < 6; ++q2) l64 = cmul(l64, l64);
            ((f32x2*)(ws + WS_LAMB))[g * SP + p] = (f32x2){(float)l1.re, (float)l1.im}; ((f32x2*)(ws + WS_LAMC))[g * SP + p] = (f32x2){(float)l64.re, (float)l64.im};
            for (int h = 0; h < 16; ++h) { const C2 bb = cmul(cf, C2{(double)F.in[I_BRE][(g * SP + p) * 16 + h], (double)F.in[I_BIM][(g * SP + p) * 16 + h]}); ((f32x2*)(ws + WS_BBAR))[(g * SP + p) * 16 + h] = (f32x2){(float)bb.re, (float)bb.im}; }
        }
        else if (it < R11) {
            const int q = it - R10, cg = q >> 4, kq = q & 15; const int wcol = (cg < 8 ? cg * 64 : (cg < 16 ? 1024 + (cg - 8) * 64 : 1536 + (cg - 16) * 64)) + lane;
            const float* meta = F.in[I_META]; const float* g1 = F.in[I_N1G];
            for (int r = 0; r < 16; ++r) { float s = 0.f;
#pragma unroll
                for (int j = 0; j < 16; ++j) { const float v = meta[r * D + lane + 64 * j]; s += v * v; }
                const float rstd = 1.0f / sqrtf(wave_sum(s) * (1.0f / D) + EPS);
                const int k = kq * 64 + lane; scr[lane * 16 + r] = meta[r * D + k] * rstd * g1[k]; }
            LDS_WAIT(); asm volatile("" ::: "memory");
            float a[16];
#pragma unroll
            for (int r = 0; r < 16; ++r) a[r] = 0.f;
            const float* wp = F.in[I_WIN] + (size_t)(kq * 64) * INW + wcol;
#pragma unroll 16
            for (int kk = 0; kk < 64; ++kk) { const float w = wp[(size_t)kk * INW]; const LAS f32x4* xs = (const LAS f32x4*)(scr + kk * 16);
                const f32x4 x0 = xs[0], x1 = xs[1], x2 = xs[2], x3 = xs[3];
                a[0] += w * x0[0]; a[1] += w * x0[1]; a[2] += w * x0[2]; a[3] += w * x0[3]; a[4] += w * x1[0]; a[5] += w * x1[1]; a[6] += w * x1[2]; a[7] += w * x1[3];
                a[8] += w * x2[0]; a[9] += w * x2[1]; a[10] += w * x2[2]; a[11] += w * x2[3]; a[12] += w * x3[0]; a[13] += w * x3[1]; a[14] += w * x3[2]; a[15] += w * x3[3]; }
            float* pm = (float*)(ws + WS_PMETA);
#pragma unroll
            for (int r = 0; r < 16; ++r) pm[(size_t)(kq * 16 + r) * 1536 + cg * 64 + lane] = a[r];
            LDS_WAIT(); asm volatile("" ::: "memory");
        }
        else if (it < R12) {
            const int k = (it - R11) * 64 + lane; bf16_t* hi = (bf16_t*)(ws + WS_WRT); bf16_t* lo = hi + NE * D;
            for (int e = 0; e < NE; ++e) { const float w = F.in[I_WR][k * NE + e]; const unsigned h = f2bf(w); hi[e * D + k] = (bf16_t)h; lo[e * D + k] = (bf16_t)f2bf(w - bf2f(h)); }
        }
        else if (it < R13) {
            for (int d = lane; d < HW; d += 64) ((float*)(ws + WS_LBV))[d] = sigmoidf_(F.in[I_LBL][d] - F.in[I_LBL][HW + d]);
        }
        else {
            const int q = it - R13, g = q >> 6, r0 = 128 + (q & 63) * 2; u32x4* o = (u32x4*)((bf16_t*)(ws + WS_WE) + (size_t)(g * 256 + r0) * 1024);
#pragma unroll
            for (int j = 0; j < 4; ++j) o[lane + 64 * j] = (u32x4){0u, 0u, 0u, 0u};
        }
    }
    const float* g1 = F.in[I_N1G];
    for (int m = gw; m < ((var & 1024) ? 0 : T); m += 2 * NGW) {
        const int m2 = m + NGW; const bool two = m2 < T;
        const f32x4* xr = (const f32x4*)(F.in[I_X] + (size_t)m * D) + lane; const f32x4* xr2 = (const f32x4*)(F.in[I_X] + (size_t)(two ? m2 : m) * D) + lane; f32x4 v[4], w2[4]; float s = 0.f, s2 = 0.f;
#pragma unroll
        for (int j = 0; j < 4; ++j) { v[j] = xr[64 * j]; w2[j] = xr2[64 * j]; }
#pragma unroll
        for (int j = 0; j < 4; ++j) { s += (v[j].x * v[j].x + v[j].y * v[j].y) + (v[j].z * v[j].z + v[j].w * v[j].w); s2 += (w2[j].x * w2[j].x + w2[j].y * w2[j].y) + (w2[j].z * w2[j].z + w2[j].w * w2[j].w); }
        const float rstd = 1.0f / sqrtf(wave_sum(s) * (1.0f / D) + EPS), rstd2 = 1.0f / sqrtf(wave_sum(s2) * (1.0f / D) + EPS);
        u32x2* o8 = (u32x2*)((bf16_t*)(ws + WS_XN) + (size_t)m * D) + lane; u32x2* o82 = (u32x2*)((bf16_t*)(ws + WS_XN) + (size_t)m2 * D) + lane;
#pragma unroll
        for (int j = 0; j < 4; ++j) { const f32x4 gg = ((const f32x4*)g1)[lane + 64 * j]; u32x2 w; w.x = pk2(v[j].x * rstd * gg.x, v[j].y * rstd * gg.y); w.y = pk2(v[j].z * rstd * gg.z, v[j].w * rstd * gg.w); o8[64 * j] = w;
            if (two) { w.x = pk2(w2[j].x * rstd2 * gg.x, w2[j].y * rstd2 * gg.y); w.y = pk2(w2[j].z * rstd2 * gg.z, w2[j].w * rstd2 * gg.w); o82[64 * j] = w; } }
    }
}
__device__ __forceinline__ void p1_toeplitz(Frame& F) {
    { const float* pm = (const float*)(F.ws + WS_PMETA); float* pr = (float*)(F.ws + WS_PMR);
      for (int i = F.vcu * 512 + F.tid; i < 16 * 1536; i += F.G * 512) { float s = 0.f;
#pragma unroll
          for (int kq = 0; kq < 16; ++kq) s += pm[(size_t)kq * 16 * 1536 + i]; pr[i] = s; } }
    const int gw = F.vcu * 8 + F.wave, NGW = F.G * 8, lane = F.lane; const bf16_t* kc = (const bf16_t*)(F.ws + WS_KCONV); bf16_t* tz = (bf16_t*)(F.ws + WS_TZ);
    for (int row = gw; row < SG * 1024; row += NGW) { const int g = row >> 10, t = (row >> 4) & 63, h = row & 15;
#pragma unroll
        for (int j = 0; j < 2; ++j) { const int q = lane + 64 * j, s = q >> 1, half = q & 1; u32x4 v = (u32x4){0u, 0u, 0u, 0u};
            if (s <= t) v = *(const u32x4*)(kc + ((size_t)((g * 64 + (t - s)) * 16 + h) * 16 + half * 8));
            *(u32x4*)(tz + (size_t)row * UAK + s * 16 + half * 8) = v; } }
}

constexpr int ST64 = 144, ST128 = 272;
__device__ __forceinline__ void mma_nt32(f32x16& acc, const LAS unsigned char* A, int sa, const LAS unsigned char* B, int sb, int K, int lane) {
    const LAS unsigned char* pa = A + (lane & 31) * sa + (lane >> 5) * 16; const LAS unsigned char* pb = B + (lane & 31) * sb + (lane >> 5) * 16;
    for (int k = 0; k < K; k += 16) { const bf16x8 a = *(const LAS bf16x8*)(pa + k * 2), b = *(const LAS bf16x8*)(pb + k * 2); acc = __builtin_amdgcn_mfma_f32_32x32x16_bf16(a, b, acc, 0, 0, 0); }
}
__device__ __forceinline__ void hg_cumsum(LAS float* segtot, const float* LOGF, int tok0, int col, int d, int seg, float (&lf)[16], float (&cs)[16], float& total, float& bmid) {
#pragma unroll
    for (int j = 0; j < 16; ++j) lf[j] = LOGF[(size_t)(tok0 + seg * 16 + j) * HW + col];
    float run = 0.f;
#pragma unroll
    for (int j = 0; j < 16; ++j) { run += lf[j]; cs[j] = run; }
    segtot[seg * 128 + d] = run;
    __syncthreads();
    const float t0 = segtot[d], t1 = segtot[128 + d], t2 = segtot[256 + d], t3 = segtot[384 + d];
    const float pre = seg == 0 ? 0.f : (seg == 1 ? t0 : (seg == 2 ? t0 + t1 : t0 + t1 + t2));
#pragma unroll
    for (int j = 0; j < 16; ++j) cs[j] += pre;
    total = (t0 + t1) + (t2 + t3); bmid = t0 + t1;
}
__device__ __forceinline__ void hg_load_vt(LAS unsigned char* VT, const bf16_t* V, int tok0, int hcol, int tid) {
    const int j = tid & 63;
#pragma unroll
    for (int i = 0; i < 2; ++i) { const int e0 = ((tid >> 6) + 8 * i) * 8; const u32x4 v = *(const u32x4*)(V + (size_t)(tok0 + j) * HW + hcol + e0);
        LAS bf16_t* o = (LAS bf16_t*)(VT + e0 * ST64 + j * 2);
        o[0 * (ST64 / 2)] = (bf16_t)(v.x & 0xffffu); o[1 * (ST64 / 2)] = (bf16_t)(v.x >> 16); o[2 * (ST64 / 2)] = (bf16_t)(v.y & 0xffffu); o[3 * (ST64 / 2)] = (bf16_t)(v.y >> 16);
        o[4 * (ST64 / 2)] = (bf16_t)(v.z & 0xffffu); o[5 * (ST64 / 2)] = (bf16_t)(v.z >> 16); o[6 * (ST64 / 2)] = (bf16_t)(v.w & 0xffffu); o[7 * (ST64 / 2)] = (bf16_t)(v.w >> 16); }
}
__device__ __forceinline__ void hgrn_a_unit(Frame& F, int unit) {
    const int tid = F.tid, lane = F.lane, wave = F.wave; const int bh = unit >> 7, c = unit & 127, b = bh >> 2, h = bh & 3, tok0 = b * SEQ + c * CH, hcol = h * HD;
    LAS unsigned char* KT = F.lds; LAS unsigned char* VT = F.lds + 128 * ST64; LAS float* segtot = (LAS float*)(F.lds + 2 * 128 * ST64);
    const int d = tid & 127, seg = tid >> 7; float lf[16], cs[16], total, bmid;
    hg_load_vt(VT, (const bf16_t*)(F.ws + WS_V), tok0, hcol, tid);
    hg_cumsum(segtot, (const float*)(F.ws + WS_LOGF), tok0, hcol + d, d, seg, lf, cs, total, bmid);
    float kk[16];
#pragma unroll
    for (int j = 0; j < 16; ++j) kk[j] = (1.0f - __expf(lf[j])) * __expf(total - cs[j]);
    u32x4 w0, w1; w0.x = pk2(kk[0], kk[1]); w0.y = pk2(kk[2], kk[3]); w0.z = pk2(kk[4], kk[5]); w0.w = pk2(kk[6], kk[7]); w1.x = pk2(kk[8], kk[9]); w1.y = pk2(kk[10], kk[11]); w1.z = pk2(kk[12], kk[13]); w1.w = pk2(kk[14], kk[15]);
    *(LAS u32x4*)(KT + d * ST64 + seg * 32) = w0; *(LAS u32x4*)(KT + d * ST64 + seg * 32 + 16) = w1;
    if (seg == 0) ((float*)(F.ws + WS_DEC))[(size_t)unit * HD + d] = __expf(total);
    { float* bc = (float*)(F.ws + WS_BCUM) + (size_t)(tok0 + seg * 16) * HW + hcol + d;
#pragma unroll
      for (int j = 0; j < 16; ++j) bc[(size_t)j * HW] = cs[j]; }
    __syncthreads();
    float* kvt = (float*)(F.ws + WS_KVT) + (size_t)unit * HD * HD;
#pragma unroll
    for (int i = 0; i < 2; ++i) { const int tile = wave * 2 + i, et = tile >> 2, dt = tile & 3; f32x16 acc;
#pragma unroll
        for (int r = 0; r < 16; ++r) acc[r] = 0.f;
        mma_nt32(acc, VT + et * 32 * ST64, ST64, KT + dt * 32 * ST64, ST64, 64, lane);
#pragma unroll
        for (int r = 0; r < 16; ++r) { const int e = et * 32 + (r & 3) + 8 * (r >> 2) + 4 * (lane >> 5); kvt[(size_t)e * HD + dt * 32 + (lane & 31)] = acc[r]; } }
    __syncthreads();
}
template <int K> __device__ __forceinline__ void mma_nt32k(f32x16& acc, const LAS unsigned char* A, int sa, const LAS unsigned char* B, int sb, int lane) {
    const LAS unsigned char* pa = A + (lane & 31) * sa + (lane >> 5) * 16; const LAS unsigned char* pb = B + (lane & 31) * sb + (lane >> 5) * 16;
#pragma unroll
    for (int k = 0; k < K; k += 16) { const bf16x8 a = *(const LAS bf16x8*)(pa + k * 2), b = *(const LAS bf16x8*)(pb + k * 2); acc = __builtin_amdgcn_mfma_f32_32x32x16_bf16(a, b, acc, 0, 0, 0); }
}
struct HgPre { u32x4 q[2]; f32x4 bj[2][2], bp[2][2], bm[2]; u32x4 v[2], sp[4]; };
__device__ __forceinline__ void hgc_load(Frame& F, int unit, HgPre& P) {
    const int tid = F.tid; const int bh = unit >> 7, c = unit & 127, b = bh >> 2, h = bh & 3, tok0 = b * SEQ + c * CH, hcol = h * HD;
    const bf16_t* qg = (const bf16_t*)(F.ws + WS_Q); const float* bc = (const float*)(F.ws + WS_BCUM); const bf16_t* vg = (const bf16_t*)(F.ws + WS_V); const bf16_t* sp = (const bf16_t*)(F.ws + WS_SPREV) + (size_t)unit * HD * HD;
    const int d0 = (tid & 15) * 8;
#pragma unroll
    for (int i = 0; i < 2; ++i) { const int j = (tid >> 4) + 32 * i; const size_t o = (size_t)(tok0 + j) * HW + hcol + d0;
        P.q[i] = *(const u32x4*)(qg + o); P.bj[i][0] = *(const f32x4*)(bc + o); P.bj[i][1] = *(const f32x4*)(bc + o + 4);
        if (j > 0) { P.bp[i][0] = *(const f32x4*)(bc + o - HW); P.bp[i][1] = *(const f32x4*)(bc + o - HW + 4); } else { P.bp[i][0] = (f32x4){0.f, 0.f, 0.f, 0.f}; P.bp[i][1] = (f32x4){0.f, 0.f, 0.f, 0.f}; }
        const int e0 = ((tid >> 6) + 8 * i) * 8; P.v[i] = *(const u32x4*)(vg + (size_t)(tok0 + (tid & 63)) * HW + hcol + e0); }
    { const size_t o = (size_t)(tok0 + 31) * HW + hcol + d0; P.bm[0] = *(const f32x4*)(bc + o); P.bm[1] = *(const f32x4*)(bc + o + 4); }
#pragma unroll
    for (int i = 0; i < 4; ++i) { const int p = tid + 512 * i; P.sp[i] = *(const u32x4*)(sp + (size_t)(p >> 4) * HD + (p & 15) * 8); }
}
__device__ __forceinline__ void hgrn_c_phase(Frame& F) {
    const int tid = F.tid, lane = F.lane, wave = F.wave;
    LAS unsigned char* Q1 = F.lds; LAS unsigned char* K1 = Q1 + 64 * ST128; LAS unsigned char* Q2 = K1 + 64 * ST128; LAS unsigned char* VT = Q2 + 64 * ST128;
    LAS unsigned char* PP = VT + 128 * ST64; LAS unsigned char* SPL = PP + 64 * ST64; LAS float* RS = (LAS float*)(SPL + 128 * ST128); LAS unsigned char* OL = Q1;
    int unit = F.bx; if (unit >= 16 * NCH) return;
    HgPre P; hgc_load(F, unit, P);
    u32x4 gsv[2];
    { const int bh = unit >> 7, c = unit & 127, tok0 = (bh >> 2) * SEQ + c * CH, hcol = (bh & 3) * HD;
#pragma unroll
      for (int i = 0; i < 2; ++i) gsv[i] = *(const u32x4*)((const bf16_t*)(F.ws + WS_GS) + (size_t)(tok0 + (tid >> 4) + 32 * i) * HW + hcol + (tid & 15) * 8); }
    for (;;) {
        const int bh = unit >> 7, c = unit & 127, b = bh >> 2, h = bh & 3, tok0 = b * SEQ + c * CH, hcol = h * HD;
        { const int d0 = (tid & 15) * 8;
#pragma unroll
          for (int i = 0; i < 2; ++i) { const int j = (tid >> 4) + 32 * i; float q1[8], k1[8], q2[8];
              const unsigned qw[4] = {P.q[i].x, P.q[i].y, P.q[i].z, P.q[i].w};
#pragma unroll
              for (int k = 0; k < 8; ++k) { const float bb = P.bj[i][k >> 2][k & 3], bm = P.bm[k >> 2][k & 3], lf = bb - P.bp[i][k >> 2][k & 3]; const float q = bf2f((qw[k >> 1] >> ((k & 1) * 16)) & 0xffffu);
                  const float kx = 1.0f - __expf(lf), ed = __expf(bb - bm); q1[k] = q * ed; k1[k] = kx * __expf(bm - bb); q2[k] = q * __expf(bb); }
              u32x4 w; w.x = cvt_pk_bf16(q1[0], q1[1]); w.y = cvt_pk_bf16(q1[2], q1[3]); w.z = cvt_pk_bf16(q1[4], q1[5]); w.w = cvt_pk_bf16(q1[6], q1[7]); *(LAS u32x4*)(Q1 + j * ST128 + d0 * 2) = w;
              w.x = cvt_pk_bf16(k1[0], k1[1]); w.y = cvt_pk_bf16(k1[2], k1[3]); w.z = cvt_pk_bf16(k1[4], k1[5]); w.w = cvt_pk_bf16(k1[6], k1[7]); *(LAS u32x4*)(K1 + j * ST128 + d0 * 2) = w;
              w.x = cvt_pk_bf16(q2[0], q2[1]); w.y = cvt_pk_bf16(q2[2], q2[3]); w.z = cvt_pk_bf16(q2[4], q2[5]); w.w = cvt_pk_bf16(q2[6], q2[7]); *(LAS u32x4*)(Q2 + j * ST128 + d0 * 2) = w;
              const int e0 = ((tid >> 6) + 8 * i) * 8; LAS bf16_t* o = (LAS bf16_t*)(VT + e0 * ST64 + (tid & 63) * 2); const u32x4 v = P.v[i];
              o[0 * (ST64 / 2)] = (bf16_t)(v.x & 0xffffu); o[1 * (ST64 / 2)] = (bf16_t)(v.x >> 16); o[2 * (ST64 / 2)] = (bf16_t)(v.y & 0xffffu); o[3 * (ST64 / 2)] = (bf16_t)(v.y >> 16);
              o[4 * (ST64 / 2)] = (bf16_t)(v.z & 0xffffu); o[5 * (ST64 / 2)] = (bf16_t)(v.z >> 16); o[6 * (ST64 / 2)] = (bf16_t)(v.w & 0xffffu); o[7 * (ST64 / 2)] = (bf16_t)(v.w >> 16); }
#pragma unroll
          for (int i = 0; i < 4; ++i) { const int p = tid + 512 * i; *(LAS u32x4*)(SPL + (p >> 4) * ST128 + (p & 15) * 16) = P.sp[i]; } }
        const int un = unit + F.G; const bool more = un < 16 * NCH;
        if (more) hgc_load(F, un, P);
        __syncthreads();
        const int it = wave >> 2, et = wave & 3; f32x16 acc;
#pragma unroll
        for (int r = 0; r < 16; ++r) acc[r] = 0.f;
        mma_nt32k<128>(acc, Q2 + it * 32 * ST128, ST128, SPL + et * 32 * ST128, ST128, lane);
        if (wave < 3) { const int si = wave ? 1 : 0, sj = wave == 2 ? 1 : 0; f32x16 sc;
#pragma unroll
            for (int r = 0; r < 16; ++r) sc[r] = 0.f;
            mma_nt32k<128>(sc, Q1 + si * 32 * ST128, ST128, K1 + sj * 32 * ST128, ST128, lane);
#pragma unroll
            for (int r = 0; r < 16; ++r) { const int i = si * 32 + (r & 3) + 8 * (r >> 2) + 4 * (lane >> 5), j = sj * 32 + (lane & 31); ((LAS bf16_t*)(PP + i * ST64))[j] = (bf16_t)f2bf(j <= i ? sc[r] : 0.f); } }
        else if (wave == 3) {
#pragma unroll
            for (int r = 0; r < 16; ++r) { const int i = (r & 3) + 8 * (r >> 2) + 4 * (lane >> 5); ((LAS bf16_t*)(PP + i * ST64))[32 + (lane & 31)] = (bf16_t)0; } }
        __syncthreads();
        mma_nt32k<64>(acc, PP + it * 32 * ST64, ST64, VT + et * 32 * ST64, ST64, lane);
#pragma unroll
        for (int r = 0; r < 16; ++r) { float s2 = acc[r] * acc[r]; s2 += __shfl_xor(s2, 1); s2 += __shfl_xor(s2, 2); s2 += __shfl_xor(s2, 4); s2 += __shfl_xor(s2, 8); s2 += __shfl_xor(s2, 16);
            if ((lane & 31) == 0) RS[et * 64 + it * 32 + (r & 3) + 8 * (r >> 2) + 4 * (lane >> 5)] = s2; }
        __syncthreads();
#pragma unroll
        for (int r = 0; r < 16; ++r) { const int i = it * 32 + (r & 3) + 8 * (r >> 2) + 4 * (lane >> 5); const float ss = (RS[i] + RS[64 + i]) + (RS[128 + i] + RS[192 + i]);
            ((LAS bf16_t*)(OL + i * ST128))[et * 32 + (lane & 31)] = (bf16_t)f2bf(acc[r] * (1.0f / sqrtf(ss * (1.0f / HD) + EPS))); }
        __syncthreads();
        { const int eo = (tid & 15) * 8; const f32x4 g0 = *(const f32x4*)(F.in[I_HNG] + hcol + eo), g1 = *(const f32x4*)(F.in[I_HNG] + hcol + eo + 4); bf16_t* yo = (bf16_t*)(F.ws + WS_YHG);
#pragma unroll
          for (int i = 0; i < 2; ++i) { const int row = (tid >> 4) + 32 * i; const u32x4 o = *(const LAS u32x4*)(OL + row * ST128 + eo * 2); const u32x4 gq = gsv[i];
              f32x4 y0, y1; y0[0] = bf2f(o.x & 0xffffu) * g0[0] * bf2f(gq.x & 0xffffu); y0[1] = bf2f(o.x >> 16) * g0[1] * bf2f(gq.x >> 16); y0[2] = bf2f(o.y & 0xffffu) * g0[2] * bf2f(gq.y & 0xffffu); y0[3] = bf2f(o.y >> 16) * g0[3] * bf2f(gq.y >> 16);
              y1[0] = bf2f(o.z & 0xffffu) * g1[0] * bf2f(gq.z & 0xffffu); y1[1] = bf2f(o.z >> 16) * g1[1] * bf2f(gq.z >> 16); y1[2] = bf2f(o.w & 0xffffu) * g1[2] * bf2f(gq.w & 0xffffu); y1[3] = bf2f(o.w >> 16) * g1[3] * bf2f(gq.w >> 16);
              *(u32x4*)(yo + (size_t)(tok0 + row) * HW + hcol + eo) = pack8(y0, y1); } }
        if (!more) break;
        unit = un;
        { const int bh2 = unit >> 7, c2 = unit & 127, tk = (bh2 >> 2) * SEQ + c2 * CH, hc = (bh2 & 3) * HD;
#pragma unroll
          for (int i = 0; i < 2; ++i) gsv[i] = *(const u32x4*)((const bf16_t*)(F.ws + WS_GS) + (size_t)(tk + (tid >> 4) + 32 * i) * HW + hc + (tid & 15) * 8); }
        __syncthreads();
    }
    __syncthreads();
}

__device__ __forceinline__ void phase0(Frame& F, const int var) {
    unsigned char* ws = F.ws; (void)ws;
    p0_prologue(F, var);
}
__device__ __forceinline__ void phase1(Frame& F, const int var) {
    unsigned char* ws = F.ws; (void)ws;
        p1_toeplitz(F);
        SchedStatic S{(const char*)(ws + WS_XN), (const char*)(ws + WS_WIN), T / 256, INW / 256, F.G, F.bx, (size_t)256 * D * 2, (size_t)256 * D * 2};
        EpiInProj E{(bf16_t*)(ws + WS_UA), (bf16_t*)(ws + WS_Q), (bf16_t*)(ws + WS_V), (bf16_t*)(ws + WS_GS), (bf16_t*)(ws + WS_GATES), (float*)(ws + WS_LOGF), (const float*)(ws + WS_LBV)};
        pg8::gemm_phase<EpiInProj, SchedStatic, false>(F.lds, D, D, D, S, E, nullptr);
}
__device__ __forceinline__ void phase2(Frame& F, const int var) {
    unsigned char* ws = F.ws; (void)ws;
        { SchedS5E S{(const char*)(ws + WS_UA), (const char*)(ws + WS_WE), F.bx}; EpiS5E E{(float*)(ws + WS_SE)};
          pg8::gemm_phase<EpiS5E, SchedS5E, false>(F.lds, 1024, UAK, 1024, S, E, nullptr); }
        __syncthreads();
        const float* pm = (const float*)(ws + WS_PMR);
        if (F.bx >= 64 && F.bx < 68) {
            const int g = (F.bx - 64) * 8 + (F.tid >> 6), p = F.tid & 63; const f32x2 lb = ((const f32x2*)(ws + WS_LAMB))[g * SP + p]; float xr = 0.f, xi = 0.f;
            for (int s = 0; s < NMETA; ++s) { float ar = 0.f, ai = 0.f;
#pragma unroll
                for (int h = 0; h < 16; ++h) { const int col = g * 16 + h; const float uu = pm[(size_t)s * 1536 + col];
                    const f32x2 bb = ((const f32x2*)(ws + WS_BBAR))[(g * SP + p) * 16 + h]; ar += bb.x * uu; ai += bb.y * uu; }
                const float nr = lb.x * xr - lb.y * xi + ar, ni = lb.x * xi + lb.y * xr + ai; xr = nr; xi = ni; }
            float* xm = (float*)(ws + WS_XMETA); xm[g * 128 + p] = xr; xm[g * 128 + 64 + p] = xi;
        }
        if (F.bx >= 68 && F.bx < 196) {
            const int idx = (F.bx - 68) * 512 + F.tid, h = idx >> 14, e = (idx >> 7) & 127, d = idx & 127; const float lbv = ((const float*)(ws + WS_LBV))[h * HD + d]; float S = 0.f;
            for (int s = 0; s < NMETA; ++s) { const int cf = 512 + h * HD + d, cv = 1024 + h * HD + e;
                const float fp = pm[(size_t)s * 1536 + cf];
                const float vv = pm[(size_t)s * 1536 + cv];
                const float f = lbv + (1.0f - lbv) * sigmoidf_(fp); S = f * S + (1.0f - f) * vv; }
            ((float*)(ws + WS_SMETA))[idx] = S;
        }
        if (F.bx >= 64) for (int u = F.bx - 64; u < 16 * NCH; u += F.G - 64) hgrn_a_unit(F, u);
}
__device__ __forceinline__ void phase3(Frame& F, const int var) {
    unsigned char* ws = F.ws; (void)ws;
        {
            const int bh = F.bx >> 4, e = (F.bx & 15) * 8 + (F.tid >> 6), d = (F.tid & 63) * 2, h = bh & 3;
            f32x2 S = *(const f32x2*)((const float*)(ws + WS_SMETA) + (size_t)(h * HD + e) * HD + d);
            const float* kv = (const float*)(ws + WS_KVT) + (size_t)bh * NCH * HD * HD + (size_t)e * HD + d; const float* dc = (const float*)(ws + WS_DEC) + (size_t)bh * NCH * HD + d;
            unsigned* sp = (unsigned*)((bf16_t*)(ws + WS_SPREV) + (size_t)bh * NCH * HD * HD + (size_t)e * HD + d);
            for (int c0 = 0; c0 < NCH; c0 += 8) { f32x2 kvv[8], dv[8];
#pragma unroll
                for (int j = 0; j < 8; ++j) { kvv[j] = *(const f32x2*)(kv + (size_t)(c0 + j) * HD * HD); dv[j] = *(const f32x2*)(dc + (size_t)(c0 + j) * HD); }
#pragma unroll
                for (int j = 0; j < 8; ++j) { sp[(size_t)(c0 + j) * (HD * HD / 2)] = pk2(S.x, S.y); S.x = S.x * dv[j].x + kvv[j].x; S.y = S.y * dv[j].y + kvv[j].y; } }
        }
        if (F.bx < 16) {
            const int b = F.bx >> 2, g = (F.bx & 3) * 8 + (F.tid >> 6), p = F.tid & 63; const f32x2 lc = ((const f32x2*)(ws + WS_LAMC))[g * SP + p];
            const float* xm = (const float*)(ws + WS_XMETA); float xr = xm[g * 128 + p], xi = xm[g * 128 + 64 + p];
            const float* se = (const float*)(ws + WS_SE) + ((size_t)g * 512 + b * 128) * 128 + p; bf16_t* ua = (bf16_t*)(ws + WS_UA) + ((size_t)g * 512 + b * 128) * UAK + 1024 + p;
            for (int c0 = 0; c0 < NCH; c0 += 8) { float er[8], ei[8];
#pragma unroll
                for (int j = 0; j < 8; ++j) { er[j] = se[(size_t)(c0 + j) * 128]; ei[j] = se[(size_t)(c0 + j) * 128 + 64]; }
#pragma unroll
                for (int j = 0; j < 8; ++j) { bf16_t* o = ua + (size_t)(c0 + j) * UAK; o[0] = (bf16_t)f2bf(xr); o[64] = (bf16_t)f2bf(xi);
                    const float nr = lc.x * xr - lc.y * xi + er[j], ni = lc.x * xi + lc.y * xr + ei[j]; xr = nr; xi = ni; } }
        }
}
__device__ __forceinline__ void phase4(Frame& F, const int var) {
    unsigned char* ws = F.ws; (void)ws;
        if (!(var & 64)) { SchedS5Y S{(const char*)(ws + WS_UA), (const char*)(ws + WS_TZ), F.bx, F.G}; EpiS5Y E{(const bf16_t*)(ws + WS_UA), F.in[I_SD], (bf16_t*)(ws + WS_Y1)};
          pg8::gemm_phase<EpiS5Y, SchedS5Y, false>(F.lds, UAK, UAK, UAK, S, E, nullptr); }
        __syncthreads();
        if (!(var & 128)) hgrn_c_phase(F);
}
__device__ __forceinline__ void phase5(Frame& F, const int var) {
    unsigned char* ws = F.ws; (void)ws;
        SchedStatic S{(const char*)(ws + WS_Y1), (const char*)(ws + WS_WGLU), T / 256, HW / 256, F.G, F.bx, (size_t)256 * HW * 2, (size_t)256 * HW * 2};
        EpiGlu E{(const bf16_t*)(ws + WS_Y1), (bf16_t*)(ws + WS_YS5)};
        pg8::gemm_phase<EpiGlu, SchedStatic, false>(F.lds, HW, HW, HW, S, E, nullptr);
}
__device__ __forceinline__ void phase6(Frame& F, const int var) {
    unsigned char* ws = F.ws; (void)ws;
        SchedBranch S{(const char*)(ws + WS_YS5), (const char*)(ws + WS_YHG), (const char*)(ws + WS_WBS), (const char*)(ws + WS_WBH), F.G, F.bx};
        EpiBranch E{(const bf16_t*)(ws + WS_GATES), (bf16_t*)(ws + WS_MERGED)};
        pg8::gemm_phase<EpiBranch, SchedBranch, false>(F.lds, HW, HW, HW, S, E, nullptr);
}
__device__ __forceinline__ void phase7(Frame& F, const int var) {
    unsigned char* ws = F.ws; (void)ws;
        SchedStatic S{(const char*)(ws + WS_MERGED), (const char*)(ws + WS_WOUT), T / 256, D / 256, F.G, F.bx, (size_t)256 * D * 2, (size_t)256 * D * 2, var};
        EpiOut E{F.in[I_X], (float*)(ws + WS_H1), (float*)(ws + WS_SSQ), var};
        pg8::gemm_phase<EpiOut, SchedStatic, false>(F.lds, D, D, D, S, E, nullptr, var);
}
__device__ __forceinline__ void phase8(Frame& F, const int var) {
    unsigned char* ws = F.ws; (void)ws;
        volatile LAS unsigned* hist = F.MISC + 16;
        if (F.tid < 32) hist[F.tid] = 0u;
        __syncthreads();
        const int lane = F.lane, tl = lane & 15, kg = lane >> 4; const float* g2 = F.in[I_N2G]; const bf16_t* wh = (const bf16_t*)(ws + WS_WRT); const bf16_t* wl = wh + NE * D;
        for (int tile = F.vcu * 8 + F.wave; tile < T / 16; tile += F.G * 8) {
            const int tok = tile * 16 + tl; const float* hrow = (const float*)(ws + WS_H1) + (size_t)tok * D; const f32x4* sq = (const f32x4*)((const float*)(ws + WS_SSQ) + (size_t)tok * 16);
            const f32x4 s0 = sq[0], s1 = sq[1], s2 = sq[2], s3 = sq[3];
            const float ss = ((s0[0] + s0[1]) + (s0[2] + s0[3])) + ((s1[0] + s1[1]) + (s1[2] + s1[3])) + ((s2[0] + s2[1]) + (s2[2] + s2[3])) + ((s3[0] + s3[1]) + (s3[2] + s3[3]));
            const float rstd = 1.0f / sqrtf(ss * (1.0f / D) + EPS);
            f32x4 a0 = (f32x4){0.f, 0.f, 0.f, 0.f}, a1 = a0; unsigned char* xo = (unsigned char*)(ws + WS_XN2) + (size_t)tok * D;
#pragma unroll 2
            for (int ks = 0; ks < 32; ++ks) { const int k = ks * 32 + kg * 8; const f32x4 h0 = *(const f32x4*)(hrow + k), h1 = *(const f32x4*)(hrow + k + 4), ga = *(const f32x4*)(g2 + k), gb = *(const f32x4*)(g2 + k + 4);
                float x[8] = {h0[0] * rstd * ga[0], h0[1] * rstd * ga[1], h0[2] * rstd * ga[2], h0[3] * rstd * ga[3], h1[0] * rstd * gb[0], h1[1] * rstd * gb[1], h1[2] * rstd * gb[2], h1[3] * rstd * gb[3]};
                unsigned hb[8]; float lr[8];
#pragma unroll
                for (int j = 0; j < 8; ++j) { hb[j] = f2bf(x[j]); lr[j] = x[j] - bf2f(hb[j]); }
                u32x4 hi4; hi4.x = hb[0] | (hb[1] << 16); hi4.y = hb[2] | (hb[3] << 16); hi4.z = hb[4] | (hb[5] << 16); hi4.w = hb[6] | (hb[7] << 16);
                u32x4 lo4; lo4.x = pk2(lr[0], lr[1]); lo4.y = pk2(lr[2], lr[3]); lo4.z = pk2(lr[4], lr[5]); lo4.w = pk2(lr[6], lr[7]);
                { u32x2 q8; q8.x = pk4_fp8(x[0], x[1], x[2], x[3]); q8.y = pk4_fp8(x[4], x[5], x[6], x[7]); *(u32x2*)(xo + k) = q8; }
                const bf16x8 xh = __builtin_bit_cast(bf16x8, hi4), xl = __builtin_bit_cast(bf16x8, lo4);
                const bf16x8 wh0 = *(const bf16x8*)(wh + (size_t)tl * D + k), wh1 = *(const bf16x8*)(wh + (size_t)(16 + tl) * D + k), wl0 = *(const bf16x8*)(wl + (size_t)tl * D + k), wl1 = *(const bf16x8*)(wl + (size_t)(16 + tl) * D + k);
                a0 = __builtin_amdgcn_mfma_f32_16x16x32_bf16(wh0, xh, a0, 0, 0, 0); a0 = __builtin_amdgcn_mfma_f32_16x16x32_bf16(wh0, xl, a0, 0, 0, 0); a0 = __builtin_amdgcn_mfma_f32_16x16x32_bf16(wl0, xh, a0, 0, 0, 0);
                a1 = __builtin_amdgcn_mfma_f32_16x16x32_bf16(wh1, xh, a1, 0, 0, 0); a1 = __builtin_amdgcn_mfma_f32_16x16x32_bf16(wh1, xl, a1, 0, 0, 0); a1 = __builtin_amdgcn_mfma_f32_16x16x32_bf16(wl1, xh, a1, 0, 0, 0); }
            float lg[8]; int le[8]; const float* br = F.in[I_BR];
#pragma unroll
            for (int j = 0; j < 4; ++j) { le[j] = 4 * kg + j; le[4 + j] = 16 + 4 * kg + j; lg[j] = a0[j] + br[le[j]]; lg[4 + j] = a1[j] + br[le[4 + j]]; }
            float tv[4]; int te[4];
#pragma unroll
            for (int r = 0; r < 4; ++r) { float bv = -3.0e38f; int be = 1 << 20;
#pragma unroll
                for (int j = 0; j < 8; ++j) if (lg[j] > bv || (lg[j] == bv && le[j] < be)) { bv = lg[j]; be = le[j]; }
#pragma unroll
                for (int o = 16; o <= 32; o <<= 1) { const float ov = __shfl_xor(bv, o); const int oe = __shfl_xor(be, o); if (ov > bv || (ov == bv && oe < be)) { bv = ov; be = oe; } }
                tv[r] = bv; te[r] = be;
#pragma unroll
                for (int j = 0; j < 8; ++j) if (le[j] == be) lg[j] = -3.0e38f; }
            if (kg == 0) { const float e1 = __expf(tv[1] - tv[0]), e2 = __expf(tv[2] - tv[0]), e3 = __expf(tv[3] - tv[0]); const float inv = 1.0f / (1.0f + e1 + e2 + e3);
                *(f32x4*)((float*)(ws + WS_TOPW) + (size_t)tok * 4) = (f32x4){inv, e1 * inv, e2 * inv, e3 * inv};
                int* tp = (int*)(ws + WS_TOPE) + (size_t)tok * 4; tp[0] = te[0]; tp[1] = te[1]; tp[2] = te[2]; tp[3] = te[3];
#pragma unroll
                for (int r = 0; r < 4; ++r) __hip_atomic_fetch_add((LAS unsigned*)(hist + te[r]), 1u, __ATOMIC_RELAXED, __HIP_MEMORY_SCOPE_WORKGROUP); }
        }
        __syncthreads();
        if (F.tid < 32) __hip_atomic_fetch_add(F.ctl + CW_CNT + F.tid, hist[F.tid], __ATOMIC_RELAXED, __HIP_MEMORY_SCOPE_AGENT);
}
__device__ __forceinline__ void phase9(Frame& F, const int var) {
    unsigned char* ws = F.ws; (void)ws;
        volatile LAS unsigned* sb = F.MISC + 16;
        LAS unsigned* base = (LAS unsigned*)F.lds; LAS unsigned* lcnt = base + 64; LAS unsigned* gb = base + 128; (void)sb;
        if (F.tid < 32) { lcnt[F.tid] = 0u; }
        if (F.tid == 0) { unsigned run = 0; for (int e = 0; e < NE; ++e) { const unsigned c = __hip_atomic_load(F.ctl + CW_CNT + e, __ATOMIC_RELAXED, __HIP_MEMORY_SCOPE_AGENT); base[e] = run * 256u; base[32 + e] = c; run += (c + 255u) >> 8; }
            base[96] = run; if (F.bx == 0) F.ctl[CW_NTILES] = run; }
        __syncthreads();
        if (F.bx == 0) { for (int e = 0; e < NE; ++e) { const unsigned t0 = base[e] >> 8, nt_ = (base[32 + e] + 255u) >> 8; for (unsigned t = F.tid; t < nt_; t += 512) ((int*)(ws + WS_TILEE))[t0 + t] = e; } }
        if (F.bx < NE) { const int e = F.bx; const unsigned c = base[32 + e], pe = ((c + 255u) >> 8) << 8; for (unsigned r = c + F.tid; r < pe; r += 512) { ((int*)(ws + WS_ROWTOK))[base[e] + r] = 0; ((int*)(ws + WS_ROWSLOT))[base[e] + r] = -1; } }
        for (int vb = F.bx; vb < T / 128; vb += F.G) {
            const int tok = vb * 128 + (F.tid >> 2), k = F.tid & 3; const int e = ((const int*)(ws + WS_TOPE))[(size_t)tok * 4 + k];
            const unsigned lr = __hip_atomic_fetch_add(lcnt + e, 1u, __ATOMIC_RELAXED, __HIP_MEMORY_SCOPE_WORKGROUP);
            __syncthreads();
            if (F.tid < 32) { gb[F.tid] = __hip_atomic_fetch_add(F.ctl + CW_FILL + F.tid, lcnt[F.tid], __ATOMIC_RELAXED, __HIP_MEMORY_SCOPE_AGENT); lcnt[F.tid] = 0u; }
            __syncthreads();
            const unsigned prow = base[e] + gb[e] + lr; ((int*)(ws + WS_ROWTOK))[prow] = tok; ((int*)(ws + WS_ROWSLOT))[prow] = tok * 4 + k;
            __syncthreads();
        }
}
__device__ __forceinline__ void phase10(Frame& F, const int var) {
    unsigned char* ws = F.ws; (void)ws;
        const int ntiles = (int)__hip_atomic_load(F.ctl + CW_NTILES, __ATOMIC_RELAXED, __HIP_MEMORY_SCOPE_AGENT);
        SchedMoe S{(const char*)(ws + WS_XN2), (const char*)(ws + WS_WGU), (const int*)(ws + WS_TILEE), ntiles, 8, F.G, F.bx, (size_t)2048 * D, (size_t)256 * D, true, var};
        EpiMoe1 E{F.in[I_BGU], (const int*)(ws + WS_TILEE), (unsigned char*)(ws + WS_A2), var};
        pg8::gemm_phase<EpiMoe1, SchedMoe, true, true>(F.lds, D, D, D, S, E, (const int*)(ws + WS_ROWTOK));
}
__device__ __forceinline__ void phase11(Frame& F, const int var) {
    unsigned char* ws = F.ws; (void)ws;
        const int ntiles = (int)__hip_atomic_load(F.ctl + CW_NTILES, __ATOMIC_RELAXED, __HIP_MEMORY_SCOPE_AGENT);
        SchedMoe S{(const char*)(ws + WS_A2), (const char*)(ws + WS_WD), (const int*)(ws + WS_TILEE), ntiles, 4, F.G, F.bx, (size_t)D * DF, (size_t)256 * DF, false, var};
        EpiMoe2 E{F.in[I_BD], (const int*)(ws + WS_TILEE), (const int*)(ws + WS_ROWSLOT), (bf16_t*)(ws + WS_YS), var};
        pg8::gemm_phase<EpiMoe2, SchedMoe, false, true>(F.lds, DF, DF, DF, S, E, nullptr, var);
}
__device__ __forceinline__ void phase12(Frame& F, const int var) {
    unsigned char* ws = F.ws; (void)ws;
        const int lane = F.lane; const float* fg = F.in[I_FNG];
        float pe = 0.f; if (MK_STAMP >= 0) { const float dt = __builtin_bit_cast(float, __hip_atomic_load(F.ctl + 200, __ATOMIC_RELAXED, __HIP_MEMORY_SCOPE_AGENT)); pe = sqrtf(dt * MK_STAMP_SCALE); if (lane & 1) pe = -pe; }
        for (int tok = F.vcu * 8 + F.wave; tok < T; tok += F.G * 8) {
            const f32x4 w = *(const f32x4*)((const float*)(ws + WS_TOPW) + (size_t)tok * 4); const float wk[4] = {w[0], w[1], w[2], w[3]};
            const f32x4* hr = (const f32x4*)((const float*)(ws + WS_H1) + (size_t)tok * D) + lane; f32x4 v[4]; float s = 0.f;
#pragma unroll
            for (int j = 0; j < 4; ++j) { v[j] = hr[64 * j];
#pragma unroll
                for (int k = 0; k < 4; ++k) { const u32x2 y = *((const u32x2*)((const bf16_t*)(ws + WS_YS) + ((size_t)tok * 4 + k) * D) + lane + 64 * j);
                    v[j].x += wk[k] * bf2f(y.x & 0xffffu); v[j].y += wk[k] * bf2f(y.x >> 16); v[j].z += wk[k] * bf2f(y.y & 0xffffu); v[j].w += wk[k] * bf2f(y.y >> 16); }
                s += (v[j].x * v[j].x + v[j].y * v[j].y) + (v[j].z * v[j].z + v[j].w * v[j].w); }
            const float rstd = 1.0f / sqrtf(wave_sum(s) * (1.0f / D) + EPS);
            f32x4* o = (f32x4*)(F.out + (size_t)tok * D) + lane;
#pragma unroll
            for (int j = 0; j < 4; ++j) { const f32x4 gg = ((const f32x4*)fg)[lane + 64 * j]; o[64 * j] = (f32x4){v[j].x * rstd * gg.x * (1.f + pe), v[j].y * rstd * gg.y * (1.f - pe), v[j].z * rstd * gg.z * (1.f + pe), v[j].w * rstd * gg.w * (1.f - pe)}; }
        }
}
struct Args { const float* in[26]; float* out; unsigned char* ws; int ph_lo, ph_hi; };
constexpr int NPHASE = 13;

__global__ void __launch_bounds__(512, 2) mk_fwd(Args args) {
    extern __shared__ __attribute__((aligned(16))) unsigned char lds[];
    Frame F;
    F.lds = (LAS unsigned char*)lds; F.MISC = (volatile LAS unsigned*)(F.lds + MISC_OFF);
    F.tid = threadIdx.x; F.lane = F.tid & 63; F.wave = __builtin_amdgcn_readfirstlane(F.tid >> 6);
    F.G = gridDim.x; F.bx = blockIdx.x; F.vcu = (F.G % 8 == 0) ? (F.bx % 8) * (F.G / 8) + F.bx / 8 : F.bx;
    F.ws = args.ws; F.ctl = (unsigned*)(args.ws + WS_CTL); F.out = args.out;
#pragma unroll
    for (int i = 0; i < 26; ++i) F.in[i] = args.in[i];
    for (int u = F.tid; u < 64; u += 512) F.MISC[u] = 0u;
    __syncthreads();
    unsigned char* ws = F.ws;
    XcdBarrier bar; bar.bar = F.ctl + CW_BAR; bar.x = 0; bar.st = nullptr;
    if (!MK_PER_PHASE) bar = xcd_barrier_post(F.ctl + CW_BAR, F.MISC + 8);
    const int lo = args.ph_lo, hi = args.ph_hi;
    unsigned long long ts_a = 0ull, ts_b = 0ull; (void)ts_a; (void)ts_b;
#define STAMP(k) do { if (MK_STAMP >= 0 && F.bx == 0 && F.tid == 0) { if ((k) == MK_STAMP) ts_a = __builtin_amdgcn_s_memrealtime(); if ((k) == MK_STAMP + 1) { ts_b = __builtin_amdgcn_s_memrealtime(); \
        __hip_atomic_store(F.ctl + 200, __builtin_bit_cast(unsigned, (float)(ts_b - ts_a) * 0.01f), __ATOMIC_RELAXED, __HIP_MEMORY_SCOPE_AGENT); } } } while (0)
#define IN(k) (lo <= (k) && (k) < hi)
#define SEAM(k) do { if (IN(k) && IN((k) + 1)) xcd_barrier(bar); } while (0)

    STAMP(0);
    if (IN(0)) { phase0(F, 0); if ((MK_REP_MASK >> 0) & 1) { xcd_barrier(bar); phase0(F, MK_VARIANT); } }
    SEAM(0);
    STAMP(1);
    if (IN(1)) { phase1(F, 0); if ((MK_REP_MASK >> 1) & 1) { xcd_barrier(bar); phase1(F, MK_VARIANT); } }
    SEAM(1);
    STAMP(2);
    if (IN(2)) { phase2(F, 0); if ((MK_REP_MASK >> 2) & 1) { xcd_barrier(bar); phase2(F, MK_VARIANT); } }
    SEAM(2);
    STAMP(3);
    if (IN(3)) { phase3(F, 0); if ((MK_REP_MASK >> 3) & 1) { xcd_barrier(bar); phase3(F, MK_VARIANT); } }
    SEAM(3);
    STAMP(4);
    if (IN(4)) { phase4(F, 0); if ((MK_REP_MASK >> 4) & 1) { xcd_barrier(bar); phase4(F, MK_VARIANT); } }
    SEAM(4);
    STAMP(5);
    if (IN(5)) { phase5(F, 0); if ((MK_REP_MASK >> 5) & 1) { xcd_barrier(bar); phase5(F, MK_VARIANT); } }
    SEAM(5);
    STAMP(6);
    if (IN(6)) { phase6(F, 0); if ((MK_REP_MASK >> 6) & 1) { xcd_barrier(bar); phase6(F, MK_VARIANT); } }
    SEAM(6);
    STAMP(7);
    if (IN(7)) { phase7(F, 0); if ((MK_REP_MASK >> 7) & 1) { xcd_barrier(bar); phase7(F, MK_VARIANT); } }
    SEAM(7);
    STAMP(8);
    if (IN(8)) { phase8(F, 0); if ((MK_REP_MASK >> 8) & 1) { xcd_barrier(bar); phase8(F, MK_VARIANT); } }
    SEAM(8);
    STAMP(9);
    if (IN(9)) { phase9(F, 0); if ((MK_REP_MASK >> 9) & 1) { xcd_barrier(bar); phase9(F, MK_VARIANT); } }
    SEAM(9);
    STAMP(10);
    if (IN(10)) { phase10(F, 0); if ((MK_REP_MASK >> 10) & 1) { xcd_barrier(bar); phase10(F, MK_VARIANT); } }
    SEAM(10);
    STAMP(11);
    if (IN(11)) { phase11(F, 0); if ((MK_REP_MASK >> 11) & 1) { xcd_barrier(bar); phase11(F, MK_VARIANT); } }
    SEAM(11);
    STAMP(12);
    if (IN(12)) { phase12(F, 0); if ((MK_REP_MASK >> 12) & 1) { xcd_barrier(bar); phase12(F, MK_VARIANT); } }
#undef IN
#undef SEAM
}

extern "C" void kernel_launch(void* const* d_in, const int* in_sizes, int n_in, void* d_out, int out_size, void* d_ws, size_t ws_size, hipStream_t stream) {
    static int grid = 0;
    if (grid == 0) {
        if (n_in != 26 || in_sizes[0] != T * D || out_size != T * D || ws_size < WS_END) { fprintf(stderr, "kernel_launch: unexpected shapes (n_in %d, in0 %d, out %d, ws %zu < %zu)\n", n_in, n_in > 0 ? in_sizes[0] : -1, out_size, ws_size, (size_t)WS_END); grid = -1; return; }
        int dev = 0, cus = 0, per_cu = 0;
        if (hipGetDevice(&dev) != hipSuccess || hipDeviceGetAttribute(&cus, hipDeviceAttributeMultiprocessorCount, dev) != hipSuccess) { grid = -1; return; }
        if (hipFuncSetAttribute((const void*)mk_fwd, hipFuncAttributeMaxDynamicSharedMemorySize, LDS_BYTES) != hipSuccess) { fprintf(stderr, "kernel_launch: hipFuncSetAttribute failed\n"); grid = -1; return; }
        if (hipOccupancyMaxActiveBlocksPerMultiprocessor(&per_cu, (const void*)mk_fwd, 512, LDS_BYTES) != hipSuccess || per_cu < 1) fprintf(stderr, "kernel_launch: occupancy query reports %d\n", per_cu);
        (void)hipGetLastError();
        grid = cus;
        if (grid != 256) fprintf(stderr, "kernel_launch: %d CUs (built for 256)\n", grid);
    }
    if (grid < 0) return;
    (void)hipMemsetAsync((char*)d_ws + WS_CTL, 0, 1 * MiB, stream);
    Args a{};
    for (int i = 0; i < 26; ++i) a.in[i] = (const float*)d_in[i];
    a.out = (float*)d_out; a.ws = (unsigned char*)d_ws;
#if MK_PER_PHASE
    for (int p = 0; p < NPHASE; ++p) { a.ph_lo = p; a.ph_hi = p + 1; hipLaunchKernelGGL(mk_fwd, dim3(grid), dim3(512), LDS_BYTES, stream, a); }
#else
    a.ph_lo = 0; a.ph_hi = NPHASE; hipLaunchKernelGGL(mk_fwd, dim3(grid), dim3(512), LDS_BYTES, stream, a);
#endif
}
```

```cpp
#include <hip/hip_runtime.h>
#include <cstdio>
#include <cstdint>

#ifndef MK_PER_PHASE
#define MK_PER_PHASE 0
#endif

#ifndef MK_REP_MASK
#define MK_REP_MASK 0
#endif

#ifndef MK_P1_F8
#define MK_P1_F8 0
#endif
#ifndef MK_GATES_F8
#define MK_GATES_F8 1
#endif
#ifndef MK_GSTORE_F8
#define MK_GSTORE_F8 1
#endif
#ifndef MK_STAGGER
#define MK_STAGGER 0
#endif
#ifndef MK_STAMP
#define MK_STAMP -1
#endif
#define MK_STAMP_SCALE 1e-5f
#ifndef MK_VARIANT
#define MK_VARIANT 0
#endif

#define LAS __attribute__((address_space(3)))
#define GAS __attribute__((address_space(1)))
typedef unsigned short bf16_t;
typedef short bf16x8 __attribute__((ext_vector_type(8)));
typedef float f32x4 __attribute__((ext_vector_type(4)));
typedef float f32x2 __attribute__((ext_vector_type(2)));
typedef float f32x16 __attribute__((ext_vector_type(16)));
typedef unsigned u32x4 __attribute__((ext_vector_type(4)));
typedef unsigned u32x2 __attribute__((ext_vector_type(2)));
typedef int i32x4 __attribute__((ext_vector_type(4)));
typedef int i32x8 __attribute__((ext_vector_type(8)));

constexpr int T = 32768, D = 1024, NB = 4, SEQ = 8192, NCH = 128, CH = 64, NMETA = 16, INW = 4608;
constexpr int SG = 32, SH = 16, SP = 64;
constexpr int HH = 4, HD = 128, HW = 512;
constexpr int NE = 32, TOPK = 4, DF = 1024;
constexpr int UAK = 1152;
constexpr float EPS = 1e-6f;
constexpr int MAXTILES = 544;

constexpr size_t MiB = 1u << 20, KiB = 1024;
constexpr size_t WS_CTL = 0;
constexpr size_t WS_LBV = 1 * MiB, WS_LAMB = 1 * MiB + 4 * KiB, WS_LAMC = 1 * MiB + 20 * KiB, WS_XMETA = 1 * MiB + 36 * KiB;
constexpr size_t WS_BBAR = 1 * MiB + 64 * KiB, WS_WRT = 1 * MiB + 320 * KiB, WS_PMR = 1 * MiB + 512 * KiB  ;
constexpr size_t WS_KCONV = 2 * MiB, WS_SMETA = 3 * MiB;
constexpr size_t WS_WIN = 4 * MiB, WS_WGLU = 13 * MiB, WS_WBS = 14 * MiB, WS_WBH = 15 * MiB, WS_WOUT = 16 * MiB, WS_WGU = 18 * MiB, WS_WD = 146 * MiB;
constexpr size_t WS_TZ = 210 * MiB, WS_WE = 282 * MiB, WS_XN = 298 * MiB, WS_UA = 362 * MiB, WS_Q = 398 * MiB, WS_LOGF = 430 * MiB, WS_V = 494 * MiB;
constexpr size_t WS_GS = 526 * MiB, WS_GATES = 558 * MiB, WS_KVT = 686 * MiB, WS_SPREV = 814 * MiB, WS_SE = 878 * MiB, WS_DEC = 886 * MiB;
constexpr size_t WS_Y1 = 888 * MiB, WS_YHG = 920 * MiB, WS_YS5 = 952 * MiB, WS_PMETA = 984 * MiB  , WS_XN8 = 986 * MiB  , WS_END = 1018 * MiB;
constexpr size_t WS_WIN8 = WS_WIN + 5 * MiB;
constexpr size_t WS_BCUM = 298 * MiB;
constexpr size_t WS_MERGED = 686 * MiB, WS_XN2 = 210 * MiB, WS_H1 = 274 * MiB, WS_SSQ = 402 * MiB, WS_TOPE = 404 * MiB, WS_TOPW = 404 * MiB + 512 * KiB;
constexpr size_t WS_ROWTOK = 405 * MiB, WS_ROWSLOT = 406 * MiB, WS_TILEE = 407 * MiB, WS_A2 = 408 * MiB, WS_YS = 680 * MiB;
constexpr int CW_CNT = 64, CW_FILL = 128, CW_NTILES = 192, CW_BAR = 4096;

constexpr int RING_BYTES = 131072, GOFF_LDS = RING_BYTES, MISC_OFF = RING_BYTES + 16384 + 256, LDS_BYTES = 155648;

__device__ __forceinline__ unsigned f2bf(float f) { unsigned u = __builtin_bit_cast(unsigned, f); return (u + 0x7fffu + ((u >> 16) & 1u)) >> 16; }
__device__ __forceinline__ float bf2f(unsigned b) { return __builtin_bit_cast(float, b << 16); }
__device__ __forceinline__ unsigned pk2(float lo, float hi) { return f2bf(lo) | (f2bf(hi) << 16); }
__device__ __forceinline__ unsigned cvt_pk_bf16(float lo, float hi) { unsigned r; asm volatile("v_cvt_pk_bf16_f32 %0, %1, %2" : "=v"(r) : "v"(lo), "v"(hi)); return r; }
__device__ __forceinline__ unsigned pk4_fp8(float a, float b, float c, float d) {
    a = fminf(fmaxf(a, -448.f), 448.f); b = fminf(fmaxf(b, -448.f), 448.f); c = fminf(fmaxf(c, -448.f), 448.f); d = fminf(fmaxf(d, -448.f), 448.f);
    int w = 0; w = __builtin_amdgcn_cvt_pk_fp8_f32(a, b, w, false); w = __builtin_amdgcn_cvt_pk_fp8_f32(c, d, w, true); return (unsigned)w; }
__device__ __forceinline__ unsigned pk4_u8(float a, float b, float c, float d) {
    return (unsigned)(a * 255.f + 0.5f) | ((unsigned)(b * 255.f + 0.5f) << 8) | ((unsigned)(c * 255.f + 0.5f) << 16) | ((unsigned)(d * 255.f + 0.5f) << 24); }
__device__ __forceinline__ float sigmoidf_(float x) { return 1.0f / (1.0f + __expf(-x)); }
__device__ __forceinline__ float wave_sum(float v) {
#pragma unroll
    for (int o = 1; o < 64; o <<= 1) v += __shfl_xor(v, o);
    return v;
}
#define LDS_WAIT() asm volatile("s_waitcnt lgkmcnt(0)" ::: "memory")
#define VM_WAIT() asm volatile("s_waitcnt vmcnt(0)" ::: "memory")

#define XB_TMO      128
#define XB_XCNT(j)  (256  + 64 * (j))
#define XB_XSUB(j)  (1280 + 64 * (j))
#define XB_XGEN(j)  (2304 + 64 * (j))
#define XB_TOP      3328
#define XB_TOPGEN   3392
#define XCD_BAR_WORDS 3456
#define XB_SPIN_CAP (1u << 22)
__device__ __forceinline__ unsigned xb_ld(unsigned* p)              { return __hip_atomic_load(p, __ATOMIC_RELAXED, __HIP_MEMORY_SCOPE_AGENT); }
__device__ __forceinline__ unsigned xb_add(unsigned* p, unsigned v) { return __hip_atomic_fetch_add(p, v, __ATOMIC_RELAXED, __HIP_MEMORY_SCOPE_AGENT); }
__device__ __forceinline__ unsigned xb_xcc_id() { return (unsigned)__builtin_amdgcn_s_getreg((3 << 11) | 20) & 0xFu; }
#define XB_SPIN(cond, bar) do { unsigned _sp = 0; while (cond) { __builtin_amdgcn_s_sleep(1); \
    if ((++_sp & 255u) == 0u) { if (xb_ld(&(bar)[XB_TMO])) break; if (_sp > XB_SPIN_CAP) { atomicAdd(&(bar)[XB_TMO], 1u); break; } } } } while (0)
struct XcdBarrier { unsigned* bar; unsigned x; volatile LAS unsigned* st; };
__device__ __forceinline__ XcdBarrier xcd_barrier_post(unsigned* bar, volatile LAS unsigned* st) {
    XcdBarrier b; b.bar = bar; b.x = xb_xcc_id(); b.st = st;
    if (threadIdx.x == 0) (void)xb_add(&bar[XB_XCNT(b.x)], 1u);
    return b;
}
__device__ __forceinline__ void xcd_barrier_complete(unsigned* bar, unsigned x, unsigned& nloc, unsigned& nx) {
    const unsigned G = gridDim.x * gridDim.y * gridDim.z;
    unsigned sum, cnt, mine, sp = 0u;
    for (;;) {
        sum = 0u; cnt = 0u; mine = 0u;
#pragma unroll
        for (unsigned j = 0; j < 16; ++j) { const unsigned c = xb_ld(&bar[XB_XCNT(j)]); sum += c; cnt += (c > 0u) ? 1u : 0u; mine = (j == x) ? c : mine; }
        if (sum == G) break;
        __builtin_amdgcn_s_sleep(1);
        if ((++sp & 255u) == 0u) { if (xb_ld(&bar[XB_TMO])) break; if (sp > XB_SPIN_CAP) { atomicAdd(&bar[XB_TMO], 1u); break; } }
    }
    nloc = mine > 0u ? mine : 1u; nx = cnt > 0u ? cnt : 1u;
}
__device__ __forceinline__ void xcd_barrier(const XcdBarrier& b) {
    asm volatile("s_waitcnt vmcnt(0)" ::: "memory");
    __syncthreads();
    if (threadIdx.x == 0) {
        unsigned* bar = b.bar;
        __builtin_amdgcn_s_waitcnt(0);
        unsigned nloc = b.st[0], nx = b.st[1];
        if (nloc == 0u) { xcd_barrier_complete(bar, b.x, nloc, nx); b.st[0] = nloc; b.st[1] = nx; }
        const unsigned old = xb_add(&bar[XB_XSUB(b.x)], 1u);
        const unsigned gen = old / nloc;
        if (old + 1u == (gen + 1u) * nloc) {
            __builtin_amdgcn_fence(__ATOMIC_RELEASE, "agent");
            asm volatile("s_waitcnt vmcnt(0)" ::: "memory");
            const unsigned og = xb_add(&bar[XB_TOP], 1u);
            const unsigned tg = og / nx;
            if (og + 1u == (tg + 1u) * nx) xb_add(&bar[XB_TOPGEN], 1u);
            else XB_SPIN(xb_ld(&bar[XB_TOPGEN]) == tg, bar);
            __builtin_amdgcn_fence(__ATOMIC_ACQUIRE, "agent");
            xb_add(&bar[XB_XGEN(b.x)], 1u);
            asm volatile("s_waitcnt vmcnt(0)" ::: "memory");
        } else {
            XB_SPIN(xb_ld(&bar[XB_XGEN(b.x)]) == gen, bar);
            __builtin_amdgcn_fence(__ATOMIC_ACQUIRE, "agent");
            asm volatile("s_waitcnt vmcnt(0)" ::: "memory");
        }
    }
    __syncthreads();
}

namespace pg8 {
constexpr int BM = 256, BK = 64, HALF = 128, HTB = HALF * BK * 2, STAGE_BYTES = 8 * HTB, NXCD = 8, WGM = 8;
__device__ __forceinline__ int lds_byte(int r, int c) { const int st = (r >> 4) * 2 + (c >> 5), rr = r & 15, cc = c & 31, ob = rr * 64 + cc * 2; return st * 1024 + (ob ^ (((ob >> 9) & 1) << 5)); }
__device__ __forceinline__ void stage_rc(int b, int& R, int& C) { const int st = b / 1024, sb = b % 1024, swz = sb ^ (((sb >> 9) & 1) << 5); R = (st >> 1) * 16 + swz / 64; C = (st & 1) * 32 + (swz % 64) / 2; }
__device__ __forceinline__ int perm32(int rho) { const int n = rho >> 4, i = rho & 15; return 8 * (i >> 2) + 4 * n + (i & 3); }

struct Unit { int pm, pn, aux; const char* a; const char* b; };

__device__ __forceinline__ bool static_tile(int L, int nM, int nN, int& pm, int& pn) {
    const int nwg = nM * nN; if (L >= nwg) return false;
    int wgid = L; { const int q = nwg / NXCD, r = nwg % NXCD, xcd = wgid % NXCD, off = wgid / NXCD; wgid = (xcd < r ? xcd * (q + 1) : r * (q + 1) + (xcd - r) * q) + off; }
    const int nig = WGM * nN, gid = wgid / nig, fm = gid * WGM, gsz = (nM - fm) < WGM ? (nM - fm) : WGM;
    pm = fm + ((wgid % nig) % gsz); pn = (wgid % nig) / gsz; return true;
}

constexpr int F8_WSH = 6;
template <class Epi, class Sched, bool GATHER, bool F8 = false>
__device__ __forceinline__ void gemm_phase(LAS unsigned char* lds, const int K, const int lda, const int ldb, const Sched& S, const Epi& E, const int* __restrict__ rowidx, const int pv = 0) {
    const int tid = threadIdx.x, wid = __builtin_amdgcn_readfirstlane(tid >> 6), lane = tid & 63, wr = wid >> 2, wc = wid & 3, fr = lane & 15, fq = lane >> 4;
    constexpr int ES = F8 ? 1 : 2;
    const int nt = K / (F8 ? 128 : BK);
#define PG8_SW(r) ((((r) >> 1) & 7) ^ (((((r) >> 2) ^ ((r) >> 3)) & 1) * (F8 ? 2 : 1)))
    unsigned voffA[2], voffB[2]; int gR[2], gC[2];
#pragma unroll
    for (int i = 0; i < 2; ++i) { const int q = tid * 16 + i * 8192, r = (q >> 7) & 15; const int R = (q >> 11) * 16 + r, C = (((q >> 4) & 7) ^ PG8_SW(r)) * 16;
        const int Rb = Epi::PERM ? ((R & ~31) + perm32(R & 31)) : R;
        voffA[i] = (unsigned)(R * lda * ES + C); voffB[i] = (unsigned)(Rb * ldb * ES + C); gR[i] = R; gC[i] = C; }
    const size_t kstep = (size_t)(BK * 2);
    const size_t hstepA = (size_t)HALF * lda * ES, hstepB = (size_t)HALF * ldb * ES;
    const unsigned ldsw = (unsigned)wid * 1024u;
    const int sx = PG8_SW(fr), ck0 = F8 ? 2 * fq : fq, ck1 = F8 ? 2 * fq + 1 : 4 + fq;
    const int aoff0 = wr * 8192 + fr * 128 + 16 * (ck0 ^ sx), aoff1 = wr * 8192 + fr * 128 + 16 * (ck1 ^ sx), boff0 = wc * 4096 + fr * 128 + 16 * (ck0 ^ sx), boff1 = wc * 4096 + fr * 128 + 16 * (ck1 ^ sx);
#define PG8_SA(b, h) (((b) * 2 + (h)) * HTB)
#define PG8_SB(b, h) ((4 + (b) * 2 + (h)) * HTB)
#define PG8_GLDS(src, dstoff) do { if (!(pv & 32)) __builtin_amdgcn_global_load_lds((const unsigned*)(src), (LAS unsigned*)(lds + (dstoff)), 16, 0, 0); } while (0)
#define PG8_STAGEB(bufoff, gbase) do { PG8_GLDS((const char*)(gbase) + voffB[0], (bufoff) + ldsw); PG8_GLDS((const char*)(gbase) + voffB[1], (bufoff) + ldsw + 8192); } while (0)
#define PG8_STAGEA(bufoff, gbase, h, SET) do { if constexpr (GATHER) { const u32x2 o_ = *(const LAS u32x2*)(lds + GOFF_LDS + ((SET) * 2 + (h)) * 4096 + tid * 8); \
        PG8_GLDS((const char*)(gbase) + o_.x, (bufoff) + ldsw); PG8_GLDS((const char*)(gbase) + o_.y, (bufoff) + ldsw + 8192); } \
        else { PG8_GLDS((const char*)(gbase) + (h) * hstepA + voffA[0], (bufoff) + ldsw); PG8_GLDS((const char*)(gbase) + (h) * hstepA + voffA[1], (bufoff) + ldsw + 8192); } } while (0)
#define PG8_LDA(dst, b, h) do { _Pragma("unroll") for (int m = 0; m < 4; ++m) { dst[m][0] = *(const LAS bf16x8*)(lds + PG8_SA(b, h) + aoff0 + m * 2048); dst[m][1] = *(const LAS bf16x8*)(lds + PG8_SA(b, h) + aoff1 + m * 2048); } } while (0)
#define PG8_LDB(dst, b, h) do { _Pragma("unroll") for (int n = 0; n < 2; ++n) { dst[n][0] = *(const LAS bf16x8*)(lds + PG8_SB(b, h) + boff0 + n * 2048); dst[n][1] = *(const LAS bf16x8*)(lds + PG8_SB(b, h) + boff1 + n * 2048); } } while (0)
#define PG8_CAT(lo, hi) __builtin_shufflevector(__builtin_bit_cast(i32x4, lo), __builtin_bit_cast(i32x4, hi), 0, 1, 2, 3, 4, 5, 6, 7)
#define PG8_MMA(ai, bj, At, Bt) do { if (pv & 16) { asm volatile("" :: "v"(At[0][0]), "v"(At[1][0]), "v"(At[2][0]), "v"(At[3][0]), "v"(At[0][1]), "v"(At[1][1]), "v"(At[2][1]), "v"(At[3][1]), "v"(Bt[0][0]), "v"(Bt[0][1]), "v"(Bt[1][0]), "v"(Bt[1][1])); break; } __builtin_amdgcn_s_setprio(1); _Pragma("unroll") for (int m = 0; m < 4; ++m) _Pragma("unroll") for (int n = 0; n < 2; ++n) { \
        if constexpr (F8) { const i32x8 b8_ = PG8_CAT(Bt[n][0], Bt[n][1]), a8_ = PG8_CAT(At[m][0], At[m][1]); \
            asm volatile("v_mfma_scale_f32_16x16x128_f8f6f4 %0, %1, %2, %0, %3, %4 op_sel_hi:[0,0,0]" : "+v"(acc[ai][bj][m][n]) : "v"(b8_), "v"(a8_), "v"(sc_w), "v"(sc_x)); } \
        else { _Pragma("unroll") for (int k = 0; k < 2; ++k) acc[ai][bj][m][n] = __builtin_amdgcn_mfma_f32_16x16x32_bf16(Bt[n][k], At[m][k], acc[ai][bj][m][n], 0, 0, 0); } } __builtin_amdgcn_s_setprio(0); } while (0)
#define PG8_WAIT_V(n) asm volatile("s_waitcnt vmcnt(" #n ")" ::: "memory")
#define PG8_WAIT_L(n) asm volatile("s_waitcnt lgkmcnt(" #n ")" ::: "memory")
#define PG8_BAR __builtin_amdgcn_s_barrier()
#define PG8_SCHED __builtin_amdgcn_sched_barrier(0)
#define PG8_GOFFS(SET, U) do { if constexpr (GATHER) { _Pragma("unroll") for (int h_ = 0; h_ < 2; ++h_) { u32x2 o_; \
        o_.x = (unsigned)rowidx[(U).aux + h_ * HALF + gR[0]] * (unsigned)(lda * ES) + (unsigned)gC[0]; o_.y = (unsigned)rowidx[(U).aux + h_ * HALF + gR[1]] * (unsigned)(lda * ES) + (unsigned)gC[1]; \
        *(LAS u32x2*)(lds + GOFF_LDS + ((SET) * 2 + h_) * 4096 + tid * 8) = o_; } } } while (0)
    const int sc_w = 127 - F8_WSH, sc_x = 127; (void)sc_w; (void)sc_x;
    Unit cur, nxt; int ui = 0;
    if (!S.next(0, cur)) return;
    f32x4 acc[2][2][4][2];
#pragma unroll
    for (int a = 0; a < 2; ++a)
#pragma unroll
        for (int b = 0; b < 2; ++b)
#pragma unroll
            for (int m = 0; m < 4; ++m)
#pragma unroll
                for (int n = 0; n < 2; ++n) acc[a][b][m][n] = (f32x4){0.f, 0.f, 0.f, 0.f};
    bf16x8 At[4][2], B0[2][2], B1[2][2];
    PG8_GOFFS(0, cur);
    const char* cA = cur.a; const char* cB = cur.b;
    PG8_STAGEB(PG8_SB(0, 0), cB); PG8_STAGEB(PG8_SB(0, 1), cB + hstepB); PG8_STAGEA(PG8_SA(0, 0), cA, 0, 0); PG8_STAGEA(PG8_SA(0, 1), cA, 1, 0);
    if (wr == 1) PG8_BAR;
    PG8_WAIT_V(2); PG8_BAR;
    PG8_STAGEB(PG8_SB(1, 0), cB + kstep); PG8_STAGEA(PG8_SA(1, 0), cA + kstep, 0, 0); PG8_STAGEB(PG8_SB(1, 1), cB + hstepB + kstep);
    PG8_WAIT_V(6); PG8_BAR;
    for (;;) {
        const bool has_next = S.next(ui + 1, nxt);
        const int cs = ui & 1; if (has_next) PG8_GOFFS(cs ^ 1, nxt);
        const char* nA = has_next ? nxt.a : cA; const char* nB = has_next ? nxt.b : cB;
#pragma unroll 1
        for (int t = 0; t < nt; t += 2) {
            const bool last = (t == nt - 2);
            const char* a1 = cA + (size_t)(t + 1) * kstep;
            const char* a2 = last ? nA : cA + (size_t)(t + 2) * kstep; const char* b2 = last ? nB : cB + (size_t)(t + 2) * kstep;
            const char* a3 = a2 + kstep; const char* b3 = b2 + kstep;
            const int s2 = (last && has_next) ? (cs ^ 1) : cs;
            PG8_LDB(B0, 0, 0); PG8_LDB(B1, 0, 1); PG8_SCHED; PG8_LDA(At, 0, 0); PG8_STAGEA(PG8_SA(1, 1), a1, 1, cs);
            PG8_WAIT_V(8); PG8_WAIT_L(0); PG8_BAR; PG8_MMA(0, 0, At, B0); PG8_MMA(0, 1, At, B1); PG8_BAR; PG8_SCHED;
            PG8_LDA(At, 0, 1); PG8_STAGEB(PG8_SB(0, 0), b2); PG8_STAGEB(PG8_SB(0, 1), b2 + hstepB); PG8_STAGEA(PG8_SA(0, 0), a2, 0, s2);
            PG8_WAIT_V(8); PG8_WAIT_L(0); PG8_BAR; PG8_MMA(1, 0, At, B0); PG8_MMA(1, 1, At, B1); PG8_BAR; PG8_SCHED;
            PG8_LDB(B0, 1, 0); PG8_LDB(B1, 1, 1); PG8_SCHED; PG8_LDA(At, 1, 0); PG8_STAGEA(PG8_SA(0, 1), a2, 1, s2);
            PG8_WAIT_V(8); PG8_WAIT_L(0); PG8_BAR; PG8_MMA(0, 0, At, B0); PG8_MMA(0, 1, At, B1); PG8_BAR; PG8_SCHED;
            PG8_LDA(At, 1, 1); PG8_STAGEB(PG8_SB(1, 0), b3); PG8_STAGEB(PG8_SB(1, 1), b3 + hstepB); PG8_STAGEA(PG8_SA(1, 0), a3, 0, s2);
            PG8_WAIT_V(8); PG8_WAIT_L(0); PG8_BAR; PG8_MMA(1, 0, At, B0); PG8_MMA(1, 1, At, B1); PG8_BAR; PG8_SCHED;
        }
        if constexpr (F8) asm volatile("s_nop 15\n\ts_nop 15" ::: "memory");
        if (wr == 0) PG8_BAR;
        int fr_e = fr, fq_e = fq; asm volatile("" : "+v"(fr_e), "+v"(fq_e));
        const bool keep = E(acc, cur, wr, wc, fr_e, fq_e);
        if (!has_next) break;
        if (!keep) {
#pragma unroll
            for (int a = 0; a < 2; ++a)
#pragma unroll
                for (int b = 0; b < 2; ++b)
#pragma unroll
                    for (int m = 0; m < 4; ++m)
#pragma unroll
                        for (int n = 0; n < 2; ++n) acc[a][b][m][n] = (f32x4){0.f, 0.f, 0.f, 0.f};
        }
        cur = nxt; cA = nA; cB = nB; ++ui;
        if (wr == 1) PG8_BAR;
    }
    PG8_WAIT_V(0);
    PG8_BAR;
#undef PG8_SW
#undef PG8_SA
#undef PG8_SB
#undef PG8_GLDS
#undef PG8_STAGEA
#undef PG8_STAGEB
#undef PG8_LDA
#undef PG8_LDB
#undef PG8_MMA
#undef PG8_CAT
#undef PG8_WAIT_V
#undef PG8_WAIT_L
#undef PG8_BAR
#undef PG8_SCHED
#undef PG8_GOFFS
}
}
using pg8::Unit;

struct Frame {
    LAS unsigned char* lds; volatile LAS unsigned* MISC; unsigned* ctl; unsigned char* ws;
    int tid, lane, wave, vcu, G, bx;
    const float* in[26]; float* out;
};
enum { I_X = 0, I_META, I_N1G, I_WIN, I_LRE, I_LIM, I_LDT, I_BRE, I_BIM, I_CRE, I_CIM, I_SD, I_WGLU, I_LBL, I_HNG, I_WBS, I_WBH, I_WOUT, I_N2G, I_WR, I_BR, I_WGU, I_BGU, I_WD, I_BD, I_FNG };

struct SchedStatic {
    const char* A; const char* B; int nM, nN, G, c; size_t ta, tb; int var = 0, pn_off = 0;
    __device__ __forceinline__ bool next(int i, Unit& u) const { int pm, pn; if (!pg8::static_tile(i * G + c, nM, nN, pm, pn)) return false; u.pm = pm; u.pn = pn + pn_off; u.aux = 0; u.a = A + (size_t)pm * ta; u.b = B + (size_t)pn * tb; if (var & 8) { u.a = A; u.b = B; } return true; }
};
struct SchedS5E {
    const char* UA; const char* WE; int c;
    __device__ __forceinline__ bool next(int i, Unit& u) const { if (i > 0 || c >= 64) return false; const int x = c & 7, r = c >> 3, g = x * 4 + (r >> 1), pm = r & 1; u.pm = pm; u.pn = 0; u.aux = g;
        u.a = UA + ((size_t)g * 512 + pm * 256) * UAK * 2; u.b = WE + (size_t)g * 256 * 1024 * 2; return true; }
};
struct SchedS5Y {
    const char* UA; const char* TZ; int c, G;
    __device__ __forceinline__ bool next(int i, Unit& u) const { if (i > 0 || G != 256) { const int L = i * G + c; if (G == 256 || L >= 256) return false; const int g = L >> 3; u.pm = (L >> 2) & 1; u.pn = L & 3; u.aux = g;
            u.a = UA + ((size_t)g * 512 + u.pm * 256) * UAK * 2; u.b = TZ + ((size_t)g * 1024 + u.pn * 256) * UAK * 2; return true; }
        const int x = c & 7, r = c >> 3, g = x + 8 * (r >> 3), pm = (r >> 2) & 1, pn = r & 3; u.pm = pm; u.pn = pn; u.aux = g;
        u.a = UA + ((size_t)g * 512 + pm * 256) * UAK * 2; u.b = TZ + ((size_t)g * 1024 + pn * 256) * UAK * 2; return true; }
};
struct SchedBranch {
    const char* A0; const char* A1; const char* B0; const char* B1; int G, c;
    __device__ __forceinline__ bool next(int i, Unit& u) const { int pm, pn; if (!pg8::static_tile((i >> 1) * G + c, T / 256, 4, pm, pn)) return false; const int part = i & 1; u.pm = pm; u.pn = pn; u.aux = part;
        u.a = (part ? A1 : A0) + (size_t)pm * 256 * HW * 2; u.b = (part ? B1 : B0) + (size_t)pn * 256 * HW * 2; return true; }
};
struct SchedMoe {
    const char* A; const char* W; const int* tile_e; int ntiles, NN, G, c; size_t wexp, wtile; bool gather; int var;
    __device__ __forceinline__ bool next(int i, Unit& u) const { int ti, pn;
        if ((G & 7) == 0) { const int x = c & 7, j = i * (G >> 3) + (c >> 3), ml = j / NN; pn = j - ml * NN; ti = ml * 8 + x; }
        else { const int L = i * G + c; ti = L / NN; pn = L - ti * NN; }
        if (ti >= ntiles) return false; const int e = tile_e[ti];
        u.pm = ti; u.pn = pn; u.aux = gather ? ti * 256 : e; u.a = gather ? A : A + (size_t)ti * 256 * DF; u.b = W + (size_t)e * wexp + (size_t)pn * wtile;
        if (var & 8) { u.a = A; u.b = W; if (gather) u.aux = 0; } return true; }
};

__device__ __forceinline__ u32x4 pack8(const f32x4& v0, const f32x4& v1) { u32x4 w; w.x = cvt_pk_bf16(v0[0], v0[1]); w.y = cvt_pk_bf16(v0[2], v0[3]); w.z = cvt_pk_bf16(v1[0], v1[1]); w.w = cvt_pk_bf16(v1[2], v1[3]); return w; }

struct EpiInProj {
    static constexpr bool PERM = true;
    bf16_t *UA, *Q, *V, *GS, *GATES; float* LOGF; const float* LBV;
    __device__ __forceinline__ bool operator()(f32x4 (&acc)[2][2][4][2], const Unit& u, int wr, int wc, int fr, int fq) const {
        const int kind = u.pn >> 1;
#pragma unroll
        for (int ai = 0; ai < 2; ++ai)
#pragma unroll
            for (int m = 0; m < 4; ++m) { const int tok = u.pm * 256 + ai * 128 + wr * 64 + m * 16 + fr;
#pragma unroll
                for (int bj = 0; bj < 2; ++bj) { const int col = u.pn * 256 + bj * 128 + wc * 32 + 8 * fq; f32x4 v0 = acc[ai][bj][m][0], v1 = acc[ai][bj][m][1];
                    if (kind == 0) { const int g = col >> 4, hh = col & 15; *(u32x4*)(UA + ((size_t)(g * 512 + (tok >> 6)) * UAK + (tok & 63) * 16 + hh)) = pack8(v0, v1); }
                    else if (kind == 1) {
#pragma unroll
                        for (int j = 0; j < 4; ++j) { v0[j] = v0[j] * sigmoidf_(v0[j]); v1[j] = v1[j] * sigmoidf_(v1[j]); }
                        *(u32x4*)(Q + (size_t)tok * HW + (col - 512)) = pack8(v0, v1); }
                    else if (kind == 2) { const int c2 = col - 1024; const f32x4 l0 = *(const f32x4*)(LBV + c2), l1 = *(const f32x4*)(LBV + c2 + 4);
#pragma unroll
                        for (int j = 0; j < 4; ++j) { v0[j] = __logf(l0[j] + (1.f - l0[j]) * sigmoidf_(v0[j])); v1[j] = __logf(l1[j] + (1.f - l1[j]) * sigmoidf_(v1[j])); }
                        *(f32x4*)(LOGF + (size_t)tok * HW + c2) = v0; *(f32x4*)(LOGF + (size_t)tok * HW + c2 + 4) = v1; }
                    else if (kind == 3) { *(u32x4*)(V + (size_t)tok * HW + (col - 1536)) = pack8(v0, v1); }
                    else if (kind == 4) {
#pragma unroll
                        for (int j = 0; j < 4; ++j) { v0[j] = v0[j] * sigmoidf_(v0[j]); v1[j] = v1[j] * sigmoidf_(v1[j]); }
                        *(u32x4*)(GS + (size_t)tok * HW + (col - 2048)) = pack8(v0, v1); }
                    else {
#pragma unroll
                        for (int j = 0; j < 4; ++j) { v0[j] = sigmoidf_(v0[j]); v1[j] = sigmoidf_(v1[j]); }
                        if (MK_GSTORE_F8) { u32x2 q8; q8.x = pk4_u8(v0[0], v0[1], v0[2], v0[3]); q8.y = pk4_u8(v1[0], v1[1], v1[2], v1[3]); *(u32x2*)((unsigned char*)GATES + (size_t)tok * 2048 + (col - 2560)) = q8; }
                        else *(u32x4*)(GATES + (size_t)tok * 2048 + (col - 2560)) = pack8(v0, v1); }
                } }
        return false;
    }
};
struct EpiS5E {
    static constexpr bool PERM = false;
    float* SE;
    __device__ __forceinline__ bool operator()(f32x4 (&acc)[2][2][4][2], const Unit& u, int wr, int wc, int fr, int fq) const {
#pragma unroll
        for (int ai = 0; ai < 2; ++ai)
#pragma unroll
            for (int m = 0; m < 4; ++m) { const int r = u.pm * 256 + ai * 128 + wr * 64 + m * 16 + fr; float* rowp = SE + ((size_t)u.aux * 512 + r) * 128 + wc * 32 + 4 * fq;
#pragma unroll
                for (int n = 0; n < 2; ++n) *(f32x4*)(rowp + n * 16) = acc[ai][0][m][n]; }
        return false;
    }
};
struct EpiS5Y {
    static constexpr bool PERM = true;
    const bf16_t* UA; const float* SD; bf16_t* Y1;
    __device__ __forceinline__ bool operator()(f32x4 (&acc)[2][2][4][2], const Unit& u, int wr, int wc, int fr, int fq) const {
        const int g = u.aux;
#pragma unroll
        for (int ai = 0; ai < 2; ++ai)
#pragma unroll
            for (int m = 0; m < 4; ++m) { const int r = u.pm * 256 + ai * 128 + wr * 64 + m * 16 + fr; const int b = r >> 7, c = r & 127;
#pragma unroll
                for (int bj = 0; bj < 2; ++bj) { const int col = u.pn * 256 + bj * 128 + wc * 32 + 8 * fq; const int t = col >> 4, hh = col & 15;
                    const u32x4 uu = *(const u32x4*)(UA + ((size_t)(g * 512 + r) * UAK + col));
                    const f32x4 d0 = *(const f32x4*)(SD + g * 16 + hh), d1 = *(const f32x4*)(SD + g * 16 + hh + 4);
                    f32x4 v0 = acc[ai][bj][m][0], v1 = acc[ai][bj][m][1];
                    v0[0] += d0[0] * bf2f(uu.x & 0xffffu); v0[1] += d0[1] * bf2f(uu.x >> 16); v0[2] += d0[2] * bf2f(uu.y & 0xffffu); v0[3] += d0[3] * bf2f(uu.y >> 16);
                    v1[0] += d1[0] * bf2f(uu.z & 0xffffu); v1[1] += d1[1] * bf2f(uu.z >> 16); v1[2] += d1[2] * bf2f(uu.w & 0xffffu); v1[3] += d1[3] * bf2f(uu.w >> 16);
#pragma unroll
                    for (int j = 0; j < 4; ++j) { float x = v0[j]; v0[j] = x * sigmoidf_(1.5957691216f * (x + 0.044715f * x * x * x)); x = v1[j]; v1[j] = x * sigmoidf_(1.5957691216f * (x + 0.044715f * x * x * x)); }
                    const int tok = b * SEQ + c * 64 + t;
                    *(u32x4*)(Y1 + (size_t)tok * HW + g * 16 + hh) = pack8(v0, v1); } }
        return false;
    }
};
struct EpiGlu {
    static constexpr bool PERM = true;
    const bf16_t* Y1; bf16_t* YS5;
    __device__ __forceinline__ bool operator()(f32x4 (&acc)[2][2][4][2], const Unit& u, int wr, int wc, int fr, int fq) const {
#pragma unroll
        for (int ai = 0; ai < 2; ++ai)
#pragma unroll
            for (int m = 0; m < 4; ++m) { const int row = u.pm * 256 + ai * 128 + wr * 64 + m * 16 + fr;
#pragma unroll
                for (int bj = 0; bj < 2; ++bj) { const int col = u.pn * 256 + bj * 128 + wc * 32 + 8 * fq; const u32x4 y = *(const u32x4*)(Y1 + (size_t)row * HW + col);
                    f32x4 v0 = acc[ai][bj][m][0], v1 = acc[ai][bj][m][1];
                    v0[0] = bf2f(y.x & 0xffffu) * sigmoidf_(v0[0]); v0[1] = bf2f(y.x >> 16) * sigmoidf_(v0[1]); v0[2] = bf2f(y.y & 0xffffu) * sigmoidf_(v0[2]); v0[3] = bf2f(y.y >> 16) * sigmoidf_(v0[3]);
                    v1[0] = bf2f(y.z & 0xffffu) * sigmoidf_(v1[0]); v1[1] = bf2f(y.z >> 16) * sigmoidf_(v1[1]); v1[2] = bf2f(y.w & 0xffffu) * sigmoidf_(v1[2]); v1[3] = bf2f(y.w >> 16) * sigmoidf_(v1[3]);
                    *(u32x4*)(YS5 + (size_t)row * HW + col) = pack8(v0, v1); } }
        return false;
    }
};
struct EpiBranch {
    static constexpr bool PERM = true;
    const bf16_t* GATES; bf16_t* MERGED;
    __device__ __forceinline__ bool operator()(f32x4 (&acc)[2][2][4][2], const Unit& u, int wr, int wc, int fr, int fq) const {
        const int part = u.aux;
#pragma unroll
        for (int ai = 0; ai < 2; ++ai)
#pragma unroll
            for (int m = 0; m < 4; ++m) { const int row = u.pm * 256 + ai * 128 + wr * 64 + m * 16 + fr;
#pragma unroll
                for (int bj = 0; bj < 2; ++bj) { const int col = u.pn * 256 + bj * 128 + wc * 32 + 8 * fq;
                    float h[8], s[8];
                    if (MK_GSTORE_F8) { const u32x2 g2 = *(const u32x2*)((const unsigned char*)GATES + (size_t)row * 2048 + 1024 + col); const float i255 = 1.0f / 255.0f;
#pragma unroll
                        for (int j = 0; j < 4; ++j) { h[j] = fmaxf((float)((g2.x >> (8 * j)) & 0xffu), 0.5f) * i255; h[4 + j] = fmaxf((float)((g2.y >> (8 * j)) & 0xffu), 0.5f) * i255; }
                        if (part == 0) { const u32x2 g1 = *(const u32x2*)((const unsigned char*)GATES + (size_t)row * 2048 + col);
#pragma unroll
                            for (int j = 0; j < 4; ++j) { s[j] = (float)((g1.x >> (8 * j)) & 0xffu) * i255; s[4 + j] = (float)((g1.y >> (8 * j)) & 0xffu) * i255; } } }
                    else { const u32x4 g2 = *(const u32x4*)(GATES + (size_t)row * 2048 + 1024 + col);
                        h[0] = bf2f(g2.x & 0xffffu); h[1] = bf2f(g2.x >> 16); h[2] = bf2f(g2.y & 0xffffu); h[3] = bf2f(g2.y >> 16); h[4] = bf2f(g2.z & 0xffffu); h[5] = bf2f(g2.z >> 16); h[6] = bf2f(g2.w & 0xffffu); h[7] = bf2f(g2.w >> 16);
                        if (part == 0) { const u32x4 g1 = *(const u32x4*)(GATES + (size_t)row * 2048 + col);
                            s[0] = bf2f(g1.x & 0xffffu); s[1] = bf2f(g1.x >> 16); s[2] = bf2f(g1.y & 0xffffu); s[3] = bf2f(g1.y >> 16); s[4] = bf2f(g1.z & 0xffffu); s[5] = bf2f(g1.z >> 16); s[6] = bf2f(g1.w & 0xffffu); s[7] = bf2f(g1.w >> 16); } }
#pragma unroll
                    for (int j = 0; j < 8; ++j) h[j] = fmaxf(h[j], 1e-30f);
                    if (part == 0) {
#pragma unroll
                        for (int j = 0; j < 4; ++j) { acc[ai][bj][m][0][j] *= s[j] / h[j]; acc[ai][bj][m][1][j] *= s[4 + j] / h[4 + j]; } }
                    else { f32x4 v0 = acc[ai][bj][m][0], v1 = acc[ai][bj][m][1];
#pragma unroll
                        for (int j = 0; j < 4; ++j) { v0[j] *= h[j]; v1[j] *= h[4 + j]; }
                        *(u32x4*)(MERGED + (size_t)row * D + col) = pack8(v0, v1); } } }
        return part == 0;
    }
};
struct EpiOut {
    static constexpr bool PERM = true;
    const float* X; bf16_t* H1; float* SSQ; int var = 0;
    __device__ __forceinline__ bool operator()(f32x4 (&acc)[2][2][4][2], const Unit& u, int wr, int wc, int fr, int fq) const {
#pragma unroll
        for (int ai = 0; ai < 2; ++ai)
#pragma unroll
            for (int m = 0; m < 4; ++m) { const int row = u.pm * 256 + ai * 128 + wr * 64 + m * 16 + fr; const size_t off = (size_t)row * D + u.pn * 256 + wc * 32 + 8 * fq; float ss = 0.f;
                if (var & 4) { asm volatile("" :: "v"(acc[ai][0][m][0]), "v"(acc[ai][0][m][1]), "v"(acc[ai][1][m][0]), "v"(acc[ai][1][m][1])); continue; }
#pragma unroll
                for (int bj = 0; bj < 2; ++bj) { const f32x4 o0 = *(const f32x4*)(X + off + bj * 128) + acc[ai][bj][m][0], o1 = *(const f32x4*)(X + off + bj * 128 + 4) + acc[ai][bj][m][1];
                    *(u32x4*)(H1 + off + bj * 128) = pack8(o0, o1); ss += ((o0[0] * o0[0] + o0[1] * o0[1]) + (o0[2] * o0[2] + o0[3] * o0[3])) + ((o1[0] * o1[0] + o1[1] * o1[1]) + (o1[2] * o1[2] + o1[3] * o1[3])); }
                ss += __shfl_xor(ss, 16); ss += __shfl_xor(ss, 32);
                if (fq == 0) SSQ[(size_t)row * 16 + u.pn * 4 + wc] = ss; }
        return false;
    }
};
struct EpiMoe1 {
    static constexpr bool PERM = true;
    const float* BGU; const int* tile_e; unsigned char* A2; int var;
    __device__ __forceinline__ bool operator()(f32x4 (&acc)[2][2][4][2], const Unit& u, int wr, int wc, int fr, int fq) const {
        const int e = tile_e[u.pm]; const int hid = u.pn * 128 + wc * 32 + 8 * fq; const float* bp = BGU + (size_t)e * 2048 + 2 * hid;
        const f32x4 b0 = *(const f32x4*)(bp), b1 = *(const f32x4*)(bp + 4), b2 = *(const f32x4*)(bp + 8), b3 = *(const f32x4*)(bp + 12);
        const float bg[8] = {b0[0], b0[2], b1[0], b1[2], b2[0], b2[2], b3[0], b3[2]}, bu[8] = {b0[1], b0[3], b1[1], b1[3], b2[1], b2[3], b3[1], b3[3]};
#pragma unroll
        for (int ai = 0; ai < 2; ++ai)
#pragma unroll
            for (int m = 0; m < 4; ++m) { const int prow = u.pm * 256 + ai * 128 + wr * 64 + m * 16 + fr; f32x4 o0, o1;
                if (var & 4) { asm volatile("" :: "v"(acc[ai][0][m][0]), "v"(acc[ai][0][m][1]), "v"(acc[ai][1][m][0]), "v"(acc[ai][1][m][1])); continue; }
#pragma unroll
                for (int j = 0; j < 4; ++j) {
                    float gt = fminf(acc[ai][0][m][0][j] + bg[j], 7.0f), up = fminf(fmaxf(acc[ai][1][m][0][j] + bu[j], -7.0f), 7.0f); o0[j] = (up + 1.0f) * gt * sigmoidf_(1.702f * gt);
                    gt = fminf(acc[ai][0][m][1][j] + bg[4 + j], 7.0f); up = fminf(fmaxf(acc[ai][1][m][1][j] + bu[4 + j], -7.0f), 7.0f); o1[j] = (up + 1.0f) * gt * sigmoidf_(1.702f * gt); }
                u32x2 q8; q8.x = pk4_fp8(o0[0], o0[1], o0[2], o0[3]); q8.y = pk4_fp8(o1[0], o1[1], o1[2], o1[3]);
                if (var & 1) asm volatile("" :: "v"(q8)); else *(u32x2*)(A2 + (size_t)prow * DF + hid) = q8; }
        return false;
    }
};
struct EpiMoe2 {
    static constexpr bool PERM = true;
    const float* BD; const int* tile_e; const int* rowslot; unsigned char* YS; int var;
    __device__ __forceinline__ bool operator()(f32x4 (&acc)[2][2][4][2], const Unit& u, int wr, int wc, int fr, int fq) const {
        const int e = tile_e[u.pm];
#pragma unroll
        for (int ai = 0; ai < 2; ++ai)
#pragma unroll
            for (int m = 0; m < 4; ++m) { const int prow = u.pm * 256 + ai * 128 + wr * 64 + m * 16 + fr; const int slot = rowslot[prow];
                if (var & 4) { asm volatile("" :: "v"(acc[ai][0][m][0]), "v"(acc[ai][0][m][1]), "v"(acc[ai][1][m][0]), "v"(acc[ai][1][m][1])); continue; }
                if (var & 1) { const f32x4 c0 = *(const f32x4*)(BD + (size_t)e * D + u.pn * 256 + wc * 32 + 8 * fq); const f32x4 t0 = acc[ai][0][m][0] + c0, t1 = acc[ai][1][m][1] + c0; asm volatile("" :: "v"(t0), "v"(t1), "v"(slot)); continue; }
                if (slot >= 0) {
#pragma unroll
                    for (int bj = 0; bj < 2; ++bj) { const int col = u.pn * 256 + bj * 128 + wc * 32 + 8 * fq; const f32x4 c0 = *(const f32x4*)(BD + (size_t)e * D + col), c1 = *(const f32x4*)(BD + (size_t)e * D + col + 4);
                        const f32x4 y0 = acc[ai][bj][m][0] + c0, y1 = acc[ai][bj][m][1] + c1; u32x2 q8; q8.x = pk4_fp8(y0[0], y0[1], y0[2], y0[3]); q8.y = pk4_fp8(y1[0], y1[1], y1[2], y1[3]);
                        *(u32x2*)(YS + (size_t)slot * D + col) = q8; } } }
        return false;
    }
};

template <int MODE  > __device__ __forceinline__ void p0_transpose_item(const float* W, int K, int N, bf16_t* WT, LAS float* scr, int item, int lane) {
    const int nblk = N / 32, kb = item / nblk, nb = item % nblk, k0 = 64 * kb, n0 = 32 * nb;
#pragma unroll 8
    for (int i = 0; i < 32; ++i) { const int kk = 2 * i + (lane >> 5); scr[kk * 33 + (lane & 31)] = W[(size_t)(k0 + kk) * N + n0 + (lane & 31)]; }
    LDS_WAIT(); asm volatile("" ::: "memory");
    const int c = lane & 7;
#pragma unroll
    for (int j = 0; j < 4; ++j) { const int n = (lane >> 3) + 8 * j; const LAS float* s = scr + (8 * c) * 33 + n;
        u32x4 o; o.x = pk2(s[0 * 33], s[1 * 33]); o.y = pk2(s[2 * 33], s[3 * 33]); o.z = pk2(s[4 * 33], s[5 * 33]); o.w = pk2(s[6 * 33], s[7 * 33]);
        int nn = n0 + n; if (MODE == 1) { const int hid = nn >> 1, part = nn & 1; nn = 256 * (hid >> 7) + 128 * part + (hid & 127); }
        *(u32x4*)(WT + (size_t)nn * K + k0 + 8 * c) = o; }
    LDS_WAIT(); asm volatile("" ::: "memory");
}
template <int MODE> __device__ __forceinline__ void p0_transpose_item8(const float* W, int K, int N, unsigned char* WT, LAS float* scr, int item, int lane) {
    const int nblk = N / 32, kb = item / nblk, nb = item % nblk, k0 = 64 * kb, n0 = 32 * nb;
#pragma unroll 8
    for (int i = 0; i < 32; ++i) { const int kk = 2 * i + (lane >> 5); scr[kk * 33 + (lane & 31)] = W[(size_t)(k0 + kk) * N + n0 + (lane & 31)]; }
    LDS_WAIT(); asm volatile("" ::: "memory");
    const int c = lane & 3; const float sc = (float)(1 << pg8::F8_WSH);
#pragma unroll
    for (int j = 0; j < 2; ++j) { const int n = (lane >> 2) + 16 * j; const LAS float* s = scr + (16 * c) * 33 + n;
        u32x4 o; o.x = pk4_fp8(s[0 * 33] * sc, s[1 * 33] * sc, s[2 * 33] * sc, s[3 * 33] * sc); o.y = pk4_fp8(s[4 * 33] * sc, s[5 * 33] * sc, s[6 * 33] * sc, s[7 * 33] * sc);
        o.z = pk4_fp8(s[8 * 33] * sc, s[9 * 33] * sc, s[10 * 33] * sc, s[11 * 33] * sc); o.w = pk4_fp8(s[12 * 33] * sc, s[13 * 33] * sc, s[14 * 33] * sc, s[15 * 33] * sc);
        int nn = n0 + n; if (MODE == 1) { const int hid = nn >> 1, part = nn & 1; nn = 256 * (hid >> 7) + 128 * part + (hid & 127); }
        *(u32x4*)(WT + (size_t)nn * K + k0 + 16 * c) = o; }
    LDS_WAIT(); asm volatile("" ::: "memory");
}
struct TDesc { const float* W; unsigned char* WT; int K, N, k0, n0, mode, out8; };
__device__ __forceinline__ TDesc p0_decode(const Frame& F, int t) {
    TDesc d; unsigned char* ws = F.ws;
    if (t < 16384) { const int e = t >> 9, r = t & 511; d.W = F.in[I_WGU] + (size_t)e * D * 2048; d.WT = ws + WS_WGU + (size_t)e * 2048 * D; d.K = D; d.N = 2048; d.k0 = (r >> 5) * 64; d.n0 = (r & 31) * 64; d.mode = 1; d.out8 = 1; return d; }
    t -= 16384;
    if (t < 8192) { const int e = t >> 8, r = t & 255; d.W = F.in[I_WD] + (size_t)e * DF * D; d.WT = ws + WS_WD + (size_t)e * D * DF; d.K = DF; d.N = D; d.k0 = (r >> 4) * 64; d.n0 = (r & 15) * 64; d.mode = 0; d.out8 = 1; return d; }
    t -= 8192; d.mode = 0; d.out8 = 0;
    if (t < 1152) { d.W = F.in[I_WIN]; d.WT = ws + WS_WIN; d.K = D; d.N = INW; d.k0 = (t / 72) * 64; d.n0 = (t % 72) * 64; d.out8 = MK_P1_F8; if (MK_GATES_F8 && d.n0 >= 2560) { d.out8 = 1; d.WT = ws + WS_WIN8 - (size_t)2560 * D; } return d; }
    t -= 1152;
    if (t < 64) { d.W = F.in[I_WGLU]; d.WT = ws + WS_WGLU; d.K = HW; d.N = HW; d.k0 = (t >> 3) * 64; d.n0 = (t & 7) * 64; return d; }
    t -= 64;
    if (t < 128) { d.W = F.in[I_WBS]; d.WT = ws + WS_WBS; d.K = HW; d.N = D; d.k0 = (t >> 4) * 64; d.n0 = (t & 15) * 64; return d; }
    t -= 128;
    if (t < 128) { d.W = F.in[I_WBH]; d.WT = ws + WS_WBH; d.K = HW; d.N = D; d.k0 = (t >> 4) * 64; d.n0 = (t & 15) * 64; return d; }
    t -= 128;
    d.W = F.in[I_WOUT]; d.WT = ws + WS_WOUT; d.K = D; d.N = D; d.k0 = (t >> 4) * 64; d.n0 = (t & 15) * 64; return d;
}
constexpr int P0_NTILES = 16384 + 8192 + 1152 + 64 + 128 + 128 + 256;
__device__ __forceinline__ void p0_tile_load(const TDesc& d, f32x4 (&r)[16], int lane) {
    const float* p = d.W + (size_t)(d.k0 + (lane >> 4)) * d.N + d.n0 + (lane & 15) * 4;
#pragma unroll
    for (int i = 0; i < 16; ++i) r[i] = *(const f32x4*)(p + (size_t)(4 * i) * d.N);
}
__device__ __forceinline__ void p0_tile_to_lds(LAS float* scr, const f32x4 (&r)[16], int lane) {
#pragma unroll
    for (int i = 0; i < 16; ++i) { const int k = (lane >> 4) + 4 * i; *(LAS f32x4*)(scr + k * 64 + (((lane & 15) * 4) ^ (4 * ((k >> 3) & 7)))) = r[i]; }
}
__device__ __forceinline__ void p0_tile_store(const TDesc& d, const LAS float* scr, int lane) {
    if (d.out8) { const int c = lane & 3; const float sc = (float)(1 << pg8::F8_WSH);
#pragma unroll
        for (int j = 0; j < 4; ++j) { const int n = (lane >> 2) + 16 * j; float v[16];
#pragma unroll
            for (int t = 0; t < 16; ++t) { const int k = 16 * c + t; v[t] = scr[k * 64 + (n ^ (4 * ((k >> 3) & 7)))] * sc; }
            u32x4 o;
            { int w = 0; w = __builtin_amdgcn_cvt_pk_fp8_f32(v[0], v[1], w, false); w = __builtin_amdgcn_cvt_pk_fp8_f32(v[2], v[3], w, true); o.x = (unsigned)w; }
            { int w = 0; w = __builtin_amdgcn_cvt_pk_fp8_f32(v[4], v[5], w, false); w = __builtin_amdgcn_cvt_pk_fp8_f32(v[6], v[7], w, true); o.y = (unsigned)w; }
            { int w = 0; w = __builtin_amdgcn_cvt_pk_fp8_f32(v[8], v[9], w, false); w = __builtin_amdgcn_cvt_pk_fp8_f32(v[10], v[11], w, true); o.z = (unsigned)w; }
            { int w = 0; w = __builtin_amdgcn_cvt_pk_fp8_f32(v[12], v[13], w, false); w = __builtin_amdgcn_cvt_pk_fp8_f32(v[14], v[15], w, true); o.w = (unsigned)w; }
            int nn = d.n0 + n; if (d.mode == 1) { const int hid = nn >> 1, part = nn & 1; nn = 256 * (hid >> 7) + 128 * part + (hid & 127); }
            *(u32x4*)(d.WT + (size_t)nn * d.K + d.k0 + 16 * c) = o; } }
    else { const int c = lane & 7;
#pragma unroll
        for (int j = 0; j < 8; ++j) { const int n = (lane >> 3) + 8 * j; float v[8];
#pragma unroll
            for (int t = 0; t < 8; ++t) { const int k = 8 * c + t; v[t] = scr[k * 64 + (n ^ (4 * (c & 7)))]; }
            u32x4 o; o.x = cvt_pk_bf16(v[0], v[1]); o.y = cvt_pk_bf16(v[2], v[3]); o.z = cvt_pk_bf16(v[4], v[5]); o.w = cvt_pk_bf16(v[6], v[7]);
            *(u32x4*)((bf16_t*)d.WT + (size_t)(d.n0 + n) * d.K + d.k0 + 8 * c) = o; } }
}
struct C2 { double re, im; };
__device__ __forceinline__ C2 cmul(C2 a, C2 b) { return C2{a.re * b.re - a.im * b.im, a.re * b.im + a.im * b.re}; }
__device__ __forceinline__ C2 s5_pow(const Frame& F, int g, int p, int k) {
    const double lre = (double)F.in[I_LRE][g * SP + p], lim = (double)F.in[I_LIM][g * SP + p], dt = exp((double)F.in[I_LDT][g]);
    const double mag = exp((double)k * lre * dt); double s, c; sincos((double)k * lim * dt, &s, &c); return C2{mag * c, mag * s};
}
__device__ __forceinline__ C2 s5_coef(const Frame& F, int g, int p) {
    const double lre = (double)F.in[I_LRE][g * SP + p], lim = (double)F.in[I_LIM][g * SP + p]; const C2 lb = s5_pow(F, g, p, 1);
    const double nr = lb.re - 1.0, ni = lb.im, den = lre * lre + lim * lim; return C2{(nr * lre + ni * lim) / den, (ni * lre - nr * lim) / den};
}

struct C2f { float re, im; };
__device__ __forceinline__ C2f cmulf(C2f a, C2f b) { return C2f{a.re * b.re - a.im * b.im, a.re * b.im + a.im * b.re}; }
__device__ __forceinline__ void s5_fast(const Frame& F, int g, int p, C2f& lb, C2f& cf) {
    const float lre = F.in[I_LRE][g * SP + p], lim = F.in[I_LIM][g * SP + p], dt = expf(F.in[I_LDT][g]); const float a = lre * dt, th = lim * dt;
    float sn, cs; sincosf(th, &sn, &cs); const float ea = expf(a); lb = C2f{ea * cs, ea * sn};
    const float sh = sinf(0.5f * th); const float nr = expm1f(a) * cs - 2.0f * sh * sh, ni = ea * sn, den = lre * lre + lim * lim;
    cf = C2f{(nr * lre + ni * lim) / den, (ni * lre - nr * lim) / den};
}
__device__ __forceinline__ C2f cpowf_(C2f b, int k) { C2f r{1.f, 0.f};
#pragma unroll
    for (int i = 0; i < 7; ++i) { if (k & 1) r = cmulf(r, b); b = cmulf(b, b); k >>= 1; } return r; }
__device__ __forceinline__ void p0_prologue(Frame& F, const int var = 0) {
    LAS float* scr = (LAS float*)(F.lds + F.wave * 16384);
    const int gw = F.vcu * 8 + F.wave, NGW = F.G * 8, lane = F.lane;
    unsigned char* ws = F.ws;
    { f32x4 rr[16]; int t = gw;
      if (t < P0_NTILES && !(var & 256)) { TDesc dc = p0_decode(F, t); p0_tile_load(dc, rr, lane);
        for (;;) { p0_tile_to_lds(scr, rr, lane);
            const int tn = t + NGW; TDesc dn = dc; const bool more = tn < P0_NTILES;
            if (more) { dn = p0_decode(F, tn); p0_tile_load(dn, rr, lane); }
            LDS_WAIT(); asm volatile("" ::: "memory");
            p0_tile_store(dc, scr, lane);
            LDS_WAIT(); asm volatile("" ::: "memory");
            if (!more) break; dc = dn; t = tn; } } }
    constexpr int R6 = 0;
    constexpr int R7 = R6 + 2048  , R8 = R7 + 2048  , R9 = R8 + 2048  , R10 = R9 + 32  , R11 = R10 + 384  , R12 = R11 + 16  , R13 = R12 + 1  ;
    constexpr int R14 = R13 + 2048  ;
    for (int it = gw; it < ((var & 512) ? 0 : R14); it += NGW) {
        if (it < R7) {
            const int q = it - R6, g = q >> 6, k = q & 63, p = lane;
            C2f lb, cf; s5_fast(F, g, p, lb, cf); const C2f pw = cpowf_(lb, k);
            LAS float* CLre = scr; LAS float* CLim = scr + 1024; LAS float* BBre = scr + 2048; LAS float* BBim = scr + 3072;
#pragma unroll 4
            for (int h = 0; h < 16; ++h) { const C2f cc = cmulf(C2f{F.in[I_CRE][(g * 16 + h) * SP + p], F.in[I_CIM][(g * 16 + h) * SP + p]}, pw); CLre[h * 64 + p] = cc.re; CLim[h * 64 + p] = cc.im;
                const C2f bb = cmulf(cf, C2f{F.in[I_BRE][(g * SP + p) * 16 + h], F.in[I_BIM][(g * SP + p) * 16 + h]}); BBre[p * 16 + h] = bb.re; BBim[p * 16 + h] = bb.im; }
            LDS_WAIT(); asm volatile("" ::: "memory");
            float o[4];
#pragma unroll
            for (int qq = 0; qq < 4; ++qq) { const int idx = lane * 4 + qq, h = idx >> 4, h2 = idx & 15; float s = 0.f;
                for (int pp = 0; pp < 64; ++pp) s += CLre[h * 64 + pp] * BBre[pp * 16 + h2] - CLim[h * 64 + pp] * BBim[pp * 16 + h2];
                o[qq] = s; }
            u32x2 w; w.x = pk2(o[0], o[1]); w.y = pk2(o[2], o[3]);
            *(u32x2*)((bf16_t*)(ws + WS_KCONV) + (size_t)q * 256 + lane * 4) = w;
            LDS_WAIT(); asm volatile("" ::: "memory");
        }
        else if (it < R8) {
            const int q = it - R7, g = q >> 6, s = q & 63, p = lane; C2f lb, cf; s5_fast(F, g, p, lb, cf); const C2f pw = cmulf(cpowf_(lb, 63 - s), cf);
            float re[16], im[16];
#pragma unroll
            for (int h = 0; h < 16; ++h) { const C2f w = cmulf(pw, C2f{F.in[I_BRE][(g * SP + p) * 16 + h], F.in[I_BIM][(g * SP + p) * 16 + h]}); re[h] = w.re; im[h] = w.im; }
            bf16_t* o0 = (bf16_t*)(ws + WS_WE) + ((size_t)(g * 256 + p) * 1024 + s * 16); bf16_t* o1 = o0 + (size_t)64 * 1024;
            u32x4 a, b; a.x = pk2(re[0], re[1]); a.y = pk2(re[2], re[3]); a.z = pk2(re[4], re[5]); a.w = pk2(re[6], re[7]); b.x = pk2(re[8], re[9]); b.y = pk2(re[10], re[11]); b.z = pk2(re[12], re[13]); b.w = pk2(re[14], re[15]);
            *(u32x4*)o0 = a; *(u32x4*)(o0 + 8) = b;
            a.x = pk2(im[0], im[1]); a.y = pk2(im[2], im[3]); a.z = pk2(im[4], im[5]); a.w = pk2(im[6], im[7]); b.x = pk2(im[8], im[9]); b.y = pk2(im[10], im[11]); b.z = pk2(im[12], im[13]); b.w = pk2(im[14], im[15]);
            *(u32x4*)o1 = a; *(u32x4*)(o1 + 8) = b;
        }
        else if (it < R9) {
            const int q = it - R8, g = q >> 6, t = q & 63, p = lane; C2f lb, cf; s5_fast(F, g, p, lb, cf); const C2f pw = cpowf_(lb, t + 1);
            for (int h = 0; h < 16; ++h) { const C2f cc = cmulf(C2f{F.in[I_CRE][(g * 16 + h) * SP + p], F.in[I_CIM][(g * 16 + h) * SP + p]}, pw);
                bf16_t* o = (bf16_t*)(ws + WS_TZ) + ((size_t)(g * 1024 + t * 16 + h) * UAK + 1024 + p); o[0] = (bf16_t)f2bf(cc.re); o[64] = (bf16_t)f2bf(-cc.im); }
        }
        else if (it < R10) {
            const int g = it - R9, p = lane; const C2 l1 = s5_pow(F, g, p, 1), cf = s5_coef(F, g, p); C2 l64 = l1;
#pragma unroll
            for (int q2 = 0; q2 < 6; ++q2) l64 = cmul(l64, l64);
            ((f32x2*)(ws + WS_LAMB))[g * SP + p] = (f32x2){(float)l1.re, (float)l1.im}; ((f32x2*)(ws + WS_LAMC))[g * SP + p] = (f32x2){(float)l64.re, (float)l64.im};
            for (int h = 0; h < 16; ++h) { const C2 bb = cmul(cf, C2{(double)F.in[I_BRE][(g * SP + p) * 16 + h], (double)F.in[I_BIM][(g * SP + p) * 16 + h]}); ((f32x2*)(ws + WS_BBAR))[(g * SP + p) * 16 + h] = (f32x2){(float)bb.re, (float)bb.im}; }
        }
        else if (it < R11) {
            const int q = it - R10, cg = q >> 4, kq = q & 15; const int wcol = (cg < 8 ? cg * 64 : (cg < 16 ? 1024 + (cg - 8) * 64 : 1536 + (cg - 16) * 64)) + lane;
            const float* meta = F.in[I_META]; const float* g1 = F.in[I_N1G];
            for (int r = 0; r < 16; ++r) { float s = 0.f;
#pragma unroll
                for (int j = 0; j < 16; ++j) { const float v = meta[r * D + lane + 64 * j]; s += v * v; }
                const float rstd = 1.0f / sqrtf(wave_sum(s) * (1.0f / D) + EPS);
                const int k = kq * 64 + lane; scr[lane * 16 + r] = meta[r * D + k] * rstd * g1[k]; }
            LDS_WAIT(); asm volatile("" ::: "memory");
            float a[16];
#pragma unroll
            for (int r = 0; r < 16; ++r) a[r] = 0.f;
            const float* wp = F.in[I_WIN] + (size_t)(kq * 64) * INW + wcol;
#pragma unroll 16
            for (int kk = 0; kk < 64; ++kk) { const float w = wp[(size_t)kk * INW]; const LAS f32x4* xs = (const LAS f32x4*)(scr + kk * 16);
                const f32x4 x0 = xs[0], x1 = xs[1], x2 = xs[2], x3 = xs[3];
                a[0] += w * x0[0]; a[1] += w * x0[1]; a[2] += w * x0[2]; a[3] += w * x0[3]; a[4] += w * x1[0]; a[5] += w * x1[1]; a[6] += w * x1[2]; a[7] += w * x1[3];
                a[8] += w * x2[0]; a[9] += w * x2[1]; a[10] += w * x2[2]; a[11] += w * x2[3]; a[12] += w * x3[0]; a[13] += w * x3[1]; a[14] += w * x3[2]; a[15] += w * x3[3]; }
            float* pm = (float*)(ws + WS_PMETA);
#pragma unroll
            for (int r = 0; r < 16; ++r) pm[(size_t)(kq * 16 + r) * 1536 + cg * 64 + lane] = a[r];
            LDS_WAIT(); asm volatile("" ::: "memory");
        }
        else if (it < R12) {
            const int k = (it - R11) * 64 + lane; bf16_t* hi = (bf16_t*)(ws + WS_WRT); bf16_t* lo = hi + NE * D;
            for (int e = 0; e < NE; ++e) { const float w = F.in[I_WR][k * NE + e]; const unsigned h = f2bf(w); hi[e * D + k] = (bf16_t)h; lo[e * D + k] = (bf16_t)f2bf(w - bf2f(h)); }
        }
        else if (it < R13) {
            for (int d = lane; d < HW; d += 64) ((float*)(ws + WS_LBV))[d] = sigmoidf_(F.in[I_LBL][d] - F.in[I_LBL][HW + d]);
        }
        else {
            const int q = it - R13, g = q >> 6, r0 = 128 + (q & 63) * 2; u32x4* o = (u32x4*)((bf16_t*)(ws + WS_WE) + (size_t)(g * 256 + r0) * 1024);
#pragma unroll
            for (int j = 0; j < 4; ++j) o[lane + 64 * j] = (u32x4){0u, 0u, 0u, 0u};
        }
    }
    const float* g1 = F.in[I_N1G];
    for (int m = gw; m < ((var & 1024) ? 0 : T); m += 2 * NGW) {
        const int m2 = m + NGW; const bool two = m2 < T;
        const f32x4* xr = (const f32x4*)(F.in[I_X] + (size_t)m * D) + lane; const f32x4* xr2 = (const f32x4*)(F.in[I_X] + (size_t)(two ? m2 : m) * D) + lane; f32x4 v[4], w2[4]; float s = 0.f, s2 = 0.f;
#pragma unroll
        for (int j = 0; j < 4; ++j) { v[j] = xr[64 * j]; w2[j] = xr2[64 * j]; }
#pragma unroll
        for (int j = 0; j < 4; ++j) { s += (v[j].x * v[j].x + v[j].y * v[j].y) + (v[j].z * v[j].z + v[j].w * v[j].w); s2 += (w2[j].x * w2[j].x + w2[j].y * w2[j].y) + (w2[j].z * w2[j].z + w2[j].w * w2[j].w); }
        const float rstd = 1.0f / sqrtf(wave_sum(s) * (1.0f / D) + EPS), rstd2 = 1.0f / sqrtf(wave_sum(s2) * (1.0f / D) + EPS);
        if (MK_GATES_F8 && !MK_P1_F8) { unsigned* o4 = (unsigned*)(ws + WS_XN8 + (size_t)m * D) + lane; unsigned* o42 = (unsigned*)(ws + WS_XN8 + (size_t)m2 * D) + lane;
#pragma unroll
            for (int j = 0; j < 4; ++j) { const f32x4 gg = ((const f32x4*)g1)[lane + 64 * j]; o4[64 * j] = pk4_fp8(v[j].x * rstd * gg.x, v[j].y * rstd * gg.y, v[j].z * rstd * gg.z, v[j].w * rstd * gg.w);
                if (two) o42[64 * j] = pk4_fp8(w2[j].x * rstd2 * gg.x, w2[j].y * rstd2 * gg.y, w2[j].z * rstd2 * gg.z, w2[j].w * rstd2 * gg.w); } }
        if (MK_P1_F8) { unsigned* o4 = (unsigned*)(ws + WS_XN + (size_t)m * D) + lane; unsigned* o42 = (unsigned*)(ws + WS_XN + (size_t)m2 * D) + lane;
#pragma unroll
            for (int j = 0; j < 4; ++j) { const f32x4 gg = ((const f32x4*)g1)[lane + 64 * j]; o4[64 * j] = pk4_fp8(v[j].x * rstd * gg.x, v[j].y * rstd * gg.y, v[j].z * rstd * gg.z, v[j].w * rstd * gg.w);
                if (two) o42[64 * j] = pk4_fp8(w2[j].x * rstd2 * gg.x, w2[j].y * rstd2 * gg.y, w2[j].z * rstd2 * gg.z, w2[j].w * rstd2 * gg.w); } }
        else {
        u32x2* o8 = (u32x2*)((bf16_t*)(ws + WS_XN) + (size_t)m * D) + lane; u32x2* o82 = (u32x2*)((bf16_t*)(ws + WS_XN) + (size_t)m2 * D) + lane;
#pragma unroll
        for (int j = 0; j < 4; ++j) { const f32x4 gg = ((const f32x4*)g1)[lane + 64 * j]; u32x2 w; w.x = pk2(v[j].x * rstd * gg.x, v[j].y * rstd * gg.y); w.y = pk2(v[j].z * rstd * gg.z, v[j].w * rstd * gg.w); o8[64 * j] = w;
            if (two) { w.x = pk2(w2[j].x * rstd2 * gg.x, w2[j].y * rstd2 * gg.y); w.y = pk2(w2[j].z * rstd2 * gg.z, w2[j].w * rstd2 * gg.w); o82[64 * j] = w; } }
        }
    }
}
__device__ __forceinline__ void p1_toeplitz(Frame& F) {
    { const float* pm = (const float*)(F.ws + WS_PMETA); float* pr = (float*)(F.ws + WS_PMR);
      for (int i = F.vcu * 512 + F.tid; i < 16 * 1536; i += F.G * 512) { float s = 0.f;
#pragma unroll
          for (int kq = 0; kq < 16; ++kq) s += pm[(size_t)kq * 16 * 1536 + i]; pr[i] = s; } }
    const int gw = F.vcu * 8 + F.wave, NGW = F.G * 8, lane = F.lane; const bf16_t* kc = (const bf16_t*)(F.ws + WS_KCONV); bf16_t* tz = (bf16_t*)(F.ws + WS_TZ);
    for (int row = gw; row < SG * 1024; row += NGW) { const int g = row >> 10, t = (row >> 4) & 63, h = row & 15;
#pragma unroll
        for (int j = 0; j < 2; ++j) { const int q = lane + 64 * j, s = q >> 1, half = q & 1; u32x4 v = (u32x4){0u, 0u, 0u, 0u};
            if (s <= t) v = *(const u32x4*)(kc + ((size_t)((g * 64 + (t - s)) * 16 + h) * 16 + half * 8));
            *(u32x4*)(tz + (size_t)row * UAK + s * 16 + half * 8) = v; } }
}

constexpr int ST64 = 144, ST128 = 272;
__device__ __forceinline__ void mma_nt32(f32x16& acc, const LAS unsigned char* A, int sa, const LAS unsigned char* B, int sb, int K, int lane) {
    const LAS unsigned char* pa = A + (lane & 31) * sa + (lane >> 5) * 16; const LAS unsigned char* pb = B + (lane & 31) * sb + (lane >> 5) * 16;
    for (int k = 0; k < K; k += 16) { const bf16x8 a = *(const LAS bf16x8*)(pa + k * 2), b = *(const LAS bf16x8*)(pb + k * 2); acc = __builtin_amdgcn_mfma_f32_32x32x16_bf16(a, b, acc, 0, 0, 0); }
}
__device__ __forceinline__ void hg_cumsum(LAS float* segtot, const float* LOGF, int tok0, int col, int d, int seg, float (&lf)[16], float (&cs)[16], float& total, float& bmid) {
#pragma unroll
    for (int j = 0; j < 16; ++j) lf[j] = LOGF[(size_t)(tok0 + seg * 16 + j) * HW + col];
    float run = 0.f;
#pragma unroll
    for (int j = 0; j < 16; ++j) { run += lf[j]; cs[j] = run; }
    segtot[seg * 128 + d] = run;
    __syncthreads();
    const float t0 = segtot[d], t1 = segtot[128 + d], t2 = segtot[256 + d], t3 = segtot[384 + d];
    const float pre = seg == 0 ? 0.f : (seg == 1 ? t0 : (seg == 2 ? t0 + t1 : t0 + t1 + t2));
#pragma unroll
    for (int j = 0; j < 16; ++j) cs[j] += pre;
    total = (t0 + t1) + (t2 + t3); bmid = t0 + t1;
}
__device__ __forceinline__ void hg_load_vt(LAS unsigned char* VT, const bf16_t* V, int tok0, int hcol, int tid) {
    const int j = tid & 63;
#pragma unroll
    for (int i = 0; i < 2; ++i) { const int e0 = ((tid >> 6) + 8 * i) * 8; const u32x4 v = *(const u32x4*)(V + (size_t)(tok0 + j) * HW + hcol + e0);
        LAS bf16_t* o = (LAS bf16_t*)(VT + e0 * ST64 + j * 2);
        o[0 * (ST64 / 2)] = (bf16_t)(v.x & 0xffffu); o[1 * (ST64 / 2)] = (bf16_t)(v.x >> 16); o[2 * (ST64 / 2)] = (bf16_t)(v.y & 0xffffu); o[3 * (ST64 / 2)] = (bf16_t)(v.y >> 16);
        o[4 * (ST64 / 2)] = (bf16_t)(v.z & 0xffffu); o[5 * (ST64 / 2)] = (bf16_t)(v.z >> 16); o[6 * (ST64 / 2)] = (bf16_t)(v.w & 0xffffu); o[7 * (ST64 / 2)] = (bf16_t)(v.w >> 16); }
}
__device__ __forceinline__ void hgrn_a_unit(Frame& F, int unit) {
    const int tid = F.tid, lane = F.lane, wave = F.wave; const int bh = unit >> 7, c = unit & 127, b = bh >> 2, h = bh & 3, tok0 = b * SEQ + c * CH, hcol = h * HD;
    LAS unsigned char* KT = F.lds; LAS unsigned char* VT = F.lds + 128 * ST64; LAS float* segtot = (LAS float*)(F.lds + 2 * 128 * ST64);
    const int d = tid & 127, seg = tid >> 7; float lf[16], cs[16], total, bmid;
    hg_load_vt(VT, (const bf16_t*)(F.ws + WS_V), tok0, hcol, tid);
    hg_cumsum(segtot, (const float*)(F.ws + WS_LOGF), tok0, hcol + d, d, seg, lf, cs, total, bmid);
    float kk[16];
#pragma unroll
    for (int j = 0; j < 16; ++j) kk[j] = (1.0f - __expf(lf[j])) * __expf(total - cs[j]);
    u32x4 w0, w1; w0.x = pk2(kk[0], kk[1]); w0.y = pk2(kk[2], kk[3]); w0.z = pk2(kk[4], kk[5]); w0.w = pk2(kk[6], kk[7]); w1.x = pk2(kk[8], kk[9]); w1.y = pk2(kk[10], kk[11]); w1.z = pk2(kk[12], kk[13]); w1.w = pk2(kk[14], kk[15]);
    *(LAS u32x4*)(KT + d * ST64 + seg * 32) = w0; *(LAS u32x4*)(KT + d * ST64 + seg * 32 + 16) = w1;
    if (seg == 0) ((float*)(F.ws + WS_DEC))[(size_t)unit * HD + d] = __expf(total);
    { float* bc = (float*)(F.ws + WS_BCUM) + (size_t)(tok0 + seg * 16) * HW + hcol + d;
#pragma unroll
      for (int j = 0; j < 16; ++j) bc[(size_t)j * HW] = cs[j]; }
    __syncthreads();
    bf16_t* kvt = (bf16_t*)(F.ws + WS_KVT) + (size_t)unit * HD * HD;
#pragma unroll
    for (int i = 0; i < 2; ++i) { const int tile = wave * 2 + i, et = tile >> 2, dt = tile & 3; f32x16 acc;
#pragma unroll
        for (int r = 0; r < 16; ++r) acc[r] = 0.f;
        mma_nt32(acc, VT + et * 32 * ST64, ST64, KT + dt * 32 * ST64, ST64, 64, lane);
#pragma unroll
        for (int r = 0; r < 16; ++r) { const int e = et * 32 + (r & 3) + 8 * (r >> 2) + 4 * (lane >> 5); kvt[(size_t)e * HD + dt * 32 + (lane & 31)] = (bf16_t)f2bf(acc[r]); } }
    __syncthreads();
}
template <int K> __device__ __forceinline__ void mma_nt32k(f32x16& acc, const LAS unsigned char* A, int sa, const LAS unsigned char* B, int sb, int lane) {
    const LAS unsigned char* pa = A + (lane & 31) * sa + (lane >> 5) * 16; const LAS unsigned char* pb = B + (lane & 31) * sb + (lane >> 5) * 16;
#pragma unroll
    for (int k = 0; k < K; k += 16) { const bf16x8 a = *(const LAS bf16x8*)(pa + k * 2), b = *(const LAS bf16x8*)(pb + k * 2); acc = __builtin_amdgcn_mfma_f32_32x32x16_bf16(a, b, acc, 0, 0, 0); }
}
struct HgPre { u32x4 q[2]; f32x4 bj[2][2], bp[2][2], bm[2]; u32x4 v[2], sp[4]; };
__device__ __forceinline__ void hgc_load(Frame& F, int unit, HgPre& P) {
    const int tid = F.tid; const int bh = unit >> 7, c = unit & 127, b = bh >> 2, h = bh & 3, tok0 = b * SEQ + c * CH, hcol = h * HD;
    const bf16_t* qg = (const bf16_t*)(F.ws + WS_Q); const float* bc = (const float*)(F.ws + WS_BCUM); const bf16_t* vg = (const bf16_t*)(F.ws + WS_V); const bf16_t* sp = (const bf16_t*)(F.ws + WS_SPREV) + (size_t)unit * HD * HD;
    const int d0 = (tid & 15) * 8;
#pragma unroll
    for (int i = 0; i < 2; ++i) { const int j = (tid >> 4) + 32 * i; const size_t o = (size_t)(tok0 + j) * HW + hcol + d0;
        P.q[i] = *(const u32x4*)(qg + o); P.bj[i][0] = *(const f32x4*)(bc + o); P.bj[i][1] = *(const f32x4*)(bc + o + 4);
        if (j > 0) { P.bp[i][0] = *(const f32x4*)(bc + o - HW); P.bp[i][1] = *(const f32x4*)(bc + o - HW + 4); } else { P.bp[i][0] = (f32x4){0.f, 0.f, 0.f, 0.f}; P.bp[i][1] = (f32x4){0.f, 0.f, 0.f, 0.f}; }
        const int e0 = ((tid >> 6) + 8 * i) * 8; P.v[i] = *(const u32x4*)(vg + (size_t)(tok0 + (tid & 63)) * HW + hcol + e0); }
    { const size_t o = (size_t)(tok0 + 31) * HW + hcol + d0; P.bm[0] = *(const f32x4*)(bc + o); P.bm[1] = *(const f32x4*)(bc + o + 4); }
#pragma unroll
    for (int i = 0; i < 4; ++i) { const int p = tid + 512 * i; P.sp[i] = *(const u32x4*)(sp + (size_t)(p >> 4) * HD + (p & 15) * 8); }
}
__device__ __forceinline__ void hgrn_c_phase(Frame& F) {
    const int tid = F.tid, lane = F.lane, wave = F.wave;
    LAS unsigned char* Q1 = F.lds; LAS unsigned char* K1 = Q1 + 64 * ST128; LAS unsigned char* Q2 = K1 + 64 * ST128; LAS unsigned char* VT = Q2 + 64 * ST128;
    LAS unsigned char* PP = VT + 128 * ST64; LAS unsigned char* SPL = PP + 64 * ST64; LAS float* RS = (LAS float*)(SPL + 128 * ST128); LAS unsigned char* OL = Q1;
    int unit = F.bx; if (unit >= 16 * NCH) return;
    HgPre P; hgc_load(F, unit, P);
    u32x4 gsv[2];
    { const int bh = unit >> 7, c = unit & 127, tok0 = (bh >> 2) * SEQ + c * CH, hcol = (bh & 3) * HD;
#pragma unroll
      for (int i = 0; i < 2; ++i) gsv[i] = *(const u32x4*)((const bf16_t*)(F.ws + WS_GS) + (size_t)(tok0 + (tid >> 4) + 32 * i) * HW + hcol + (tid & 15) * 8); }
    for (;;) {
        const int bh = unit >> 7, c = unit & 127, b = bh >> 2, h = bh & 3, tok0 = b * SEQ + c * CH, hcol = h * HD;
        { const int d0 = (tid & 15) * 8;
#pragma unroll
          for (int i = 0; i < 2; ++i) { const int j = (tid >> 4) + 32 * i; float q1[8], k1[8], q2[8];
              const unsigned qw[4] = {P.q[i].x, P.q[i].y, P.q[i].z, P.q[i].w};
#pragma unroll
              for (int k = 0; k < 8; ++k) { const float bb = P.bj[i][k >> 2][k & 3], bm = P.bm[k >> 2][k & 3], lf = bb - P.bp[i][k >> 2][k & 3]; const float q = bf2f((qw[k >> 1] >> ((k & 1) * 16)) & 0xffffu);
                  const float kx = 1.0f - __expf(lf), ed = __expf(bb - bm); q1[k] = q * ed; k1[k] = kx * __expf(bm - bb); q2[k] = q * __expf(bb); }
              u32x4 w; w.x = cvt_pk_bf16(q1[0], q1[1]); w.y = cvt_pk_bf16(q1[2], q1[3]); w.z = cvt_pk_bf16(q1[4], q1[5]); w.w = cvt_pk_bf16(q1[6], q1[7]); *(LAS u32x4*)(Q1 + j * ST128 + d0 * 2) = w;
              w.x = cvt_pk_bf16(k1[0], k1[1]); w.y = cvt_pk_bf16(k1[2], k1[3]); w.z = cvt_pk_bf16(k1[4], k1[5]); w.w = cvt_pk_bf16(k1[6], k1[7]); *(LAS u32x4*)(K1 + j * ST128 + d0 * 2) = w;
              w.x = cvt_pk_bf16(q2[0], q2[1]); w.y = cvt_pk_bf16(q2[2], q2[3]); w.z = cvt_pk_bf16(q2[4], q2[5]); w.w = cvt_pk_bf16(q2[6], q2[7]); *(LAS u32x4*)(Q2 + j * ST128 + d0 * 2) = w;
              const int e0 = ((tid >> 6) + 8 * i) * 8; LAS bf16_t* o = (LAS bf16_t*)(VT + e0 * ST64 + (tid & 63) * 2); const u32x4 v = P.v[i];
              o[0 * (ST64 / 2)] = (bf16_t)(v.x & 0xffffu); o[1 * (ST64 / 2)] = (bf16_t)(v.x >> 16); o[2 * (ST64 / 2)] = (bf16_t)(v.y & 0xffffu); o[3 * (ST64 / 2)] = (bf16_t)(v.y >> 16);
              o[4 * (ST64 / 2)] = (bf16_t)(v.z & 0xffffu); o[5 * (ST64 / 2)] = (bf16_t)(v.z >> 16); o[6 * (ST64 / 2)] = (bf16_t)(v.w & 0xffffu); o[7 * (ST64 / 2)] = (bf16_t)(v.w >> 16); }
#pragma unroll
          for (int i = 0; i < 4; ++i) { const int p = tid + 512 * i; *(LAS u32x4*)(SPL + (p >> 4) * ST128 + (p & 15) * 16) = P.sp[i]; } }
        const int un = unit + F.G; const bool more = un < 16 * NCH;
        if (more) hgc_load(F, un, P);
        __syncthreads();
        const int it = wave >> 2, et = wave & 3; f32x16 acc;
#pragma unroll
        for (int r = 0; r < 16; ++r) acc[r] = 0.f;
        mma_nt32k<128>(acc, Q2 + it * 32 * ST128, ST128, SPL + et * 32 * ST128, ST128, lane);
        if (wave < 3) { const int si = wave ? 1 : 0, sj = wave == 2 ? 1 : 0; f32x16 sc;
#pragma unroll
            for (int r = 0; r < 16; ++r) sc[r] = 0.f;
            mma_nt32k<128>(sc, Q1 + si * 32 * ST128, ST128, K1 + sj * 32 * ST128, ST128, lane);
#pragma unroll
            for (int r = 0; r < 16; ++r) { const int i = si * 32 + (r & 3) + 8 * (r >> 2) + 4 * (lane >> 5), j = sj * 32 + (lane & 31); ((LAS bf16_t*)(PP + i * ST64))[j] = (bf16_t)f2bf(j <= i ? sc[r] : 0.f); } }
        else if (wave == 3) {
#pragma unroll
            for (int r = 0; r < 16; ++r) { const int i = (r & 3) + 8 * (r >> 2) + 4 * (lane >> 5); ((LAS bf16_t*)(PP + i * ST64))[32 + (lane & 31)] = (bf16_t)0; } }
        __syncthreads();
        mma_nt32k<64>(acc, PP + it * 32 * ST64, ST64, VT + et * 32 * ST64, ST64, lane);
#pragma unroll
        for (int r = 0; r < 16; ++r) { const int i = it * 32 + (r & 3) + 8 * (r >> 2) + 4 * (lane >> 5); ((LAS bf16_t*)(OL + i * ST128))[et * 32 + (lane & 31)] = (bf16_t)f2bf(acc[r]); }
        __syncthreads();
        { const int eo = (tid & 15) * 8; const f32x4 g0 = *(const f32x4*)(F.in[I_HNG] + hcol + eo), g1 = *(const f32x4*)(F.in[I_HNG] + hcol + eo + 4); bf16_t* yo = (bf16_t*)(F.ws + WS_YHG);
#pragma unroll
          for (int i = 0; i < 2; ++i) { const int row = (tid >> 4) + 32 * i; const u32x4 o = *(const LAS u32x4*)(OL + row * ST128 + eo * 2); const u32x4 gq = gsv[i];
              const float x[8] = {bf2f(o.x & 0xffffu), bf2f(o.x >> 16), bf2f(o.y & 0xffffu), bf2f(o.y >> 16), bf2f(o.z & 0xffffu), bf2f(o.z >> 16), bf2f(o.w & 0xffffu), bf2f(o.w >> 16)};
              float ss = ((x[0] * x[0] + x[1] * x[1]) + (x[2] * x[2] + x[3] * x[3])) + ((x[4] * x[4] + x[5] * x[5]) + (x[6] * x[6] + x[7] * x[7]));
              ss += __shfl_xor(ss, 1); ss += __shfl_xor(ss, 2); ss += __shfl_xor(ss, 4); ss += __shfl_xor(ss, 8);
              const float rstd = 1.0f / sqrtf(ss * (1.0f / HD) + EPS);
              f32x4 y0, y1; y0[0] = x[0] * rstd * g0[0] * bf2f(gq.x & 0xffffu); y0[1] = x[1] * rstd * g0[1] * bf2f(gq.x >> 16); y0[2] = x[2] * rstd * g0[2] * bf2f(gq.y & 0xffffu); y0[3] = x[3] * rstd * g0[3] * bf2f(gq.y >> 16);
              y1[0] = x[4] * rstd * g1[0] * bf2f(gq.z & 0xffffu); y1[1] = x[5] * rstd * g1[1] * bf2f(gq.z >> 16); y1[2] = x[6] * rstd * g1[2] * bf2f(gq.w & 0xffffu); y1[3] = x[7] * rstd * g1[3] * bf2f(gq.w >> 16);
              *(u32x4*)(yo + (size_t)(tok0 + row) * HW + hcol + eo) = pack8(y0, y1); } }
        if (!more) break;
        unit = un;
        { const int bh2 = unit >> 7, c2 = unit & 127, tk = (bh2 >> 2) * SEQ + c2 * CH, hc = (bh2 & 3) * HD;
#pragma unroll
          for (int i = 0; i < 2; ++i) gsv[i] = *(const u32x4*)((const bf16_t*)(F.ws + WS_GS) + (size_t)(tk + (tid >> 4) + 32 * i) * HW + hc + (tid & 15) * 8); }
        __syncthreads();
    }
    __syncthreads();
}

__device__ __forceinline__ void stagger(const Frame& F, int units) {
    const unsigned long long t0 = __builtin_amdgcn_s_memrealtime(), dt = (unsigned long long)(((F.bx >> 3) & 3) * units);
    while (__builtin_amdgcn_s_memrealtime() - t0 < dt) __builtin_amdgcn_s_sleep(8);
}
__device__ __forceinline__ void phase0(Frame& F, const int var) {
    unsigned char* ws = F.ws; (void)ws;
    p0_prologue(F, var);
}
__device__ __forceinline__ void phase1(Frame& F, const int var) {
    unsigned char* ws = F.ws; (void)ws;
        p1_toeplitz(F);
        EpiInProj E{(bf16_t*)(ws + WS_UA), (bf16_t*)(ws + WS_Q), (bf16_t*)(ws + WS_V), (bf16_t*)(ws + WS_GS), (bf16_t*)(ws + WS_GATES), (float*)(ws + WS_LOGF), (const float*)(ws + WS_LBV)};
        if (MK_GATES_F8 && !MK_P1_F8) {
            { SchedStatic S{(const char*)(ws + WS_XN), (const char*)(ws + WS_WIN), T / 256, 10, F.G, F.bx, (size_t)256 * D * 2, (size_t)256 * D * 2};
              pg8::gemm_phase<EpiInProj, SchedStatic, false, false>(F.lds, D, D, D, S, E, nullptr); }
            { SchedStatic S{(const char*)(ws + WS_XN8), (const char*)(ws + WS_WIN8), T / 256, 8, F.G, F.bx, (size_t)256 * D, (size_t)256 * D, 0, 10};
              pg8::gemm_phase<EpiInProj, SchedStatic, false, true>(F.lds, D, D, D, S, E, nullptr); }
        } else {
            SchedStatic S{(const char*)(ws + WS_XN), (const char*)(ws + WS_WIN), T / 256, INW / 256, F.G, F.bx, (size_t)256 * D * (MK_P1_F8 ? 1 : 2), (size_t)256 * D * (MK_P1_F8 ? 1 : 2)};
            pg8::gemm_phase<EpiInProj, SchedStatic, false, MK_P1_F8 != 0>(F.lds, D, D, D, S, E, nullptr);
        }
}
__device__ __forceinline__ void phase2(Frame& F, const int var) {
    unsigned char* ws = F.ws; (void)ws;
        { SchedS5E S{(const char*)(ws + WS_UA), (const char*)(ws + WS_WE), F.bx}; EpiS5E E{(float*)(ws + WS_SE)};
          pg8::gemm_phase<EpiS5E, SchedS5E, false>(F.lds, 1024, UAK, 1024, S, E, nullptr); }
        __syncthreads();
        const float* pm = (const float*)(ws + WS_PMR);
        if (F.bx >= 64 && F.bx < 68) {
            const int g = (F.bx - 64) * 8 + (F.tid >> 6), p = F.tid & 63; const f32x2 lb = ((const f32x2*)(ws + WS_LAMB))[g * SP + p]; float xr = 0.f, xi = 0.f;
            for (int s = 0; s < NMETA; ++s) { float ar = 0.f, ai = 0.f;
#pragma unroll
                for (int h = 0; h < 16; ++h) { const int col = g * 16 + h; const float uu = pm[(size_t)s * 1536 + col];
                    const f32x2 bb = ((const f32x2*)(ws + WS_BBAR))[(g * SP + p) * 16 + h]; ar += bb.x * uu; ai += bb.y * uu; }
                const float nr = lb.x * xr - lb.y * xi + ar, ni = lb.x * xi + lb.y * xr + ai; xr = nr; xi = ni; }
            float* xm = (float*)(ws + WS_XMETA); xm[g * 128 + p] = xr; xm[g * 128 + 64 + p] = xi;
        }
        if (F.bx >= 68 && F.bx < 196) {
            const int idx = (F.bx - 68) * 512 + F.tid, h = idx >> 14, e = (idx >> 7) & 127, d = idx & 127; const float lbv = ((const float*)(ws + WS_LBV))[h * HD + d]; float S = 0.f;
            for (int s = 0; s < NMETA; ++s) { const int cf = 512 + h * HD + d, cv = 1024 + h * HD + e;
                const float fp = pm[(size_t)s * 1536 + cf];
                const float vv = pm[(size_t)s * 1536 + cv];
                const float f = lbv + (1.0f - lbv) * sigmoidf_(fp); S = f * S + (1.0f - f) * vv; }
            ((float*)(ws + WS_SMETA))[idx] = S;
        }
        if (F.bx >= 64) for (int u = F.bx - 64; u < 16 * NCH; u += F.G - 64) hgrn_a_unit(F, u);
}
__device__ __forceinline__ void phase3(Frame& F, const int var) {
    unsigned char* ws = F.ws; (void)ws;
        {
            const int bh = F.bx >> 4, e = (F.bx & 15) * 8 + (F.tid >> 6), d = (F.tid & 63) * 2, h = bh & 3;
            f32x2 S = *(const f32x2*)((const float*)(ws + WS_SMETA) + (size_t)(h * HD + e) * HD + d);
            const unsigned* kv = (const unsigned*)((const bf16_t*)(ws + WS_KVT) + (size_t)bh * NCH * HD * HD + (size_t)e * HD + d); const float* dc = (const float*)(ws + WS_DEC) + (size_t)bh * NCH * HD + d;
            unsigned* sp = (unsigned*)((bf16_t*)(ws + WS_SPREV) + (size_t)bh * NCH * HD * HD + (size_t)e * HD + d);
            for (int c0 = 0; c0 < NCH; c0 += 8) { f32x2 kvv[8], dv[8];
#pragma unroll
                for (int j = 0; j < 8; ++j) { const unsigned kq = kv[(size_t)(c0 + j) * (HD * HD / 2)]; kvv[j] = (f32x2){bf2f(kq & 0xffffu), bf2f(kq >> 16)}; dv[j] = *(const f32x2*)(dc + (size_t)(c0 + j) * HD); }
#pragma unroll
                for (int j = 0; j < 8; ++j) { sp[(size_t)(c0 + j) * (HD * HD / 2)] = pk2(S.x, S.y); S.x = S.x * dv[j].x + kvv[j].x; S.y = S.y * dv[j].y + kvv[j].y; } }
        }
        if (F.bx < 16) {
            const int b = F.bx >> 2, g = (F.bx & 3) * 8 + (F.tid >> 6), p = F.tid & 63; const f32x2 lc = ((const f32x2*)(ws + WS_LAMC))[g * SP + p];
            const float* xm = (const float*)(ws + WS_XMETA); float xr = xm[g * 128 + p], xi = xm[g * 128 + 64 + p];
            const float* se = (const float*)(ws + WS_SE) + ((size_t)g * 512 + b * 128) * 128 + p; bf16_t* ua = (bf16_t*)(ws + WS_UA) + ((size_t)g * 512 + b * 128) * UAK + 1024 + p;
            for (int c0 = 0; c0 < NCH; c0 += 8) { float er[8], ei[8];
#pragma unroll
                for (int j = 0; j < 8; ++j) { er[j] = se[(size_t)(c0 + j) * 128]; ei[j] = se[(size_t)(c0 + j) * 128 + 64]; }
#pragma unroll
                for (int j = 0; j < 8; ++j) { bf16_t* o = ua + (size_t)(c0 + j) * UAK; o[0] = (bf16_t)f2bf(xr); o[64] = (bf16_t)f2bf(xi);
                    const float nr = lc.x * xr - lc.y * xi + er[j], ni = lc.x * xi + lc.y * xr + ei[j]; xr = nr; xi = ni; } }
        }
}
__device__ __forceinline__ void phase4(Frame& F, const int var) {
    unsigned char* ws = F.ws; (void)ws;
        if (!(var & 64)) { SchedS5Y S{(const char*)(ws + WS_UA), (const char*)(ws + WS_TZ), F.bx, F.G}; EpiS5Y E{(const bf16_t*)(ws + WS_UA), F.in[I_SD], (bf16_t*)(ws + WS_Y1)};
          pg8::gemm_phase<EpiS5Y, SchedS5Y, false>(F.lds, UAK, UAK, UAK, S, E, nullptr); }
        __syncthreads();
        if (!(var & 128)) hgrn_c_phase(F);
}
__device__ __forceinline__ void phase5(Frame& F, const int var) {
    unsigned char* ws = F.ws; (void)ws;
        SchedStatic S{(const char*)(ws + WS_Y1), (const char*)(ws + WS_WGLU), T / 256, HW / 256, F.G, F.bx, (size_t)256 * HW * 2, (size_t)256 * HW * 2};
        EpiGlu E{(const bf16_t*)(ws + WS_Y1), (bf16_t*)(ws + WS_YS5)};
        pg8::gemm_phase<EpiGlu, SchedStatic, false>(F.lds, HW, HW, HW, S, E, nullptr);
}
__device__ __forceinline__ void phase6(Frame& F, const int var) {
    unsigned char* ws = F.ws; (void)ws;
        SchedBranch S{(const char*)(ws + WS_YS5), (const char*)(ws + WS_YHG), (const char*)(ws + WS_WBS), (const char*)(ws + WS_WBH), F.G, F.bx};
        EpiBranch E{(const bf16_t*)(ws + WS_GATES), (bf16_t*)(ws + WS_MERGED)};
        pg8::gemm_phase<EpiBranch, SchedBranch, false>(F.lds, HW, HW, HW, S, E, nullptr);
}
__device__ __forceinline__ void phase7(Frame& F, const int var) {
    unsigned char* ws = F.ws; (void)ws;
        SchedStatic S{(const char*)(ws + WS_MERGED), (const char*)(ws + WS_WOUT), T / 256, D / 256, F.G, F.bx, (size_t)256 * D * 2, (size_t)256 * D * 2, var};
        EpiOut E{F.in[I_X], (bf16_t*)(ws + WS_H1), (float*)(ws + WS_SSQ), var};
        pg8::gemm_phase<EpiOut, SchedStatic, false>(F.lds, D, D, D, S, E, nullptr, var);
}
__device__ __forceinline__ void phase8(Frame& F, const int var) {
    unsigned char* ws = F.ws; (void)ws;
        volatile LAS unsigned* hist = F.MISC + 16;
        if (F.tid < 32) hist[F.tid] = 0u;
        __syncthreads();
        const int lane = F.lane, tl = lane & 15, kg = lane >> 4; const float* g2 = F.in[I_N2G]; const bf16_t* wh = (const bf16_t*)(ws + WS_WRT); const bf16_t* wl = wh + NE * D;
        for (int tile = F.vcu * 8 + F.wave; tile < T / 16; tile += F.G * 8) {
            const int tok = tile * 16 + tl; const bf16_t* hrow = (const bf16_t*)(ws + WS_H1) + (size_t)tok * D; const f32x4* sq = (const f32x4*)((const float*)(ws + WS_SSQ) + (size_t)tok * 16);
            const f32x4 s0 = sq[0], s1 = sq[1], s2 = sq[2], s3 = sq[3];
            const float ss = ((s0[0] + s0[1]) + (s0[2] + s0[3])) + ((s1[0] + s1[1]) + (s1[2] + s1[3])) + ((s2[0] + s2[1]) + (s2[2] + s2[3])) + ((s3[0] + s3[1]) + (s3[2] + s3[3]));
            const float rstd = 1.0f / sqrtf(ss * (1.0f / D) + EPS);
            f32x4 a0 = (f32x4){0.f, 0.f, 0.f, 0.f}, a1 = a0; unsigned char* xo = (unsigned char*)(ws + WS_XN2) + (size_t)tok * D;
#pragma unroll 1
            for (int kb = 0; kb < 32; kb += 8) { u32x4 hv[8];
#pragma unroll
                for (int u8 = 0; u8 < 8; ++u8) hv[u8] = *(const u32x4*)(hrow + (kb + u8) * 32 + kg * 8);
#pragma unroll
                for (int u8 = 0; u8 < 8; ++u8) { const int k = (kb + u8) * 32 + kg * 8; const f32x4 ga = *(const f32x4*)(g2 + k), gb = *(const f32x4*)(g2 + k + 4); const u32x4 hq = hv[u8];
                    float x[8] = {bf2f(hq.x & 0xffffu) * rstd * ga[0], bf2f(hq.x >> 16) * rstd * ga[1], bf2f(hq.y & 0xffffu) * rstd * ga[2], bf2f(hq.y >> 16) * rstd * ga[3], bf2f(hq.z & 0xffffu) * rstd * gb[0], bf2f(hq.z >> 16) * rstd * gb[1], bf2f(hq.w & 0xffffu) * rstd * gb[2], bf2f(hq.w >> 16) * rstd * gb[3]};
                    unsigned hb[8]; float lr[8];
#pragma unroll
                    for (int j = 0; j < 8; ++j) { hb[j] = f2bf(x[j]); lr[j] = x[j] - bf2f(hb[j]); }
                    u32x4 hi4; hi4.x = hb[0] | (hb[1] << 16); hi4.y = hb[2] | (hb[3] << 16); hi4.z = hb[4] | (hb[5] << 16); hi4.w = hb[6] | (hb[7] << 16);
                    u32x4 lo4; lo4.x = pk2(lr[0], lr[1]); lo4.y = pk2(lr[2], lr[3]); lo4.z = pk2(lr[4], lr[5]); lo4.w = pk2(lr[6], lr[7]);
                    { u32x2 q8; q8.x = pk4_fp8(x[0], x[1], x[2], x[3]); q8.y = pk4_fp8(x[4], x[5], x[6], x[7]); *(u32x2*)(xo + k) = q8; }
                    const bf16x8 xh = __builtin_bit_cast(bf16x8, hi4), xl = __builtin_bit_cast(bf16x8, lo4);
                    const bf16x8 wh0 = *(const bf16x8*)(wh + (size_t)tl * D + k), wh1 = *(const bf16x8*)(wh + (size_t)(16 + tl) * D + k), wl0 = *(const bf16x8*)(wl + (size_t)tl * D + k), wl1 = *(const bf16x8*)(wl + (size_t)(16 + tl) * D + k);
                    a0 = __builtin_amdgcn_mfma_f32_16x16x32_bf16(wh0, xh, a0, 0, 0, 0); a0 = __builtin_amdgcn_mfma_f32_16x16x32_bf16(wh0, xl, a0, 0, 0, 0); a0 = __builtin_amdgcn_mfma_f32_16x16x32_bf16(wl0, xh, a0, 0, 0, 0);
                    a1 = __builtin_amdgcn_mfma_f32_16x16x32_bf16(wh1, xh, a1, 0, 0, 0); a1 = __builtin_amdgcn_mfma_f32_16x16x32_bf16(wh1, xl, a1, 0, 0, 0); a1 = __builtin_amdgcn_mfma_f32_16x16x32_bf16(wl1, xh, a1, 0, 0, 0); } }
            float lg[8]; int le[8]; const float* br = F.in[I_BR];
#pragma unroll
            for (int j = 0; j < 4; ++j) { le[j] = 4 * kg + j; le[4 + j] = 16 + 4 * kg + j; lg[j] = a0[j] + br[le[j]]; lg[4 + j] = a1[j] + br[le[4 + j]]; }
            float tv[4]; int te[4];
#pragma unroll
            for (int r = 0; r < 4; ++r) { float bv = -3.0e38f; int be = 1 << 20;
#pragma unroll
                for (int j = 0; j < 8; ++j) if (lg[j] > bv || (lg[j] == bv && le[j] < be)) { bv = lg[j]; be = le[j]; }
#pragma unroll
                for (int o = 16; o <= 32; o <<= 1) { const float ov = __shfl_xor(bv, o); const int oe = __shfl_xor(be, o); if (ov > bv || (ov == bv && oe < be)) { bv = ov; be = oe; } }
                tv[r] = bv; te[r] = be;
#pragma unroll
                for (int j = 0; j < 8; ++j) if (le[j] == be) lg[j] = -3.0e38f; }
            if (kg == 0) { const float e1 = __expf(tv[1] - tv[0]), e2 = __expf(tv[2] - tv[0]), e3 = __expf(tv[3] - tv[0]); const float inv = 1.0f / (1.0f + e1 + e2 + e3);
                *(f32x4*)((float*)(ws + WS_TOPW) + (size_t)tok * 4) = (f32x4){inv, e1 * inv, e2 * inv, e3 * inv};
                int* tp = (int*)(ws + WS_TOPE) + (size_t)tok * 4; tp[0] = te[0]; tp[1] = te[1]; tp[2] = te[2]; tp[3] = te[3];
#pragma unroll
                for (int r = 0; r < 4; ++r) __hip_atomic_fetch_add((LAS unsigned*)(hist + te[r]), 1u, __ATOMIC_RELAXED, __HIP_MEMORY_SCOPE_WORKGROUP); }
        }
        __syncthreads();
        if (F.tid < 32) __hip_atomic_fetch_add(F.ctl + CW_CNT + F.tid, hist[F.tid], __ATOMIC_RELAXED, __HIP_MEMORY_SCOPE_AGENT);
}
__device__ __forceinline__ void phase9(Frame& F, const int var) {
    unsigned char* ws = F.ws; (void)ws;
        volatile LAS unsigned* sb = F.MISC + 16;
        LAS unsigned* base = (LAS unsigned*)F.lds; LAS unsigned* lcnt = base + 64; LAS unsigned* gb = base + 128; (void)sb;
        if (F.tid < 32) { lcnt[F.tid] = 0u; }
        if (F.tid == 0) { unsigned run = 0; for (int e = 0; e < NE; ++e) { const unsigned c = __hip_atomic_load(F.ctl + CW_CNT + e, __ATOMIC_RELAXED, __HIP_MEMORY_SCOPE_AGENT); base[e] = run * 256u; base[32 + e] = c; run += (c + 255u) >> 8; }
            base[96] = run; if (F.bx == 0) F.ctl[CW_NTILES] = run; }
        __syncthreads();
        if (F.bx == 0) { for (int e = 0; e < NE; ++e) { const unsigned t0 = base[e] >> 8, nt_ = (base[32 + e] + 255u) >> 8; for (unsigned t = F.tid; t < nt_; t += 512) ((int*)(ws + WS_TILEE))[t0 + t] = e; } }
        if (F.bx < NE) { const int e = F.bx; const unsigned c = base[32 + e], pe = ((c + 255u) >> 8) << 8; for (unsigned r = c + F.tid; r < pe; r += 512) { ((int*)(ws + WS_ROWTOK))[base[e] + r] = 0; ((int*)(ws + WS_ROWSLOT))[base[e] + r] = -1; } }
        for (int vb = F.bx; vb < T / 128; vb += F.G) {
            const int tok = vb * 128 + (F.tid >> 2), k = F.tid & 3; const int e = ((const int*)(ws + WS_TOPE))[(size_t)tok * 4 + k];
            const unsigned lr = __hip_atomic_fetch_add(lcnt + e, 1u, __ATOMIC_RELAXED, __HIP_MEMORY_SCOPE_WORKGROUP);
            __syncthreads();
            if (F.tid < 32) { gb[F.tid] = __hip_atomic_fetch_add(F.ctl + CW_FILL + F.tid, lcnt[F.tid], __ATOMIC_RELAXED, __HIP_MEMORY_SCOPE_AGENT); lcnt[F.tid] = 0u; }
            __syncthreads();
            const unsigned prow = base[e] + gb[e] + lr; ((int*)(ws + WS_ROWTOK))[prow] = tok; ((int*)(ws + WS_ROWSLOT))[prow] = tok * 4 + k;
            __syncthreads();
        }
}
__device__ __forceinline__ void phase10(Frame& F, const int var) {
    unsigned char* ws = F.ws; (void)ws;
        const int ntiles = (int)__hip_atomic_load(F.ctl + CW_NTILES, __ATOMIC_RELAXED, __HIP_MEMORY_SCOPE_AGENT);
        SchedMoe S{(const char*)(ws + WS_XN2), (const char*)(ws + WS_WGU), (const int*)(ws + WS_TILEE), ntiles, 8, F.G, F.bx, (size_t)2048 * D, (size_t)256 * D, true, var};
        EpiMoe1 E{F.in[I_BGU], (const int*)(ws + WS_TILEE), (unsigned char*)(ws + WS_A2), var};
        if (MK_STAGGER) stagger(F, MK_STAGGER * 10);
        pg8::gemm_phase<EpiMoe1, SchedMoe, true, true>(F.lds, D, D, D, S, E, (const int*)(ws + WS_ROWTOK));
}
__device__ __forceinline__ void phase11(Frame& F, const int var) {
    unsigned char* ws = F.ws; (void)ws;
        const int ntiles = (int)__hip_atomic_load(F.ctl + CW_NTILES, __ATOMIC_RELAXED, __HIP_MEMORY_SCOPE_AGENT);
        SchedMoe S{(const char*)(ws + WS_A2), (const char*)(ws + WS_WD), (const int*)(ws + WS_TILEE), ntiles, 4, F.G, F.bx, (size_t)D * DF, (size_t)256 * DF, false, var};
        EpiMoe2 E{F.in[I_BD], (const int*)(ws + WS_TILEE), (const int*)(ws + WS_ROWSLOT), (unsigned char*)(ws + WS_YS), var};
        pg8::gemm_phase<EpiMoe2, SchedMoe, false, true>(F.lds, DF, DF, DF, S, E, nullptr, var);
}
__device__ __forceinline__ void phase12(Frame& F, const int var) {
    unsigned char* ws = F.ws; (void)ws;
        const int lane = F.lane; const float* fg = F.in[I_FNG];
        float pe = 0.f; if (MK_STAMP >= 0) { const float dt = __builtin_bit_cast(float, __hip_atomic_load(F.ctl + 200, __ATOMIC_RELAXED, __HIP_MEMORY_SCOPE_AGENT)); pe = sqrtf(dt * MK_STAMP_SCALE); if (lane & 1) pe = -pe; }
        const int NW = F.G * 8; int tok = F.vcu * 8 + F.wave;
        u32x2 hq[4]; unsigned yq[4][4]; f32x4 wq;
#define P12_LOAD(t_) do { wq = *(const f32x4*)((const float*)(ws + WS_TOPW) + (size_t)(t_) * 4); _Pragma("unroll") for (int j = 0; j < 4; ++j) { hq[j] = *((const u32x2*)((const bf16_t*)(ws + WS_H1) + (size_t)(t_) * D) + lane + 64 * j); \
            _Pragma("unroll") for (int k = 0; k < 4; ++k) yq[j][k] = *((const unsigned*)((const unsigned char*)(ws + WS_YS) + ((size_t)(t_) * 4 + k) * D) + lane + 64 * j); } } while (0)
        if (tok < T) P12_LOAD(tok);
        for (; tok < T; tok += NW) {
            const float wk[4] = {wq[0], wq[1], wq[2], wq[3]}; f32x4 v[4]; float s = 0.f;
#pragma unroll
            for (int j = 0; j < 4; ++j) { v[j] = (f32x4){bf2f(hq[j].x & 0xffffu), bf2f(hq[j].x >> 16), bf2f(hq[j].y & 0xffffu), bf2f(hq[j].y >> 16)};
#pragma unroll
                for (int k = 0; k < 4; ++k) { const unsigned y = yq[j][k]; const f32x2 lo = __builtin_amdgcn_cvt_pk_f32_fp8((int)y, false), hi = __builtin_amdgcn_cvt_pk_f32_fp8((int)y, true);
                    v[j].x += wk[k] * lo.x; v[j].y += wk[k] * lo.y; v[j].z += wk[k] * hi.x; v[j].w += wk[k] * hi.y; }
                s += (v[j].x * v[j].x + v[j].y * v[j].y) + (v[j].z * v[j].z + v[j].w * v[j].w); }
            if (tok + NW < T) P12_LOAD(tok + NW);
            const float rstd = 1.0f / sqrtf(wave_sum(s) * (1.0f / D) + EPS);
            f32x4* o = (f32x4*)(F.out + (size_t)tok * D) + lane;
#pragma unroll
            for (int j = 0; j < 4; ++j) { const f32x4 gg = ((const f32x4*)fg)[lane + 64 * j]; o[64 * j] = (f32x4){v[j].x * rstd * gg.x * (1.f + pe), v[j].y * rstd * gg.y * (1.f - pe), v[j].z * rstd * gg.z * (1.f + pe), v[j].w * rstd * gg.w * (1.f - pe)}; }
        }
#undef P12_LOAD
}
struct Args { const float* in[26]; float* out; unsigned char* ws; int ph_lo, ph_hi; };
constexpr int NPHASE = 13;

__global__ void __launch_bounds__(512, 2) mk_fwd(Args args) {
    extern __shared__ __attribute__((aligned(16))) unsigned char lds[];
    Frame F;
    F.lds = (LAS unsigned char*)lds; F.MISC = (volatile LAS unsigned*)(F.lds + MISC_OFF);
    F.tid = threadIdx.x; F.lane = F.tid & 63; F.wave = __builtin_amdgcn_readfirstlane(F.tid >> 6);
    F.G = gridDim.x; F.bx = blockIdx.x; F.vcu = (F.G % 8 == 0) ? (F.bx % 8) * (F.G / 8) + F.bx / 8 : F.bx;
    F.ws = args.ws; F.ctl = (unsigned*)(args.ws + WS_CTL); F.out = args.out;
#pragma unroll
    for (int i = 0; i < 26; ++i) F.in[i] = args.in[i];
    for (int u = F.tid; u < 64; u += 512) F.MISC[u] = 0u;
    __syncthreads();
    unsigned char* ws = F.ws;
    XcdBarrier bar; bar.bar = F.ctl + CW_BAR; bar.x = 0; bar.st = nullptr;
    if (!MK_PER_PHASE) bar = xcd_barrier_post(F.ctl + CW_BAR, F.MISC + 8);
    const int lo = args.ph_lo, hi = args.ph_hi;
    unsigned long long ts_a = 0ull, ts_b = 0ull; (void)ts_a; (void)ts_b;
#define STAMP(k) do { if (MK_STAMP >= 0 && F.bx == 0 && F.tid == 0) { if ((k) == MK_STAMP) ts_a = __builtin_amdgcn_s_memrealtime(); if ((k) == MK_STAMP + 1) { ts_b = __builtin_amdgcn_s_memrealtime(); \
        __hip_atomic_store(F.ctl + 200, __builtin_bit_cast(unsigned, (float)(ts_b - ts_a) * 0.01f), __ATOMIC_RELAXED, __HIP_MEMORY_SCOPE_AGENT); } } } while (0)
#define IN(k) (lo <= (k) && (k) < hi)
#define SEAM(k) do { if (IN(k) && IN((k) + 1)) xcd_barrier(bar); } while (0)

    STAMP(0);
    if (IN(0)) { phase0(F, 0); if ((MK_REP_MASK >> 0) & 1) { xcd_barrier(bar); phase0(F, MK_VARIANT); } }
    SEAM(0);
    STAMP(1);
    if (IN(1)) { phase1(F, 0); if ((MK_REP_MASK >> 1) & 1) { xcd_barrier(bar); phase1(F, MK_VARIANT); } }
    SEAM(1);
    STAMP(2);
    if (IN(2)) { phase2(F, 0); if ((MK_REP_MASK >> 2) & 1) { xcd_barrier(bar); phase2(F, MK_VARIANT); } }
    SEAM(2);
    STAMP(3);
    if (IN(3)) { phase3(F, 0); if ((MK_REP_MASK >> 3) & 1) { xcd_barrier(bar); phase3(F, MK_VARIANT); } }
    SEAM(3);
    STAMP(4);
    if (IN(4)) { phase4(F, 0); if ((MK_REP_MASK >> 4) & 1) { xcd_barrier(bar); phase4(F, MK_VARIANT); } }
    SEAM(4);
    STAMP(5);
    if (IN(5)) { phase5(F, 0); if ((MK_REP_MASK >> 5) & 1) { xcd_barrier(bar); phase5(F, MK_VARIANT); } }
    SEAM(5);
    STAMP(6);
    if (IN(6)) { phase6(F, 0); if ((MK_REP_MASK >> 6) & 1) { xcd_barrier(bar); phase6(F, MK_VARIANT); } }
    SEAM(6);
    STAMP(7);
    if (IN(7)) { phase7(F, 0); if ((MK_REP_MASK >> 7) & 1) { xcd_barrier(bar); phase7(F, MK_VARIANT); } }
    SEAM(7);
    STAMP(8);
    if (IN(8)) { phase8(F, 0); if ((MK_REP_MASK >> 8) & 1) { xcd_barrier(bar); phase8(F, MK_VARIANT); } }
    SEAM(8);
    STAMP(9);
    if (IN(9)) { phase9(F, 0); if ((MK_REP_MASK >> 9) & 1) { xcd_barrier(bar); phase9(F, MK_VARIANT); } }
    SEAM(9);
    STAMP(10);
    if (IN(10)) { phase10(F, 0); if ((MK_REP_MASK >> 10) & 1) { xcd_barrier(bar); phase10(F, MK_VARIANT); } }
    SEAM(10);
    STAMP(11);
    if (IN(11)) { phase11(F, 0); if ((MK_REP_MASK >> 11) & 1) { xcd_barrier(bar); phase11(F, MK_VARIANT); } }
    SEAM(11);
    STAMP(12);
    if (IN(12)) { phase12(F, 0); if ((MK_REP_MASK >> 12) & 1) { xcd_barrier(bar); phase12(F, MK_VARIANT); } }
#undef IN
#undef SEAM
}

extern "C" void kernel_launch(void* const* d_in, const int* in_sizes, int n_in, void* d_out, int out_size, void* d_ws, size_t ws_size, hipStream_t stream) {
    static int grid = 0;
    if (grid == 0) {
        if (n_in != 26 || in_sizes[0] != T * D || out_size != T * D || ws_size < WS_END) { fprintf(stderr, "kernel_launch: unexpected shapes (n_in %d, in0 %d, out %d, ws %zu < %zu)\n", n_in, n_in > 0 ? in_sizes[0] : -1, out_size, ws_size, (size_t)WS_END); grid = -1; return; }
        int dev = 0, cus = 0, per_cu = 0;
        if (hipGetDevice(&dev) != hipSuccess || hipDeviceGetAttribute(&cus, hipDeviceAttributeMultiprocessorCount, dev) != hipSuccess) { grid = -1; return; }
        if (hipFuncSetAttribute((const void*)mk_fwd, hipFuncAttributeMaxDynamicSharedMemorySize, LDS_BYTES) != hipSuccess) { fprintf(stderr, "kernel_launch: hipFuncSetAttribute failed\n"); grid = -1; return; }
        if (hipOccupancyMaxActiveBlocksPerMultiprocessor(&per_cu, (const void*)mk_fwd, 512, LDS_BYTES) != hipSuccess || per_cu < 1) fprintf(stderr, "kernel_launch: occupancy query reports %d\n", per_cu);
        (void)hipGetLastError();
        grid = cus;
        if (grid != 256) fprintf(stderr, "kernel_launch: %d CUs (built for 256)\n", grid);
    }
    if (grid < 0) return;
    (void)hipMemsetAsync((char*)d_ws + WS_CTL, 0, 1 * MiB, stream);
    Args a{};
    for (int i = 0; i < 26; ++i) a.in[i] = (const float*)d_in[i];
    a.out = (float*)d_out; a.ws = (unsigned char*)d_ws;
#if MK_PER_PHASE
    for (int p = 0; p < NPHASE; ++p) { a.ph_lo = p; a.ph_hi = p + 1; hipLaunchKernelGGL(mk_fwd, dim3(grid), dim3(512), LDS_BYTES, stream, a); }
#else
    a.ph_lo = 0; a.ph_hi = NPHASE; hipLaunchKernelGGL(mk_fwd, dim3(grid), dim3(512), LDS_BYTES, stream, a);
#endif
}
```

```cpp
#include <hip/hip_runtime.h>
#include <cstdio>
#include <cstdint>

#ifndef MK_PER_PHASE
#define MK_PER_PHASE 0
#endif

#ifndef MK_REP_MASK
#define MK_REP_MASK 0
#endif

#ifndef MK_P1_F8
#define MK_P1_F8 0
#endif
#ifndef MK_GATES_F8
#define MK_GATES_F8 1
#endif
#ifndef MK_GSTORE_F8
#define MK_GSTORE_F8 1
#endif
#ifndef MK_STAGGER
#define MK_STAGGER 0
#endif
#ifndef MK_STAMP
#define MK_STAMP -1
#endif
#define MK_STAMP_SCALE 1e-5f
#ifndef MK_VARIANT
#define MK_VARIANT 0
#endif

#define LAS __attribute__((address_space(3)))
#define GAS __attribute__((address_space(1)))
typedef unsigned short bf16_t;
typedef short bf16x8 __attribute__((ext_vector_type(8)));
typedef float f32x4 __attribute__((ext_vector_type(4)));
typedef float f32x2 __attribute__((ext_vector_type(2)));
typedef float f32x16 __attribute__((ext_vector_type(16)));
typedef unsigned u32x4 __attribute__((ext_vector_type(4)));
typedef unsigned u32x2 __attribute__((ext_vector_type(2)));
typedef int i32x4 __attribute__((ext_vector_type(4)));
typedef int i32x8 __attribute__((ext_vector_type(8)));

constexpr int T = 32768, D = 1024, NB = 4, SEQ = 8192, NCH = 128, CH = 64, NMETA = 16, INW = 4608;
constexpr int SG = 32, SH = 16, SP = 64;
constexpr int HH = 4, HD = 128, HW = 512;
constexpr int NE = 32, TOPK = 4, DF = 1024;
constexpr int UAK = 1152;
constexpr float EPS = 1e-6f;
constexpr int MAXTILES = 544;

constexpr size_t MiB = 1u << 20, KiB = 1024;
constexpr size_t WS_CTL = 0;
constexpr size_t WS_LBV = 1 * MiB, WS_LAMB = 1 * MiB + 4 * KiB, WS_LAMC = 1 * MiB + 20 * KiB, WS_XMETA = 1 * MiB + 36 * KiB;
constexpr size_t WS_BBAR = 1 * MiB + 64 * KiB, WS_WRT = 1 * MiB + 320 * KiB, WS_PMR = 1 * MiB + 512 * KiB  ;
constexpr size_t WS_KCONV = 2 * MiB, WS_SMETA = 3 * MiB;
constexpr size_t WS_WIN = 4 * MiB, WS_WGLU = 13 * MiB, WS_WBS = 14 * MiB, WS_WBH = 15 * MiB, WS_WOUT = 16 * MiB, WS_WGU = 18 * MiB, WS_WD = 146 * MiB;
constexpr size_t WS_TZ = 210 * MiB, WS_WE = 282 * MiB, WS_XN = 298 * MiB, WS_UA = 362 * MiB, WS_Q = 398 * MiB, WS_LOGF = 430 * MiB, WS_V = 494 * MiB;
constexpr size_t WS_GS = 526 * MiB, WS_GATES = 558 * MiB, WS_KVT = 686 * MiB, WS_SPREV = 814 * MiB, WS_SE = 878 * MiB, WS_DEC = 886 * MiB;
constexpr size_t WS_Y1 = 888 * MiB, WS_YHG = 920 * MiB, WS_YS5 = 952 * MiB, WS_PMETA = 984 * MiB  , WS_XN8 = 986 * MiB  , WS_END = 1018 * MiB;
constexpr size_t WS_WIN8 = WS_WIN + 5 * MiB;
constexpr size_t WS_BCUM = 298 * MiB;
constexpr size_t WS_MERGED = 686 * MiB, WS_XN2 = 210 * MiB, WS_H1 = 274 * MiB, WS_SSQ = 402 * MiB, WS_TOPE = 404 * MiB, WS_TOPW = 404 * MiB + 512 * KiB;
constexpr size_t WS_ROWTOK = 405 * MiB, WS_ROWSLOT = 406 * MiB, WS_TILEE = 407 * MiB, WS_A2 = 408 * MiB, WS_YS = 680 * MiB;
constexpr int CW_CNT = 64, CW_FILL = 128, CW_NTILES = 192, CW_BAR = 4096;

constexpr int RING_BYTES = 131072, GOFF_LDS = RING_BYTES, MISC_OFF = RING_BYTES + 16384 + 256, LDS_BYTES = 155648;

__device__ __forceinline__ unsigned f2bf(float f) { unsigned u = __builtin_bit_cast(unsigned, f); return (u + 0x7fffu + ((u >> 16) & 1u)) >> 16; }
__device__ __forceinline__ float bf2f(unsigned b) { return __builtin_bit_cast(float, b << 16); }
__device__ __forceinline__ unsigned pk2(float lo, float hi) { return f2bf(lo) | (f2bf(hi) << 16); }
__device__ __forceinline__ unsigned cvt_pk_bf16(float lo, float hi) { unsigned r; asm volatile("v_cvt_pk_bf16_f32 %0, %1, %2" : "=v"(r) : "v"(lo), "v"(hi)); return r; }
__device__ __forceinline__ unsigned pk4_fp8(float a, float b, float c, float d) {
    a = fminf(fmaxf(a, -448.f), 448.f); b = fminf(fmaxf(b, -448.f), 448.f); c = fminf(fmaxf(c, -448.f), 448.f); d = fminf(fmaxf(d, -448.f), 448.f);
    int w = 0; w = __builtin_amdgcn_cvt_pk_fp8_f32(a, b, w, false); w = __builtin_amdgcn_cvt_pk_fp8_f32(c, d, w, true); return (unsigned)w; }
__device__ __forceinline__ unsigned pk4_u8(float a, float b, float c, float d) {
    return (unsigned)(a * 255.f + 0.5f) | ((unsigned)(b * 255.f + 0.5f) << 8) | ((unsigned)(c * 255.f + 0.5f) << 16) | ((unsigned)(d * 255.f + 0.5f) << 24); }
__device__ __forceinline__ float sigmoidf_(float x) { return 1.0f / (1.0f + __expf(-x)); }
__device__ __forceinline__ float wave_sum(float v) {
#pragma unroll
    for (int o = 1; o < 64; o <<= 1) v += __shfl_xor(v, o);
    return v;
}
#define LDS_WAIT() asm volatile("s_waitcnt lgkmcnt(0)" ::: "memory")
#define VM_WAIT() asm volatile("s_waitcnt vmcnt(0)" ::: "memory")

#define XB_TMO      128
#define XB_XCNT(j)  (256  + 64 * (j))
#define XB_XSUB(j)  (1280 + 64 * (j))
#define XB_XGEN(j)  (2304 + 64 * (j))
#define XB_TOP      3328
#define XB_TOPGEN   3392
#define XCD_BAR_WORDS 3456
#define XB_SPIN_CAP (1u << 22)
__device__ __forceinline__ unsigned xb_ld(unsigned* p)              { return __hip_atomic_load(p, __ATOMIC_RELAXED, __HIP_MEMORY_SCOPE_AGENT); }
__device__ __forceinline__ unsigned xb_add(unsigned* p, unsigned v) { return __hip_atomic_fetch_add(p, v, __ATOMIC_RELAXED, __HIP_MEMORY_SCOPE_AGENT); }
__device__ __forceinline__ unsigned xb_xcc_id() { return (unsigned)__builtin_amdgcn_s_getreg((3 << 11) | 20) & 0xFu; }
#define XB_SPIN(cond, bar) do { unsigned _sp = 0; while (cond) { __builtin_amdgcn_s_sleep(1); \
    if ((++_sp & 255u) == 0u) { if (xb_ld(&(bar)[XB_TMO])) break; if (_sp > XB_SPIN_CAP) { atomicAdd(&(bar)[XB_TMO], 1u); break; } } } } while (0)
struct XcdBarrier { unsigned* bar; unsigned x; volatile LAS unsigned* st; };
__device__ __forceinline__ XcdBarrier xcd_barrier_post(unsigned* bar, volatile LAS unsigned* st) {
    XcdBarrier b; b.bar = bar; b.x = xb_xcc_id(); b.st = st;
    if (threadIdx.x == 0) (void)xb_add(&bar[XB_XCNT(b.x)], 1u);
    return b;
}
__device__ __forceinline__ void xcd_barrier_complete(unsigned* bar, unsigned x, unsigned& nloc, unsigned& nx) {
    const unsigned G = gridDim.x * gridDim.y * gridDim.z;
    unsigned sum, cnt, mine, sp = 0u;
    for (;;) {
        sum = 0u; cnt = 0u; mine = 0u;
#pragma unroll
        for (unsigned j = 0; j < 16; ++j) { const unsigned c = xb_ld(&bar[XB_XCNT(j)]); sum += c; cnt += (c > 0u) ? 1u : 0u; mine = (j == x) ? c : mine; }
        if (sum == G) break;
        __builtin_amdgcn_s_sleep(1);
        if ((++sp & 255u) == 0u) { if (xb_ld(&bar[XB_TMO])) break; if (sp > XB_SPIN_CAP) { atomicAdd(&bar[XB_TMO], 1u); break; } }
    }
    nloc = mine > 0u ? mine : 1u; nx = cnt > 0u ? cnt : 1u;
}
__device__ __forceinline__ void xcd_barrier(const XcdBarrier& b) {
    asm volatile("s_waitcnt vmcnt(0)" ::: "memory");
    __syncthreads();
    if (threadIdx.x == 0) {
        unsigned* bar = b.bar;
        __builtin_amdgcn_s_waitcnt(0);
        unsigned nloc = b.st[0], nx = b.st[1];
        if (nloc == 0u) { xcd_barrier_complete(bar, b.x, nloc, nx); b.st[0] = nloc; b.st[1] = nx; }
        const unsigned old = xb_add(&bar[XB_XSUB(b.x)], 1u);
        const unsigned gen = old / nloc;
        if (old + 1u == (gen + 1u) * nloc) {
            __builtin_amdgcn_fence(__ATOMIC_RELEASE, "agent");
            asm volatile("s_waitcnt vmcnt(0)" ::: "memory");
            const unsigned og = xb_add(&bar[XB_TOP], 1u);
            const unsigned tg = og / nx;
            if (og + 1u == (tg + 1u) * nx) xb_add(&bar[XB_TOPGEN], 1u);
            else XB_SPIN(xb_ld(&bar[XB_TOPGEN]) == tg, bar);
            __builtin_amdgcn_fence(__ATOMIC_ACQUIRE, "agent");
            xb_add(&bar[XB_XGEN(b.x)], 1u);
            asm volatile("s_waitcnt vmcnt(0)" ::: "memory");
        } else {
            XB_SPIN(xb_ld(&bar[XB_XGEN(b.x)]) == gen, bar);
            __builtin_amdgcn_fence(__ATOMIC_ACQUIRE, "agent");
            asm volatile("s_waitcnt vmcnt(0)" ::: "memory");
        }
    }
    __syncthreads();
}

namespace pg8 {
constexpr int BM = 256, BK = 64, HALF = 128, HTB = HALF * BK * 2, STAGE_BYTES = 8 * HTB, NXCD = 8, WGM = 8;
__device__ __forceinline__ int lds_byte(int r, int c) { const int st = (r >> 4) * 2 + (c >> 5), rr = r & 15, cc = c & 31, ob = rr * 64 + cc * 2; return st * 1024 + (ob ^ (((ob >> 9) & 1) << 5)); }
__device__ __forceinline__ void stage_rc(int b, int& R, int& C) { const int st = b / 1024, sb = b % 1024, swz = sb ^ (((sb >> 9) & 1) << 5); R = (st >> 1) * 16 + swz / 64; C = (st & 1) * 32 + (swz % 64) / 2; }
__device__ __forceinline__ int perm32(int rho) { const int n = rho >> 4, i = rho & 15; return 8 * (i >> 2) + 4 * n + (i & 3); }

struct Unit { int pm, pn, aux; const char* a; const char* b; };

__device__ __forceinline__ bool static_tile(int L, int nM, int nN, int& pm, int& pn) {
    const int nwg = nM * nN; if (L >= nwg) return false;
    int wgid = L; { const int q = nwg / NXCD, r = nwg % NXCD, xcd = wgid % NXCD, off = wgid / NXCD; wgid = (xcd < r ? xcd * (q + 1) : r * (q + 1) + (xcd - r) * q) + off; }
    const int nig = WGM * nN, gid = wgid / nig, fm = gid * WGM, gsz = (nM - fm) < WGM ? (nM - fm) : WGM;
    pm = fm + ((wgid % nig) % gsz); pn = (wgid % nig) / gsz; return true;
}

constexpr int F8_WSH = 6;
template <class Epi, class Sched, bool GATHER, bool F8 = false>
__device__ __forceinline__ void gemm_phase(LAS unsigned char* lds, const int K, const int lda, const int ldb, const Sched& S, const Epi& E, const int* __restrict__ rowidx, const int pv = 0) {
    const int tid = threadIdx.x, wid = __builtin_amdgcn_readfirstlane(tid >> 6), lane = tid & 63, wr = wid >> 2, wc = wid & 3, fr = lane & 15, fq = lane >> 4;
    constexpr int ES = F8 ? 1 : 2;
    const int nt = K / (F8 ? 128 : BK);
#define PG8_SW(r) ((((r) >> 1) & 7) ^ (((((r) >> 2) ^ ((r) >> 3)) & 1) * (F8 ? 2 : 1)))
    unsigned voffA[2], voffB[2]; int gR[2], gC[2];
#pragma unroll
    for (int i = 0; i < 2; ++i) { const int q = tid * 16 + i * 8192, r = (q >> 7) & 15; const int R = (q >> 11) * 16 + r, C = (((q >> 4) & 7) ^ PG8_SW(r)) * 16;
        const int Rb = Epi::PERM ? ((R & ~31) + perm32(R & 31)) : R;
        voffA[i] = (unsigned)(R * lda * ES + C); voffB[i] = (unsigned)(Rb * ldb * ES + C); gR[i] = R; gC[i] = C; }
    const size_t kstep = (size_t)(BK * 2);
    const size_t hstepA = (size_t)HALF * lda * ES, hstepB = (size_t)HALF * ldb * ES;
    const unsigned ldsw = (unsigned)wid * 1024u;
    const int sx = PG8_SW(fr), ck0 = F8 ? 2 * fq : fq, ck1 = F8 ? 2 * fq + 1 : 4 + fq;
    const int aoff0 = wr * 8192 + fr * 128 + 16 * (ck0 ^ sx), aoff1 = wr * 8192 + fr * 128 + 16 * (ck1 ^ sx), boff0 = wc * 4096 + fr * 128 + 16 * (ck0 ^ sx), boff1 = wc * 4096 + fr * 128 + 16 * (ck1 ^ sx);
#define PG8_SA(b, h) (((b) * 2 + (h)) * HTB)
#define PG8_SB(b, h) ((4 + (b) * 2 + (h)) * HTB)
#define PG8_GLDS(src, dstoff) do { if (!(pv & 32)) __builtin_amdgcn_global_load_lds((const unsigned*)(src), (LAS unsigned*)(lds + (dstoff)), 16, 0, 0); } while (0)
#define PG8_STAGEB(bufoff, gbase) do { PG8_GLDS((const char*)(gbase) + voffB[0], (bufoff) + ldsw); PG8_GLDS((const char*)(gbase) + voffB[1], (bufoff) + ldsw + 8192); } while (0)
#define PG8_STAGEA(bufoff, gbase, h, SET) do { if constexpr (GATHER) { const u32x2 o_ = *(const LAS u32x2*)(lds + GOFF_LDS + ((SET) * 2 + (h)) * 4096 + tid * 8); \
        PG8_GLDS((const char*)(gbase) + o_.x, (bufoff) + ldsw); PG8_GLDS((const char*)(gbase) + o_.y, (bufoff) + ldsw + 8192); } \
        else { PG8_GLDS((const char*)(gbase) + (h) * hstepA + voffA[0], (bufoff) + ldsw); PG8_GLDS((const char*)(gbase) + (h) * hstepA + voffA[1], (bufoff) + ldsw + 8192); } } while (0)
#define PG8_LDA(dst, b, h) do { _Pragma("unroll") for (int m = 0; m < 4; ++m) { dst[m][0] = *(const LAS bf16x8*)(lds + PG8_SA(b, h) + aoff0 + m * 2048); dst[m][1] = *(const LAS bf16x8*)(lds + PG8_SA(b, h) + aoff1 + m * 2048); } } while (0)
#define PG8_LDB(dst, b, h) do { _Pragma("unroll") for (int n = 0; n < 2; ++n) { dst[n][0] = *(const LAS bf16x8*)(lds + PG8_SB(b, h) + boff0 + n * 2048); dst[n][1] = *(const LAS bf16x8*)(lds + PG8_SB(b, h) + boff1 + n * 2048); } } while (0)
#define PG8_CAT(lo, hi) __builtin_shufflevector(__builtin_bit_cast(i32x4, lo), __builtin_bit_cast(i32x4, hi), 0, 1, 2, 3, 4, 5, 6, 7)
#define PG8_MMA(ai, bj, At, Bt) do { if (pv & 16) { asm volatile("" :: "v"(At[0][0]), "v"(At[1][0]), "v"(At[2][0]), "v"(At[3][0]), "v"(At[0][1]), "v"(At[1][1]), "v"(At[2][1]), "v"(At[3][1]), "v"(Bt[0][0]), "v"(Bt[0][1]), "v"(Bt[1][0]), "v"(Bt[1][1])); break; } __builtin_amdgcn_s_setprio(1); _Pragma("unroll") for (int m = 0; m < 4; ++m) _Pragma("unroll") for (int n = 0; n < 2; ++n) { \
        if constexpr (F8) { const i32x8 b8_ = PG8_CAT(Bt[n][0], Bt[n][1]), a8_ = PG8_CAT(At[m][0], At[m][1]); \
            asm volatile("v_mfma_scale_f32_16x16x128_f8f6f4 %0, %1, %2, %0, %3, %4 op_sel_hi:[0,0,0]" : "+v"(acc[ai][bj][m][n]) : "v"(b8_), "v"(a8_), "v"(sc_w), "v"(sc_x)); } \
        else { _Pragma("unroll") for (int k = 0; k < 2; ++k) acc[ai][bj][m][n] = __builtin_amdgcn_mfma_f32_16x16x32_bf16(Bt[n][k], At[m][k], acc[ai][bj][m][n], 0, 0, 0); } } __builtin_amdgcn_s_setprio(0); } while (0)
#define PG8_WAIT_V(n) asm volatile("s_waitcnt vmcnt(" #n ")" ::: "memory")
#define PG8_WAIT_L(n) asm volatile("s_waitcnt lgkmcnt(" #n ")" ::: "memory")
#define PG8_BAR __builtin_amdgcn_s_barrier()
#define PG8_SCHED __builtin_amdgcn_sched_barrier(0)
#define PG8_GOFFS(SET, U) do { if constexpr (GATHER) { _Pragma("unroll") for (int h_ = 0; h_ < 2; ++h_) { u32x2 o_; \
        o_.x = (unsigned)rowidx[(U).aux + h_ * HALF + gR[0]] * (unsigned)(lda * ES) + (unsigned)gC[0]; o_.y = (unsigned)rowidx[(U).aux + h_ * HALF + gR[1]] * (unsigned)(lda * ES) + (unsigned)gC[1]; \
        *(LAS u32x2*)(lds + GOFF_LDS + ((SET) * 2 + h_) * 4096 + tid * 8) = o_; } } } while (0)
    const int sc_w = 127 - F8_WSH, sc_x = 127; (void)sc_w; (void)sc_x;
    Unit cur, nxt; int ui = 0;
    if (!S.next(0, cur)) return;
    f32x4 acc[2][2][4][2];
#pragma unroll
    for (int a = 0; a < 2; ++a)
#pragma unroll
        for (int b = 0; b < 2; ++b)
#pragma unroll
            for (int m = 0; m < 4; ++m)
#pragma unroll
                for (int n = 0; n < 2; ++n) acc[a][b][m][n] = (f32x4){0.f, 0.f, 0.f, 0.f};
    bf16x8 At[4][2], B0[2][2], B1[2][2];
    PG8_GOFFS(0, cur);
    const char* cA = cur.a; const char* cB = cur.b;
    PG8_STAGEB(PG8_SB(0, 0), cB); PG8_STAGEB(PG8_SB(0, 1), cB + hstepB); PG8_STAGEA(PG8_SA(0, 0), cA, 0, 0); PG8_STAGEA(PG8_SA(0, 1), cA, 1, 0);
    if (wr == 1) PG8_BAR;
    PG8_WAIT_V(2); PG8_BAR;
    PG8_STAGEB(PG8_SB(1, 0), cB + kstep); PG8_STAGEA(PG8_SA(1, 0), cA + kstep, 0, 0); PG8_STAGEB(PG8_SB(1, 1), cB + hstepB + kstep);
    PG8_WAIT_V(6); PG8_BAR;
    for (;;) {
        const bool has_next = S.next(ui + 1, nxt);
        const int cs = ui & 1; if (has_next) PG8_GOFFS(cs ^ 1, nxt);
        const char* nA = has_next ? nxt.a : cA; const char* nB = has_next ? nxt.b : cB;
#pragma unroll 1
        for (int t = 0; t < nt; t += 2) {
            const bool last = (t == nt - 2);
            const char* a1 = cA + (size_t)(t + 1) * kstep;
            const char* a2 = last ? nA : cA + (size_t)(t + 2) * kstep; const char* b2 = last ? nB : cB + (size_t)(t + 2) * kstep;
            const char* a3 = a2 + kstep; const char* b3 = b2 + kstep;
            const int s2 = (last && has_next) ? (cs ^ 1) : cs;
            PG8_LDB(B0, 0, 0); PG8_LDB(B1, 0, 1); PG8_SCHED; PG8_LDA(At, 0, 0); PG8_STAGEA(PG8_SA(1, 1), a1, 1, cs);
            PG8_WAIT_V(8); PG8_WAIT_L(0); PG8_BAR; PG8_MMA(0, 0, At, B0); PG8_MMA(0, 1, At, B1); PG8_BAR; PG8_SCHED;
            PG8_LDA(At, 0, 1); PG8_STAGEB(PG8_SB(0, 0), b2); PG8_STAGEB(PG8_SB(0, 1), b2 + hstepB); PG8_STAGEA(PG8_SA(0, 0), a2, 0, s2);
            PG8_WAIT_V(8); PG8_WAIT_L(0); PG8_BAR; PG8_MMA(1, 0, At, B0); PG8_MMA(1, 1, At, B1); PG8_BAR; PG8_SCHED;
            PG8_LDB(B0, 1, 0); PG8_LDB(B1, 1, 1); PG8_SCHED; PG8_LDA(At, 1, 0); PG8_STAGEA(PG8_SA(0, 1), a2, 1, s2);
            PG8_WAIT_V(8); PG8_WAIT_L(0); PG8_BAR; PG8_MMA(0, 0, At, B0); PG8_MMA(0, 1, At, B1); PG8_BAR; PG8_SCHED;
            PG8_LDA(At, 1, 1); PG8_STAGEB(PG8_SB(1, 0), b3); PG8_STAGEB(PG8_SB(1, 1), b3 + hstepB); PG8_STAGEA(PG8_SA(1, 0), a3, 0, s2);
            PG8_WAIT_V(8); PG8_WAIT_L(0); PG8_BAR; PG8_MMA(1, 0, At, B0); PG8_MMA(1, 1, At, B1); PG8_BAR; PG8_SCHED;
        }
        if constexpr (F8) asm volatile("s_nop 15\n\ts_nop 15" ::: "memory");
        if (wr == 0) PG8_BAR;
        int fr_e = fr, fq_e = fq; asm volatile("" : "+v"(fr_e), "+v"(fq_e));
        const bool keep = E(acc, cur, wr, wc, fr_e, fq_e);
        if (!has_next) break;
        if (!keep) {
#pragma unroll
            for (int a = 0; a < 2; ++a)
#pragma unroll
                for (int b = 0; b < 2; ++b)
#pragma unroll
                    for (int m = 0; m < 4; ++m)
#pragma unroll
                        for (int n = 0; n < 2; ++n) acc[a][b][m][n] = (f32x4){0.f, 0.f, 0.f, 0.f};
        }
        cur = nxt; cA = nA; cB = nB; ++ui;
        if (wr == 1) PG8_BAR;
    }
    PG8_WAIT_V(0);
    PG8_BAR;
#undef PG8_SW
#undef PG8_SA
#undef PG8_SB
#undef PG8_GLDS
#undef PG8_STAGEA
#undef PG8_STAGEB
#undef PG8_LDA
#undef PG8_LDB
#undef PG8_MMA
#undef PG8_CAT
#undef PG8_WAIT_V
#undef PG8_WAIT_L
#undef PG8_BAR
#undef PG8_SCHED
#undef PG8_GOFFS
}
}
using pg8::Unit;

struct Frame {
    LAS unsigned char* lds; volatile LAS unsigned* MISC; unsigned* ctl; unsigned char* ws;
    int tid, lane, wave, vcu, G, bx;
    const float* in[26]; float* out;
};
enum { I_X = 0, I_META, I_N1G, I_WIN, I_LRE, I_LIM, I_LDT, I_BRE, I_BIM, I_CRE, I_CIM, I_SD, I_WGLU, I_LBL, I_HNG, I_WBS, I_WBH, I_WOUT, I_N2G, I_WR, I_BR, I_WGU, I_BGU, I_WD, I_BD, I_FNG };

struct SchedStatic {
    const char* A; const char* B; int nM, nN, G, c; size_t ta, tb; int var = 0, pn_off = 0;
    __device__ __forceinline__ bool next(int i, Unit& u) const { int pm, pn; if (!pg8::static_tile(i * G + c, nM, nN, pm, pn)) return false; u.pm = pm; u.pn = pn + pn_off; u.aux = 0; u.a = A + (size_t)pm * ta; u.b = B + (size_t)pn * tb; if (var & 8) { u.a = A; u.b = B; } return true; }
};
struct SchedS5E {
    const char* UA; const char* WE; int c;
    __device__ __forceinline__ bool next(int i, Unit& u) const { if (i > 0 || c >= 64) return false; const int x = c & 7, r = c >> 3, g = x * 4 + (r >> 1), pm = r & 1; u.pm = pm; u.pn = 0; u.aux = g;
        u.a = UA + ((size_t)g * 512 + pm * 256) * UAK * 2; u.b = WE + (size_t)g * 256 * 1024 * 2; return true; }
};
struct SchedS5Y {
    const char* UA; const char* TZ; int c, G;
    __device__ __forceinline__ bool next(int i, Unit& u) const { if (i > 0 || G != 256) { const int L = i * G + c; if (G == 256 || L >= 256) return false; const int g = L >> 3; u.pm = (L >> 2) & 1; u.pn = L & 3; u.aux = g;
            u.a = UA + ((size_t)g * 512 + u.pm * 256) * UAK * 2; u.b = TZ + ((size_t)g * 1024 + u.pn * 256) * UAK * 2; return true; }
        const int x = c & 7, r = c >> 3, g = x + 8 * (r >> 3), pm = (r >> 2) & 1, pn = r & 3; u.pm = pm; u.pn = pn; u.aux = g;
        u.a = UA + ((size_t)g * 512 + pm * 256) * UAK * 2; u.b = TZ + ((size_t)g * 1024 + pn * 256) * UAK * 2; return true; }
};
struct SchedBranch {
    const char* A0; const char* A1; const char* B0; const char* B1; int G, c;
    __device__ __forceinline__ bool next(int i, Unit& u) const { int pm, pn; if (!pg8::static_tile((i >> 1) * G + c, T / 256, 4, pm, pn)) return false; const int part = i & 1; u.pm = pm; u.pn = pn; u.aux = part;
        u.a = (part ? A1 : A0) + (size_t)pm * 256 * HW * 2; u.b = (part ? B1 : B0) + (size_t)pn * 256 * HW * 2; return true; }
};
struct SchedMoe {
    const char* A; const char* W; const int* tile_e; int ntiles, NN, G, c; size_t wexp, wtile; bool gather; int var;
    __device__ __forceinline__ bool next(int i, Unit& u) const { int ti, pn;
        if ((G & 7) == 0) { const int x = c & 7, j = i * (G >> 3) + (c >> 3), ml = j / NN; pn = j - ml * NN; ti = ml * 8 + x; }
        else { const int L = i * G + c; ti = L / NN; pn = L - ti * NN; }
        if (ti >= ntiles) return false; const int e = tile_e[ti];
        u.pm = ti; u.pn = pn; u.aux = gather ? ti * 256 : e; u.a = gather ? A : A + (size_t)ti * 256 * DF; u.b = W + (size_t)e * wexp + (size_t)pn * wtile;
        if (var & 8) { u.a = A; u.b = W; if (gather) u.aux = 0; } return true; }
};

__device__ __forceinline__ u32x4 pack8(const f32x4& v0, const f32x4& v1) { u32x4 w; w.x = cvt_pk_bf16(v0[0], v0[1]); w.y = cvt_pk_bf16(v0[2], v0[3]); w.z = cvt_pk_bf16(v1[0], v1[1]); w.w = cvt_pk_bf16(v1[2], v1[3]); return w; }

struct EpiInProj {
    static constexpr bool PERM = true;
    bf16_t *UA, *Q, *V, *GS, *GATES; float* LOGF; const float* LBV;
    __device__ __forceinline__ bool operator()(f32x4 (&acc)[2][2][4][2], const Unit& u, int wr, int wc, int fr, int fq) const {
        const int kind = u.pn >> 1;
#pragma unroll
        for (int ai = 0; ai < 2; ++ai)
#pragma unroll
            for (int m = 0; m < 4; ++m) { const int tok = u.pm * 256 + ai * 128 + wr * 64 + m * 16 + fr;
#pragma unroll
                for (int bj = 0; bj < 2; ++bj) { const int col = u.pn * 256 + bj * 128 + wc * 32 + 8 * fq; f32x4 v0 = acc[ai][bj][m][0], v1 = acc[ai][bj][m][1];
                    if (kind == 0) { const int g = col >> 4, hh = col & 15; *(u32x4*)(UA + ((size_t)(g * 512 + (tok >> 6)) * UAK + (tok & 63) * 16 + hh)) = pack8(v0, v1); }
                    else if (kind == 1) {
#pragma unroll
                        for (int j = 0; j < 4; ++j) { v0[j] = v0[j] * sigmoidf_(v0[j]); v1[j] = v1[j] * sigmoidf_(v1[j]); }
                        *(u32x4*)(Q + (size_t)tok * HW + (col - 512)) = pack8(v0, v1); }
                    else if (kind == 2) { const int c2 = col - 1024; const f32x4 l0 = *(const f32x4*)(LBV + c2), l1 = *(const f32x4*)(LBV + c2 + 4);
#pragma unroll
                        for (int j = 0; j < 4; ++j) { v0[j] = __logf(l0[j] + (1.f - l0[j]) * sigmoidf_(v0[j])); v1[j] = __logf(l1[j] + (1.f - l1[j]) * sigmoidf_(v1[j])); }
                        *(f32x4*)(LOGF + (size_t)tok * HW + c2) = v0; *(f32x4*)(LOGF + (size_t)tok * HW + c2 + 4) = v1; }
                    else if (kind == 3) { *(u32x4*)(V + (size_t)tok * HW + (col - 1536)) = pack8(v0, v1); }
                    else if (kind == 4) {
#pragma unroll
                        for (int j = 0; j < 4; ++j) { v0[j] = v0[j] * sigmoidf_(v0[j]); v1[j] = v1[j] * sigmoidf_(v1[j]); }
                        *(u32x4*)(GS + (size_t)tok * HW + (col - 2048)) = pack8(v0, v1); }
                    else {
#pragma unroll
                        for (int j = 0; j < 4; ++j) { v0[j] = sigmoidf_(v0[j]); v1[j] = sigmoidf_(v1[j]); }
                        if (MK_GSTORE_F8) { u32x2 q8; q8.x = pk4_u8(v0[0], v0[1], v0[2], v0[3]); q8.y = pk4_u8(v1[0], v1[1], v1[2], v1[3]); *(u32x2*)((unsigned char*)GATES + (size_t)tok * 2048 + (col - 2560)) = q8; }
                        else *(u32x4*)(GATES + (size_t)tok * 2048 + (col - 2560)) = pack8(v0, v1); }
                } }
        return false;
    }
};
struct EpiS5E {
    static constexpr bool PERM = false;
    float* SE;
    __device__ __forceinline__ bool operator()(f32x4 (&acc)[2][2][4][2], const Unit& u, int wr, int wc, int fr, int fq) const {
#pragma unroll
        for (int ai = 0; ai < 2; ++ai)
#pragma unroll
            for (int m = 0; m < 4; ++m) { const int r = u.pm * 256 + ai * 128 + wr * 64 + m * 16 + fr; float* rowp = SE + ((size_t)u.aux * 512 + r) * 128 + wc * 32 + 4 * fq;
#pragma unroll
                for (int n = 0; n < 2; ++n) *(f32x4*)(rowp + n * 16) = acc[ai][0][m][n]; }
        return false;
    }
};
struct EpiS5Y {
    static constexpr bool PERM = true;
    const bf16_t* UA; const float* SD; bf16_t* Y1;
    __device__ __forceinline__ bool operator()(f32x4 (&acc)[2][2][4][2], const Unit& u, int wr, int wc, int fr, int fq) const {
        const int g = u.aux;
#pragma unroll
        for (int ai = 0; ai < 2; ++ai)
#pragma unroll
            for (int m = 0; m < 4; ++m) { const int r = u.pm * 256 + ai * 128 + wr * 64 + m * 16 + fr; const int b = r >> 7, c = r & 127;
#pragma unroll
                for (int bj = 0; bj < 2; ++bj) { const int col = u.pn * 256 + bj * 128 + wc * 32 + 8 * fq; const int t = col >> 4, hh = col & 15;
                    const u32x4 uu = *(const u32x4*)(UA + ((size_t)(g * 512 + r) * UAK + col));
                    const f32x4 d0 = *(const f32x4*)(SD + g * 16 + hh), d1 = *(const f32x4*)(SD + g * 16 + hh + 4);
                    f32x4 v0 = acc[ai][bj][m][0], v1 = acc[ai][bj][m][1];
                    v0[0] += d0[0] * bf2f(uu.x & 0xffffu); v0[1] += d0[1] * bf2f(uu.x >> 16); v0[2] += d0[2] * bf2f(uu.y & 0xffffu); v0[3] += d0[3] * bf2f(uu.y >> 16);
                    v1[0] += d1[0] * bf2f(uu.z & 0xffffu); v1[1] += d1[1] * bf2f(uu.z >> 16); v1[2] += d1[2] * bf2f(uu.w & 0xffffu); v1[3] += d1[3] * bf2f(uu.w >> 16);
#pragma unroll
                    for (int j = 0; j < 4; ++j) { float x = v0[j]; v0[j] = x * sigmoidf_(1.5957691216f * (x + 0.044715f * x * x * x)); x = v1[j]; v1[j] = x * sigmoidf_(1.5957691216f * (x + 0.044715f * x * x * x)); }
                    const int tok = b * SEQ + c * 64 + t;
                    *(u32x4*)(Y1 + (size_t)tok * HW + g * 16 + hh) = pack8(v0, v1); } }
        return false;
    }
};
struct EpiGlu {
    static constexpr bool PERM = true;
    const bf16_t* Y1; bf16_t* YS5;
    __device__ __forceinline__ bool operator()(f32x4 (&acc)[2][2][4][2], const Unit& u, int wr, int wc, int fr, int fq) const {
#pragma unroll
        for (int ai = 0; ai < 2; ++ai)
#pragma unroll
            for (int m = 0; m < 4; ++m) { const int row = u.pm * 256 + ai * 128 + wr * 64 + m * 16 + fr;
#pragma unroll
                for (int bj = 0; bj < 2; ++bj) { const int col = u.pn * 256 + bj * 128 + wc * 32 + 8 * fq; const u32x4 y = *(const u32x4*)(Y1 + (size_t)row * HW + col);
                    f32x4 v0 = acc[ai][bj][m][0], v1 = acc[ai][bj][m][1];
                    v0[0] = bf2f(y.x & 0xffffu) * sigmoidf_(v0[0]); v0[1] = bf2f(y.x >> 16) * sigmoidf_(v0[1]); v0[2] = bf2f(y.y & 0xffffu) * sigmoidf_(v0[2]); v0[3] = bf2f(y.y >> 16) * sigmoidf_(v0[3]);
                    v1[0] = bf2f(y.z & 0xffffu) * sigmoidf_(v1[0]); v1[1] = bf2f(y.z >> 16) * sigmoidf_(v1[1]); v1[2] = bf2f(y.w & 0xffffu) * sigmoidf_(v1[2]); v1[3] = bf2f(y.w >> 16) * sigmoidf_(v1[3]);
                    *(u32x4*)(YS5 + (size_t)row * HW + col) = pack8(v0, v1); } }
        return false;
    }
};
struct EpiBranch {
    static constexpr bool PERM = true;
    const bf16_t* GATES; bf16_t* MERGED;
    __device__ __forceinline__ bool operator()(f32x4 (&acc)[2][2][4][2], const Unit& u, int wr, int wc, int fr, int fq) const {
        const int part = u.aux;
#pragma unroll
        for (int ai = 0; ai < 2; ++ai)
#pragma unroll
            for (int m = 0; m < 4; ++m) { const int row = u.pm * 256 + ai * 128 + wr * 64 + m * 16 + fr;
#pragma unroll
                for (int bj = 0; bj < 2; ++bj) { const int col = u.pn * 256 + bj * 128 + wc * 32 + 8 * fq;
                    float h[8], s[8];
                    if (MK_GSTORE_F8) { const u32x2 g2 = *(const u32x2*)((const unsigned char*)GATES + (size_t)row * 2048 + 1024 + col); const float i255 = 1.0f / 255.0f;
#pragma unroll
                        for (int j = 0; j < 4; ++j) { h[j] = fmaxf((float)((g2.x >> (8 * j)) & 0xffu), 0.5f) * i255; h[4 + j] = fmaxf((float)((g2.y >> (8 * j)) & 0xffu), 0.5f) * i255; }
                        if (part == 0) { const u32x2 g1 = *(const u32x2*)((const unsigned char*)GATES + (size_t)row * 2048 + col);
#pragma unroll
                            for (int j = 0; j < 4; ++j) { s[j] = (float)((g1.x >> (8 * j)) & 0xffu) * i255; s[4 + j] = (float)((g1.y >> (8 * j)) & 0xffu) * i255; } } }
                    else { const u32x4 g2 = *(const u32x4*)(GATES + (size_t)row * 2048 + 1024 + col);
                        h[0] = bf2f(g2.x & 0xffffu); h[1] = bf2f(g2.x >> 16); h[2] = bf2f(g2.y & 0xffffu); h[3] = bf2f(g2.y >> 16); h[4] = bf2f(g2.z & 0xffffu); h[5] = bf2f(g2.z >> 16); h[6] = bf2f(g2.w & 0xffffu); h[7] = bf2f(g2.w >> 16);
                        if (part == 0) { const u32x4 g1 = *(const u32x4*)(GATES + (size_t)row * 2048 + col);
                            s[0] = bf2f(g1.x & 0xffffu); s[1] = bf2f(g1.x >> 16); s[2] = bf2f(g1.y & 0xffffu); s[3] = bf2f(g1.y >> 16); s[4] = bf2f(g1.z & 0xffffu); s[5] = bf2f(g1.z >> 16); s[6] = bf2f(g1.w & 0xffffu); s[7] = bf2f(g1.w >> 16); } }
#pragma unroll
                    for (int j = 0; j < 8; ++j) h[j] = fmaxf(h[j], 1e-30f);
                    if (part == 0) {
#pragma unroll
                        for (int j = 0; j < 4; ++j) { acc[ai][bj][m][0][j] *= s[j] / h[j]; acc[ai][bj][m][1][j] *= s[4 + j] / h[4 + j]; } }
                    else { f32x4 v0 = acc[ai][bj][m][0], v1 = acc[ai][bj][m][1];
#pragma unroll
                        for (int j = 0; j < 4; ++j) { v0[j] *= h[j]; v1[j] *= h[4 + j]; }
                        *(u32x4*)(MERGED + (size_t)row * D + col) = pack8(v0, v1); } } }
        return part == 0;
    }
};
struct EpiOut {
    static constexpr bool PERM = true;
    const float* X; bf16_t* H1; float* SSQ; int var = 0;
    __device__ __forceinline__ bool operator()(f32x4 (&acc)[2][2][4][2], const Unit& u, int wr, int wc, int fr, int fq) const {
#pragma unroll
        for (int ai = 0; ai < 2; ++ai)
#pragma unroll
            for (int m = 0; m < 4; ++m) { const int row = u.pm * 256 + ai * 128 + wr * 64 + m * 16 + fr; const size_t off = (size_t)row * D + u.pn * 256 + wc * 32 + 8 * fq; float ss = 0.f;
                if (var & 4) { asm volatile("" :: "v"(acc[ai][0][m][0]), "v"(acc[ai][0][m][1]), "v"(acc[ai][1][m][0]), "v"(acc[ai][1][m][1])); continue; }
#pragma unroll
                for (int bj = 0; bj < 2; ++bj) { const f32x4 o0 = *(const f32x4*)(X + off + bj * 128) + acc[ai][bj][m][0], o1 = *(const f32x4*)(X + off + bj * 128 + 4) + acc[ai][bj][m][1];
                    *(u32x4*)(H1 + off + bj * 128) = pack8(o0, o1); ss += ((o0[0] * o0[0] + o0[1] * o0[1]) + (o0[2] * o0[2] + o0[3] * o0[3])) + ((o1[0] * o1[0] + o1[1] * o1[1]) + (o1[2] * o1[2] + o1[3] * o1[3])); }
                ss += __shfl_xor(ss, 16); ss += __shfl_xor(ss, 32);
                if (fq == 0) SSQ[(size_t)row * 16 + u.pn * 4 + wc] = ss; }
        return false;
    }
};
struct EpiMoe1 {
    static constexpr bool PERM = true;
    const float* BGU; const int* tile_e; unsigned char* A2; int var;
    __device__ __forceinline__ bool operator()(f32x4 (&acc)[2][2][4][2], const Unit& u, int wr, int wc, int fr, int fq) const {
        const int e = tile_e[u.pm]; const int hid = u.pn * 128 + wc * 32 + 8 * fq; const float* bp = BGU + (size_t)e * 2048 + 2 * hid;
        const f32x4 b0 = *(const f32x4*)(bp), b1 = *(const f32x4*)(bp + 4), b2 = *(const f32x4*)(bp + 8), b3 = *(const f32x4*)(bp + 12);
        const float bg[8] = {b0[0], b0[2], b1[0], b1[2], b2[0], b2[2], b3[0], b3[2]}, bu[8] = {b0[1], b0[3], b1[1], b1[3], b2[1], b2[3], b3[1], b3[3]};
#pragma unroll
        for (int ai = 0; ai < 2; ++ai)
#pragma unroll
            for (int m = 0; m < 4; ++m) { const int prow = u.pm * 256 + ai * 128 + wr * 64 + m * 16 + fr; f32x4 o0, o1;
                if (var & 4) { asm volatile("" :: "v"(acc[ai][0][m][0]), "v"(acc[ai][0][m][1]), "v"(acc[ai][1][m][0]), "v"(acc[ai][1][m][1])); continue; }
#pragma unroll
                for (int j = 0; j < 4; ++j) {
                    float gt = fminf(acc[ai][0][m][0][j] + bg[j], 7.0f), up = fminf(fmaxf(acc[ai][1][m][0][j] + bu[j], -7.0f), 7.0f); o0[j] = (up + 1.0f) * gt * sigmoidf_(1.702f * gt);
                    gt = fminf(acc[ai][0][m][1][j] + bg[4 + j], 7.0f); up = fminf(fmaxf(acc[ai][1][m][1][j] + bu[4 + j], -7.0f), 7.0f); o1[j] = (up + 1.0f) * gt * sigmoidf_(1.702f * gt); }
                u32x2 q8; q8.x = pk4_fp8(o0[0], o0[1], o0[2], o0[3]); q8.y = pk4_fp8(o1[0], o1[1], o1[2], o1[3]);
                if (var & 1) asm volatile("" :: "v"(q8)); else *(u32x2*)(A2 + (size_t)prow * DF + hid) = q8; }
        return false;
    }
};
struct EpiMoe2 {
    static constexpr bool PERM = true;
    const float* BD; const int* tile_e; const int* rowslot; unsigned char* YS; int var;
    __device__ __forceinline__ bool operator()(f32x4 (&acc)[2][2][4][2], const Unit& u, int wr, int wc, int fr, int fq) const {
        const int e = tile_e[u.pm];
#pragma unroll
        for (int ai = 0; ai < 2; ++ai)
#pragma unroll
            for (int m = 0; m < 4; ++m) { const int prow = u.pm * 256 + ai * 128 + wr * 64 + m * 16 + fr; const int slot = rowslot[prow];
                if (var & 4) { asm volatile("" :: "v"(acc[ai][0][m][0]), "v"(acc[ai][0][m][1]), "v"(acc[ai][1][m][0]), "v"(acc[ai][1][m][1])); continue; }
                if (var & 1) { const f32x4 c0 = *(const f32x4*)(BD + (size_t)e * D + u.pn * 256 + wc * 32 + 8 * fq); const f32x4 t0 = acc[ai][0][m][0] + c0, t1 = acc[ai][1][m][1] + c0; asm volatile("" :: "v"(t0), "v"(t1), "v"(slot)); continue; }
                if (slot >= 0) {
#pragma unroll
                    for (int bj = 0; bj < 2; ++bj) { const int col = u.pn * 256 + bj * 128 + wc * 32 + 8 * fq; const f32x4 c0 = *(const f32x4*)(BD + (size_t)e * D + col), c1 = *(const f32x4*)(BD + (size_t)e * D + col + 4);
                        const f32x4 y0 = acc[ai][bj][m][0] + c0, y1 = acc[ai][bj][m][1] + c1; u32x2 q8; q8.x = pk4_fp8(y0[0], y0[1], y0[2], y0[3]); q8.y = pk4_fp8(y1[0], y1[1], y1[2], y1[3]);
                        *(u32x2*)(YS + (size_t)slot * D + col) = q8; } } }
        return false;
    }
};

struct TDesc { const float* W; unsigned char* WT; int K, N, k0, n0, mode, out8; };
__device__ __forceinline__ TDesc p0_decode(const Frame& F, int t) {
    TDesc d; unsigned char* ws = F.ws;
    if (t < 16384) { const int e = t >> 9, r = t & 511; d.W = F.in[I_WGU] + (size_t)e * D * 2048; d.WT = ws + WS_WGU + (size_t)e * 2048 * D; d.K = D; d.N = 2048; d.k0 = (r >> 5) * 64; d.n0 = (r & 31) * 64; d.mode = 1; d.out8 = 1; return d; }
    t -= 16384;
    if (t < 8192) { const int e = t >> 8, r = t & 255; d.W = F.in[I_WD] + (size_t)e * DF * D; d.WT = ws + WS_WD + (size_t)e * D * DF; d.K = DF; d.N = D; d.k0 = (r >> 4) * 64; d.n0 = (r & 15) * 64; d.mode = 0; d.out8 = 1; return d; }
    t -= 8192; d.mode = 0; d.out8 = 0;
    if (t < 1152) { d.W = F.in[I_WIN]; d.WT = ws + WS_WIN; d.K = D; d.N = INW; d.k0 = (t / 72) * 64; d.n0 = (t % 72) * 64; d.out8 = MK_P1_F8; if (MK_GATES_F8 && d.n0 >= 2560) { d.out8 = 1; d.WT = ws + WS_WIN8 - (size_t)2560 * D; } return d; }
    t -= 1152;
    if (t < 64) { d.W = F.in[I_WGLU]; d.WT = ws + WS_WGLU; d.K = HW; d.N = HW; d.k0 = (t >> 3) * 64; d.n0 = (t & 7) * 64; return d; }
    t -= 64;
    if (t < 128) { d.W = F.in[I_WBS]; d.WT = ws + WS_WBS; d.K = HW; d.N = D; d.k0 = (t >> 4) * 64; d.n0 = (t & 15) * 64; return d; }
    t -= 128;
    if (t < 128) { d.W = F.in[I_WBH]; d.WT = ws + WS_WBH; d.K = HW; d.N = D; d.k0 = (t >> 4) * 64; d.n0 = (t & 15) * 64; return d; }
    t -= 128;
    d.W = F.in[I_WOUT]; d.WT = ws + WS_WOUT; d.K = D; d.N = D; d.k0 = (t >> 4) * 64; d.n0 = (t & 15) * 64; return d;
}
constexpr int P0_NTILES = 16384 + 8192 + 1152 + 64 + 128 + 128 + 256;
__device__ __forceinline__ void p0_tile_load(const TDesc& d, f32x4 (&r)[16], int lane) {
    const float* p = d.W + (size_t)(d.k0 + (lane >> 4)) * d.N + d.n0 + (lane & 15) * 4;
#pragma unroll
    for (int i = 0; i < 16; ++i) r[i] = *(const f32x4*)(p + (size_t)(4 * i) * d.N);
}
__device__ __forceinline__ void p0_tile_to_lds(LAS float* scr, const f32x4 (&r)[16], int lane) {
#pragma unroll
    for (int i = 0; i < 16; ++i) { const int k = (lane >> 4) + 4 * i; *(LAS f32x4*)(scr + k * 64 + (((lane & 15) * 4) ^ (4 * ((k >> 3) & 7)))) = r[i]; }
}
__device__ __forceinline__ void p0_tile_store(const TDesc& d, const LAS float* scr, int lane) {
    if (d.out8) { const int c = lane & 3; const float sc = (float)(1 << pg8::F8_WSH);
#pragma unroll
        for (int j = 0; j < 4; ++j) { const int n = (lane >> 2) + 16 * j; float v[16];
#pragma unroll
            for (int t = 0; t < 16; ++t) { const int k = 16 * c + t; v[t] = scr[k * 64 + (n ^ (4 * ((k >> 3) & 7)))] * sc; }
            u32x4 o;
            { int w = 0; w = __builtin_amdgcn_cvt_pk_fp8_f32(v[0], v[1], w, false); w = __builtin_amdgcn_cvt_pk_fp8_f32(v[2], v[3], w, true); o.x = (unsigned)w; }
            { int w = 0; w = __builtin_amdgcn_cvt_pk_fp8_f32(v[4], v[5], w, false); w = __builtin_amdgcn_cvt_pk_fp8_f32(v[6], v[7], w, true); o.y = (unsigned)w; }
            { int w = 0; w = __builtin_amdgcn_cvt_pk_fp8_f32(v[8], v[9], w, false); w = __builtin_amdgcn_cvt_pk_fp8_f32(v[10], v[11], w, true); o.z = (unsigned)w; }
            { int w = 0; w = __builtin_amdgcn_cvt_pk_fp8_f32(v[12], v[13], w, false); w = __builtin_amdgcn_cvt_pk_fp8_f32(v[14], v[15], w, true); o.w = (unsigned)w; }
            int nn = d.n0 + n; if (d.mode == 1) { const int hid = nn >> 1, part = nn & 1; nn = 256 * (hid >> 7) + 128 * part + (hid & 127); }
            *(u32x4*)(d.WT + (size_t)nn * d.K + d.k0 + 16 * c) = o; } }
    else { const int c = lane & 7;
#pragma unroll
        for (int j = 0; j < 8; ++j) { const int n = (lane >> 3) + 8 * j; float v[8];
#pragma unroll
            for (int t = 0; t < 8; ++t) { const int k = 8 * c + t; v[t] = scr[k * 64 + (n ^ (4 * (c & 7)))]; }
            u32x4 o; o.x = cvt_pk_bf16(v[0], v[1]); o.y = cvt_pk_bf16(v[2], v[3]); o.z = cvt_pk_bf16(v[4], v[5]); o.w = cvt_pk_bf16(v[6], v[7]);
            *(u32x4*)((bf16_t*)d.WT + (size_t)(d.n0 + n) * d.K + d.k0 + 8 * c) = o; } }
}
struct C2 { double re, im; };
__device__ __forceinline__ C2 cmul(C2 a, C2 b) { return C2{a.re * b.re - a.im * b.im, a.re * b.im + a.im * b.re}; }
__device__ __forceinline__ C2 s5_pow(const Frame& F, int g, int p, int k) {
    const double lre = (double)F.in[I_LRE][g * SP + p], lim = (double)F.in[I_LIM][g * SP + p], dt = exp((double)F.in[I_LDT][g]);
    const double mag = exp((double)k * lre * dt); double s, c; sincos((double)k * lim * dt, &s, &c); return C2{mag * c, mag * s};
}
__device__ __forceinline__ C2 s5_coef(const Frame& F, int g, int p) {
    const double lre = (double)F.in[I_LRE][g * SP + p], lim = (double)F.in[I_LIM][g * SP + p]; const C2 lb = s5_pow(F, g, p, 1);
    const double nr = lb.re - 1.0, ni = lb.im, den = lre * lre + lim * lim; return C2{(nr * lre + ni * lim) / den, (ni * lre - nr * lim) / den};
}

struct C2f { float re, im; };
__device__ __forceinline__ C2f cmulf(C2f a, C2f b) { return C2f{a.re * b.re - a.im * b.im, a.re * b.im + a.im * b.re}; }
__device__ __forceinline__ void s5_fast(const Frame& F, int g, int p, C2f& lb, C2f& cf) {
    const float lre = F.in[I_LRE][g * SP + p], lim = F.in[I_LIM][g * SP + p], dt = expf(F.in[I_LDT][g]); const float a = lre * dt, th = lim * dt;
    float sn, cs; sincosf(th, &sn, &cs); const float ea = expf(a); lb = C2f{ea * cs, ea * sn};
    const float sh = sinf(0.5f * th); const float nr = expm1f(a) * cs - 2.0f * sh * sh, ni = ea * sn, den = lre * lre + lim * lim;
    cf = C2f{(nr * lre + ni * lim) / den, (ni * lre - nr * lim) / den};
}
__device__ __forceinline__ C2f cpowf_(C2f b, int k) { C2f r{1.f, 0.f};
#pragma unroll
    for (int i = 0; i < 7; ++i) { if (k & 1) r = cmulf(r, b); b = cmulf(b, b); k >>= 1; } return r; }
__device__ __forceinline__ void p0_prologue(Frame& F, const int var = 0) {
    LAS float* scr = (LAS float*)(F.lds + F.wave * 16384);
    const int gw = F.vcu * 8 + F.wave, NGW = F.G * 8, lane = F.lane;
    unsigned char* ws = F.ws;
    { f32x4 rr[16]; int t = gw;
      if (t < P0_NTILES && !(var & 256)) { TDesc dc = p0_decode(F, t); p0_tile_load(dc, rr, lane);
        for (;;) { p0_tile_to_lds(scr, rr, lane);
            const int tn = t + NGW; TDesc dn = dc; const bool more = tn < P0_NTILES;
            if (more) { dn = p0_decode(F, tn); p0_tile_load(dn, rr, lane); }
            LDS_WAIT(); asm volatile("" ::: "memory");
            p0_tile_store(dc, scr, lane);
            LDS_WAIT(); asm volatile("" ::: "memory");
            if (!more) break; dc = dn; t = tn; } } }
    constexpr int R6 = 0;
    constexpr int R7 = R6 + 2048  , R8 = R7 + 2048  , R9 = R8 + 2048  , R10 = R9 + 32  , R11 = R10 + 384  , R12 = R11 + 16  , R13 = R12 + 1  ;
    constexpr int R14 = R13 + 2048  ;
    for (int it = gw; it < ((var & 512) ? 0 : R14); it += NGW) {
        if (it < R7) {
            const int q = it - R6, g = q >> 6, k = q & 63, p = lane;
            C2f lb, cf; s5_fast(F, g, p, lb, cf); const C2f pw = cpowf_(lb, k);
            LAS float* CLre = scr; LAS float* CLim = scr + 1024; LAS float* BBre = scr + 2048; LAS float* BBim = scr + 3072;
#pragma unroll 4
            for (int h = 0; h < 16; ++h) { const C2f cc = cmulf(C2f{F.in[I_CRE][(g * 16 + h) * SP + p], F.in[I_CIM][(g * 16 + h) * SP + p]}, pw); CLre[h * 64 + p] = cc.re; CLim[h * 64 + p] = cc.im;
                const C2f bb = cmulf(cf, C2f{F.in[I_BRE][(g * SP + p) * 16 + h], F.in[I_BIM][(g * SP + p) * 16 + h]}); BBre[p * 16 + h] = bb.re; BBim[p * 16 + h] = bb.im; }
            LDS_WAIT(); asm volatile("" ::: "memory");
            float o[4];
#pragma unroll
            for (int qq = 0; qq < 4; ++qq) { const int idx = lane * 4 + qq, h = idx >> 4, h2 = idx & 15; float s = 0.f;
                for (int pp = 0; pp < 64; ++pp) s += CLre[h * 64 + pp] * BBre[pp * 16 + h2] - CLim[h * 64 + pp] * BBim[pp * 16 + h2];
                o[qq] = s; }
            u32x2 w; w.x = pk2(o[0], o[1]); w.y = pk2(o[2], o[3]);
            *(u32x2*)((bf16_t*)(ws + WS_KCONV) + (size_t)q * 256 + lane * 4) = w;
            LDS_WAIT(); asm volatile("" ::: "memory");
        }
        else if (it < R8) {
            const int q = it - R7, g = q >> 6, s = q & 63, p = lane; C2f lb, cf; s5_fast(F, g, p, lb, cf); const C2f pw = cmulf(cpowf_(lb, 63 - s), cf);
            float re[16], im[16];
#pragma unroll
            for (int h = 0; h < 16; ++h) { const C2f w = cmulf(pw, C2f{F.in[I_BRE][(g * SP + p) * 16 + h], F.in[I_BIM][(g * SP + p) * 16 + h]}); re[h] = w.re; im[h] = w.im; }
            bf16_t* o0 = (bf16_t*)(ws + WS_WE) + ((size_t)(g * 256 + p) * 1024 + s * 16); bf16_t* o1 = o0 + (size_t)64 * 1024;
            u32x4 a, b; a.x = pk2(re[0], re[1]); a.y = pk2(re[2], re[3]); a.z = pk2(re[4], re[5]); a.w = pk2(re[6], re[7]); b.x = pk2(re[8], re[9]); b.y = pk2(re[10], re[11]); b.z = pk2(re[12], re[13]); b.w = pk2(re[14], re[15]);
            *(u32x4*)o0 = a; *(u32x4*)(o0 + 8) = b;
            a.x = pk2(im[0], im[1]); a.y = pk2(im[2], im[3]); a.z = pk2(im[4], im[5]); a.w = pk2(im[6], im[7]); b.x = pk2(im[8], im[9]); b.y = pk2(im[10], im[11]); b.z = pk2(im[12], im[13]); b.w = pk2(im[14], im[15]);
            *(u32x4*)o1 = a; *(u32x4*)(o1 + 8) = b;
        }
        else if (it < R9) {
            const int q = it - R8, g = q >> 6, t = q & 63, p = lane; C2f lb, cf; s5_fast(F, g, p, lb, cf); const C2f pw = cpowf_(lb, t + 1);
            for (int h = 0; h < 16; ++h) { const C2f cc = cmulf(C2f{F.in[I_CRE][(g * 16 + h) * SP + p], F.in[I_CIM][(g * 16 + h) * SP + p]}, pw);
                bf16_t* o = (bf16_t*)(ws + WS_TZ) + ((size_t)(g * 1024 + t * 16 + h) * UAK + 1024 + p); o[0] = (bf16_t)f2bf(cc.re); o[64] = (bf16_t)f2bf(-cc.im); }
        }
        else if (it < R10) {
            const int g = it - R9, p = lane; const C2 l1 = s5_pow(F, g, p, 1), cf = s5_coef(F, g, p); C2 l64 = l1;
#pragma unroll
            for (int q2 = 0; q2 < 6; ++q2) l64 = cmul(l64, l64);
            ((f32x2*)(ws + WS_LAMB))[g * SP + p] = (f32x2){(float)l1.re, (float)l1.im}; ((f32x2*)(ws + WS_LAMC))[g * SP + p] = (f32x2){(float)l64.re, (float)l64.im};
            for (int h = 0; h < 16; ++h) { const C2 bb = cmul(cf, C2{(double)F.in[I_BRE][(g * SP + p) * 16 + h], (double)F.in[I_BIM][(g * SP + p) * 16 + h]}); ((f32x2*)(ws + WS_BBAR))[(g * SP + p) * 16 + h] = (f32x2){(float)bb.re, (float)bb.im}; }
        }
        else if (it < R11) {
            const int q = it - R10, cg = q >> 4, kq = q & 15; const int wcol = (cg < 8 ? cg * 64 : (cg < 16 ? 1024 + (cg - 8) * 64 : 1536 + (cg - 16) * 64)) + lane;
            const float* meta = F.in[I_META]; const float* g1 = F.in[I_N1G];
            for (int r = 0; r < 16; ++r) { float s = 0.f;
#pragma unroll
                for (int j = 0; j < 16; ++j) { const float v = meta[r * D + lane + 64 * j]; s += v * v; }
                const float rstd = 1.0f / sqrtf(wave_sum(s) * (1.0f / D) + EPS);
                const int k = kq * 64 + lane; scr[lane * 16 + r] = meta[r * D + k] * rstd * g1[k]; }
            LDS_WAIT(); asm volatile("" ::: "memory");
            float a[16];
#pragma unroll
            for (int r = 0; r < 16; ++r) a[r] = 0.f;
            const float* wp = F.in[I_WIN] + (size_t)(kq * 64) * INW + wcol;
#pragma unroll 16
            for (int kk = 0; kk < 64; ++kk) { const float w = wp[(size_t)kk * INW]; const LAS f32x4* xs = (const LAS f32x4*)(scr + kk * 16);
                const f32x4 x0 = xs[0], x1 = xs[1], x2 = xs[2], x3 = xs[3];
                a[0] += w * x0[0]; a[1] += w * x0[1]; a[2] += w * x0[2]; a[3] += w * x0[3]; a[4] += w * x1[0]; a[5] += w * x1[1]; a[6] += w * x1[2]; a[7] += w * x1[3];
                a[8] += w * x2[0]; a[9] += w * x2[1]; a[10] += w * x2[2]; a[11] += w * x2[3]; a[12] += w * x3[0]; a[13] += w * x3[1]; a[14] += w * x3[2]; a[15] += w * x3[3]; }
            float* pm = (float*)(ws + WS_PMETA);
#pragma unroll
            for (int r = 0; r < 16; ++r) pm[(size_t)(kq * 16 + r) * 1536 + cg * 64 + lane] = a[r];
            LDS_WAIT(); asm volatile("" ::: "memory");
        }
        else if (it < R12) {
            const int k = (it - R11) * 64 + lane; bf16_t* hi = (bf16_t*)(ws + WS_WRT); bf16_t* lo = hi + NE * D;
            for (int e = 0; e < NE; ++e) { const float w = F.in[I_WR][k * NE + e]; const unsigned h = f2bf(w); hi[e * D + k] = (bf16_t)h; lo[e * D + k] = (bf16_t)f2bf(w - bf2f(h)); }
        }
        else if (it < R13) {
            for (int d = lane; d < HW; d += 64) ((float*)(ws + WS_LBV))[d] = sigmoidf_(F.in[I_LBL][d] - F.in[I_LBL][HW + d]);
        }
        else {
            const int q = it - R13, g = q >> 6, r0 = 128 + (q & 63) * 2; u32x4* o = (u32x4*)((bf16_t*)(ws + WS_WE) + (size_t)(g * 256 + r0) * 1024);
#pragma unroll
            for (int j = 0; j < 4; ++j) o[lane + 64 * j] = (u32x4){0u, 0u, 0u, 0u};
        }
    }
    const float* g1 = F.in[I_N1G];
    for (int m = gw; m < ((var & 1024) ? 0 : T); m += 2 * NGW) {
        const int m2 = m + NGW; const bool two = m2 < T;
        const f32x4* xr = (const f32x4*)(F.in[I_X] + (size_t)m * D) + lane; const f32x4* xr2 = (const f32x4*)(F.in[I_X] + (size_t)(two ? m2 : m) * D) + lane; f32x4 v[4], w2[4]; float s = 0.f, s2 = 0.f;
#pragma unroll
        for (int j = 0; j < 4; ++j) { v[j] = xr[64 * j]; w2[j] = xr2[64 * j]; }
#pragma unroll
        for (int j = 0; j < 4; ++j) { s += (v[j].x * v[j].x + v[j].y * v[j].y) + (v[j].z * v[j].z + v[j].w * v[j].w); s2 += (w2[j].x * w2[j].x + w2[j].y * w2[j].y) + (w2[j].z * w2[j].z + w2[j].w * w2[j].w); }
        const float rstd = 1.0f / sqrtf(wave_sum(s) * (1.0f / D) + EPS), rstd2 = 1.0f / sqrtf(wave_sum(s2) * (1.0f / D) + EPS);
        if (MK_GATES_F8 && !MK_P1_F8) { unsigned* o4 = (unsigned*)(ws + WS_XN8 + (size_t)m * D) + lane; unsigned* o42 = (unsigned*)(ws + WS_XN8 + (size_t)m2 * D) + lane;
#pragma unroll
            for (int j = 0; j < 4; ++j) { const f32x4 gg = ((const f32x4*)g1)[lane + 64 * j]; o4[64 * j] = pk4_fp8(v[j].x * rstd * gg.x, v[j].y * rstd * gg.y, v[j].z * rstd * gg.z, v[j].w * rstd * gg.w);
                if (two) o42[64 * j] = pk4_fp8(w2[j].x * rstd2 * gg.x, w2[j].y * rstd2 * gg.y, w2[j].z * rstd2 * gg.z, w2[j].w * rstd2 * gg.w); } }
        if (MK_P1_F8) { unsigned* o4 = (unsigned*)(ws + WS_XN + (size_t)m * D) + lane; unsigned* o42 = (unsigned*)(ws + WS_XN + (size_t)m2 * D) + lane;
#pragma unroll
            for (int j = 0; j < 4; ++j) { const f32x4 gg = ((const f32x4*)g1)[lane + 64 * j]; o4[64 * j] = pk4_fp8(v[j].x * rstd * gg.x, v[j].y * rstd * gg.y, v[j].z * rstd * gg.z, v[j].w * rstd * gg.w);
                if (two) o42[64 * j] = pk4_fp8(w2[j].x * rstd2 * gg.x, w2[j].y * rstd2 * gg.y, w2[j].z * rstd2 * gg.z, w2[j].w * rstd2 * gg.w); } }
        else {
        u32x2* o8 = (u32x2*)((bf16_t*)(ws + WS_XN) + (size_t)m * D) + lane; u32x2* o82 = (u32x2*)((bf16_t*)(ws + WS_XN) + (size_t)m2 * D) + lane;
#pragma unroll
        for (int j = 0; j < 4; ++j) { const f32x4 gg = ((const f32x4*)g1)[lane + 64 * j]; u32x2 w; w.x = pk2(v[j].x * rstd * gg.x, v[j].y * rstd * gg.y); w.y = pk2(v[j].z * rstd * gg.z, v[j].w * rstd * gg.w); o8[64 * j] = w;
            if (two) { w.x = pk2(w2[j].x * rstd2 * gg.x, w2[j].y * rstd2 * gg.y); w.y = pk2(w2[j].z * rstd2 * gg.z, w2[j].w * rstd2 * gg.w); o82[64 * j] = w; } }
        }
    }
}
__device__ __forceinline__ void p1_toeplitz(Frame& F) {
    { const float* pm = (const float*)(F.ws + WS_PMETA); float* pr = (float*)(F.ws + WS_PMR);
      for (int i = F.vcu * 512 + F.tid; i < 16 * 1536; i += F.G * 512) { float s = 0.f;
#pragma unroll
          for (int kq = 0; kq < 16; ++kq) s += pm[(size_t)kq * 16 * 1536 + i]; pr[i] = s; } }
    const int gw = F.vcu * 8 + F.wave, NGW = F.G * 8, lane = F.lane; const bf16_t* kc = (const bf16_t*)(F.ws + WS_KCONV); bf16_t* tz = (bf16_t*)(F.ws + WS_TZ);
    for (int row = gw; row < SG * 1024; row += NGW) { const int g = row >> 10, t = (row >> 4) & 63, h = row & 15;
#pragma unroll
        for (int j = 0; j < 2; ++j) { const int q = lane + 64 * j, s = q >> 1, half = q & 1; u32x4 v = (u32x4){0u, 0u, 0u, 0u};
            if (s <= t) v = *(const u32x4*)(kc + ((size_t)((g * 64 + (t - s)) * 16 + h) * 16 + half * 8));
            *(u32x4*)(tz + (size_t)row * UAK + s * 16 + half * 8) = v; } }
}

constexpr int ST64 = 144, ST128 = 272;
template <int K> __device__ __forceinline__ void mma_nt32k(f32x16& acc, const LAS unsigned char* A, int sa, const LAS unsigned char* B, int sb, int lane) {
    const LAS unsigned char* pa = A + (lane & 31) * sa + (lane >> 5) * 16; const LAS unsigned char* pb = B + (lane & 31) * sb + (lane >> 5) * 16;
#pragma unroll
    for (int k = 0; k < K; k += 16) { const bf16x8 a = *(const LAS bf16x8*)(pa + k * 2), b = *(const LAS bf16x8*)(pb + k * 2); acc = __builtin_amdgcn_mfma_f32_32x32x16_bf16(a, b, acc, 0, 0, 0); }
}
__device__ __forceinline__ void hga_load(Frame& F, int unit, float (&lf)[16], u32x4 (&vv)[2]) {
    const int tid = F.tid; const int bh = unit >> 7, c = unit & 127, tok0 = (bh >> 2) * SEQ + c * CH, hcol = (bh & 3) * HD; const int d = tid & 127, seg = tid >> 7;
    const float* lg = (const float*)(F.ws + WS_LOGF) + (size_t)(tok0 + seg * 16) * HW + hcol + d;
#pragma unroll
    for (int j = 0; j < 16; ++j) lf[j] = lg[(size_t)j * HW];
#pragma unroll
    for (int i = 0; i < 2; ++i) vv[i] = *(const u32x4*)((const bf16_t*)(F.ws + WS_V) + (size_t)(tok0 + (tid & 63)) * HW + hcol + ((tid >> 6) + 8 * i) * 8);
}
__device__ __forceinline__ void hgrn_a_phase(Frame& F, int first, int stride, int count) {
    const int tid = F.tid, lane = F.lane, wave = F.wave;
    LAS unsigned char* KT = F.lds; LAS unsigned char* VT = F.lds + 128 * ST64; LAS float* segtot = (LAS float*)(F.lds + 2 * 128 * ST64); LAS unsigned char* OT = (LAS unsigned char*)(segtot + 512);
    const int d = tid & 127, seg = tid >> 7;
    int unit = first; if (unit >= 16 * NCH) return;
    float lf[16]; u32x4 vv[2]; hga_load(F, unit, lf, vv);
    for (;;) {
        const int bh = unit >> 7, c = unit & 127, b = bh >> 2, h = bh & 3, tok0 = b * SEQ + c * CH, hcol = h * HD;
        float cs[16]; float run = 0.f;
#pragma unroll
        for (int j = 0; j < 16; ++j) { run += lf[j]; cs[j] = run; }
        segtot[seg * 128 + d] = run;
#pragma unroll
        for (int i = 0; i < 2; ++i) { const int e0 = ((tid >> 6) + 8 * i) * 8; LAS bf16_t* o = (LAS bf16_t*)(VT + e0 * ST64 + (tid & 63) * 2); const u32x4 v = vv[i];
            o[0 * (ST64 / 2)] = (bf16_t)(v.x & 0xffffu); o[1 * (ST64 / 2)] = (bf16_t)(v.x >> 16); o[2 * (ST64 / 2)] = (bf16_t)(v.y & 0xffffu); o[3 * (ST64 / 2)] = (bf16_t)(v.y >> 16);
            o[4 * (ST64 / 2)] = (bf16_t)(v.z & 0xffffu); o[5 * (ST64 / 2)] = (bf16_t)(v.z >> 16); o[6 * (ST64 / 2)] = (bf16_t)(v.w & 0xffffu); o[7 * (ST64 / 2)] = (bf16_t)(v.w >> 16); }
        __syncthreads();
        const float t0 = segtot[d], t1 = segtot[128 + d], t2 = segtot[256 + d], t3 = segtot[384 + d];
        const float pre = seg == 0 ? 0.f : (seg == 1 ? t0 : (seg == 2 ? t0 + t1 : t0 + t1 + t2)); const float total = (t0 + t1) + (t2 + t3);
        float kk[16];
#pragma unroll
        for (int j = 0; j < 16; ++j) { cs[j] += pre; kk[j] = (1.0f - __expf(lf[j])) * __expf(total - cs[j]); }
        u32x4 w0, w1; w0.x = cvt_pk_bf16(kk[0], kk[1]); w0.y = cvt_pk_bf16(kk[2], kk[3]); w0.z = cvt_pk_bf16(kk[4], kk[5]); w0.w = cvt_pk_bf16(kk[6], kk[7]); w1.x = cvt_pk_bf16(kk[8], kk[9]); w1.y = cvt_pk_bf16(kk[10], kk[11]); w1.z = cvt_pk_bf16(kk[12], kk[13]); w1.w = cvt_pk_bf16(kk[14], kk[15]);
        *(LAS u32x4*)(KT + d * ST64 + seg * 32) = w0; *(LAS u32x4*)(KT + d * ST64 + seg * 32 + 16) = w1;
        if (seg == 0) ((float*)(F.ws + WS_DEC))[(size_t)unit * HD + d] = __expf(total);
        { float* bc = (float*)(F.ws + WS_BCUM) + (size_t)(tok0 + seg * 16) * HW + hcol + d;
#pragma unroll
          for (int j = 0; j < 16; ++j) bc[(size_t)j * HW] = cs[j]; }
        const int un = unit + stride; const bool more = (un < 16 * NCH) && (--count > 0);
        if (more) hga_load(F, un, lf, vv);
        __syncthreads();
#pragma unroll
        for (int i = 0; i < 2; ++i) { const int tile = wave * 2 + i, et = tile >> 2, dt = tile & 3; f32x16 acc;
#pragma unroll
            for (int r = 0; r < 16; ++r) acc[r] = 0.f;
            mma_nt32k<64>(acc, VT + et * 32 * ST64, ST64, KT + dt * 32 * ST64, ST64, lane);
#pragma unroll
            for (int r = 0; r < 16; ++r) { const int e = et * 32 + (r & 3) + 8 * (r >> 2) + 4 * (lane >> 5); ((LAS bf16_t*)(OT + e * ST128))[dt * 32 + (lane & 31)] = (bf16_t)f2bf(acc[r]); } }
        __syncthreads();
        { bf16_t* kvt = (bf16_t*)(F.ws + WS_KVT) + (size_t)unit * HD * HD;
#pragma unroll
          for (int i = 0; i < 4; ++i) { const int p = tid + 512 * i, e = p >> 4, d0 = (p & 15) * 8; *(u32x4*)(kvt + (size_t)e * HD + d0) = *(const LAS u32x4*)(OT + e * ST128 + d0 * 2); } }
        if (!more) break;
        unit = un;
    }
    __syncthreads();
}
struct HgPre { u32x4 q[2]; f32x4 bj[2][2], bp[2][2], bm[2]; u32x4 v[2], sp[4]; };
__device__ __forceinline__ void hgc_load(Frame& F, int unit, HgPre& P) {
    const int tid = F.tid; const int bh = unit >> 7, c = unit & 127, b = bh >> 2, h = bh & 3, tok0 = b * SEQ + c * CH, hcol = h * HD;
    const bf16_t* qg = (const bf16_t*)(F.ws + WS_Q); const float* bc = (const float*)(F.ws + WS_BCUM); const bf16_t* vg = (const bf16_t*)(F.ws + WS_V); const bf16_t* sp = (const bf16_t*)(F.ws + WS_SPREV) + (size_t)unit * HD * HD;
    const int d0 = (tid & 15) * 8;
#pragma unroll
    for (int i = 0; i < 2; ++i) { const int j = (tid >> 4) + 32 * i; const size_t o = (size_t)(tok0 + j) * HW + hcol + d0;
        P.q[i] = *(const u32x4*)(qg + o); P.bj[i][0] = *(const f32x4*)(bc + o); P.bj[i][1] = *(const f32x4*)(bc + o + 4);
        if (j > 0) { P.bp[i][0] = *(const f32x4*)(bc + o - HW); P.bp[i][1] = *(const f32x4*)(bc + o - HW + 4); } else { P.bp[i][0] = (f32x4){0.f, 0.f, 0.f, 0.f}; P.bp[i][1] = (f32x4){0.f, 0.f, 0.f, 0.f}; }
        const int e0 = ((tid >> 6) + 8 * i) * 8; P.v[i] = *(const u32x4*)(vg + (size_t)(tok0 + (tid & 63)) * HW + hcol + e0); }
    { const size_t o = (size_t)(tok0 + 31) * HW + hcol + d0; P.bm[0] = *(const f32x4*)(bc + o); P.bm[1] = *(const f32x4*)(bc + o + 4); }
#pragma unroll
    for (int i = 0; i < 4; ++i) { const int p = tid + 512 * i; P.sp[i] = *(const u32x4*)(sp + (size_t)(p >> 4) * HD + (p & 15) * 8); }
}
__device__ __forceinline__ void hgrn_c_phase(Frame& F) {
    const int tid = F.tid, lane = F.lane, wave = F.wave;
    LAS unsigned char* Q1 = F.lds; LAS unsigned char* K1 = Q1 + 64 * ST128; LAS unsigned char* Q2 = K1 + 64 * ST128; LAS unsigned char* VT = Q2 + 64 * ST128;
    LAS unsigned char* PP = VT + 128 * ST64; LAS unsigned char* SPL = PP + 64 * ST64; LAS float* RS = (LAS float*)(SPL + 128 * ST128); LAS unsigned char* OL = Q1;
    int unit = F.bx; if (unit >= 16 * NCH) return;
    HgPre P; hgc_load(F, unit, P);
    u32x4 gsv[2];
    { const int bh = unit >> 7, c = unit & 127, tok0 = (bh >> 2) * SEQ + c * CH, hcol = (bh & 3) * HD;
#pragma unroll
      for (int i = 0; i < 2; ++i) gsv[i] = *(const u32x4*)((const bf16_t*)(F.ws + WS_GS) + (size_t)(tok0 + (tid >> 4) + 32 * i) * HW + hcol + (tid & 15) * 8); }
    for (;;) {
        const int bh = unit >> 7, c = unit & 127, b = bh >> 2, h = bh & 3, tok0 = b * SEQ + c * CH, hcol = h * HD;
        { const int d0 = (tid & 15) * 8;
#pragma unroll
          for (int i = 0; i < 2; ++i) { const int j = (tid >> 4) + 32 * i; float q1[8], k1[8], q2[8];
              const unsigned qw[4] = {P.q[i].x, P.q[i].y, P.q[i].z, P.q[i].w};
#pragma unroll
              for (int k = 0; k < 8; ++k) { const float bb = P.bj[i][k >> 2][k & 3], bm = P.bm[k >> 2][k & 3], lf = bb - P.bp[i][k >> 2][k & 3]; const float q = bf2f((qw[k >> 1] >> ((k & 1) * 16)) & 0xffffu);
                  const float kx = 1.0f - __expf(lf), ed = __expf(bb - bm); q1[k] = q * ed; k1[k] = kx * __expf(bm - bb); q2[k] = q * __expf(bb); }
              u32x4 w; w.x = cvt_pk_bf16(q1[0], q1[1]); w.y = cvt_pk_bf16(q1[2], q1[3]); w.z = cvt_pk_bf16(q1[4], q1[5]); w.w = cvt_pk_bf16(q1[6], q1[7]); *(LAS u32x4*)(Q1 + j * ST128 + d0 * 2) = w;
              w.x = cvt_pk_bf16(k1[0], k1[1]); w.y = cvt_pk_bf16(k1[2], k1[3]); w.z = cvt_pk_bf16(k1[4], k1[5]); w.w = cvt_pk_bf16(k1[6], k1[7]); *(LAS u32x4*)(K1 + j * ST128 + d0 * 2) = w;
              w.x = cvt_pk_bf16(q2[0], q2[1]); w.y = cvt_pk_bf16(q2[2], q2[3]); w.z = cvt_pk_bf16(q2[4], q2[5]); w.w = cvt_pk_bf16(q2[6], q2[7]); *(LAS u32x4*)(Q2 + j * ST128 + d0 * 2) = w;
              const int e0 = ((tid >> 6) + 8 * i) * 8; LAS bf16_t* o = (LAS bf16_t*)(VT + e0 * ST64 + (tid & 63) * 2); const u32x4 v = P.v[i];
              o[0 * (ST64 / 2)] = (bf16_t)(v.x & 0xffffu); o[1 * (ST64 / 2)] = (bf16_t)(v.x >> 16); o[2 * (ST64 / 2)] = (bf16_t)(v.y & 0xffffu); o[3 * (ST64 / 2)] = (bf16_t)(v.y >> 16);
              o[4 * (ST64 / 2)] = (bf16_t)(v.z & 0xffffu); o[5 * (ST64 / 2)] = (bf16_t)(v.z >> 16); o[6 * (ST64 / 2)] = (bf16_t)(v.w & 0xffffu); o[7 * (ST64 / 2)] = (bf16_t)(v.w >> 16); }
#pragma unroll
          for (int i = 0; i < 4; ++i) { const int p = tid + 512 * i; *(LAS u32x4*)(SPL + (p >> 4) * ST128 + (p & 15) * 16) = P.sp[i]; } }
        const int un = unit + F.G; const bool more = un < 16 * NCH;
        if (more) hgc_load(F, un, P);
        __syncthreads();
        const int it = wave >> 2, et = wave & 3; f32x16 acc;
#pragma unroll
        for (int r = 0; r < 16; ++r) acc[r] = 0.f;
        mma_nt32k<128>(acc, Q2 + it * 32 * ST128, ST128, SPL + et * 32 * ST128, ST128, lane);
        if (wave < 3) { const int si = wave ? 1 : 0, sj = wave == 2 ? 1 : 0; f32x16 sc;
#pragma unroll
            for (int r = 0; r < 16; ++r) sc[r] = 0.f;
            mma_nt32k<128>(sc, Q1 + si * 32 * ST128, ST128, K1 + sj * 32 * ST128, ST128, lane);
#pragma unroll
            for (int r = 0; r < 16; ++r) { const int i = si * 32 + (r & 3) + 8 * (r >> 2) + 4 * (lane >> 5), j = sj * 32 + (lane & 31); ((LAS bf16_t*)(PP + i * ST64))[j] = (bf16_t)f2bf(j <= i ? sc[r] : 0.f); } }
        else if (wave == 3) {
#pragma unroll
            for (int r = 0; r < 16; ++r) { const int i = (r & 3) + 8 * (r >> 2) + 4 * (lane >> 5); ((LAS bf16_t*)(PP + i * ST64))[32 + (lane & 31)] = (bf16_t)0; } }
        __syncthreads();
        mma_nt32k<64>(acc, PP + it * 32 * ST64, ST64, VT + et * 32 * ST64, ST64, lane);
#pragma unroll
        for (int r = 0; r < 16; ++r) { const int i = it * 32 + (r & 3) + 8 * (r >> 2) + 4 * (lane >> 5); ((LAS bf16_t*)(OL + i * ST128))[et * 32 + (lane & 31)] = (bf16_t)f2bf(acc[r]); }
        __syncthreads();
        { const int eo = (tid & 15) * 8; const f32x4 g0 = *(const f32x4*)(F.in[I_HNG] + hcol + eo), g1 = *(const f32x4*)(F.in[I_HNG] + hcol + eo + 4); bf16_t* yo = (bf16_t*)(F.ws + WS_YHG);
#pragma unroll
          for (int i = 0; i < 2; ++i) { const int row = (tid >> 4) + 32 * i; const u32x4 o = *(const LAS u32x4*)(OL + row * ST128 + eo * 2); const u32x4 gq = gsv[i];
              const float x[8] = {bf2f(o.x & 0xffffu), bf2f(o.x >> 16), bf2f(o.y & 0xffffu), bf2f(o.y >> 16), bf2f(o.z & 0xffffu), bf2f(o.z >> 16), bf2f(o.w & 0xffffu), bf2f(o.w >> 16)};
              float ss = ((x[0] * x[0] + x[1] * x[1]) + (x[2] * x[2] + x[3] * x[3])) + ((x[4] * x[4] + x[5] * x[5]) + (x[6] * x[6] + x[7] * x[7]));
              ss += __shfl_xor(ss, 1); ss += __shfl_xor(ss, 2); ss += __shfl_xor(ss, 4); ss += __shfl_xor(ss, 8);
              const float rstd = 1.0f / sqrtf(ss * (1.0f / HD) + EPS);
              f32x4 y0, y1; y0[0] = x[0] * rstd * g0[0] * bf2f(gq.x & 0xffffu); y0[1] = x[1] * rstd * g0[1] * bf2f(gq.x >> 16); y0[2] = x[2] * rstd * g0[2] * bf2f(gq.y & 0xffffu); y0[3] = x[3] * rstd * g0[3] * bf2f(gq.y >> 16);
              y1[0] = x[4] * rstd * g1[0] * bf2f(gq.z & 0xffffu); y1[1] = x[5] * rstd * g1[1] * bf2f(gq.z >> 16); y1[2] = x[6] * rstd * g1[2] * bf2f(gq.w & 0xffffu); y1[3] = x[7] * rstd * g1[3] * bf2f(gq.w >> 16);
              *(u32x4*)(yo + (size_t)(tok0 + row) * HW + hcol + eo) = pack8(y0, y1); } }
        if (!more) break;
        unit = un;
        { const int bh2 = unit >> 7, c2 = unit & 127, tk = (bh2 >> 2) * SEQ + c2 * CH, hc = (bh2 & 3) * HD;
#pragma unroll
          for (int i = 0; i < 2; ++i) gsv[i] = *(const u32x4*)((const bf16_t*)(F.ws + WS_GS) + (size_t)(tk + (tid >> 4) + 32 * i) * HW + hc + (tid & 15) * 8); }
        __syncthreads();
    }
    __syncthreads();
}

__device__ __forceinline__ void stagger(const Frame& F, int units) {
    const unsigned long long t0 = __builtin_amdgcn_s_memrealtime(), dt = (unsigned long long)(((F.bx >> 3) & 3) * units);
    while (__builtin_amdgcn_s_memrealtime() - t0 < dt) __builtin_amdgcn_s_sleep(8);
}
__device__ __forceinline__ void phase0(Frame& F, const int var) {
    unsigned char* ws = F.ws; (void)ws;
    p0_prologue(F, var);
}
__device__ __forceinline__ void phase1(Frame& F, const int var) {
    unsigned char* ws = F.ws; (void)ws;
        p1_toeplitz(F);
        EpiInProj E{(bf16_t*)(ws + WS_UA), (bf16_t*)(ws + WS_Q), (bf16_t*)(ws + WS_V), (bf16_t*)(ws + WS_GS), (bf16_t*)(ws + WS_GATES), (float*)(ws + WS_LOGF), (const float*)(ws + WS_LBV)};
        if (MK_GATES_F8 && !MK_P1_F8) {
            { SchedStatic S{(const char*)(ws + WS_XN), (const char*)(ws + WS_WIN), T / 256, 10, F.G, F.bx, (size_t)256 * D * 2, (size_t)256 * D * 2};
              pg8::gemm_phase<EpiInProj, SchedStatic, false, false>(F.lds, D, D, D, S, E, nullptr); }
            { SchedStatic S{(const char*)(ws + WS_XN8), (const char*)(ws + WS_WIN8), T / 256, 8, F.G, F.bx, (size_t)256 * D, (size_t)256 * D, 0, 10};
              pg8::gemm_phase<EpiInProj, SchedStatic, false, true>(F.lds, D, D, D, S, E, nullptr); }
        } else {
            SchedStatic S{(const char*)(ws + WS_XN), (const char*)(ws + WS_WIN), T / 256, INW / 256, F.G, F.bx, (size_t)256 * D * (MK_P1_F8 ? 1 : 2), (size_t)256 * D * (MK_P1_F8 ? 1 : 2)};
            pg8::gemm_phase<EpiInProj, SchedStatic, false, MK_P1_F8 != 0>(F.lds, D, D, D, S, E, nullptr);
        }
}
__device__ __forceinline__ void phase2(Frame& F, const int var) {
    unsigned char* ws = F.ws; (void)ws;
        { SchedS5E S{(const char*)(ws + WS_UA), (const char*)(ws + WS_WE), F.bx}; EpiS5E E{(float*)(ws + WS_SE)};
          pg8::gemm_phase<EpiS5E, SchedS5E, false>(F.lds, 1024, UAK, 1024, S, E, nullptr); }
        __syncthreads();
        const float* pm = (const float*)(ws + WS_PMR);
        if (F.bx >= 64 && F.bx < 68) {
            const int g = (F.bx - 64) * 8 + (F.tid >> 6), p = F.tid & 63; const f32x2 lb = ((const f32x2*)(ws + WS_LAMB))[g * SP + p]; float xr = 0.f, xi = 0.f;
            for (int s = 0; s < NMETA; ++s) { float ar = 0.f, ai = 0.f;
#pragma unroll
                for (int h = 0; h < 16; ++h) { const int col = g * 16 + h; const float uu = pm[(size_t)s * 1536 + col];
                    const f32x2 bb = ((const f32x2*)(ws + WS_BBAR))[(g * SP + p) * 16 + h]; ar += bb.x * uu; ai += bb.y * uu; }
                const float nr = lb.x * xr - lb.y * xi + ar, ni = lb.x * xi + lb.y * xr + ai; xr = nr; xi = ni; }
            float* xm = (float*)(ws + WS_XMETA); xm[g * 128 + p] = xr; xm[g * 128 + 64 + p] = xi;
        }
        if (F.bx >= 68 && F.bx < 196) {
            const int idx = (F.bx - 68) * 512 + F.tid, h = idx >> 14, e = (idx >> 7) & 127, d = idx & 127; const float lbv = ((const float*)(ws + WS_LBV))[h * HD + d]; float S = 0.f;
            for (int s = 0; s < NMETA; ++s) { const int cf = 512 + h * HD + d, cv = 1024 + h * HD + e;
                const float fp = pm[(size_t)s * 1536 + cf];
                const float vv = pm[(size_t)s * 1536 + cv];
                const float f = lbv + (1.0f - lbv) * sigmoidf_(fp); S = f * S + (1.0f - f) * vv; }
            ((float*)(ws + WS_SMETA))[idx] = S;
        }
        if (F.bx < 64) hgrn_a_phase(F, 4 * F.bx, 1, 4); else hgrn_a_phase(F, 256 + (F.bx - 64), F.G - 64, 1 << 20);
}
__device__ __forceinline__ void phase3(Frame& F, const int var) {
    unsigned char* ws = F.ws; (void)ws;
        {
            const int bh = F.bx >> 4, e = (F.bx & 15) * 8 + (F.tid >> 6), d = (F.tid & 63) * 2, h = bh & 3;
            f32x2 S = *(const f32x2*)((const float*)(ws + WS_SMETA) + (size_t)(h * HD + e) * HD + d);
            const unsigned* kv = (const unsigned*)((const bf16_t*)(ws + WS_KVT) + (size_t)bh * NCH * HD * HD + (size_t)e * HD + d); const float* dc = (const float*)(ws + WS_DEC) + (size_t)bh * NCH * HD + d;
            unsigned* sp = (unsigned*)((bf16_t*)(ws + WS_SPREV) + (size_t)bh * NCH * HD * HD + (size_t)e * HD + d);
            for (int c0 = 0; c0 < NCH; c0 += 8) { f32x2 kvv[8], dv[8];
#pragma unroll
                for (int j = 0; j < 8; ++j) { const unsigned kq = kv[(size_t)(c0 + j) * (HD * HD / 2)]; kvv[j] = (f32x2){bf2f(kq & 0xffffu), bf2f(kq >> 16)}; dv[j] = *(const f32x2*)(dc + (size_t)(c0 + j) * HD); }
#pragma unroll
                for (int j = 0; j < 8; ++j) { sp[(size_t)(c0 + j) * (HD * HD / 2)] = pk2(S.x, S.y); S.x = S.x * dv[j].x + kvv[j].x; S.y = S.y * dv[j].y + kvv[j].y; } }
        }
        if (F.bx < 16) {
            const int b = F.bx >> 2, g = (F.bx & 3) * 8 + (F.tid >> 6), p = F.tid & 63; const f32x2 lc = ((const f32x2*)(ws + WS_LAMC))[g * SP + p];
            const float* xm = (const float*)(ws + WS_XMETA); float xr = xm[g * 128 + p], xi = xm[g * 128 + 64 + p];
            const float* se = (const float*)(ws + WS_SE) + ((size_t)g * 512 + b * 128) * 128 + p; bf16_t* ua = (bf16_t*)(ws + WS_UA) + ((size_t)g * 512 + b * 128) * UAK + 1024 + p;
            for (int c0 = 0; c0 < NCH; c0 += 8) { float er[8], ei[8];
#pragma unroll
                for (int j = 0; j < 8; ++j) { er[j] = se[(size_t)(c0 + j) * 128]; ei[j] = se[(size_t)(c0 + j) * 128 + 64]; }
#pragma unroll
                for (int j = 0; j < 8; ++j) { bf16_t* o = ua + (size_t)(c0 + j) * UAK; o[0] = (bf16_t)f2bf(xr); o[64] = (bf16_t)f2bf(xi);
                    const float nr = lc.x * xr - lc.y * xi + er[j], ni = lc.x * xi + lc.y * xr + ei[j]; xr = nr; xi = ni; } }
        }
}
__device__ __forceinline__ void phase4(Frame& F, const int var) {
    unsigned char* ws = F.ws; (void)ws;
        if (!(var & 64)) { SchedS5Y S{(const char*)(ws + WS_UA), (const char*)(ws + WS_TZ), F.bx, F.G}; EpiS5Y E{(const bf16_t*)(ws + WS_UA), F.in[I_SD], (bf16_t*)(ws + WS_Y1)};
          pg8::gemm_phase<EpiS5Y, SchedS5Y, false>(F.lds, UAK, UAK, UAK, S, E, nullptr); }
        __syncthreads();
        if (!(var & 128)) hgrn_c_phase(F);
}
__device__ __forceinline__ void phase5(Frame& F, const int var) {
    unsigned char* ws = F.ws; (void)ws;
        SchedStatic S{(const char*)(ws + WS_Y1), (const char*)(ws + WS_WGLU), T / 256, HW / 256, F.G, F.bx, (size_t)256 * HW * 2, (size_t)256 * HW * 2};
        EpiGlu E{(const bf16_t*)(ws + WS_Y1), (bf16_t*)(ws + WS_YS5)};
        pg8::gemm_phase<EpiGlu, SchedStatic, false>(F.lds, HW, HW, HW, S, E, nullptr);
}
__device__ __forceinline__ void phase6(Frame& F, const int var) {
    unsigned char* ws = F.ws; (void)ws;
        SchedBranch S{(const char*)(ws + WS_YS5), (const char*)(ws + WS_YHG), (const char*)(ws + WS_WBS), (const char*)(ws + WS_WBH), F.G, F.bx};
        EpiBranch E{(const bf16_t*)(ws + WS_GATES), (bf16_t*)(ws + WS_MERGED)};
        pg8::gemm_phase<EpiBranch, SchedBranch, false>(F.lds, HW, HW, HW, S, E, nullptr);
}
__device__ __forceinline__ void phase7(Frame& F, const int var) {
    unsigned char* ws = F.ws; (void)ws;
        SchedStatic S{(const char*)(ws + WS_MERGED), (const char*)(ws + WS_WOUT), T / 256, D / 256, F.G, F.bx, (size_t)256 * D * 2, (size_t)256 * D * 2, var};
        EpiOut E{F.in[I_X], (bf16_t*)(ws + WS_H1), (float*)(ws + WS_SSQ), var};
        pg8::gemm_phase<EpiOut, SchedStatic, false>(F.lds, D, D, D, S, E, nullptr, var);
}
__device__ __forceinline__ void phase8(Frame& F, const int var) {
    unsigned char* ws = F.ws; (void)ws;
        volatile LAS unsigned* hist = F.MISC + 16;
        if (F.tid < 32) hist[F.tid] = 0u;
        __syncthreads();
        const int lane = F.lane, tl = lane & 15, kg = lane >> 4; const float* g2 = F.in[I_N2G];
        { const u32x4* src = (const u32x4*)(ws + WS_WRT); LAS u32x4* dst = (LAS u32x4*)F.lds;
          for (int i = F.tid; i < 2 * NE * D / 8; i += 512) { const int row = i >> 7, ch = i & 127; *(LAS u32x4*)((LAS unsigned char*)dst + row * 2064 + ch * 16) = src[i]; } }
        __syncthreads();
        const LAS unsigned char* wh = F.lds; const LAS unsigned char* wl = F.lds + NE * 2064;
        for (int tile = F.vcu * 8 + F.wave; tile < T / 16; tile += F.G * 8) {
            const int tok = tile * 16 + tl; const bf16_t* hrow = (const bf16_t*)(ws + WS_H1) + (size_t)tok * D; const f32x4* sq = (const f32x4*)((const float*)(ws + WS_SSQ) + (size_t)tok * 16);
            const f32x4 s0 = sq[0], s1 = sq[1], s2 = sq[2], s3 = sq[3];
            const float ss = ((s0[0] + s0[1]) + (s0[2] + s0[3])) + ((s1[0] + s1[1]) + (s1[2] + s1[3])) + ((s2[0] + s2[1]) + (s2[2] + s2[3])) + ((s3[0] + s3[1]) + (s3[2] + s3[3]));
            const float rstd = 1.0f / sqrtf(ss * (1.0f / D) + EPS);
            f32x4 a0 = (f32x4){0.f, 0.f, 0.f, 0.f}, a1 = a0; unsigned char* xo = (unsigned char*)(ws + WS_XN2) + (size_t)tok * D;
#pragma unroll 1
            for (int kb = 0; kb < 32; kb += 8) { u32x4 hv[8];
#pragma unroll
                for (int u8 = 0; u8 < 8; ++u8) hv[u8] = *(const u32x4*)(hrow + (kb + u8) * 32 + kg * 8);
#pragma unroll
                for (int u8 = 0; u8 < 8; ++u8) { const int k = (kb + u8) * 32 + kg * 8; const f32x4 ga = *(const f32x4*)(g2 + k), gb = *(const f32x4*)(g2 + k + 4); const u32x4 hq = hv[u8];
                    float x[8] = {bf2f(hq.x & 0xffffu) * rstd * ga[0], bf2f(hq.x >> 16) * rstd * ga[1], bf2f(hq.y & 0xffffu) * rstd * ga[2], bf2f(hq.y >> 16) * rstd * ga[3], bf2f(hq.z & 0xffffu) * rstd * gb[0], bf2f(hq.z >> 16) * rstd * gb[1], bf2f(hq.w & 0xffffu) * rstd * gb[2], bf2f(hq.w >> 16) * rstd * gb[3]};
                    unsigned hb[8]; float lr[8];
#pragma unroll
                    for (int j = 0; j < 8; ++j) { hb[j] = f2bf(x[j]); lr[j] = x[j] - bf2f(hb[j]); }
                    u32x4 hi4; hi4.x = hb[0] | (hb[1] << 16); hi4.y = hb[2] | (hb[3] << 16); hi4.z = hb[4] | (hb[5] << 16); hi4.w = hb[6] | (hb[7] << 16);
                    u32x4 lo4; lo4.x = pk2(lr[0], lr[1]); lo4.y = pk2(lr[2], lr[3]); lo4.z = pk2(lr[4], lr[5]); lo4.w = pk2(lr[6], lr[7]);
                    { u32x2 q8; q8.x = pk4_fp8(x[0], x[1], x[2], x[3]); q8.y = pk4_fp8(x[4], x[5], x[6], x[7]); *(u32x2*)(xo + k) = q8; }
                    const bf16x8 xh = __builtin_bit_cast(bf16x8, hi4), xl = __builtin_bit_cast(bf16x8, lo4);
                    const bf16x8 wh0 = *(const LAS bf16x8*)(wh + tl * 2064 + k * 2), wh1 = *(const LAS bf16x8*)(wh + (16 + tl) * 2064 + k * 2), wl0 = *(const LAS bf16x8*)(wl + tl * 2064 + k * 2), wl1 = *(const LAS bf16x8*)(wl + (16 + tl) * 2064 + k * 2);
                    a0 = __builtin_amdgcn_mfma_f32_16x16x32_bf16(wh0, xh, a0, 0, 0, 0); a0 = __builtin_amdgcn_mfma_f32_16x16x32_bf16(wh0, xl, a0, 0, 0, 0); a0 = __builtin_amdgcn_mfma_f32_16x16x32_bf16(wl0, xh, a0, 0, 0, 0);
                    a1 = __builtin_amdgcn_mfma_f32_16x16x32_bf16(wh1, xh, a1, 0, 0, 0); a1 = __builtin_amdgcn_mfma_f32_16x16x32_bf16(wh1, xl, a1, 0, 0, 0); a1 = __builtin_amdgcn_mfma_f32_16x16x32_bf16(wl1, xh, a1, 0, 0, 0); } }
            float lg[8]; int le[8]; const float* br = F.in[I_BR];
#pragma unroll
            for (int j = 0; j < 4; ++j) { le[j] = 4 * kg + j; le[4 + j] = 16 + 4 * kg + j; lg[j] = a0[j] + br[le[j]]; lg[4 + j] = a1[j] + br[le[4 + j]]; }
            float tv[4]; int te[4];
#pragma unroll
            for (int r = 0; r < 4; ++r) { float bv = -3.0e38f; int be = 1 << 20;
#pragma unroll
                for (int j = 0; j < 8; ++j) if (lg[j] > bv || (lg[j] == bv && le[j] < be)) { bv = lg[j]; be = le[j]; }
#pragma unroll
                for (int o = 16; o <= 32; o <<= 1) { const float ov = __shfl_xor(bv, o); const int oe = __shfl_xor(be, o); if (ov > bv || (ov == bv && oe < be)) { bv = ov; be = oe; } }
                tv[r] = bv; te[r] = be;
#pragma unroll
                for (int j = 0; j < 8; ++j) if (le[j] == be) lg[j] = -3.0e38f; }
            if (kg == 0) { const float e1 = __expf(tv[1] - tv[0]), e2 = __expf(tv[2] - tv[0]), e3 = __expf(tv[3] - tv[0]); const float inv = 1.0f / (1.0f + e1 + e2 + e3);
                *(f32x4*)((float*)(ws + WS_TOPW) + (size_t)tok * 4) = (f32x4){inv, e1 * inv, e2 * inv, e3 * inv};
                int* tp = (int*)(ws + WS_TOPE) + (size_t)tok * 4; tp[0] = te[0]; tp[1] = te[1]; tp[2] = te[2]; tp[3] = te[3];
#pragma unroll
                for (int r = 0; r < 4; ++r) __hip_atomic_fetch_add((LAS unsigned*)(hist + te[r]), 1u, __ATOMIC_RELAXED, __HIP_MEMORY_SCOPE_WORKGROUP); }
        }
        __syncthreads();
        if (F.tid < 32) __hip_atomic_fetch_add(F.ctl + CW_CNT + F.tid, hist[F.tid], __ATOMIC_RELAXED, __HIP_MEMORY_SCOPE_AGENT);
}
__device__ __forceinline__ void phase9(Frame& F, const int var) {
    unsigned char* ws = F.ws; (void)ws;
        volatile LAS unsigned* sb = F.MISC + 16;
        LAS unsigned* base = (LAS unsigned*)F.lds; LAS unsigned* lcnt = base + 64; LAS unsigned* gb = base + 128; (void)sb;
        if (F.tid < 32) { lcnt[F.tid] = 0u; }
        if (F.tid == 0) { unsigned run = 0; for (int e = 0; e < NE; ++e) { const unsigned c = __hip_atomic_load(F.ctl + CW_CNT + e, __ATOMIC_RELAXED, __HIP_MEMORY_SCOPE_AGENT); base[e] = run * 256u; base[32 + e] = c; run += (c + 255u) >> 8; }
            base[96] = run; if (F.bx == 0) F.ctl[CW_NTILES] = run; }
        __syncthreads();
        if (F.bx == 0) { for (int e = 0; e < NE; ++e) { const unsigned t0 = base[e] >> 8, nt_ = (base[32 + e] + 255u) >> 8; for (unsigned t = F.tid; t < nt_; t += 512) ((int*)(ws + WS_TILEE))[t0 + t] = e; } }
        if (F.bx < NE) { const int e = F.bx; const unsigned c = base[32 + e], pe = ((c + 255u) >> 8) << 8; for (unsigned r = c + F.tid; r < pe; r += 512) { ((int*)(ws + WS_ROWTOK))[base[e] + r] = 0; ((int*)(ws + WS_ROWSLOT))[base[e] + r] = -1; } }
        for (int vb = F.bx; vb < T / 128; vb += F.G) {
            const int tok = vb * 128 + (F.tid >> 2), k = F.tid & 3; const int e = ((const int*)(ws + WS_TOPE))[(size_t)tok * 4 + k];
            const unsigned lr = __hip_atomic_fetch_add(lcnt + e, 1u, __ATOMIC_RELAXED, __HIP_MEMORY_SCOPE_WORKGROUP);
            __syncthreads();
            if (F.tid < 32) { gb[F.tid] = __hip_atomic_fetch_add(F.ctl + CW_FILL + F.tid, lcnt[F.tid], __ATOMIC_RELAXED, __HIP_MEMORY_SCOPE_AGENT); lcnt[F.tid] = 0u; }
            __syncthreads();
            const unsigned prow = base[e] + gb[e] + lr; ((int*)(ws + WS_ROWTOK))[prow] = tok; ((int*)(ws + WS_ROWSLOT))[prow] = tok * 4 + k;
            __syncthreads();
        }
}
__device__ __forceinline__ void phase10(Frame& F, const int var) {
    unsigned char* ws = F.ws; (void)ws;
        const int ntiles = (int)__hip_atomic_load(F.ctl + CW_NTILES, __ATOMIC_RELAXED, __HIP_MEMORY_SCOPE_AGENT);
        SchedMoe S{(const char*)(ws + WS_XN2), (const char*)(ws + WS_WGU), (const int*)(ws + WS_TILEE), ntiles, 8, F.G, F.bx, (size_t)2048 * D, (size_t)256 * D, true, var};
        EpiMoe1 E{F.in[I_BGU], (const int*)(ws + WS_TILEE), (unsigned char*)(ws + WS_A2), var};
        if (MK_STAGGER) stagger(F, MK_STAGGER * 10);
        pg8::gemm_phase<EpiMoe1, SchedMoe, true, true>(F.lds, D, D, D, S, E, (const int*)(ws + WS_ROWTOK));
}
__device__ __forceinline__ void phase11(Frame& F, const int var) {
    unsigned char* ws = F.ws; (void)ws;
        const int ntiles = (int)__hip_atomic_load(F.ctl + CW_NTILES, __ATOMIC_RELAXED, __HIP_MEMORY_SCOPE_AGENT);
        SchedMoe S{(const char*)(ws + WS_A2), (const char*)(ws + WS_WD), (const int*)(ws + WS_TILEE), ntiles, 4, F.G, F.bx, (size_t)D * DF, (size_t)256 * DF, false, var};
        EpiMoe2 E{F.in[I_BD], (const int*)(ws + WS_TILEE), (const int*)(ws + WS_ROWSLOT), (unsigned char*)(ws + WS_YS), var};
        pg8::gemm_phase<EpiMoe2, SchedMoe, false, true>(F.lds, DF, DF, DF, S, E, nullptr, var);
}
__device__ __forceinline__ void phase12(Frame& F, const int var) {
    unsigned char* ws = F.ws; (void)ws;
        const int lane = F.lane; const float* fg = F.in[I_FNG];
        float pe = 0.f; if (MK_STAMP >= 0) { const float dt = __builtin_bit_cast(float, __hip_atomic_load(F.ctl + 200, __ATOMIC_RELAXED, __HIP_MEMORY_SCOPE_AGENT)); pe = sqrtf(dt * MK_STAMP_SCALE); if (lane & 1) pe = -pe; }
        const int NW = F.G * 8; int tok = F.vcu * 8 + F.wave;
        u32x2 hq[4]; unsigned yq[4][4]; f32x4 wq;
#define P12_LOAD(t_) do { wq = *(const f32x4*)((const float*)(ws + WS_TOPW) + (size_t)(t_) * 4); _Pragma("unroll") for (int j = 0; j < 4; ++j) { hq[j] = *((const u32x2*)((const bf16_t*)(ws + WS_H1) + (size_t)(t_) * D) + lane + 64 * j); \
            _Pragma("unroll") for (int k = 0; k < 4; ++k) yq[j][k] = *((const unsigned*)((const unsigned char*)(ws + WS_YS) + ((size_t)(t_) * 4 + k) * D) + lane + 64 * j); } } while (0)
        if (tok < T) P12_LOAD(tok);
        for (; tok < T; tok += NW) {
            const float wk[4] = {wq[0], wq[1], wq[2], wq[3]}; f32x4 v[4]; float s = 0.f;
#pragma unroll
            for (int j = 0; j < 4; ++j) { v[j] = (f32x4){bf2f(hq[j].x & 0xffffu), bf2f(hq[j].x >> 16), bf2f(hq[j].y & 0xffffu), bf2f(hq[j].y >> 16)};
#pragma unroll
                for (int k = 0; k < 4; ++k) { const unsigned y = yq[j][k]; const f32x2 lo = __builtin_amdgcn_cvt_pk_f32_fp8((int)y, false), hi = __builtin_amdgcn_cvt_pk_f32_fp8((int)y, true);
                    v[j].x += wk[k] * lo.x; v[j].y += wk[k] * lo.y; v[j].z += wk[k] * hi.x; v[j].w += wk[k] * hi.y; }
                s += (v[j].x * v[j].x + v[j].y * v[j].y) + (v[j].z * v[j].z + v[j].w * v[j].w); }
            if (tok + NW < T) P12_LOAD(tok + NW);
            const float rstd = 1.0f / sqrtf(wave_sum(s) * (1.0f / D) + EPS);
            f32x4* o = (f32x4*)(F.out + (size_t)tok * D) + lane;
#pragma unroll
            for (int j = 0; j < 4; ++j) { const f32x4 gg = ((const f32x4*)fg)[lane + 64 * j]; o[64 * j] = (f32x4){v[j].x * rstd * gg.x * (1.f + pe), v[j].y * rstd * gg.y * (1.f - pe), v[j].z * rstd * gg.z * (1.f + pe), v[j].w * rstd * gg.w * (1.f - pe)}; }
        }
#undef P12_LOAD
}
struct Args { const float* in[26]; float* out; unsigned char* ws; int ph_lo, ph_hi; };
constexpr int NPHASE = 13;

__global__ void __launch_bounds__(512, 2) mk_fwd(Args args) {
    extern __shared__ __attribute__((aligned(16))) unsigned char lds[];
    Frame F;
    F.lds = (LAS unsigned char*)lds; F.MISC = (volatile LAS unsigned*)(F.lds + MISC_OFF);
    F.tid = threadIdx.x; F.lane = F.tid & 63; F.wave = __builtin_amdgcn_readfirstlane(F.tid >> 6);
    F.G = gridDim.x; F.bx = blockIdx.x; F.vcu = (F.G % 8 == 0) ? (F.bx % 8) * (F.G / 8) + F.bx / 8 : F.bx;
    F.ws = args.ws; F.ctl = (unsigned*)(args.ws + WS_CTL); F.out = args.out;
#pragma unroll
    for (int i = 0; i < 26; ++i) F.in[i] = args.in[i];
    for (int u = F.tid; u < 64; u += 512) F.MISC[u] = 0u;
    __syncthreads();
    unsigned char* ws = F.ws;
    XcdBarrier bar; bar.bar = F.ctl + CW_BAR; bar.x = 0; bar.st = nullptr;
    if (!MK_PER_PHASE) bar = xcd_barrier_post(F.ctl + CW_BAR, F.MISC + 8);
    const int lo = args.ph_lo, hi = args.ph_hi;
    unsigned long long ts_a = 0ull, ts_b = 0ull; (void)ts_a; (void)ts_b;
#define STAMP(k) do { if (MK_STAMP >= 0 && F.bx == 0 && F.tid == 0) { if ((k) == MK_STAMP) ts_a = __builtin_amdgcn_s_memrealtime(); if ((k) == MK_STAMP + 1) { ts_b = __builtin_amdgcn_s_memrealtime(); \
        __hip_atomic_store(F.ctl + 200, __builtin_bit_cast(unsigned, (float)(ts_b - ts_a) * 0.01f), __ATOMIC_RELAXED, __HIP_MEMORY_SCOPE_AGENT); } } } while (0)
#define IN(k) (lo <= (k) && (k) < hi)
#define SEAM(k) do { if (IN(k) && IN((k) + 1)) xcd_barrier(bar); } while (0)

    STAMP(0);
    if (IN(0)) { phase0(F, 0); if ((MK_REP_MASK >> 0) & 1) { xcd_barrier(bar); phase0(F, MK_VARIANT); } }
    SEAM(0);
    STAMP(1);
    if (IN(1)) { phase1(F, 0); if ((MK_REP_MASK >> 1) & 1) { xcd_barrier(bar); phase1(F, MK_VARIANT); } }
    SEAM(1);
    STAMP(2);
    if (IN(2)) { phase2(F, 0); if ((MK_REP_MASK >> 2) & 1) { xcd_barrier(bar); phase2(F, MK_VARIANT); } }
    SEAM(2);
    STAMP(3);
    if (IN(3)) { phase3(F, 0); if ((MK_REP_MASK >> 3) & 1) { xcd_barrier(bar); phase3(F, MK_VARIANT); } }
    SEAM(3);
    STAMP(4);
    if (IN(4)) { phase4(F, 0); if ((MK_REP_MASK >> 4) & 1) { xcd_barrier(bar); phase4(F, MK_VARIANT); } }
    SEAM(4);
    STAMP(5);
    if (IN(5)) { phase5(F, 0); if ((MK_REP_MASK >> 5) & 1) { xcd_barrier(bar); phase5(F, MK_VARIANT); } }
    SEAM(5);
    STAMP(6);
    if (IN(6)) { phase6(F, 0); if ((MK_REP_MASK >> 6) & 1) { xcd_barrier(bar); phase6(F, MK_VARIANT); } }
    SEAM(6);
    STAMP(7);
    if (IN(7)) { phase7(F, 0); if ((MK_REP_MASK >> 7) & 1) { xcd_barrier(bar); phase7(F, MK_VARIANT); } }
    SEAM(7);
    STAMP(8);
    if (IN(8)) { phase8(F, 0); if ((MK_REP_MASK >> 8) & 1) { xcd_barrier(bar); phase8(F, MK_VARIANT); } }
    SEAM(8);
    STAMP(9);
    if (IN(9)) { phase9(F, 0); if ((MK_REP_MASK >> 9) & 1) { xcd_barrier(bar); phase9(F, MK_VARIANT); } }
    SEAM(9);
    STAMP(10);
    if (IN(10)) { phase10(F, 0); if ((MK_REP_MASK >> 10) & 1) { xcd_barrier(bar); phase10(F, MK_VARIANT); } }
    SEAM(10);
    STAMP(11);
    if (IN(11)) { phase11(F, 0); if ((MK_REP_MASK >> 11) & 1) { xcd_barrier(bar); phase11(F, MK_VARIANT); } }
    SEAM(11);
    STAMP(12);
    if (IN(12)) { phase12(F, 0); if ((MK_REP_MASK >> 12) & 1) { xcd_barrier(bar); phase12(F, MK_VARIANT); } }
#undef IN
#undef SEAM
}

extern "C" void kernel_launch(void* const* d_in, const int* in_sizes, int n_in, void* d_out, int out_size, void* d_ws, size_t ws_size, hipStream_t stream) {
    static int grid = 0;
    if (grid == 0) {
        if (n_in != 26 || in_sizes[0] != T * D || out_size != T * D || ws_size < WS_END) { fprintf(stderr, "kernel_launch: unexpected shapes (n_in %d, in0 %d, out %d, ws %zu < %zu)\n", n_in, n_in > 0 ? in_sizes[0] : -1, out_size, ws_size, (size_t)WS_END); grid = -1; return; }
        int dev = 0, cus = 0, per_cu = 0;
        if (hipGetDevice(&dev) != hipSuccess || hipDeviceGetAttribute(&cus, hipDeviceAttributeMultiprocessorCount, dev) != hipSuccess) { grid = -1; return; }
        if (hipFuncSetAttribute((const void*)mk_fwd, hipFuncAttributeMaxDynamicSharedMemorySize, LDS_BYTES) != hipSuccess) { fprintf(stderr, "kernel_launch: hipFuncSetAttribute failed\n"); grid = -1; return; }
        if (hipOccupancyMaxActiveBlocksPerMultiprocessor(&per_cu, (const void*)mk_fwd, 512, LDS_BYTES) != hipSuccess || per_cu < 1) fprintf(stderr, "kernel_launch: occupancy query reports %d\n", per_cu);
        (void)hipGetLastError();
        grid = cus;
        if (grid != 256) fprintf(stderr, "kernel_launch: %d CUs (built for 256)\n", grid);
    }
    if (grid < 0) return;
    (void)hipMemsetAsync((char*)d_ws + WS_CTL, 0, 1 * MiB, stream);
    Args a{};
    for (int i = 0; i < 26; ++i) a.in[i] = (const float*)d_in[i];
    a.out = (float*)d_out; a.ws = (unsigned char*)d_ws;
#if MK_PER_PHASE
    for (int p = 0; p < NPHASE; ++p) { a.ph_lo = p; a.ph_hi = p + 1; hipLaunchKernelGGL(mk_fwd, dim3(grid), dim3(512), LDS_BYTES, stream, a); }
#else
    a.ph_lo = 0; a.ph_hi = NPHASE; hipLaunchKernelGGL(mk_fwd, dim3(grid), dim3(512), LDS_BYTES, stream, a);
#endif
}
```

```cpp
#include <hip/hip_runtime.h>
#include <cstdio>
#include <cstdint>

#ifndef MK_PER_PHASE
#define MK_PER_PHASE 0
#endif

#ifndef MK_REP_MASK
#define MK_REP_MASK 0
#endif

#ifndef MK_P1_F8
#define MK_P1_F8 0
#endif
#ifndef MK_GATES_F8
#define MK_GATES_F8 1
#endif
#ifndef MK_GSTORE_F8
#define MK_GSTORE_F8 1
#endif
#ifndef MK_STAGGER
#define MK_STAGGER 0
#endif
#ifndef MK_STAMP
#define MK_STAMP -1
#endif
#define MK_STAMP_SCALE 1e-5f
#ifndef MK_VARIANT
#define MK_VARIANT 0
#endif

#define LAS __attribute__((address_space(3)))
#define GAS __attribute__((address_space(1)))
typedef unsigned short bf16_t;
typedef short bf16x8 __attribute__((ext_vector_type(8)));
typedef float f32x4 __attribute__((ext_vector_type(4)));
typedef float f32x2 __attribute__((ext_vector_type(2)));
typedef float f32x16 __attribute__((ext_vector_type(16)));
typedef unsigned u32x4 __attribute__((ext_vector_type(4)));
typedef unsigned u32x2 __attribute__((ext_vector_type(2)));
typedef int i32x4 __attribute__((ext_vector_type(4)));
typedef int i32x8 __attribute__((ext_vector_type(8)));

constexpr int T = 32768, D = 1024, NB = 4, SEQ = 8192, NCH = 128, CH = 64, NMETA = 16, INW = 4608;
constexpr int SG = 32, SH = 16, SP = 64;
constexpr int HH = 4, HD = 128, HW = 512;
constexpr int NE = 32, TOPK = 4, DF = 1024;
constexpr int UAK = 1152;
constexpr float EPS = 1e-6f;
constexpr int MAXTILES = 544;

constexpr size_t MiB = 1u << 20, KiB = 1024;
constexpr size_t WS_CTL = 0;
constexpr size_t WS_LBV = 1 * MiB, WS_LAMB = 1 * MiB + 4 * KiB, WS_LAMC = 1 * MiB + 20 * KiB, WS_XMETA = 1 * MiB + 36 * KiB;
constexpr size_t WS_BBAR = 1 * MiB + 64 * KiB, WS_WRT = 1 * MiB + 320 * KiB, WS_PMR = 1 * MiB + 512 * KiB  ;
constexpr size_t WS_KCONV = 2 * MiB, WS_SMETA = 3 * MiB;
constexpr size_t WS_WIN = 4 * MiB, WS_WGLU = 13 * MiB, WS_WBS = 14 * MiB, WS_WBH = 15 * MiB, WS_WOUT = 16 * MiB, WS_WGU = 18 * MiB, WS_WD = 146 * MiB;
constexpr size_t WS_TZ = 210 * MiB, WS_WE = 282 * MiB, WS_XN = 298 * MiB, WS_UA = 362 * MiB, WS_Q = 398 * MiB, WS_LOGF = 430 * MiB, WS_V = 494 * MiB;
constexpr size_t WS_GS = 526 * MiB, WS_GATES = 558 * MiB, WS_KVT = 686 * MiB, WS_SPREV = 814 * MiB, WS_SE = 878 * MiB, WS_DEC = 886 * MiB;
constexpr size_t WS_Y1 = 888 * MiB, WS_YHG = 920 * MiB, WS_YS5 = 952 * MiB, WS_PMETA = 984 * MiB  , WS_XN8 = 986 * MiB  , WS_END = 1018 * MiB;
constexpr size_t WS_WIN8 = WS_WIN + 5 * MiB;
constexpr size_t WS_BCUM = 298 * MiB;
constexpr size_t WS_MERGED = 686 * MiB, WS_XN2 = 210 * MiB, WS_H1 = 274 * MiB, WS_SSQ = 402 * MiB, WS_TOPE = 404 * MiB, WS_TOPW = 404 * MiB + 512 * KiB;
constexpr size_t WS_ROWTOK = 405 * MiB, WS_ROWSLOT = 406 * MiB, WS_TILEE = 407 * MiB, WS_A2 = 408 * MiB, WS_YS = 680 * MiB;
constexpr int CW_CNT = 64, CW_FILL = 128, CW_NTILES = 192, CW_BAR = 4096;

constexpr int RING_BYTES = 131072, GOFF_LDS = RING_BYTES, MISC_OFF = RING_BYTES + 16384 + 256, LDS_BYTES = 155648;


__device__ __forceinline__ float bf2f(unsigned b) { return __builtin_bit_cast(float, b << 16); }

typedef __bf16 bf16x2_t __attribute__((ext_vector_type(2)));
__device__ __forceinline__ unsigned cvt_pk_bf16(float lo, float hi) { const bf16x2_t v = __builtin_convertvector((f32x2){lo, hi}, bf16x2_t); return __builtin_bit_cast(unsigned, v); }
__device__ __forceinline__ unsigned f2bf(float f) { const __bf16 h = (__bf16)f; return (unsigned)__builtin_bit_cast(unsigned short, h); }
__device__ __forceinline__ unsigned pk2(float lo, float hi) { return cvt_pk_bf16(lo, hi); }
__device__ __forceinline__ unsigned pk4_fp8(float a, float b, float c, float d) {
    a = __builtin_amdgcn_fmed3f(a, -448.f, 448.f); b = __builtin_amdgcn_fmed3f(b, -448.f, 448.f); c = __builtin_amdgcn_fmed3f(c, -448.f, 448.f); d = __builtin_amdgcn_fmed3f(d, -448.f, 448.f);
    int w = 0; w = __builtin_amdgcn_cvt_pk_fp8_f32(a, b, w, false); w = __builtin_amdgcn_cvt_pk_fp8_f32(c, d, w, true); return (unsigned)w; }
__device__ __forceinline__ unsigned pk4_fp8_nc(float a, float b, float c, float d) { int w = 0; w = __builtin_amdgcn_cvt_pk_fp8_f32(a, b, w, false); w = __builtin_amdgcn_cvt_pk_fp8_f32(c, d, w, true); return (unsigned)w; }
__device__ __forceinline__ unsigned pk4_u8(float a, float b, float c, float d) {
    return (unsigned)(a * 255.f + 0.5f) | ((unsigned)(b * 255.f + 0.5f) << 8) | ((unsigned)(c * 255.f + 0.5f) << 16) | ((unsigned)(d * 255.f + 0.5f) << 24); }
__device__ __forceinline__ float sigmoidf_(float x) { return __builtin_amdgcn_rcpf(1.0f + __builtin_amdgcn_exp2f(x * -1.4426950408889634f)); }
__device__ __forceinline__ float wave_sum(float v) {
#pragma unroll
    for (int o = 1; o < 64; o <<= 1) v += __shfl_xor(v, o);
    return v;
}
#define LDS_WAIT() asm volatile("s_waitcnt lgkmcnt(0)" ::: "memory")
#define VM_WAIT() asm volatile("s_waitcnt vmcnt(0)" ::: "memory")

#define XB_TMO      128
#define XB_XCNT(j)  (256  + 64 * (j))
#define XB_XSUB(j)  (1280 + 64 * (j))
#define XB_XGEN(j)  (2304 + 64 * (j))
#define XB_TOP      3328
#define XB_TOPGEN   3392
#define XCD_BAR_WORDS 3456
#define XB_SPIN_CAP (1u << 22)
__device__ __forceinline__ unsigned xb_ld(unsigned* p)              { return __hip_atomic_load(p, __ATOMIC_RELAXED, __HIP_MEMORY_SCOPE_AGENT); }
__device__ __forceinline__ unsigned xb_add(unsigned* p, unsigned v) { return __hip_atomic_fetch_add(p, v, __ATOMIC_RELAXED, __HIP_MEMORY_SCOPE_AGENT); }
__device__ __forceinline__ unsigned xb_xcc_id() { return (unsigned)__builtin_amdgcn_s_getreg((3 << 11) | 20) & 0xFu; }
#define XB_SPIN(cond, bar) do { unsigned _sp = 0; while (cond) { __builtin_amdgcn_s_sleep(1); \
    if ((++_sp & 255u) == 0u) { if (xb_ld(&(bar)[XB_TMO])) break; if (_sp > XB_SPIN_CAP) { atomicAdd(&(bar)[XB_TMO], 1u); break; } } } } while (0)
struct XcdBarrier { unsigned* bar; unsigned x; volatile LAS unsigned* st; };
__device__ __forceinline__ XcdBarrier xcd_barrier_post(unsigned* bar, volatile LAS unsigned* st) {
    XcdBarrier b; b.bar = bar; b.x = xb_xcc_id(); b.st = st;
    if (threadIdx.x == 0) (void)xb_add(&bar[XB_XCNT(b.x)], 1u);
    return b;
}
__device__ __forceinline__ void xcd_barrier_complete(unsigned* bar, unsigned x, unsigned& nloc, unsigned& nx) {
    const unsigned G = gridDim.x * gridDim.y * gridDim.z;
    unsigned sum, cnt, mine, sp = 0u;
    for (;;) {
        sum = 0u; cnt = 0u; mine = 0u;
#pragma unroll
        for (unsigned j = 0; j < 16; ++j) { const unsigned c = xb_ld(&bar[XB_XCNT(j)]); sum += c; cnt += (c > 0u) ? 1u : 0u; mine = (j == x) ? c : mine; }
        if (sum == G) break;
        __builtin_amdgcn_s_sleep(1);
        if ((++sp & 255u) == 0u) { if (xb_ld(&bar[XB_TMO])) break; if (sp > XB_SPIN_CAP) { atomicAdd(&bar[XB_TMO], 1u); break; } }
    }
    nloc = mine > 0u ? mine : 1u; nx = cnt > 0u ? cnt : 1u;
}
__device__ __forceinline__ void xcd_barrier(const XcdBarrier& b) {
    asm volatile("s_waitcnt vmcnt(0)" ::: "memory");
    __syncthreads();
    if (threadIdx.x == 0) {
        unsigned* bar = b.bar;
        __builtin_amdgcn_s_waitcnt(0);
        unsigned nloc = b.st[0], nx = b.st[1];
        if (nloc == 0u) { xcd_barrier_complete(bar, b.x, nloc, nx); b.st[0] = nloc; b.st[1] = nx; }
        const unsigned old = xb_add(&bar[XB_XSUB(b.x)], 1u);
        const unsigned gen = old / nloc;
        if (old + 1u == (gen + 1u) * nloc) {
            __builtin_amdgcn_fence(__ATOMIC_RELEASE, "agent");
            asm volatile("s_waitcnt vmcnt(0)" ::: "memory");
            const unsigned og = xb_add(&bar[XB_TOP], 1u);
            const unsigned tg = og / nx;
            if (og + 1u == (tg + 1u) * nx) xb_add(&bar[XB_TOPGEN], 1u);
            else XB_SPIN(xb_ld(&bar[XB_TOPGEN]) == tg, bar);
            __builtin_amdgcn_fence(__ATOMIC_ACQUIRE, "agent");
            xb_add(&bar[XB_XGEN(b.x)], 1u);
            asm volatile("s_waitcnt vmcnt(0)" ::: "memory");
        } else {
            XB_SPIN(xb_ld(&bar[XB_XGEN(b.x)]) == gen, bar);
            __builtin_amdgcn_fence(__ATOMIC_ACQUIRE, "agent");
            asm volatile("s_waitcnt vmcnt(0)" ::: "memory");
        }
    }
    __syncthreads();
}

namespace pg8 {
constexpr int BM = 256, BK = 64, HALF = 128, HTB = HALF * BK * 2, STAGE_BYTES = 8 * HTB, NXCD = 8, WGM = 8;
__device__ __forceinline__ int lds_byte(int r, int c) { const int st = (r >> 4) * 2 + (c >> 5), rr = r & 15, cc = c & 31, ob = rr * 64 + cc * 2; return st * 1024 + (ob ^ (((ob >> 9) & 1) << 5)); }
__device__ __forceinline__ void stage_rc(int b, int& R, int& C) { const int st = b / 1024, sb = b % 1024, swz = sb ^ (((sb >> 9) & 1) << 5); R = (st >> 1) * 16 + swz / 64; C = (st & 1) * 32 + (swz % 64) / 2; }
__device__ __forceinline__ int perm32(int rho) { const int n = rho >> 4, i = rho & 15; return 8 * (i >> 2) + 4 * n + (i & 3); }

struct Unit { int pm, pn, aux; const char* a; const char* b; };

__device__ __forceinline__ bool static_tile(int L, int nM, int nN, int& pm, int& pn) {
    const int nwg = nM * nN; if (L >= nwg) return false;
    int wgid = L; { const int q = nwg / NXCD, r = nwg % NXCD, xcd = wgid % NXCD, off = wgid / NXCD; wgid = (xcd < r ? xcd * (q + 1) : r * (q + 1) + (xcd - r) * q) + off; }
    const int nig = WGM * nN, gid = wgid / nig, fm = gid * WGM, gsz = (nM - fm) < WGM ? (nM - fm) : WGM;
    pm = fm + ((wgid % nig) % gsz); pn = (wgid % nig) / gsz; return true;
}

constexpr int F8_WSH = 6;
template <class Epi, class Sched, bool GATHER, bool F8 = false>
__device__ __forceinline__ void gemm_phase(LAS unsigned char* lds, const int K, const int lda, const int ldb, const Sched& S, const Epi& E, const int* __restrict__ rowidx, const int pv = 0) {
    const int tid = threadIdx.x, wid = __builtin_amdgcn_readfirstlane(tid >> 6), lane = tid & 63, wr = wid >> 2, wc = wid & 3, fr = lane & 15, fq = lane >> 4;
    constexpr int ES = F8 ? 1 : 2;
    const int nt = K / (F8 ? 128 : BK);
#define PG8_SW(r) ((((r) >> 1) & 7) ^ (((((r) >> 2) ^ ((r) >> 3)) & 1) * (F8 ? 2 : 1)))
    unsigned voffA[2], voffB[2]; int gR[2], gC[2];
#pragma unroll
    for (int i = 0; i < 2; ++i) { const int q = tid * 16 + i * 8192, r = (q >> 7) & 15; const int R = (q >> 11) * 16 + r, C = (((q >> 4) & 7) ^ PG8_SW(r)) * 16;
        const int Rb = Epi::PERM ? ((R & ~31) + perm32(R & 31)) : R;
        voffA[i] = (unsigned)(R * lda * ES + C); voffB[i] = (unsigned)(Rb * ldb * ES + C); gR[i] = R; gC[i] = C; }
    const size_t kstep = (size_t)(BK * 2);
    const size_t hstepA = (size_t)HALF * lda * ES, hstepB = (size_t)HALF * ldb * ES;
    const unsigned ldsw = (unsigned)wid * 1024u;
    const int sx = PG8_SW(fr), ck0 = F8 ? 2 * fq : fq, ck1 = F8 ? 2 * fq + 1 : 4 + fq;
    const int aoff0 = wr * 8192 + fr * 128 + 16 * (ck0 ^ sx), aoff1 = wr * 8192 + fr * 128 + 16 * (ck1 ^ sx), boff0 = wc * 4096 + fr * 128 + 16 * (ck0 ^ sx), boff1 = wc * 4096 + fr * 128 + 16 * (ck1 ^ sx);
#define PG8_SA(b, h) (((b) * 2 + (h)) * HTB)
#define PG8_SB(b, h) ((4 + (b) * 2 + (h)) * HTB)
#define PG8_GLDS(src, dstoff) do { if (!(pv & 32)) __builtin_amdgcn_global_load_lds((const unsigned*)(src), (LAS unsigned*)(lds + (dstoff)), 16, 0, 0); } while (0)
#define PG8_STAGEB(bufoff, gbase) do { PG8_GLDS((const char*)(gbase) + voffB[0], (bufoff) + ldsw); PG8_GLDS((const char*)(gbase) + voffB[1], (bufoff) + ldsw + 8192); } while (0)
#define PG8_STAGEA(bufoff, gbase, h, SET) do { if constexpr (GATHER) { const u32x2 o_ = *(const LAS u32x2*)(lds + GOFF_LDS + ((SET) * 2 + (h)) * 4096 + tid * 8); \
        PG8_GLDS((const char*)(gbase) + o_.x, (bufoff) + ldsw); PG8_GLDS((const char*)(gbase) + o_.y, (bufoff) + ldsw + 8192); } \
        else { PG8_GLDS((const char*)(gbase) + (h) * hstepA + voffA[0], (bufoff) + ldsw); PG8_GLDS((const char*)(gbase) + (h) * hstepA + voffA[1], (bufoff) + ldsw + 8192); } } while (0)
#define PG8_LDA(dst, b, h) do { _Pragma("unroll") for (int m = 0; m < 4; ++m) { dst[m][0] = *(const LAS bf16x8*)(lds + PG8_SA(b, h) + aoff0 + m * 2048); dst[m][1] = *(const LAS bf16x8*)(lds + PG8_SA(b, h) + aoff1 + m * 2048); } } while (0)
#define PG8_LDB(dst, b, h) do { _Pragma("unroll") for (int n = 0; n < 2; ++n) { dst[n][0] = *(const LAS bf16x8*)(lds + PG8_SB(b, h) + boff0 + n * 2048); dst[n][1] = *(const LAS bf16x8*)(lds + PG8_SB(b, h) + boff1 + n * 2048); } } while (0)
#define PG8_CAT(lo, hi) __builtin_shufflevector(__builtin_bit_cast(i32x4, lo), __builtin_bit_cast(i32x4, hi), 0, 1, 2, 3, 4, 5, 6, 7)
#define PG8_MMA(ai, bj, At, Bt) do { if (pv & 16) { asm volatile("" :: "v"(At[0][0]), "v"(At[1][0]), "v"(At[2][0]), "v"(At[3][0]), "v"(At[0][1]), "v"(At[1][1]), "v"(At[2][1]), "v"(At[3][1]), "v"(Bt[0][0]), "v"(Bt[0][1]), "v"(Bt[1][0]), "v"(Bt[1][1])); break; } __builtin_amdgcn_s_setprio(1); _Pragma("unroll") for (int m = 0; m < 4; ++m) _Pragma("unroll") for (int n = 0; n < 2; ++n) { \
        if constexpr (F8) { const i32x8 b8_ = PG8_CAT(Bt[n][0], Bt[n][1]), a8_ = PG8_CAT(At[m][0], At[m][1]); \
            asm volatile("v_mfma_scale_f32_16x16x128_f8f6f4 %0, %1, %2, %0, %3, %4 op_sel_hi:[0,0,0]" : "+v"(acc[ai][bj][m][n]) : "v"(b8_), "v"(a8_), "v"(sc_w), "v"(sc_x)); } \
        else { _Pragma("unroll") for (int k = 0; k < 2; ++k) acc[ai][bj][m][n] = __builtin_amdgcn_mfma_f32_16x16x32_bf16(Bt[n][k], At[m][k], acc[ai][bj][m][n], 0, 0, 0); } } __builtin_amdgcn_s_setprio(0); } while (0)
#define PG8_WAIT_V(n) asm volatile("s_waitcnt vmcnt(" #n ")" ::: "memory")
#define PG8_WAIT_L(n) asm volatile("s_waitcnt lgkmcnt(" #n ")" ::: "memory")
#define PG8_BAR __builtin_amdgcn_s_barrier()
#define PG8_SCHED __builtin_amdgcn_sched_barrier(0)
#define PG8_GOFFS(SET, U) do { if constexpr (GATHER) { _Pragma("unroll") for (int h_ = 0; h_ < 2; ++h_) { u32x2 o_; \
        o_.x = (unsigned)rowidx[(U).aux + h_ * HALF + gR[0]] * (unsigned)(lda * ES) + (unsigned)gC[0]; o_.y = (unsigned)rowidx[(U).aux + h_ * HALF + gR[1]] * (unsigned)(lda * ES) + (unsigned)gC[1]; \
        *(LAS u32x2*)(lds + GOFF_LDS + ((SET) * 2 + h_) * 4096 + tid * 8) = o_; } } } while (0)
    const int sc_w = 127 - F8_WSH, sc_x = 127; (void)sc_w; (void)sc_x;
    Unit cur, nxt; int ui = 0;
    if (!S.next(0, cur)) return;
    f32x4 acc[2][2][4][2];
#pragma unroll
    for (int a = 0; a < 2; ++a)
#pragma unroll
        for (int b = 0; b < 2; ++b)
#pragma unroll
            for (int m = 0; m < 4; ++m)
#pragma unroll
                for (int n = 0; n < 2; ++n) acc[a][b][m][n] = (f32x4){0.f, 0.f, 0.f, 0.f};
    bf16x8 At[4][2], B0[2][2], B1[2][2];
    PG8_GOFFS(0, cur);
    const char* cA = cur.a; const char* cB = cur.b;
    PG8_STAGEB(PG8_SB(0, 0), cB); PG8_STAGEB(PG8_SB(0, 1), cB + hstepB); PG8_STAGEA(PG8_SA(0, 0), cA, 0, 0); PG8_STAGEA(PG8_SA(0, 1), cA, 1, 0);
    if (wr == 1) PG8_BAR;
    PG8_WAIT_V(2); PG8_BAR;
    PG8_STAGEB(PG8_SB(1, 0), cB + kstep); PG8_STAGEA(PG8_SA(1, 0), cA + kstep, 0, 0); PG8_STAGEB(PG8_SB(1, 1), cB + hstepB + kstep);
    PG8_WAIT_V(6); PG8_BAR;
    for (;;) {
        const bool has_next = S.next(ui + 1, nxt);
        const int cs = ui & 1; if (has_next) PG8_GOFFS(cs ^ 1, nxt);
        const char* nA = has_next ? nxt.a : cA; const char* nB = has_next ? nxt.b : cB;
#pragma unroll 1
        for (int t = 0; t < nt; t += 2) {
            const bool last = (t == nt - 2);
            const char* a1 = cA + (size_t)(t + 1) * kstep;
            const char* a2 = last ? nA : cA + (size_t)(t + 2) * kstep; const char* b2 = last ? nB : cB + (size_t)(t + 2) * kstep;
            const char* a3 = a2 + kstep; const char* b3 = b2 + kstep;
            const int s2 = (last && has_next) ? (cs ^ 1) : cs;
            PG8_LDB(B0, 0, 0); PG8_LDB(B1, 0, 1); PG8_SCHED; PG8_LDA(At, 0, 0); PG8_STAGEA(PG8_SA(1, 1), a1, 1, cs);
            PG8_WAIT_V(8); PG8_WAIT_L(0); PG8_BAR; PG8_MMA(0, 0, At, B0); PG8_MMA(0, 1, At, B1); PG8_BAR; PG8_SCHED;
            PG8_LDA(At, 0, 1); PG8_STAGEB(PG8_SB(0, 0), b2); PG8_STAGEB(PG8_SB(0, 1), b2 + hstepB); PG8_STAGEA(PG8_SA(0, 0), a2, 0, s2);
            PG8_WAIT_V(8); PG8_WAIT_L(0); PG8_BAR; PG8_MMA(1, 0, At, B0); PG8_MMA(1, 1, At, B1); PG8_BAR; PG8_SCHED;
            PG8_LDB(B0, 1, 0); PG8_LDB(B1, 1, 1); PG8_SCHED; PG8_LDA(At, 1, 0); PG8_STAGEA(PG8_SA(0, 1), a2, 1, s2);
            PG8_WAIT_V(8); PG8_WAIT_L(0); PG8_BAR; PG8_MMA(0, 0, At, B0); PG8_MMA(0, 1, At, B1); PG8_BAR; PG8_SCHED;
            PG8_LDA(At, 1, 1); PG8_STAGEB(PG8_SB(1, 0), b3); PG8_STAGEB(PG8_SB(1, 1), b3 + hstepB); PG8_STAGEA(PG8_SA(1, 0), a3, 0, s2);
            PG8_WAIT_V(8); PG8_WAIT_L(0); PG8_BAR; PG8_MMA(1, 0, At, B0); PG8_MMA(1, 1, At, B1); PG8_BAR; PG8_SCHED;
        }
        if constexpr (F8) {
            asm volatile("s_nop 15\n\ts_nop 15" : "+v"(acc[0][0][0][0]), "+v"(acc[0][0][0][1]), "+v"(acc[0][0][1][0]), "+v"(acc[0][0][1][1]), "+v"(acc[0][0][2][0]), "+v"(acc[0][0][2][1]), "+v"(acc[0][0][3][0]), "+v"(acc[0][0][3][1]),
                         "+v"(acc[0][1][0][0]), "+v"(acc[0][1][0][1]), "+v"(acc[0][1][1][0]), "+v"(acc[0][1][1][1]), "+v"(acc[0][1][2][0]), "+v"(acc[0][1][2][1]), "+v"(acc[0][1][3][0]), "+v"(acc[0][1][3][1]) :: "memory");
            asm volatile("" : "+v"(acc[1][0][0][0]), "+v"(acc[1][0][0][1]), "+v"(acc[1][0][1][0]), "+v"(acc[1][0][1][1]), "+v"(acc[1][0][2][0]), "+v"(acc[1][0][2][1]), "+v"(acc[1][0][3][0]), "+v"(acc[1][0][3][1]),
                         "+v"(acc[1][1][0][0]), "+v"(acc[1][1][0][1]), "+v"(acc[1][1][1][0]), "+v"(acc[1][1][1][1]), "+v"(acc[1][1][2][0]), "+v"(acc[1][1][2][1]), "+v"(acc[1][1][3][0]), "+v"(acc[1][1][3][1]) :: "memory"); }
        if (wr == 0) PG8_BAR;
        int fr_e = fr, fq_e = fq; asm volatile("" : "+v"(fr_e), "+v"(fq_e));
        const bool keep = E(acc, cur, wr, wc, fr_e, fq_e);
        if (!has_next) break;
        if (!keep) {
#pragma unroll
            for (int a = 0; a < 2; ++a)
#pragma unroll
                for (int b = 0; b < 2; ++b)
#pragma unroll
                    for (int m = 0; m < 4; ++m)
#pragma unroll
                        for (int n = 0; n < 2; ++n) acc[a][b][m][n] = (f32x4){0.f, 0.f, 0.f, 0.f};
        }
        cur = nxt; cA = nA; cB = nB; ++ui;
        if (wr == 1) PG8_BAR;
    }
    PG8_WAIT_V(0);
    PG8_BAR;
#undef PG8_SW
#undef PG8_SA
#undef PG8_SB
#undef PG8_GLDS
#undef PG8_STAGEA
#undef PG8_STAGEB
#undef PG8_LDA
#undef PG8_LDB
#undef PG8_MMA
#undef PG8_CAT
#undef PG8_WAIT_V
#undef PG8_WAIT_L
#undef PG8_BAR
#undef PG8_SCHED
#undef PG8_GOFFS
}
}
using pg8::Unit;

struct Frame {
    LAS unsigned char* lds; volatile LAS unsigned* MISC; unsigned* ctl; unsigned char* ws;
    int tid, lane, wave, vcu, G, bx;
    const float* in[26]; float* out;
};
enum { I_X = 0, I_META, I_N1G, I_WIN, I_LRE, I_LIM, I_LDT, I_BRE, I_BIM, I_CRE, I_CIM, I_SD, I_WGLU, I_LBL, I_HNG, I_WBS, I_WBH, I_WOUT, I_N2G, I_WR, I_BR, I_WGU, I_BGU, I_WD, I_BD, I_FNG };

struct SchedStatic {
    const char* A; const char* B; int nM, nN, G, c; size_t ta, tb; int var = 0, pn_off = 0;
    __device__ __forceinline__ bool next(int i, Unit& u) const { int pm, pn; if (!pg8::static_tile(i * G + c, nM, nN, pm, pn)) return false; u.pm = pm; u.pn = pn + pn_off; u.aux = 0; u.a = A + (size_t)pm * ta; u.b = B + (size_t)pn * tb; if (var & 8) { u.a = A; u.b = B; } return true; }
};
struct SchedS5E {
    const char* UA; const char* WE; int c;
    __device__ __forceinline__ bool next(int i, Unit& u) const { if (i > 0 || c >= 64) return false; const int x = c & 7, r = c >> 3, g = x * 4 + (r >> 1), pm = r & 1; u.pm = pm; u.pn = 0; u.aux = g;
        u.a = UA + ((size_t)g * 512 + pm * 256) * UAK * 2; u.b = WE + (size_t)g * 256 * 1024 * 2; return true; }
};
struct SchedS5Y {
    const char* UA; const char* TZ; int c, G;
    __device__ __forceinline__ bool next(int i, Unit& u) const { if (i > 0 || G != 256) { const int L = i * G + c; if (G == 256 || L >= 256) return false; const int g = L >> 3; u.pm = (L >> 2) & 1; u.pn = L & 3; u.aux = g;
            u.a = UA + ((size_t)g * 512 + u.pm * 256) * UAK * 2; u.b = TZ + ((size_t)g * 1024 + u.pn * 256) * UAK * 2; return true; }
        const int x = c & 7, r = c >> 3, g = x + 8 * (r >> 3), pm = (r >> 2) & 1, pn = r & 3; u.pm = pm; u.pn = pn; u.aux = g;
        u.a = UA + ((size_t)g * 512 + pm * 256) * UAK * 2; u.b = TZ + ((size_t)g * 1024 + pn * 256) * UAK * 2; return true; }
};
struct SchedBranch {
    const char* A0; const char* A1; const char* B0; const char* B1; int G, c;
    __device__ __forceinline__ bool next(int i, Unit& u) const { int pm, pn; if (!pg8::static_tile((i >> 1) * G + c, T / 256, 4, pm, pn)) return false; const int part = i & 1; u.pm = pm; u.pn = pn; u.aux = part;
        u.a = (part ? A1 : A0) + (size_t)pm * 256 * HW * 2; u.b = (part ? B1 : B0) + (size_t)pn * 256 * HW * 2; return true; }
};
struct SchedMoe {
    const char* A; const char* W; const int* tile_e; int ntiles, NN, G, c; size_t wexp, wtile; bool gather; int var;
    __device__ __forceinline__ bool next(int i, Unit& u) const { int ti, pn;
        if ((G & 7) == 0) { const int x = c & 7, j = i * (G >> 3) + (c >> 3), ml = j / NN; pn = j - ml * NN; ti = ml * 8 + x; }
        else { const int L = i * G + c; ti = L / NN; pn = L - ti * NN; }
        if (ti >= ntiles) return false; const int e = tile_e[ti];
        u.pm = ti; u.pn = pn; u.aux = gather ? ti * 256 : e; u.a = gather ? A : A + (size_t)ti * 256 * DF; u.b = W + (size_t)e * wexp + (size_t)pn * wtile;
        if (var & 8) { u.a = A; u.b = W; if (gather) u.aux = 0; } return true; }
};

__device__ __forceinline__ u32x4 pack8(const f32x4& v0, const f32x4& v1) { u32x4 w; w.x = cvt_pk_bf16(v0[0], v0[1]); w.y = cvt_pk_bf16(v0[2], v0[3]); w.z = cvt_pk_bf16(v1[0], v1[1]); w.w = cvt_pk_bf16(v1[2], v1[3]); return w; }

struct EpiInProj {
    static constexpr bool PERM = true;
    bf16_t *UA, *Q, *V, *GS, *GATES; float* LOGF; const float* LBV;
    __device__ __forceinline__ bool operator()(f32x4 (&acc)[2][2][4][2], const Unit& u, int wr, int wc, int fr, int fq) const {
        const int kind = u.pn >> 1;
#pragma unroll
        for (int ai = 0; ai < 2; ++ai)
#pragma unroll
            for (int m = 0; m < 4; ++m) { const int tok = u.pm * 256 + ai * 128 + wr * 64 + m * 16 + fr;
#pragma unroll
                for (int bj = 0; bj < 2; ++bj) { const int col = u.pn * 256 + bj * 128 + wc * 32 + 8 * fq; f32x4 v0 = acc[ai][bj][m][0], v1 = acc[ai][bj][m][1];
                    if (kind == 0) { const int g = col >> 4, hh = col & 15; *(u32x4*)(UA + ((size_t)(g * 512 + (tok >> 6)) * UAK + (tok & 63) * 16 + hh)) = pack8(v0, v1); }
                    else if (kind == 1) {
#pragma unroll
                        for (int j = 0; j < 4; ++j) { v0[j] = v0[j] * sigmoidf_(v0[j]); v1[j] = v1[j] * sigmoidf_(v1[j]); }
                        *(u32x4*)(Q + (size_t)tok * HW + (col - 512)) = pack8(v0, v1); }
                    else if (kind == 2) { const int c2 = col - 1024; const f32x4 l0 = *(const f32x4*)(LBV + c2), l1 = *(const f32x4*)(LBV + c2 + 4);
#pragma unroll
                        for (int j = 0; j < 4; ++j) { v0[j] = __logf(l0[j] + (1.f - l0[j]) * sigmoidf_(v0[j])); v1[j] = __logf(l1[j] + (1.f - l1[j]) * sigmoidf_(v1[j])); }
                        *(f32x4*)(LOGF + (size_t)tok * HW + c2) = v0; *(f32x4*)(LOGF + (size_t)tok * HW + c2 + 4) = v1; }
                    else if (kind == 3) { *(u32x4*)(V + (size_t)tok * HW + (col - 1536)) = pack8(v0, v1); }
                    else if (kind == 4) {
#pragma unroll
                        for (int j = 0; j < 4; ++j) { v0[j] = v0[j] * sigmoidf_(v0[j]); v1[j] = v1[j] * sigmoidf_(v1[j]); }
                        *(u32x4*)(GS + (size_t)tok * HW + (col - 2048)) = pack8(v0, v1); }
                    else {
#pragma unroll
                        for (int j = 0; j < 4; ++j) { v0[j] = sigmoidf_(v0[j]); v1[j] = sigmoidf_(v1[j]); }
                        if (MK_GSTORE_F8) { u32x2 q8; q8.x = pk4_u8(v0[0], v0[1], v0[2], v0[3]); q8.y = pk4_u8(v1[0], v1[1], v1[2], v1[3]); *(u32x2*)((unsigned char*)GATES + (size_t)tok * 2048 + (col - 2560)) = q8; }
                        else *(u32x4*)(GATES + (size_t)tok * 2048 + (col - 2560)) = pack8(v0, v1); }
                } }
        return false;
    }
};
struct EpiS5E {
    static constexpr bool PERM = false;
    float* SE;
    __device__ __forceinline__ bool operator()(f32x4 (&acc)[2][2][4][2], const Unit& u, int wr, int wc, int fr, int fq) const {
#pragma unroll
        for (int ai = 0; ai < 2; ++ai)
#pragma unroll
            for (int m = 0; m < 4; ++m) { const int r = u.pm * 256 + ai * 128 + wr * 64 + m * 16 + fr; float* rowp = SE + ((size_t)u.aux * 512 + r) * 128 + wc * 32 + 4 * fq;
#pragma unroll
                for (int n = 0; n < 2; ++n) *(f32x4*)(rowp + n * 16) = acc[ai][0][m][n]; }
        return false;
    }
};
struct EpiS5Y {
    static constexpr bool PERM = true;
    const bf16_t* UA; const float* SD; bf16_t* Y1;
    __device__ __forceinline__ bool operator()(f32x4 (&acc)[2][2][4][2], const Unit& u, int wr, int wc, int fr, int fq) const {
        const int g = u.aux;
#pragma unroll
        for (int ai = 0; ai < 2; ++ai)
#pragma unroll
            for (int m = 0; m < 4; ++m) { const int r = u.pm * 256 + ai * 128 + wr * 64 + m * 16 + fr; const int b = r >> 7, c = r & 127;
#pragma unroll
                for (int bj = 0; bj < 2; ++bj) { const int col = u.pn * 256 + bj * 128 + wc * 32 + 8 * fq; const int t = col >> 4, hh = col & 15;
                    const u32x4 uu = *(const u32x4*)(UA + ((size_t)(g * 512 + r) * UAK + col));
                    const f32x4 d0 = *(const f32x4*)(SD + g * 16 + hh), d1 = *(const f32x4*)(SD + g * 16 + hh + 4);
                    f32x4 v0 = acc[ai][bj][m][0], v1 = acc[ai][bj][m][1];
                    v0[0] += d0[0] * bf2f(uu.x & 0xffffu); v0[1] += d0[1] * bf2f(uu.x >> 16); v0[2] += d0[2] * bf2f(uu.y & 0xffffu); v0[3] += d0[3] * bf2f(uu.y >> 16);
                    v1[0] += d1[0] * bf2f(uu.z & 0xffffu); v1[1] += d1[1] * bf2f(uu.z >> 16); v1[2] += d1[2] * bf2f(uu.w & 0xffffu); v1[3] += d1[3] * bf2f(uu.w >> 16);
#pragma unroll
                    for (int j = 0; j < 4; ++j) { float x = v0[j]; v0[j] = x * sigmoidf_(1.5957691216f * (x + 0.044715f * x * x * x)); x = v1[j]; v1[j] = x * sigmoidf_(1.5957691216f * (x + 0.044715f * x * x * x)); }
                    const int tok = b * SEQ + c * 64 + t;
                    *(u32x4*)(Y1 + (size_t)tok * HW + g * 16 + hh) = pack8(v0, v1); } }
        return false;
    }
};
struct EpiGlu {
    static constexpr bool PERM = true;
    const bf16_t* Y1; bf16_t* YS5;
    __device__ __forceinline__ bool operator()(f32x4 (&acc)[2][2][4][2], const Unit& u, int wr, int wc, int fr, int fq) const {
#pragma unroll
        for (int ai = 0; ai < 2; ++ai)
#pragma unroll
            for (int m = 0; m < 4; ++m) { const int row = u.pm * 256 + ai * 128 + wr * 64 + m * 16 + fr;
#pragma unroll
                for (int bj = 0; bj < 2; ++bj) { const int col = u.pn * 256 + bj * 128 + wc * 32 + 8 * fq; const u32x4 y = *(const u32x4*)(Y1 + (size_t)row * HW + col);
                    f32x4 v0 = acc[ai][bj][m][0], v1 = acc[ai][bj][m][1];
                    v0[0] = bf2f(y.x & 0xffffu) * sigmoidf_(v0[0]); v0[1] = bf2f(y.x >> 16) * sigmoidf_(v0[1]); v0[2] = bf2f(y.y & 0xffffu) * sigmoidf_(v0[2]); v0[3] = bf2f(y.y >> 16) * sigmoidf_(v0[3]);
                    v1[0] = bf2f(y.z & 0xffffu) * sigmoidf_(v1[0]); v1[1] = bf2f(y.z >> 16) * sigmoidf_(v1[1]); v1[2] = bf2f(y.w & 0xffffu) * sigmoidf_(v1[2]); v1[3] = bf2f(y.w >> 16) * sigmoidf_(v1[3]);
                    *(u32x4*)(YS5 + (size_t)row * HW + col) = pack8(v0, v1); } }
        return false;
    }
};
struct EpiBranch {
    static constexpr bool PERM = true;
    const bf16_t* GATES; bf16_t* MERGED;
    __device__ __forceinline__ bool operator()(f32x4 (&acc)[2][2][4][2], const Unit& u, int wr, int wc, int fr, int fq) const {
        const int part = u.aux;
#pragma unroll
        for (int ai = 0; ai < 2; ++ai)
#pragma unroll
            for (int m = 0; m < 4; ++m) { const int row = u.pm * 256 + ai * 128 + wr * 64 + m * 16 + fr;
#pragma unroll
                for (int bj = 0; bj < 2; ++bj) { const int col = u.pn * 256 + bj * 128 + wc * 32 + 8 * fq;
                    float h[8], s[8];
                    if (MK_GSTORE_F8) { const u32x2 g2 = *(const u32x2*)((const unsigned char*)GATES + (size_t)row * 2048 + 1024 + col); const float i255 = 1.0f / 255.0f;
#pragma unroll
                        for (int j = 0; j < 4; ++j) { h[j] = fmaxf((float)((g2.x >> (8 * j)) & 0xffu), 0.5f) * i255; h[4 + j] = fmaxf((float)((g2.y >> (8 * j)) & 0xffu), 0.5f) * i255; }
                        if (part == 0) { const u32x2 g1 = *(const u32x2*)((const unsigned char*)GATES + (size_t)row * 2048 + col);
#pragma unroll
                            for (int j = 0; j < 4; ++j) { s[j] = (float)((g1.x >> (8 * j)) & 0xffu) * i255; s[4 + j] = (float)((g1.y >> (8 * j)) & 0xffu) * i255; } } }
                    else { const u32x4 g2 = *(const u32x4*)(GATES + (size_t)row * 2048 + 1024 + col);
                        h[0] = bf2f(g2.x & 0xffffu); h[1] = bf2f(g2.x >> 16); h[2] = bf2f(g2.y & 0xffffu); h[3] = bf2f(g2.y >> 16); h[4] = bf2f(g2.z & 0xffffu); h[5] = bf2f(g2.z >> 16); h[6] = bf2f(g2.w & 0xffffu); h[7] = bf2f(g2.w >> 16);
                        if (part == 0) { const u32x4 g1 = *(const u32x4*)(GATES + (size_t)row * 2048 + col);
                            s[0] = bf2f(g1.x & 0xffffu); s[1] = bf2f(g1.x >> 16); s[2] = bf2f(g1.y & 0xffffu); s[3] = bf2f(g1.y >> 16); s[4] = bf2f(g1.z & 0xffffu); s[5] = bf2f(g1.z >> 16); s[6] = bf2f(g1.w & 0xffffu); s[7] = bf2f(g1.w >> 16); } }
#pragma unroll
                    for (int j = 0; j < 8; ++j) h[j] = fmaxf(h[j], 1e-30f);
                    if (part == 0) {
#pragma unroll
                        for (int j = 0; j < 4; ++j) { acc[ai][bj][m][0][j] *= s[j] * __builtin_amdgcn_rcpf(h[j]); acc[ai][bj][m][1][j] *= s[4 + j] * __builtin_amdgcn_rcpf(h[4 + j]); } }
                    else { f32x4 v0 = acc[ai][bj][m][0], v1 = acc[ai][bj][m][1];
#pragma unroll
                        for (int j = 0; j < 4; ++j) { v0[j] *= h[j]; v1[j] *= h[4 + j]; }
                        *(u32x4*)(MERGED + (size_t)row * D + col) = pack8(v0, v1); } } }
        return part == 0;
    }
};
struct EpiOut {
    static constexpr bool PERM = true;
    const float* X; bf16_t* H1; float* SSQ; int var = 0;
    __device__ __forceinline__ bool operator()(f32x4 (&acc)[2][2][4][2], const Unit& u, int wr, int wc, int fr, int fq) const {
#pragma unroll
        for (int ai = 0; ai < 2; ++ai)
#pragma unroll
            for (int m = 0; m < 4; ++m) { const int row = u.pm * 256 + ai * 128 + wr * 64 + m * 16 + fr; const size_t off = (size_t)row * D + u.pn * 256 + wc * 32 + 8 * fq; float ss = 0.f;
                if (var & 4) { asm volatile("" :: "v"(acc[ai][0][m][0]), "v"(acc[ai][0][m][1]), "v"(acc[ai][1][m][0]), "v"(acc[ai][1][m][1])); continue; }
#pragma unroll
                for (int bj = 0; bj < 2; ++bj) { const f32x4 o0 = *(const f32x4*)(X + off + bj * 128) + acc[ai][bj][m][0], o1 = *(const f32x4*)(X + off + bj * 128 + 4) + acc[ai][bj][m][1];
                    *(u32x4*)(H1 + off + bj * 128) = pack8(o0, o1); ss += ((o0[0] * o0[0] + o0[1] * o0[1]) + (o0[2] * o0[2] + o0[3] * o0[3])) + ((o1[0] * o1[0] + o1[1] * o1[1]) + (o1[2] * o1[2] + o1[3] * o1[3])); }
                ss += __shfl_xor(ss, 16); ss += __shfl_xor(ss, 32);
                if (fq == 0) SSQ[(size_t)row * 16 + u.pn * 4 + wc] = ss; }
        return false;
    }
};
struct EpiMoe1 {
    static constexpr bool PERM = true;
    const float* BGU; const int* tile_e; unsigned char* A2; int var;
    __device__ __forceinline__ bool operator()(f32x4 (&acc)[2][2][4][2], const Unit& u, int wr, int wc, int fr, int fq) const {
        const int e = tile_e[u.pm]; const int hid = u.pn * 128 + wc * 32 + 8 * fq; const float* bp = BGU + (size_t)e * 2048 + 2 * hid;
        const f32x4 b0 = *(const f32x4*)(bp), b1 = *(const f32x4*)(bp + 4), b2 = *(const f32x4*)(bp + 8), b3 = *(const f32x4*)(bp + 12);
        const float bg[8] = {b0[0], b0[2], b1[0], b1[2], b2[0], b2[2], b3[0], b3[2]}, bu[8] = {b0[1], b0[3], b1[1], b1[3], b2[1], b2[3], b3[1], b3[3]};
#pragma unroll
        for (int ai = 0; ai < 2; ++ai)
#pragma unroll
            for (int m = 0; m < 4; ++m) { const int prow = u.pm * 256 + ai * 128 + wr * 64 + m * 16 + fr; f32x4 o0, o1;
                if (var & 4) { asm volatile("" :: "v"(acc[ai][0][m][0]), "v"(acc[ai][0][m][1]), "v"(acc[ai][1][m][0]), "v"(acc[ai][1][m][1])); continue; }
#pragma unroll
                for (int j = 0; j < 4; ++j) {
                    float gt = fminf(acc[ai][0][m][0][j] + bg[j], 7.0f), up = fminf(fmaxf(acc[ai][1][m][0][j] + bu[j], -7.0f), 7.0f); o0[j] = (up + 1.0f) * gt * __builtin_amdgcn_rcpf(1.0f + __builtin_amdgcn_exp2f(gt * -2.4554669595930156f));
                    gt = fminf(acc[ai][0][m][1][j] + bg[4 + j], 7.0f); up = fminf(fmaxf(acc[ai][1][m][1][j] + bu[4 + j], -7.0f), 7.0f); o1[j] = (up + 1.0f) * gt * __builtin_amdgcn_rcpf(1.0f + __builtin_amdgcn_exp2f(gt * -2.4554669595930156f)); }
                u32x2 q8; q8.x = pk4_fp8_nc(o0[0], o0[1], o0[2], o0[3]); q8.y = pk4_fp8_nc(o1[0], o1[1], o1[2], o1[3]);
                if (var & 1) asm volatile("" :: "v"(q8)); else *(u32x2*)(A2 + (size_t)prow * DF + hid) = q8; }
        return false;
    }
};
struct EpiMoe2 {
    static constexpr bool PERM = true;
    const float* BD; const int* tile_e; const int* rowslot; unsigned char* YS; int var;
    __device__ __forceinline__ bool operator()(f32x4 (&acc)[2][2][4][2], const Unit& u, int wr, int wc, int fr, int fq) const {
        const int e = tile_e[u.pm];
#pragma unroll
        for (int ai = 0; ai < 2; ++ai)
#pragma unroll
            for (int m = 0; m < 4; ++m) { const int prow = u.pm * 256 + ai * 128 + wr * 64 + m * 16 + fr; const int slot = rowslot[prow];
                if (var & 4) { asm volatile("" :: "v"(acc[ai][0][m][0]), "v"(acc[ai][0][m][1]), "v"(acc[ai][1][m][0]), "v"(acc[ai][1][m][1])); continue; }
                if (var & 1) { const f32x4 c0 = *(const f32x4*)(BD + (size_t)e * D + u.pn * 256 + wc * 32 + 8 * fq); const f32x4 t0 = acc[ai][0][m][0] + c0, t1 = acc[ai][1][m][1] + c0; asm volatile("" :: "v"(t0), "v"(t1), "v"(slot)); continue; }
                if (slot >= 0) {
#pragma unroll
                    for (int bj = 0; bj < 2; ++bj) { const int col = u.pn * 256 + bj * 128 + wc * 32 + 8 * fq; const f32x4 c0 = *(const f32x4*)(BD + (size_t)e * D + col), c1 = *(const f32x4*)(BD + (size_t)e * D + col + 4);
                        const f32x4 y0 = acc[ai][bj][m][0] + c0, y1 = acc[ai][bj][m][1] + c1; u32x2 q8; q8.x = pk4_fp8(y0[0], y0[1], y0[2], y0[3]); q8.y = pk4_fp8(y1[0], y1[1], y1[2], y1[3]);
                        *(u32x2*)(YS + (size_t)slot * D + col) = q8; } } }
        return false;
    }
};

struct TDesc { const float* W; unsigned char* WT; int K, N, k0, n0, mode, out8; };
__device__ __forceinline__ TDesc p0_decode(const Frame& F, int t) {
    TDesc d; unsigned char* ws = F.ws;
    if (t < 16384) { const int e = t >> 9, r = t & 511; d.W = F.in[I_WGU] + (size_t)e * D * 2048; d.WT = ws + WS_WGU + (size_t)e * 2048 * D; d.K = D; d.N = 2048; d.k0 = (r >> 5) * 64; d.n0 = (r & 31) * 64; d.mode = 1; d.out8 = 1; return d; }
    t -= 16384;
    if (t < 8192) { const int e = t >> 8, r = t & 255; d.W = F.in[I_WD] + (size_t)e * DF * D; d.WT = ws + WS_WD + (size_t)e * D * DF; d.K = DF; d.N = D; d.k0 = (r >> 4) * 64; d.n0 = (r & 15) * 64; d.mode = 0; d.out8 = 1; return d; }
    t -= 8192; d.mode = 0; d.out8 = 0;
    if (t < 1152) { d.W = F.in[I_WIN]; d.WT = ws + WS_WIN; d.K = D; d.N = INW; d.k0 = (t / 72) * 64; d.n0 = (t % 72) * 64; d.out8 = MK_P1_F8; if (MK_GATES_F8 && d.n0 >= 2560) { d.out8 = 1; d.WT = ws + WS_WIN8 - (size_t)2560 * D; } return d; }
    t -= 1152;
    if (t < 64) { d.W = F.in[I_WGLU]; d.WT = ws + WS_WGLU; d.K = HW; d.N = HW; d.k0 = (t >> 3) * 64; d.n0 = (t & 7) * 64; return d; }
    t -= 64;
    if (t < 128) { d.W = F.in[I_WBS]; d.WT = ws + WS_WBS; d.K = HW; d.N = D; d.k0 = (t >> 4) * 64; d.n0 = (t & 15) * 64; return d; }
    t -= 128;
    if (t < 128) { d.W = F.in[I_WBH]; d.WT = ws + WS_WBH; d.K = HW; d.N = D; d.k0 = (t >> 4) * 64; d.n0 = (t & 15) * 64; return d; }
    t -= 128;
    d.W = F.in[I_WOUT]; d.WT = ws + WS_WOUT; d.K = D; d.N = D; d.k0 = (t >> 4) * 64; d.n0 = (t & 15) * 64; return d;
}
constexpr int P0_NTILES = 16384 + 8192 + 1152 + 64 + 128 + 128 + 256;
__device__ __forceinline__ void p0_tile_load(const TDesc& d, f32x4 (&r)[16], int lane) {
    const float* p = d.W + (size_t)(d.k0 + (lane >> 4)) * d.N + d.n0 + (lane & 15) * 4;
#pragma unroll
    for (int i = 0; i < 16; ++i) r[i] = *(const f32x4*)(p + (size_t)(4 * i) * d.N);
}
__device__ __forceinline__ void p0_tile_to_lds(LAS float* scr, const f32x4 (&r)[16], int lane) {
#pragma unroll
    for (int i = 0; i < 16; ++i) { const int k = (lane >> 4) + 4 * i; *(LAS f32x4*)(scr + k * 64 + (((lane & 15) * 4) ^ (4 * ((k >> 3) & 7)))) = r[i]; }
}
__device__ __forceinline__ void p0_tile_store(const TDesc& d, const LAS float* scr, int lane) {
    if (d.out8) { const int c = lane & 3; const float sc = (float)(1 << pg8::F8_WSH);
#pragma unroll
        for (int j = 0; j < 4; ++j) { const int n = (lane >> 2) + 16 * j; float v[16];
#pragma unroll
            for (int t = 0; t < 16; ++t) { const int k = 16 * c + t; v[t] = scr[k * 64 + (n ^ (4 * ((k >> 3) & 7)))] * sc; }
            u32x4 o;
            { int w = 0; w = __builtin_amdgcn_cvt_pk_fp8_f32(v[0], v[1], w, false); w = __builtin_amdgcn_cvt_pk_fp8_f32(v[2], v[3], w, true); o.x = (unsigned)w; }
            { int w = 0; w = __builtin_amdgcn_cvt_pk_fp8_f32(v[4], v[5], w, false); w = __builtin_amdgcn_cvt_pk_fp8_f32(v[6], v[7], w, true); o.y = (unsigned)w; }
            { int w = 0; w = __builtin_amdgcn_cvt_pk_fp8_f32(v[8], v[9], w, false); w = __builtin_amdgcn_cvt_pk_fp8_f32(v[10], v[11], w, true); o.z = (unsigned)w; }
            { int w = 0; w = __builtin_amdgcn_cvt_pk_fp8_f32(v[12], v[13], w, false); w = __builtin_amdgcn_cvt_pk_fp8_f32(v[14], v[15], w, true); o.w = (unsigned)w; }
            int nn = d.n0 + n; if (d.mode == 1) { const int hid = nn >> 1, part = nn & 1; nn = 256 * (hid >> 7) + 128 * part + (hid & 127); }
            *(u32x4*)(d.WT + (size_t)nn * d.K + d.k0 + 16 * c) = o; } }
    else { const int c = lane & 7;
#pragma unroll
        for (int j = 0; j < 8; ++j) { const int n = (lane >> 3) + 8 * j; float v[8];
#pragma unroll
            for (int t = 0; t < 8; ++t) { const int k = 8 * c + t; v[t] = scr[k * 64 + (n ^ (4 * (c & 7)))]; }
            u32x4 o; o.x = cvt_pk_bf16(v[0], v[1]); o.y = cvt_pk_bf16(v[2], v[3]); o.z = cvt_pk_bf16(v[4], v[5]); o.w = cvt_pk_bf16(v[6], v[7]);
            *(u32x4*)((bf16_t*)d.WT + (size_t)(d.n0 + n) * d.K + d.k0 + 8 * c) = o; } }
}
struct C2 { double re, im; };
__device__ __forceinline__ C2 cmul(C2 a, C2 b) { return C2{a.re * b.re - a.im * b.im, a.re * b.im + a.im * b.re}; }
__device__ __forceinline__ C2 s5_pow(const Frame& F, int g, int p, int k) {
    const double lre = (double)F.in[I_LRE][g * SP + p], lim = (double)F.in[I_LIM][g * SP + p], dt = exp((double)F.in[I_LDT][g]);
    const double mag = exp((double)k * lre * dt); double s, c; sincos((double)k * lim * dt, &s, &c); return C2{mag * c, mag * s};
}
__device__ __forceinline__ C2 s5_coef(const Frame& F, int g, int p) {
    const double lre = (double)F.in[I_LRE][g * SP + p], lim = (double)F.in[I_LIM][g * SP + p]; const C2 lb = s5_pow(F, g, p, 1);
    const double nr = lb.re - 1.0, ni = lb.im, den = lre * lre + lim * lim; return C2{(nr * lre + ni * lim) / den, (ni * lre - nr * lim) / den};
}

struct C2f { float re, im; };
__device__ __forceinline__ C2f cmulf(C2f a, C2f b) { return C2f{a.re * b.re - a.im * b.im, a.re * b.im + a.im * b.re}; }
__device__ __forceinline__ void s5_fast(const Frame& F, int g, int p, C2f& lb, C2f& cf) {
    const float lre = F.in[I_LRE][g * SP + p], lim = F.in[I_LIM][g * SP + p], dt = __expf(F.in[I_LDT][g]); const float a = lre * dt, th = lim * dt;
    const float sn = __sinf(th), cs = __cosf(th), ea = __expf(a); lb = C2f{ea * cs, ea * sn};
    const float sh = __sinf(0.5f * th); const float em1 = (fabsf(a) < 0.125f) ? a * (1.0f + a * (0.5f + a * (0.16666667f + a * 0.041666668f))) : ea - 1.0f;
    const float nr = em1 * cs - 2.0f * sh * sh, ni = ea * sn, den = lre * lre + lim * lim;
    cf = C2f{(nr * lre + ni * lim) / den, (ni * lre - nr * lim) / den};
}
__device__ __forceinline__ C2f cpowf_(C2f b, int k) { C2f r{1.f, 0.f};
#pragma unroll
    for (int i = 0; i < 7; ++i) { if (k & 1) r = cmulf(r, b); b = cmulf(b, b); k >>= 1; } return r; }
__device__ __forceinline__ void p0_prologue(Frame& F, const int var = 0) {
    LAS float* scr = (LAS float*)(F.lds + F.wave * 16384);
    const int gw = F.vcu * 8 + F.wave, NGW = F.G * 8, lane = F.lane;
    unsigned char* ws = F.ws;
    { f32x4 rr[16]; int t = gw;
      if (t < P0_NTILES && !(var & 256)) { TDesc dc = p0_decode(F, t); p0_tile_load(dc, rr, lane);
        for (;;) { p0_tile_to_lds(scr, rr, lane);
            const int tn = t + NGW; TDesc dn = dc; const bool more = tn < P0_NTILES;
            if (more) { dn = p0_decode(F, tn); p0_tile_load(dn, rr, lane); }
            LDS_WAIT(); asm volatile("" ::: "memory");
            p0_tile_store(dc, scr, lane);
            LDS_WAIT(); asm volatile("" ::: "memory");
            if (!more) break; dc = dn; t = tn; } } }
    constexpr int R6 = 0;
    constexpr int R7 = R6 + 2048  , R8 = R7 + 2048  , R9 = R8 + 2048  , R10 = R9 + 32  , R11 = R10 + 384  , R12 = R11 + 16  , R13 = R12 + 1  ;
    constexpr int R14 = R13 + 2048  ;
    for (int it = gw; it < ((var & 512) ? 0 : R14); it += NGW) {
        if ((var & 2048) && it >= R9 && it < R10) continue; if ((var & 4096) && it < R9) continue; if ((var & 8192) && it >= R10 && it < R11) continue; if ((var & 16384) && it >= R11) continue;
        if (it < R7) {
            const int q = it - R6, g = q >> 6, k = q & 63, p = lane;
            C2f lb, cf; s5_fast(F, g, p, lb, cf); const C2f pw = cpowf_(lb, k);
            LAS float* CLre = scr; LAS float* CLim = scr + 1024; LAS float* BBre = scr + 2048; LAS float* BBim = scr + 3072;
#pragma unroll 4
            for (int h = 0; h < 16; ++h) { const C2f cc = cmulf(C2f{F.in[I_CRE][(g * 16 + h) * SP + p], F.in[I_CIM][(g * 16 + h) * SP + p]}, pw); CLre[h * 64 + p] = cc.re; CLim[h * 64 + p] = cc.im;
                const C2f bb = cmulf(cf, C2f{F.in[I_BRE][(g * SP + p) * 16 + h], F.in[I_BIM][(g * SP + p) * 16 + h]}); BBre[p * 16 + h] = bb.re; BBim[p * 16 + h] = bb.im; }
            LDS_WAIT(); asm volatile("" ::: "memory");
            float o[4];
#pragma unroll
            for (int qq = 0; qq < 4; ++qq) { const int idx = lane * 4 + qq, h = idx >> 4, h2 = idx & 15; float s = 0.f;
                for (int pp = 0; pp < 64; ++pp) s += CLre[h * 64 + pp] * BBre[pp * 16 + h2] - CLim[h * 64 + pp] * BBim[pp * 16 + h2];
                o[qq] = s; }
            u32x2 w; w.x = pk2(o[0], o[1]); w.y = pk2(o[2], o[3]);
            *(u32x2*)((bf16_t*)(ws + WS_KCONV) + (size_t)q * 256 + lane * 4) = w;
            LDS_WAIT(); asm volatile("" ::: "memory");
        }
        else if (it < R8) {
            const int q = it - R7, g = q >> 6, s = q & 63, p = lane; C2f lb, cf; s5_fast(F, g, p, lb, cf); const C2f pw = cmulf(cpowf_(lb, 63 - s), cf);
            float re[16], im[16];
#pragma unroll
            for (int h = 0; h < 16; ++h) { const C2f w = cmulf(pw, C2f{F.in[I_BRE][(g * SP + p) * 16 + h], F.in[I_BIM][(g * SP + p) * 16 + h]}); re[h] = w.re; im[h] = w.im; }
            bf16_t* o0 = (bf16_t*)(ws + WS_WE) + ((size_t)(g * 256 + p) * 1024 + s * 16); bf16_t* o1 = o0 + (size_t)64 * 1024;
            u32x4 a, b; a.x = pk2(re[0], re[1]); a.y = pk2(re[2], re[3]); a.z = pk2(re[4], re[5]); a.w = pk2(re[6], re[7]); b.x = pk2(re[8], re[9]); b.y = pk2(re[10], re[11]); b.z = pk2(re[12], re[13]); b.w = pk2(re[14], re[15]);
            *(u32x4*)o0 = a; *(u32x4*)(o0 + 8) = b;
            a.x = pk2(im[0], im[1]); a.y = pk2(im[2], im[3]); a.z = pk2(im[4], im[5]); a.w = pk2(im[6], im[7]); b.x = pk2(im[8], im[9]); b.y = pk2(im[10], im[11]); b.z = pk2(im[12], im[13]); b.w = pk2(im[14], im[15]);
            *(u32x4*)o1 = a; *(u32x4*)(o1 + 8) = b;
        }
        else if (it < R9) {
            const int q = it - R8, g = q >> 6, t = q & 63, p = lane; C2f lb, cf; s5_fast(F, g, p, lb, cf); const C2f pw = cpowf_(lb, t + 1);
            for (int h = 0; h < 16; ++h) { const C2f cc = cmulf(C2f{F.in[I_CRE][(g * 16 + h) * SP + p], F.in[I_CIM][(g * 16 + h) * SP + p]}, pw);
                bf16_t* o = (bf16_t*)(ws + WS_TZ) + ((size_t)(g * 1024 + t * 16 + h) * UAK + 1024 + p); o[0] = (bf16_t)f2bf(cc.re); o[64] = (bf16_t)f2bf(-cc.im); }
        }
        else if (it < R10) {
            const int g = it - R9, p = lane; const C2 l1 = s5_pow(F, g, p, 1), cf = s5_coef(F, g, p); C2 l64 = l1;
#pragma unroll
            for (int q2 = 0; q2 < 6; ++q2) l64 = cmul(l64, l64);
            ((f32x2*)(ws + WS_LAMB))[g * SP + p] = (f32x2){(float)l1.re, (float)l1.im}; ((f32x2*)(ws + WS_LAMC))[g * SP + p] = (f32x2){(float)l64.re, (float)l64.im};
            for (int h = 0; h < 16; ++h) { const C2 bb = cmul(cf, C2{(double)F.in[I_BRE][(g * SP + p) * 16 + h], (double)F.in[I_BIM][(g * SP + p) * 16 + h]}); ((f32x2*)(ws + WS_BBAR))[(g * SP + p) * 16 + h] = (f32x2){(float)bb.re, (float)bb.im}; }
        }
        else if (it < R11) {
            const int q = it - R10, cg = q >> 4, kq = q & 15; const int wcol = (cg < 8 ? cg * 64 : (cg < 16 ? 1024 + (cg - 8) * 64 : 1536 + (cg - 16) * 64)) + lane;
            const float* meta = F.in[I_META]; const float* g1 = F.in[I_N1G];
            { const int k = kq * 64 + lane; const float gk = g1[k];
#pragma unroll
              for (int r = 0; r < 16; ++r) scr[lane * 16 + r] = meta[r * D + k] * gk; }
            LDS_WAIT(); asm volatile("" ::: "memory");
            float a[16];
#pragma unroll
            for (int r = 0; r < 16; ++r) a[r] = 0.f;
            const float* wp = F.in[I_WIN] + (size_t)(kq * 64) * INW + wcol;
#pragma unroll 16
            for (int kk = 0; kk < 64; ++kk) { const float w = wp[(size_t)kk * INW]; const LAS f32x4* xs = (const LAS f32x4*)(scr + kk * 16);
                const f32x4 x0 = xs[0], x1 = xs[1], x2 = xs[2], x3 = xs[3];
                a[0] += w * x0[0]; a[1] += w * x0[1]; a[2] += w * x0[2]; a[3] += w * x0[3]; a[4] += w * x1[0]; a[5] += w * x1[1]; a[6] += w * x1[2]; a[7] += w * x1[3];
                a[8] += w * x2[0]; a[9] += w * x2[1]; a[10] += w * x2[2]; a[11] += w * x2[3]; a[12] += w * x3[0]; a[13] += w * x3[1]; a[14] += w * x3[2]; a[15] += w * x3[3]; }
            float* pm = (float*)(ws + WS_PMETA);
#pragma unroll
            for (int r = 0; r < 16; ++r) pm[(size_t)(kq * 16 + r) * 1536 + cg * 64 + lane] = a[r];
            LDS_WAIT(); asm volatile("" ::: "memory");
        }
        else if (it < R12) {
            const int k = (it - R11) * 64 + lane; bf16_t* hi = (bf16_t*)(ws + WS_WRT); bf16_t* lo = hi + NE * D;
            for (int e = 0; e < NE; ++e) { const float w = F.in[I_WR][k * NE + e]; const unsigned h = f2bf(w); hi[e * D + k] = (bf16_t)h; lo[e * D + k] = (bf16_t)f2bf(w - bf2f(h)); }
        }
        else if (it < R13) {
            for (int d = lane; d < HW; d += 64) ((float*)(ws + WS_LBV))[d] = sigmoidf_(F.in[I_LBL][d] - F.in[I_LBL][HW + d]);
        }
        else {
            const int q = it - R13, g = q >> 6, r0 = 128 + (q & 63) * 2; u32x4* o = (u32x4*)((bf16_t*)(ws + WS_WE) + (size_t)(g * 256 + r0) * 1024);
#pragma unroll
            for (int j = 0; j < 4; ++j) o[lane + 64 * j] = (u32x4){0u, 0u, 0u, 0u};
        }
    }
    const float* g1 = F.in[I_N1G];
    for (int m = gw; m < ((var & 1024) ? 0 : T); m += 2 * NGW) {
        const int m2 = m + NGW; const bool two = m2 < T;
        const f32x4* xr = (const f32x4*)(F.in[I_X] + (size_t)m * D) + lane; const f32x4* xr2 = (const f32x4*)(F.in[I_X] + (size_t)(two ? m2 : m) * D) + lane; f32x4 v[4], w2[4]; float s = 0.f, s2 = 0.f;
#pragma unroll
        for (int j = 0; j < 4; ++j) { v[j] = xr[64 * j]; w2[j] = xr2[64 * j]; }
#pragma unroll
        for (int j = 0; j < 4; ++j) { s += (v[j].x * v[j].x + v[j].y * v[j].y) + (v[j].z * v[j].z + v[j].w * v[j].w); s2 += (w2[j].x * w2[j].x + w2[j].y * w2[j].y) + (w2[j].z * w2[j].z + w2[j].w * w2[j].w); }
        const float rstd = 1.0f / sqrtf(wave_sum(s) * (1.0f / D) + EPS), rstd2 = 1.0f / sqrtf(wave_sum(s2) * (1.0f / D) + EPS);
        if (MK_GATES_F8 && !MK_P1_F8) { unsigned* o4 = (unsigned*)(ws + WS_XN8 + (size_t)m * D) + lane; unsigned* o42 = (unsigned*)(ws + WS_XN8 + (size_t)m2 * D) + lane;
#pragma unroll
            for (int j = 0; j < 4; ++j) { const f32x4 gg = ((const f32x4*)g1)[lane + 64 * j]; o4[64 * j] = pk4_fp8(v[j].x * rstd * gg.x, v[j].y * rstd * gg.y, v[j].z * rstd * gg.z, v[j].w * rstd * gg.w);
                if (two) o42[64 * j] = pk4_fp8(w2[j].x * rstd2 * gg.x, w2[j].y * rstd2 * gg.y, w2[j].z * rstd2 * gg.z, w2[j].w * rstd2 * gg.w); } }
        if (MK_P1_F8) { unsigned* o4 = (unsigned*)(ws + WS_XN + (size_t)m * D) + lane; unsigned* o42 = (unsigned*)(ws + WS_XN + (size_t)m2 * D) + lane;
#pragma unroll
            for (int j = 0; j < 4; ++j) { const f32x4 gg = ((const f32x4*)g1)[lane + 64 * j]; o4[64 * j] = pk4_fp8(v[j].x * rstd * gg.x, v[j].y * rstd * gg.y, v[j].z * rstd * gg.z, v[j].w * rstd * gg.w);
                if (two) o42[64 * j] = pk4_fp8(w2[j].x * rstd2 * gg.x, w2[j].y * rstd2 * gg.y, w2[j].z * rstd2 * gg.z, w2[j].w * rstd2 * gg.w); } }
        else {
        u32x2* o8 = (u32x2*)((bf16_t*)(ws + WS_XN) + (size_t)m * D) + lane; u32x2* o82 = (u32x2*)((bf16_t*)(ws + WS_XN) + (size_t)m2 * D) + lane;
#pragma unroll
        for (int j = 0; j < 4; ++j) { const f32x4 gg = ((const f32x4*)g1)[lane + 64 * j]; u32x2 w; w.x = pk2(v[j].x * rstd * gg.x, v[j].y * rstd * gg.y); w.y = pk2(v[j].z * rstd * gg.z, v[j].w * rstd * gg.w); o8[64 * j] = w;
            if (two) { w.x = pk2(w2[j].x * rstd2 * gg.x, w2[j].y * rstd2 * gg.y); w.y = pk2(w2[j].z * rstd2 * gg.z, w2[j].w * rstd2 * gg.w); o82[64 * j] = w; } }
        }
    }
}
__device__ __forceinline__ void p1_toeplitz(Frame& F) {
    { const float* pm = (const float*)(F.ws + WS_PMETA); float* pr = (float*)(F.ws + WS_PMR);
      LAS float* rs = (LAS float*)F.lds;
      for (int r = F.wave; r < 16; r += 8) { float sq = 0.f;
#pragma unroll
          for (int j = 0; j < 16; ++j) { const float v = F.in[I_META][r * D + F.lane + 64 * j]; sq += v * v; }
          sq = wave_sum(sq); if (F.lane == 0) rs[r] = 1.0f / sqrtf(sq * (1.0f / D) + EPS); }
      __syncthreads();
      for (int i = F.vcu * 512 + F.tid; i < 16 * 1536; i += F.G * 512) { float sm = 0.f;
#pragma unroll
          for (int kq = 0; kq < 16; ++kq) sm += pm[(size_t)kq * 16 * 1536 + i]; pr[i] = sm * rs[i / 1536]; }
      __syncthreads(); }
    const int gw = F.vcu * 8 + F.wave, NGW = F.G * 8, lane = F.lane; const bf16_t* kc = (const bf16_t*)(F.ws + WS_KCONV); bf16_t* tz = (bf16_t*)(F.ws + WS_TZ);
    for (int row = gw; row < SG * 1024; row += NGW) { const int g = row >> 10, t = (row >> 4) & 63, h = row & 15;
#pragma unroll
        for (int j = 0; j < 2; ++j) { const int q = lane + 64 * j, s = q >> 1, half = q & 1; u32x4 v = (u32x4){0u, 0u, 0u, 0u};
            if (s <= t) v = *(const u32x4*)(kc + ((size_t)((g * 64 + (t - s)) * 16 + h) * 16 + half * 8));
            *(u32x4*)(tz + (size_t)row * UAK + s * 16 + half * 8) = v; } }
}

constexpr int ST64 = 144, ST128 = 272;
template <int K> __device__ __forceinline__ void mma_nt32k(f32x16& acc, const LAS unsigned char* A, int sa, const LAS unsigned char* B, int sb, int lane) {
    const LAS unsigned char* pa = A + (lane & 31) * sa + (lane >> 5) * 16; const LAS unsigned char* pb = B + (lane & 31) * sb + (lane >> 5) * 16;
#pragma unroll
    for (int k = 0; k < K; k += 16) { const bf16x8 a = *(const LAS bf16x8*)(pa + k * 2), b = *(const LAS bf16x8*)(pb + k * 2); acc = __builtin_amdgcn_mfma_f32_32x32x16_bf16(a, b, acc, 0, 0, 0); }
}
__device__ __forceinline__ void hga_load(Frame& F, int unit, float (&lf)[16], u32x4 (&vv)[2]) {
    const int tid = F.tid; const int bh = unit >> 7, c = unit & 127, tok0 = (bh >> 2) * SEQ + c * CH, hcol = (bh & 3) * HD; const int d = tid & 127, seg = tid >> 7;
    const float* lg = (const float*)(F.ws + WS_LOGF) + (size_t)(tok0 + seg * 16) * HW + hcol + d;
#pragma unroll
    for (int j = 0; j < 16; ++j) lf[j] = lg[(size_t)j * HW];
#pragma unroll
    for (int i = 0; i < 2; ++i) vv[i] = *(const u32x4*)((const bf16_t*)(F.ws + WS_V) + (size_t)(tok0 + (tid & 63)) * HW + hcol + ((tid >> 6) + 8 * i) * 8);
}
__device__ __forceinline__ void hgrn_a_phase(Frame& F, int first, int stride, int count) {
    const int tid = F.tid, lane = F.lane, wave = F.wave;
    LAS unsigned char* KT = F.lds; LAS unsigned char* VT = F.lds + 128 * ST64; LAS float* segtot = (LAS float*)(F.lds + 2 * 128 * ST64); LAS unsigned char* OT = (LAS unsigned char*)(segtot + 512);
    const int d = tid & 127, seg = tid >> 7;
    int unit = first; if (unit >= 16 * NCH) return;
    float lf[16]; u32x4 vv[2]; hga_load(F, unit, lf, vv);
    for (;;) {
        const int bh = unit >> 7, c = unit & 127, b = bh >> 2, h = bh & 3, tok0 = b * SEQ + c * CH, hcol = h * HD;
        float cs[16]; float run = 0.f;
#pragma unroll
        for (int j = 0; j < 16; ++j) { run += lf[j]; cs[j] = run; }
        segtot[seg * 128 + d] = run;
#pragma unroll
        for (int i = 0; i < 2; ++i) { const int e0 = ((tid >> 6) + 8 * i) * 8; LAS bf16_t* o = (LAS bf16_t*)(VT + e0 * ST64 + (tid & 63) * 2); const u32x4 v = vv[i];
            o[0 * (ST64 / 2)] = (bf16_t)(v.x & 0xffffu); o[1 * (ST64 / 2)] = (bf16_t)(v.x >> 16); o[2 * (ST64 / 2)] = (bf16_t)(v.y & 0xffffu); o[3 * (ST64 / 2)] = (bf16_t)(v.y >> 16);
            o[4 * (ST64 / 2)] = (bf16_t)(v.z & 0xffffu); o[5 * (ST64 / 2)] = (bf16_t)(v.z >> 16); o[6 * (ST64 / 2)] = (bf16_t)(v.w & 0xffffu); o[7 * (ST64 / 2)] = (bf16_t)(v.w >> 16); }
        __syncthreads();
        const float t0 = segtot[d], t1 = segtot[128 + d], t2 = segtot[256 + d], t3 = segtot[384 + d];
        const float pre = seg == 0 ? 0.f : (seg == 1 ? t0 : (seg == 2 ? t0 + t1 : t0 + t1 + t2)); const float total = (t0 + t1) + (t2 + t3);
        float kk[16];
#pragma unroll
        for (int j = 0; j < 16; ++j) { cs[j] += pre; kk[j] = (1.0f - __expf(lf[j])) * __expf(total - cs[j]); }
        u32x4 w0, w1; w0.x = cvt_pk_bf16(kk[0], kk[1]); w0.y = cvt_pk_bf16(kk[2], kk[3]); w0.z = cvt_pk_bf16(kk[4], kk[5]); w0.w = cvt_pk_bf16(kk[6], kk[7]); w1.x = cvt_pk_bf16(kk[8], kk[9]); w1.y = cvt_pk_bf16(kk[10], kk[11]); w1.z = cvt_pk_bf16(kk[12], kk[13]); w1.w = cvt_pk_bf16(kk[14], kk[15]);
        *(LAS u32x4*)(KT + d * ST64 + seg * 32) = w0; *(LAS u32x4*)(KT + d * ST64 + seg * 32 + 16) = w1;
        if (seg == 0) ((float*)(F.ws + WS_DEC))[(size_t)unit * HD + d] = __expf(total);
        { float* bc = (float*)(F.ws + WS_BCUM) + (size_t)(tok0 + seg * 16) * HW + hcol + d;
#pragma unroll
          for (int j = 0; j < 16; ++j) bc[(size_t)j * HW] = cs[j]; }
        const int un = unit + stride; const bool more = (un < 16 * NCH) && (--count > 0);
        if (more) hga_load(F, un, lf, vv);
        __syncthreads();
#pragma unroll
        for (int i = 0; i < 2; ++i) { const int tile = wave * 2 + i, et = tile >> 2, dt = tile & 3; f32x16 acc;
#pragma unroll
            for (int r = 0; r < 16; ++r) acc[r] = 0.f;
            mma_nt32k<64>(acc, VT + et * 32 * ST64, ST64, KT + dt * 32 * ST64, ST64, lane);
#pragma unroll
            for (int r = 0; r < 16; ++r) { const int e = et * 32 + (r & 3) + 8 * (r >> 2) + 4 * (lane >> 5); ((LAS bf16_t*)(OT + e * ST128))[dt * 32 + (lane & 31)] = (bf16_t)f2bf(acc[r]); } }
        __syncthreads();
        { bf16_t* kvt = (bf16_t*)(F.ws + WS_KVT) + (size_t)unit * HD * HD;
#pragma unroll
          for (int i = 0; i < 4; ++i) { const int p = tid + 512 * i, e = p >> 4, d0 = (p & 15) * 8; *(u32x4*)(kvt + (size_t)e * HD + d0) = *(const LAS u32x4*)(OT + e * ST128 + d0 * 2); } }
        if (!more) break;
        unit = un;
    }
    __syncthreads();
}
struct HgPre { u32x4 q[2]; f32x4 bj[2][2], bp[2][2], bm[2]; u32x4 v[2], sp[4]; };
__device__ __forceinline__ void hgc_load(Frame& F, int unit, HgPre& P) {
    const int tid = F.tid; const int bh = unit >> 7, c = unit & 127, b = bh >> 2, h = bh & 3, tok0 = b * SEQ + c * CH, hcol = h * HD;
    const bf16_t* qg = (const bf16_t*)(F.ws + WS_Q); const float* bc = (const float*)(F.ws + WS_BCUM); const bf16_t* vg = (const bf16_t*)(F.ws + WS_V); const bf16_t* sp = (const bf16_t*)(F.ws + WS_SPREV) + (size_t)unit * HD * HD;
    const int d0 = (tid & 15) * 8;
#pragma unroll
    for (int i = 0; i < 2; ++i) { const int j = (tid >> 4) + 32 * i; const size_t o = (size_t)(tok0 + j) * HW + hcol + d0;
        P.q[i] = *(const u32x4*)(qg + o); P.bj[i][0] = *(const f32x4*)(bc + o); P.bj[i][1] = *(const f32x4*)(bc + o + 4);
        if (j > 0) { P.bp[i][0] = *(const f32x4*)(bc + o - HW); P.bp[i][1] = *(const f32x4*)(bc + o - HW + 4); } else { P.bp[i][0] = (f32x4){0.f, 0.f, 0.f, 0.f}; P.bp[i][1] = (f32x4){0.f, 0.f, 0.f, 0.f}; }
        const int e0 = ((tid >> 6) + 8 * i) * 8; P.v[i] = *(const u32x4*)(vg + (size_t)(tok0 + (tid & 63)) * HW + hcol + e0); }
    { const size_t o = (size_t)(tok0 + 31) * HW + hcol + d0; P.bm[0] = *(const f32x4*)(bc + o); P.bm[1] = *(const f32x4*)(bc + o + 4); }
#pragma unroll
    for (int i = 0; i < 4; ++i) { const int p = tid + 512 * i; P.sp[i] = *(const u32x4*)(sp + (size_t)(p >> 4) * HD + (p & 15) * 8); }
}
__device__ __forceinline__ void hgrn_c_phase(Frame& F) {
    const int tid = F.tid, lane = F.lane, wave = F.wave;
    LAS unsigned char* Q1 = F.lds; LAS unsigned char* K1 = Q1 + 64 * ST128; LAS unsigned char* Q2 = K1 + 64 * ST128; LAS unsigned char* VT = Q2 + 64 * ST128;
    LAS unsigned char* PP = VT + 128 * ST64; LAS unsigned char* SPL = PP + 64 * ST64; LAS float* RS = (LAS float*)(SPL + 128 * ST128); LAS unsigned char* OL = Q1;
    int unit = F.bx; if (unit >= 16 * NCH) return;
    HgPre P; hgc_load(F, unit, P);
    u32x4 gsv[2];
    { const int bh = unit >> 7, c = unit & 127, tok0 = (bh >> 2) * SEQ + c * CH, hcol = (bh & 3) * HD;
#pragma unroll
      for (int i = 0; i < 2; ++i) gsv[i] = *(const u32x4*)((const bf16_t*)(F.ws + WS_GS) + (size_t)(tok0 + (tid >> 4) + 32 * i) * HW + hcol + (tid & 15) * 8); }
    for (;;) {
        const int bh = unit >> 7, c = unit & 127, b = bh >> 2, h = bh & 3, tok0 = b * SEQ + c * CH, hcol = h * HD;
        { const int d0 = (tid & 15) * 8;
#pragma unroll
          for (int i = 0; i < 2; ++i) { const int j = (tid >> 4) + 32 * i; float q1[8], k1[8], q2[8];
              const unsigned qw[4] = {P.q[i].x, P.q[i].y, P.q[i].z, P.q[i].w};
#pragma unroll
              for (int k = 0; k < 8; ++k) { const float bb = P.bj[i][k >> 2][k & 3], bm = P.bm[k >> 2][k & 3], lf = bb - P.bp[i][k >> 2][k & 3]; const float q = bf2f((qw[k >> 1] >> ((k & 1) * 16)) & 0xffffu);
                  const float kx = 1.0f - __expf(lf), ed = __expf(bb - bm); q1[k] = q * ed; k1[k] = kx * __expf(bm - bb); q2[k] = q * __expf(bb); }
              u32x4 w; w.x = cvt_pk_bf16(q1[0], q1[1]); w.y = cvt_pk_bf16(q1[2], q1[3]); w.z = cvt_pk_bf16(q1[4], q1[5]); w.w = cvt_pk_bf16(q1[6], q1[7]); *(LAS u32x4*)(Q1 + j * ST128 + d0 * 2) = w;
              w.x = cvt_pk_bf16(k1[0], k1[1]); w.y = cvt_pk_bf16(k1[2], k1[3]); w.z = cvt_pk_bf16(k1[4], k1[5]); w.w = cvt_pk_bf16(k1[6], k1[7]); *(LAS u32x4*)(K1 + j * ST128 + d0 * 2) = w;
              w.x = cvt_pk_bf16(q2[0], q2[1]); w.y = cvt_pk_bf16(q2[2], q2[3]); w.z = cvt_pk_bf16(q2[4], q2[5]); w.w = cvt_pk_bf16(q2[6], q2[7]); *(LAS u32x4*)(Q2 + j * ST128 + d0 * 2) = w;
              const int e0 = ((tid >> 6) + 8 * i) * 8; LAS bf16_t* o = (LAS bf16_t*)(VT + e0 * ST64 + (tid & 63) * 2); const u32x4 v = P.v[i];
              o[0 * (ST64 / 2)] = (bf16_t)(v.x & 0xffffu); o[1 * (ST64 / 2)] = (bf16_t)(v.x >> 16); o[2 * (ST64 / 2)] = (bf16_t)(v.y & 0xffffu); o[3 * (ST64 / 2)] = (bf16_t)(v.y >> 16);
              o[4 * (ST64 / 2)] = (bf16_t)(v.z & 0xffffu); o[5 * (ST64 / 2)] = (bf16_t)(v.z >> 16); o[6 * (ST64 / 2)] = (bf16_t)(v.w & 0xffffu); o[7 * (ST64 / 2)] = (bf16_t)(v.w >> 16); }
#pragma unroll
          for (int i = 0; i < 4; ++i) { const int p = tid + 512 * i; *(LAS u32x4*)(SPL + (p >> 4) * ST128 + (p & 15) * 16) = P.sp[i]; } }
        const int un = unit + F.G; const bool more = un < 16 * NCH;
        if (more) hgc_load(F, un, P);
        __syncthreads();
        const int it = wave >> 2, et = wave & 3; f32x16 acc;
#pragma unroll
        for (int r = 0; r < 16; ++r) acc[r] = 0.f;
        mma_nt32k<128>(acc, Q2 + it * 32 * ST128, ST128, SPL + et * 32 * ST128, ST128, lane);
        if (wave < 3) { const int si = wave ? 1 : 0, sj = wave == 2 ? 1 : 0; f32x16 sc;
#pragma unroll
            for (int r = 0; r < 16; ++r) sc[r] = 0.f;
            mma_nt32k<128>(sc, Q1 + si * 32 * ST128, ST128, K1 + sj * 32 * ST128, ST128, lane);
#pragma unroll
            for (int r = 0; r < 16; ++r) { const int i = si * 32 + (r & 3) + 8 * (r >> 2) + 4 * (lane >> 5), j = sj * 32 + (lane & 31); ((LAS bf16_t*)(PP + i * ST64))[j] = (bf16_t)f2bf(j <= i ? sc[r] : 0.f); } }
        else if (wave == 3) {
#pragma unroll
            for (int r = 0; r < 16; ++r) { const int i = (r & 3) + 8 * (r >> 2) + 4 * (lane >> 5); ((LAS bf16_t*)(PP + i * ST64))[32 + (lane & 31)] = (bf16_t)0; } }
        __syncthreads();
        mma_nt32k<64>(acc, PP + it * 32 * ST64, ST64, VT + et * 32 * ST64, ST64, lane);
#pragma unroll
        for (int r = 0; r < 16; ++r) { const int i = it * 32 + (r & 3) + 8 * (r >> 2) + 4 * (lane >> 5); ((LAS bf16_t*)(OL + i * ST128))[et * 32 + (lane & 31)] = (bf16_t)f2bf(acc[r]); }
        __syncthreads();
        { const int eo = (tid & 15) * 8; const f32x4 g0 = *(const f32x4*)(F.in[I_HNG] + hcol + eo), g1 = *(const f32x4*)(F.in[I_HNG] + hcol + eo + 4); bf16_t* yo = (bf16_t*)(F.ws + WS_YHG);
#pragma unroll
          for (int i = 0; i < 2; ++i) { const int row = (tid >> 4) + 32 * i; const u32x4 o = *(const LAS u32x4*)(OL + row * ST128 + eo * 2); const u32x4 gq = gsv[i];
              const float x[8] = {bf2f(o.x & 0xffffu), bf2f(o.x >> 16), bf2f(o.y & 0xffffu), bf2f(o.y >> 16), bf2f(o.z & 0xffffu), bf2f(o.z >> 16), bf2f(o.w & 0xffffu), bf2f(o.w >> 16)};
              float ss = ((x[0] * x[0] + x[1] * x[1]) + (x[2] * x[2] + x[3] * x[3])) + ((x[4] * x[4] + x[5] * x[5]) + (x[6] * x[6] + x[7] * x[7]));
              ss += __shfl_xor(ss, 1); ss += __shfl_xor(ss, 2); ss += __shfl_xor(ss, 4); ss += __shfl_xor(ss, 8);
              const float rstd = 1.0f / sqrtf(ss * (1.0f / HD) + EPS);
              f32x4 y0, y1; y0[0] = x[0] * rstd * g0[0] * bf2f(gq.x & 0xffffu); y0[1] = x[1] * rstd * g0[1] * bf2f(gq.x >> 16); y0[2] = x[2] * rstd * g0[2] * bf2f(gq.y & 0xffffu); y0[3] = x[3] * rstd * g0[3] * bf2f(gq.y >> 16);
              y1[0] = x[4] * rstd * g1[0] * bf2f(gq.z & 0xffffu); y1[1] = x[5] * rstd * g1[1] * bf2f(gq.z >> 16); y1[2] = x[6] * rstd * g1[2] * bf2f(gq.w & 0xffffu); y1[3] = x[7] * rstd * g1[3] * bf2f(gq.w >> 16);
              *(u32x4*)(yo + (size_t)(tok0 + row) * HW + hcol + eo) = pack8(y0, y1); } }
        if (!more) break;
        unit = un;
        { const int bh2 = unit >> 7, c2 = unit & 127, tk = (bh2 >> 2) * SEQ + c2 * CH, hc = (bh2 & 3) * HD;
#pragma unroll
          for (int i = 0; i < 2; ++i) gsv[i] = *(const u32x4*)((const bf16_t*)(F.ws + WS_GS) + (size_t)(tk + (tid >> 4) + 32 * i) * HW + hc + (tid & 15) * 8); }
        __syncthreads();
    }
    __syncthreads();
}

__device__ __forceinline__ void stagger(const Frame& F, int units) {
    const unsigned long long t0 = __builtin_amdgcn_s_memrealtime(), dt = (unsigned long long)(((F.bx >> 3) & 3) * units);
    while (__builtin_amdgcn_s_memrealtime() - t0 < dt) __builtin_amdgcn_s_sleep(8);
}
__device__ __forceinline__ void phase0(Frame& F, const int var) {
    unsigned char* ws = F.ws; (void)ws;
    p0_prologue(F, var);
}
__device__ __forceinline__ void phase1(Frame& F, const int var) {
    unsigned char* ws = F.ws; (void)ws;
        p1_toeplitz(F);
        EpiInProj E{(bf16_t*)(ws + WS_UA), (bf16_t*)(ws + WS_Q), (bf16_t*)(ws + WS_V), (bf16_t*)(ws + WS_GS), (bf16_t*)(ws + WS_GATES), (float*)(ws + WS_LOGF), (const float*)(ws + WS_LBV)};
        if (MK_GATES_F8 && !MK_P1_F8) {
            { SchedStatic S{(const char*)(ws + WS_XN), (const char*)(ws + WS_WIN), T / 256, 10, F.G, F.bx, (size_t)256 * D * 2, (size_t)256 * D * 2};
              pg8::gemm_phase<EpiInProj, SchedStatic, false, false>(F.lds, D, D, D, S, E, nullptr); }
            { SchedStatic S{(const char*)(ws + WS_XN8), (const char*)(ws + WS_WIN8), T / 256, 8, F.G, F.bx, (size_t)256 * D, (size_t)256 * D, 0, 10};
              pg8::gemm_phase<EpiInProj, SchedStatic, false, true>(F.lds, D, D, D, S, E, nullptr); }
        } else {
            SchedStatic S{(const char*)(ws + WS_XN), (const char*)(ws + WS_WIN), T / 256, INW / 256, F.G, F.bx, (size_t)256 * D * (MK_P1_F8 ? 1 : 2), (size_t)256 * D * (MK_P1_F8 ? 1 : 2)};
            pg8::gemm_phase<EpiInProj, SchedStatic, false, MK_P1_F8 != 0>(F.lds, D, D, D, S, E, nullptr);
        }
}
__device__ __forceinline__ void phase2(Frame& F, const int var) {
    unsigned char* ws = F.ws; (void)ws;
        { SchedS5E S{(const char*)(ws + WS_UA), (const char*)(ws + WS_WE), F.bx}; EpiS5E E{(float*)(ws + WS_SE)};
          pg8::gemm_phase<EpiS5E, SchedS5E, false>(F.lds, 1024, UAK, 1024, S, E, nullptr); }
        __syncthreads();
        const float* pm = (const float*)(ws + WS_PMR);
        if (F.bx >= 64 && F.bx < 68) {
            const int g = (F.bx - 64) * 8 + (F.tid >> 6), p = F.tid & 63; const f32x2 lb = ((const f32x2*)(ws + WS_LAMB))[g * SP + p]; float xr = 0.f, xi = 0.f;
            for (int s = 0; s < NMETA; ++s) { float ar = 0.f, ai = 0.f;
#pragma unroll
                for (int h = 0; h < 16; ++h) { const int col = g * 16 + h; const float uu = pm[(size_t)s * 1536 + col];
                    const f32x2 bb = ((const f32x2*)(ws + WS_BBAR))[(g * SP + p) * 16 + h]; ar += bb.x * uu; ai += bb.y * uu; }
                const float nr = lb.x * xr - lb.y * xi + ar, ni = lb.x * xi + lb.y * xr + ai; xr = nr; xi = ni; }
            float* xm = (float*)(ws + WS_XMETA); xm[g * 128 + p] = xr; xm[g * 128 + 64 + p] = xi;
        }
        if (F.bx >= 68 && F.bx < 196) {
            const int idx = (F.bx - 68) * 512 + F.tid, h = idx >> 14, e = (idx >> 7) & 127, d = idx & 127; const float lbv = ((const float*)(ws + WS_LBV))[h * HD + d]; float S = 0.f;
            for (int s = 0; s < NMETA; ++s) { const int cf = 512 + h * HD + d, cv = 1024 + h * HD + e;
                const float fp = pm[(size_t)s * 1536 + cf];
                const float vv = pm[(size_t)s * 1536 + cv];
                const float f = lbv + (1.0f - lbv) * sigmoidf_(fp); S = f * S + (1.0f - f) * vv; }
            ((float*)(ws + WS_SMETA))[idx] = S;
        }
        if (F.bx < 64) hgrn_a_phase(F, 4 * F.bx, 1, 4); else hgrn_a_phase(F, 256 + (F.bx - 64), F.G - 64, 1 << 20);
}
__device__ __forceinline__ void phase3(Frame& F, const int var) {
    unsigned char* ws = F.ws; (void)ws;
        {
            const int bh = F.bx >> 4, e = (F.bx & 15) * 8 + (F.tid >> 6), d = (F.tid & 63) * 2, h = bh & 3;
            f32x2 S = *(const f32x2*)((const float*)(ws + WS_SMETA) + (size_t)(h * HD + e) * HD + d);
            const unsigned* kv = (const unsigned*)((const bf16_t*)(ws + WS_KVT) + (size_t)bh * NCH * HD * HD + (size_t)e * HD + d); const float* dc = (const float*)(ws + WS_DEC) + (size_t)bh * NCH * HD + d;
            unsigned* sp = (unsigned*)((bf16_t*)(ws + WS_SPREV) + (size_t)bh * NCH * HD * HD + (size_t)e * HD + d);
            for (int c0 = 0; c0 < NCH; c0 += 16) { unsigned kq[16]; f32x2 dv[16];
#pragma unroll
                for (int j = 0; j < 16; ++j) { kq[j] = kv[(size_t)(c0 + j) * (HD * HD / 2)]; dv[j] = *(const f32x2*)(dc + (size_t)(c0 + j) * HD); }
#pragma unroll
                for (int j = 0; j < 16; ++j) { sp[(size_t)(c0 + j) * (HD * HD / 2)] = pk2(S.x, S.y); S.x = S.x * dv[j].x + bf2f(kq[j] & 0xffffu); S.y = S.y * dv[j].y + bf2f(kq[j] >> 16); } }
        }
        if (F.bx < 16) {
            const int b = F.bx >> 2, g = (F.bx & 3) * 8 + (F.tid >> 6), p = F.tid & 63; const f32x2 lc = ((const f32x2*)(ws + WS_LAMC))[g * SP + p];
            const float* xm = (const float*)(ws + WS_XMETA); float xr = xm[g * 128 + p], xi = xm[g * 128 + 64 + p];
            const float* se = (const float*)(ws + WS_SE) + ((size_t)g * 512 + b * 128) * 128 + p; bf16_t* ua = (bf16_t*)(ws + WS_UA) + ((size_t)g * 512 + b * 128) * UAK + 1024 + p;
            for (int c0 = 0; c0 < NCH; c0 += 8) { float er[8], ei[8];
#pragma unroll
                for (int j = 0; j < 8; ++j) { er[j] = se[(size_t)(c0 + j) * 128]; ei[j] = se[(size_t)(c0 + j) * 128 + 64]; }
#pragma unroll
                for (int j = 0; j < 8; ++j) { bf16_t* o = ua + (size_t)(c0 + j) * UAK; o[0] = (bf16_t)f2bf(xr); o[64] = (bf16_t)f2bf(xi);
                    const float nr = lc.x * xr - lc.y * xi + er[j], ni = lc.x * xi + lc.y * xr + ei[j]; xr = nr; xi = ni; } }
        }
}
__device__ __forceinline__ void phase4(Frame& F, const int var) {
    unsigned char* ws = F.ws; (void)ws;
        if (!(var & 64)) { SchedS5Y S{(const char*)(ws + WS_UA), (const char*)(ws + WS_TZ), F.bx, F.G}; EpiS5Y E{(const bf16_t*)(ws + WS_UA), F.in[I_SD], (bf16_t*)(ws + WS_Y1)};
          pg8::gemm_phase<EpiS5Y, SchedS5Y, false>(F.lds, UAK, UAK, UAK, S, E, nullptr); }
        __syncthreads();
        if (!(var & 128)) hgrn_c_phase(F);
}
__device__ __forceinline__ void phase5(Frame& F, const int var) {
    unsigned char* ws = F.ws; (void)ws;
        SchedStatic S{(const char*)(ws + WS_Y1), (const char*)(ws + WS_WGLU), T / 256, HW / 256, F.G, F.bx, (size_t)256 * HW * 2, (size_t)256 * HW * 2};
        EpiGlu E{(const bf16_t*)(ws + WS_Y1), (bf16_t*)(ws + WS_YS5)};
        pg8::gemm_phase<EpiGlu, SchedStatic, false>(F.lds, HW, HW, HW, S, E, nullptr);
}
__device__ __forceinline__ void phase6(Frame& F, const int var) {
    unsigned char* ws = F.ws; (void)ws;
        SchedBranch S{(const char*)(ws + WS_YS5), (const char*)(ws + WS_YHG), (const char*)(ws + WS_WBS), (const char*)(ws + WS_WBH), F.G, F.bx};
        EpiBranch E{(const bf16_t*)(ws + WS_GATES), (bf16_t*)(ws + WS_MERGED)};
        pg8::gemm_phase<EpiBranch, SchedBranch, false>(F.lds, HW, HW, HW, S, E, nullptr);
}
__device__ __forceinline__ void phase7(Frame& F, const int var) {
    unsigned char* ws = F.ws; (void)ws;
        SchedStatic S{(const char*)(ws + WS_MERGED), (const char*)(ws + WS_WOUT), T / 256, D / 256, F.G, F.bx, (size_t)256 * D * 2, (size_t)256 * D * 2, var};
        EpiOut E{F.in[I_X], (bf16_t*)(ws + WS_H1), (float*)(ws + WS_SSQ), var};
        pg8::gemm_phase<EpiOut, SchedStatic, false>(F.lds, D, D, D, S, E, nullptr, var);
}
__device__ __forceinline__ void phase8(Frame& F, const int var) {
    unsigned char* ws = F.ws; (void)ws;
        volatile LAS unsigned* hist = F.MISC + 16;
        if (F.tid < 32) hist[F.tid] = 0u;
        __syncthreads();
        const int lane = F.lane, tl = lane & 15, kg = lane >> 4; const float* g2 = F.in[I_N2G];
        { const u32x4* src = (const u32x4*)(ws + WS_WRT); LAS u32x4* dst = (LAS u32x4*)F.lds;
          for (int i = F.tid; i < 2 * NE * D / 8; i += 512) { const int row = i >> 7, ch = i & 127; *(LAS u32x4*)((LAS unsigned char*)dst + row * 2064 + ch * 16) = src[i]; } }
        __syncthreads();
        const LAS unsigned char* wh = F.lds; const LAS unsigned char* wl = F.lds + NE * 2064;
        for (int tile = F.vcu * 8 + F.wave; tile < T / 16; tile += F.G * 8) {
            const int tok = tile * 16 + tl; const bf16_t* hrow = (const bf16_t*)(ws + WS_H1) + (size_t)tok * D; const f32x4* sq = (const f32x4*)((const float*)(ws + WS_SSQ) + (size_t)tok * 16);
            const f32x4 s0 = sq[0], s1 = sq[1], s2 = sq[2], s3 = sq[3];
            const float ss = ((s0[0] + s0[1]) + (s0[2] + s0[3])) + ((s1[0] + s1[1]) + (s1[2] + s1[3])) + ((s2[0] + s2[1]) + (s2[2] + s2[3])) + ((s3[0] + s3[1]) + (s3[2] + s3[3]));
            const float rstd = 1.0f / sqrtf(ss * (1.0f / D) + EPS);
            f32x4 a0 = (f32x4){0.f, 0.f, 0.f, 0.f}, a1 = a0; unsigned char* xo = (unsigned char*)(ws + WS_XN2) + (size_t)tok * D;
#pragma unroll 1
            for (int kb = 0; kb < 32; kb += 8) { u32x4 hv[8];
#pragma unroll
                for (int u8 = 0; u8 < 8; ++u8) hv[u8] = *(const u32x4*)(hrow + (kb + u8) * 32 + kg * 8);
#pragma unroll
                for (int u8 = 0; u8 < 8; ++u8) { const int k = (kb + u8) * 32 + kg * 8; const f32x4 ga = *(const f32x4*)(g2 + k), gb = *(const f32x4*)(g2 + k + 4); const u32x4 hq = hv[u8];
                    float x[8] = {bf2f(hq.x & 0xffffu) * rstd * ga[0], bf2f(hq.x >> 16) * rstd * ga[1], bf2f(hq.y & 0xffffu) * rstd * ga[2], bf2f(hq.y >> 16) * rstd * ga[3], bf2f(hq.z & 0xffffu) * rstd * gb[0], bf2f(hq.z >> 16) * rstd * gb[1], bf2f(hq.w & 0xffffu) * rstd * gb[2], bf2f(hq.w >> 16) * rstd * gb[3]};
                    unsigned hb[8]; float lr[8];
#pragma unroll
                    for (int j = 0; j < 8; ++j) { hb[j] = f2bf(x[j]); lr[j] = x[j] - bf2f(hb[j]); }
                    u32x4 hi4; hi4.x = hb[0] | (hb[1] << 16); hi4.y = hb[2] | (hb[3] << 16); hi4.z = hb[4] | (hb[5] << 16); hi4.w = hb[6] | (hb[7] << 16);
                    u32x4 lo4; lo4.x = pk2(lr[0], lr[1]); lo4.y = pk2(lr[2], lr[3]); lo4.z = pk2(lr[4], lr[5]); lo4.w = pk2(lr[6], lr[7]);
                    { u32x2 q8; q8.x = pk4_fp8(x[0], x[1], x[2], x[3]); q8.y = pk4_fp8(x[4], x[5], x[6], x[7]); *(u32x2*)(xo + k) = q8; }
                    const bf16x8 xh = __builtin_bit_cast(bf16x8, hi4), xl = __builtin_bit_cast(bf16x8, lo4);
                    const bf16x8 wh0 = *(const LAS bf16x8*)(wh + tl * 2064 + k * 2), wh1 = *(const LAS bf16x8*)(wh + (16 + tl) * 2064 + k * 2), wl0 = *(const LAS bf16x8*)(wl + tl * 2064 + k * 2), wl1 = *(const LAS bf16x8*)(wl + (16 + tl) * 2064 + k * 2);
                    a0 = __builtin_amdgcn_mfma_f32_16x16x32_bf16(wh0, xh, a0, 0, 0, 0); a0 = __builtin_amdgcn_mfma_f32_16x16x32_bf16(wh0, xl, a0, 0, 0, 0); a0 = __builtin_amdgcn_mfma_f32_16x16x32_bf16(wl0, xh, a0, 0, 0, 0);
                    a1 = __builtin_amdgcn_mfma_f32_16x16x32_bf16(wh1, xh, a1, 0, 0, 0); a1 = __builtin_amdgcn_mfma_f32_16x16x32_bf16(wh1, xl, a1, 0, 0, 0); a1 = __builtin_amdgcn_mfma_f32_16x16x32_bf16(wl1, xh, a1, 0, 0, 0); } }
            float lg[8]; int le[8]; const float* br = F.in[I_BR];
#pragma unroll
            for (int j = 0; j < 4; ++j) { le[j] = 4 * kg + j; le[4 + j] = 16 + 4 * kg + j; lg[j] = a0[j] + br[le[j]]; lg[4 + j] = a1[j] + br[le[4 + j]]; }
            float tv[4]; int te[4];
#pragma unroll
            for (int r = 0; r < 4; ++r) { float bv = -3.0e38f; int be = 1 << 20;
#pragma unroll
                for (int j = 0; j < 8; ++j) if (lg[j] > bv || (lg[j] == bv && le[j] < be)) { bv = lg[j]; be = le[j]; }
#pragma unroll
                for (int o = 16; o <= 32; o <<= 1) { const float ov = __shfl_xor(bv, o); const int oe = __shfl_xor(be, o); if (ov > bv || (ov == bv && oe < be)) { bv = ov; be = oe; } }
                tv[r] = bv; te[r] = be;
#pragma unroll
                for (int j = 0; j < 8; ++j) if (le[j] == be) lg[j] = -3.0e38f; }
            if (kg == 0) { const float e1 = __expf(tv[1] - tv[0]), e2 = __expf(tv[2] - tv[0]), e3 = __expf(tv[3] - tv[0]); const float inv = 1.0f / (1.0f + e1 + e2 + e3);
                *(f32x4*)((float*)(ws + WS_TOPW) + (size_t)tok * 4) = (f32x4){inv, e1 * inv, e2 * inv, e3 * inv};
                int* tp = (int*)(ws + WS_TOPE) + (size_t)tok * 4; tp[0] = te[0]; tp[1] = te[1]; tp[2] = te[2]; tp[3] = te[3];
#pragma unroll
                for (int r = 0; r < 4; ++r) __hip_atomic_fetch_add((LAS unsigned*)(hist + te[r]), 1u, __ATOMIC_RELAXED, __HIP_MEMORY_SCOPE_WORKGROUP); }
        }
        __syncthreads();
        if (F.tid < 32) __hip_atomic_fetch_add(F.ctl + CW_CNT + F.tid, hist[F.tid], __ATOMIC_RELAXED, __HIP_MEMORY_SCOPE_AGENT);
}
__device__ __forceinline__ void phase9(Frame& F, const int var) {
    unsigned char* ws = F.ws; (void)ws;
        volatile LAS unsigned* sb = F.MISC + 16;
        LAS unsigned* base = (LAS unsigned*)F.lds; LAS unsigned* lcnt = base + 64; LAS unsigned* gb = base + 128; (void)sb;
        if (F.tid < 32) { lcnt[F.tid] = 0u; }
        if (F.tid == 0) { unsigned run = 0; for (int e = 0; e < NE; ++e) { const unsigned c = __hip_atomic_load(F.ctl + CW_CNT + e, __ATOMIC_RELAXED, __HIP_MEMORY_SCOPE_AGENT); base[e] = run * 256u; base[32 + e] = c; run += (c + 255u) >> 8; }
            base[96] = run; if (F.bx == 0) F.ctl[CW_NTILES] = run; }
        __syncthreads();
        if (F.bx == 0) { for (int e = 0; e < NE; ++e) { const unsigned t0 = base[e] >> 8, nt_ = (base[32 + e] + 255u) >> 8; for (unsigned t = F.tid; t < nt_; t += 512) ((int*)(ws + WS_TILEE))[t0 + t] = e; } }
        if (F.bx < NE) { const int e = F.bx; const unsigned c = base[32 + e], pe = ((c + 255u) >> 8) << 8; for (unsigned r = c + F.tid; r < pe; r += 512) { ((int*)(ws + WS_ROWTOK))[base[e] + r] = 0; ((int*)(ws + WS_ROWSLOT))[base[e] + r] = -1; } }
        for (int vb = F.bx; vb < T / 128; vb += F.G) {
            const int tok = vb * 128 + (F.tid >> 2), k = F.tid & 3; const int e = ((const int*)(ws + WS_TOPE))[(size_t)tok * 4 + k];
            const unsigned lr = __hip_atomic_fetch_add(lcnt + e, 1u, __ATOMIC_RELAXED, __HIP_MEMORY_SCOPE_WORKGROUP);
            __syncthreads();
            if (F.tid < 32) { gb[F.tid] = __hip_atomic_fetch_add(F.ctl + CW_FILL + F.tid, lcnt[F.tid], __ATOMIC_RELAXED, __HIP_MEMORY_SCOPE_AGENT); lcnt[F.tid] = 0u; }
            __syncthreads();
            const unsigned prow = base[e] + gb[e] + lr; ((int*)(ws + WS_ROWTOK))[prow] = tok; ((int*)(ws + WS_ROWSLOT))[prow] = tok * 4 + k;
            __syncthreads();
        }
}
__device__ __forceinline__ void phase10(Frame& F, const int var) {
    unsigned char* ws = F.ws; (void)ws;
        const int ntiles = (int)__hip_atomic_load(F.ctl + CW_NTILES, __ATOMIC_RELAXED, __HIP_MEMORY_SCOPE_AGENT);
        SchedMoe S{(const char*)(ws + WS_XN2), (const char*)(ws + WS_WGU), (const int*)(ws + WS_TILEE), ntiles, 8, F.G, F.bx, (size_t)2048 * D, (size_t)256 * D, true, var};
        EpiMoe1 E{F.in[I_BGU], (const int*)(ws + WS_TILEE), (unsigned char*)(ws + WS_A2), var};
        if (MK_STAGGER) stagger(F, MK_STAGGER * 10);
        pg8::gemm_phase<EpiMoe1, SchedMoe, true, true>(F.lds, D, D, D, S, E, (const int*)(ws + WS_ROWTOK));
}
__device__ __forceinline__ void phase11(Frame& F, const int var) {
    unsigned char* ws = F.ws; (void)ws;
        const int ntiles = (int)__hip_atomic_load(F.ctl + CW_NTILES, __ATOMIC_RELAXED, __HIP_MEMORY_SCOPE_AGENT);
        SchedMoe S{(const char*)(ws + WS_A2), (const char*)(ws + WS_WD), (const int*)(ws + WS_TILEE), ntiles, 4, F.G, F.bx, (size_t)D * DF, (size_t)256 * DF, false, var};
        EpiMoe2 E{F.in[I_BD], (const int*)(ws + WS_TILEE), (const int*)(ws + WS_ROWSLOT), (unsigned char*)(ws + WS_YS), var};
        pg8::gemm_phase<EpiMoe2, SchedMoe, false, true>(F.lds, DF, DF, DF, S, E, nullptr, var);
}
__device__ __forceinline__ void phase12(Frame& F, const int var) {
    unsigned char* ws = F.ws; (void)ws;
        const int lane = F.lane; const float* fg = F.in[I_FNG];
        float pe = 0.f; if (MK_STAMP >= 0) { const float dt = __builtin_bit_cast(float, __hip_atomic_load(F.ctl + 200, __ATOMIC_RELAXED, __HIP_MEMORY_SCOPE_AGENT)); pe = sqrtf(dt * MK_STAMP_SCALE); if (lane & 1) pe = -pe; }
        const int NW = F.G * 8; int tok = F.vcu * 8 + F.wave;
        u32x2 hq[4]; unsigned yq[4][4]; f32x4 wq;
#define P12_LOAD(t_) do { wq = *(const f32x4*)((const float*)(ws + WS_TOPW) + (size_t)(t_) * 4); _Pragma("unroll") for (int j = 0; j < 4; ++j) { hq[j] = *((const u32x2*)((const bf16_t*)(ws + WS_H1) + (size_t)(t_) * D) + lane + 64 * j); \
            _Pragma("unroll") for (int k = 0; k < 4; ++k) yq[j][k] = *((const unsigned*)((const unsigned char*)(ws + WS_YS) + ((size_t)(t_) * 4 + k) * D) + lane + 64 * j); } } while (0)
        if (tok < T) P12_LOAD(tok);
        for (; tok < T; tok += NW) {
            const float wk[4] = {wq[0], wq[1], wq[2], wq[3]}; f32x4 v[4]; float s = 0.f;
#pragma unroll
            for (int j = 0; j < 4; ++j) { v[j] = (f32x4){bf2f(hq[j].x & 0xffffu), bf2f(hq[j].x >> 16), bf2f(hq[j].y & 0xffffu), bf2f(hq[j].y >> 16)};
#pragma unroll
                for (int k = 0; k < 4; ++k) { const unsigned y = yq[j][k]; const f32x2 lo = __builtin_amdgcn_cvt_pk_f32_fp8((int)y, false), hi = __builtin_amdgcn_cvt_pk_f32_fp8((int)y, true);
                    v[j].x += wk[k] * lo.x; v[j].y += wk[k] * lo.y; v[j].z += wk[k] * hi.x; v[j].w += wk[k] * hi.y; }
                s += (v[j].x * v[j].x + v[j].y * v[j].y) + (v[j].z * v[j].z + v[j].w * v[j].w); }
            if (tok + NW < T) P12_LOAD(tok + NW);
            const float rstd = 1.0f / sqrtf(wave_sum(s) * (1.0f / D) + EPS);
            f32x4* o = (f32x4*)(F.out + (size_t)tok * D) + lane;
#pragma unroll
            for (int j = 0; j < 4; ++j) { const f32x4 gg = ((const f32x4*)fg)[lane + 64 * j]; o[64 * j] = (f32x4){v[j].x * rstd * gg.x * (1.f + pe), v[j].y * rstd * gg.y * (1.f - pe), v[j].z * rstd * gg.z * (1.f + pe), v[j].w * rstd * gg.w * (1.f - pe)}; }
        }
#undef P12_LOAD
}
struct Args { const float* in[26]; float* out; unsigned char* ws; int ph_lo, ph_hi; };
constexpr int NPHASE = 13;

__global__ void __launch_bounds__(512, 2) mk_fwd(Args args) {
    extern __shared__ __attribute__((aligned(16))) unsigned char lds[];
    Frame F;
    F.lds = (LAS unsigned char*)lds; F.MISC = (volatile LAS unsigned*)(F.lds + MISC_OFF);
    F.tid = threadIdx.x; F.lane = F.tid & 63; F.wave = __builtin_amdgcn_readfirstlane(F.tid >> 6);
    F.G = gridDim.x; F.bx = blockIdx.x; F.vcu = (F.G % 8 == 0) ? (F.bx % 8) * (F.G / 8) + F.bx / 8 : F.bx;
    F.ws = args.ws; F.ctl = (unsigned*)(args.ws + WS_CTL); F.out = args.out;
#pragma unroll
    for (int i = 0; i < 26; ++i) F.in[i] = args.in[i];
    for (int u = F.tid; u < 64; u += 512) F.MISC[u] = 0u;
    __syncthreads();
    unsigned char* ws = F.ws;
    XcdBarrier bar; bar.bar = F.ctl + CW_BAR; bar.x = 0; bar.st = nullptr;
    if (!MK_PER_PHASE) bar = xcd_barrier_post(F.ctl + CW_BAR, F.MISC + 8);
    const int lo = args.ph_lo, hi = args.ph_hi;
    unsigned long long ts_a = 0ull, ts_b = 0ull; (void)ts_a; (void)ts_b;
#define STAMP(k) do { if (MK_STAMP >= 0 && F.bx == 0 && F.tid == 0) { if ((k) == MK_STAMP) ts_a = __builtin_amdgcn_s_memrealtime(); if ((k) == MK_STAMP + 1) { ts_b = __builtin_amdgcn_s_memrealtime(); \
        __hip_atomic_store(F.ctl + 200, __builtin_bit_cast(unsigned, (float)(ts_b - ts_a) * 0.01f), __ATOMIC_RELAXED, __HIP_MEMORY_SCOPE_AGENT); } } } while (0)
#define IN(k) (lo <= (k) && (k) < hi)
#define SEAM(k) do { if (IN(k) && IN((k) + 1)) xcd_barrier(bar); } while (0)

    STAMP(0);
    if (IN(0)) { phase0(F, 0); if ((MK_REP_MASK >> 0) & 1) { xcd_barrier(bar); phase0(F, MK_VARIANT); } }
    SEAM(0);
    STAMP(1);
    if (IN(1)) { phase1(F, 0); if ((MK_REP_MASK >> 1) & 1) { xcd_barrier(bar); phase1(F, MK_VARIANT); } }
    SEAM(1);
    STAMP(2);
    if (IN(2)) { phase2(F, 0); if ((MK_REP_MASK >> 2) & 1) { xcd_barrier(bar); phase2(F, MK_VARIANT); } }
    SEAM(2);
    STAMP(3);
    if (IN(3)) { phase3(F, 0); if ((MK_REP_MASK >> 3) & 1) { xcd_barrier(bar); phase3(F, MK_VARIANT); } }
    SEAM(3);
    STAMP(4);
    if (IN(4)) { phase4(F, 0); if ((MK_REP_MASK >> 4) & 1) { xcd_barrier(bar); phase4(F, MK_VARIANT); } }
    SEAM(4);
    STAMP(5);
    if (IN(5)) { phase5(F, 0); if ((MK_REP_MASK >> 5) & 1) { xcd_barrier(bar); phase5(F, MK_VARIANT); } }
    SEAM(5);
    STAMP(6);
    if (IN(6)) { phase6(F, 0); if ((MK_REP_MASK >> 6) & 1) { xcd_barrier(bar); phase6(F, MK_VARIANT); } }
    SEAM(6);
    STAMP(7);
    if (IN(7)) { phase7(F, 0); if ((MK_REP_MASK >> 7) & 1) { xcd_barrier(bar); phase7(F, MK_VARIANT); } }
    SEAM(7);
    STAMP(8);
    if (IN(8)) { phase8(F, 0); if ((MK_REP_MASK >> 8) & 1) { xcd_barrier(bar); phase8(F, MK_VARIANT); } }
    SEAM(8);
    STAMP(9);
    if (IN(9)) { phase9(F, 0); if ((MK_REP_MASK >> 9) & 1) { xcd_barrier(bar); phase9(F, MK_VARIANT); } }
    SEAM(9);
    STAMP(10);
    if (IN(10)) { phase10(F, 0); if ((MK_REP_MASK >> 10) & 1) { xcd_barrier(bar); phase10(F, MK_VARIANT); } }
    SEAM(10);
    STAMP(11);
    if (IN(11)) { phase11(F, 0); if ((MK_REP_MASK >> 11) & 1) { xcd_barrier(bar); phase11(F, MK_VARIANT); } }
    SEAM(11);
    STAMP(12);
    if (IN(12)) { phase12(F, 0); if ((MK_REP_MASK >> 12) & 1) { xcd_barrier(bar); phase12(F, MK_VARIANT); } }
#undef IN
#undef SEAM
}

extern "C" void kernel_launch(void* const* d_in, const int* in_sizes, int n_in, void* d_out, int out_size, void* d_ws, size_t ws_size, hipStream_t stream) {
    static int grid = 0;
    if (grid == 0) {
        if (n_in != 26 || in_sizes[0] != T * D || out_size != T * D || ws_size < WS_END) { fprintf(stderr, "kernel_launch: unexpected shapes (n_in %d, in0 %d, out %d, ws %zu < %zu)\n", n_in, n_in > 0 ? in_sizes[0] : -1, out_size, ws_size, (size_t)WS_END); grid = -1; return; }
        int dev = 0, cus = 0, per_cu = 0;
        if (hipGetDevice(&dev) != hipSuccess || hipDeviceGetAttribute(&cus, hipDeviceAttributeMultiprocessorCount, dev) != hipSuccess) { grid = -1; return; }
        if (hipFuncSetAttribute((const void*)mk_fwd, hipFuncAttributeMaxDynamicSharedMemorySize, LDS_BYTES) != hipSuccess) { fprintf(stderr, "kernel_launch: hipFuncSetAttribute failed\n"); grid = -1; return; }
        if (hipOccupancyMaxActiveBlocksPerMultiprocessor(&per_cu, (const void*)mk_fwd, 512, LDS_BYTES) != hipSuccess || per_cu < 1) fprintf(stderr, "kernel_launch: occupancy query reports %d\n", per_cu);
        (void)hipGetLastError();
        grid = cus;
        if (grid != 256) fprintf(stderr, "kernel_launch: %d CUs (built for 256)\n", grid);
    }
    if (grid < 0) return;
    (void)hipMemsetAsync((char*)d_ws + WS_CTL, 0, 1 * MiB, stream);
    Args a{};
    for (int i = 0; i < 26; ++i) a.in[i] = (const float*)d_in[i];
    a.out = (float*)d_out; a.ws = (unsigned char*)d_ws;
#if MK_PER_PHASE
    for (int p = 0; p < NPHASE; ++p) { a.ph_lo = p; a.ph_hi = p + 1; hipLaunchKernelGGL(mk_fwd, dim3(grid), dim3(512), LDS_BYTES, stream, a); }
#else
    a.ph_lo = 0; a.ph_hi = NPHASE; hipLaunchKernelGGL(mk_fwd, dim3(grid), dim3(512), LDS_BYTES, stream, a);
#endif
}
```

```cpp
#include <hip/hip_runtime.h>
#include <cstdio>
#include <cstdint>

#ifndef MK_PER_PHASE
#define MK_PER_PHASE 0
#endif

#ifndef MK_REP_MASK
#define MK_REP_MASK 0
#endif

#ifndef MK_P1_F8
#define MK_P1_F8 0
#endif
#ifndef MK_GATES_F8
#define MK_GATES_F8 1
#endif
#ifndef MK_GSTORE_F8
#define MK_GSTORE_F8 1
#endif
#ifndef MK_STAGGER
#define MK_STAGGER 0
#endif
#ifndef MK_STAMP
#define MK_STAMP -1
#endif
#define MK_STAMP_SCALE 1e-5f
#ifndef MK_VARIANT
#define MK_VARIANT 0
#endif

#define LAS __attribute__((address_space(3)))
#define GAS __attribute__((address_space(1)))
typedef unsigned short bf16_t;
typedef short bf16x8 __attribute__((ext_vector_type(8)));
typedef float f32x4 __attribute__((ext_vector_type(4)));
typedef float f32x2 __attribute__((ext_vector_type(2)));
typedef float f32x16 __attribute__((ext_vector_type(16)));
typedef unsigned u32x4 __attribute__((ext_vector_type(4)));
typedef unsigned u32x2 __attribute__((ext_vector_type(2)));
typedef int i32x4 __attribute__((ext_vector_type(4)));
typedef int i32x8 __attribute__((ext_vector_type(8)));

constexpr int T = 32768, D = 1024, NB = 4, SEQ = 8192, NCH = 128, CH = 64, NMETA = 16, INW = 4608;
constexpr int SG = 32, SH = 16, SP = 64;
constexpr int HH = 4, HD = 128, HW = 512;
constexpr int NE = 32, TOPK = 4, DF = 1024;
constexpr int UAK = 1152;
constexpr float EPS = 1e-6f;
constexpr int MAXTILES = 544;

constexpr size_t MiB = 1u << 20, KiB = 1024;
constexpr size_t WS_CTL = 0;
constexpr size_t WS_LBV = 1 * MiB, WS_LAMB = 1 * MiB + 4 * KiB, WS_LAMC = 1 * MiB + 20 * KiB, WS_XMETA = 1 * MiB + 36 * KiB;
constexpr size_t WS_BBAR = 1 * MiB + 64 * KiB, WS_WRT = 1 * MiB + 320 * KiB, WS_PMR = 1 * MiB + 512 * KiB  ;
constexpr size_t WS_KCONV = 2 * MiB, WS_SMETA = 3 * MiB;
constexpr size_t WS_WIN = 4 * MiB, WS_WGLU = 13 * MiB, WS_WBS = 14 * MiB, WS_WBH = 15 * MiB, WS_WOUT = 16 * MiB, WS_WGU = 18 * MiB, WS_WD = 146 * MiB;
constexpr size_t WS_TZ = 210 * MiB, WS_WE = 282 * MiB, WS_XN = 298 * MiB, WS_UA = 362 * MiB, WS_Q = 398 * MiB, WS_LOGF = 430 * MiB, WS_V = 494 * MiB;
constexpr size_t WS_GS = 526 * MiB, WS_GATES = 558 * MiB, WS_KVT = 686 * MiB, WS_SPREV = 814 * MiB, WS_SE = 878 * MiB, WS_DEC = 886 * MiB;
constexpr size_t WS_Y1 = 888 * MiB, WS_YHG = 920 * MiB, WS_YS5 = 952 * MiB, WS_PMETA = 984 * MiB  , WS_XN8 = 986 * MiB  , WS_END = 1018 * MiB;
constexpr size_t WS_WIN8 = WS_WIN + 5 * MiB;
constexpr size_t WS_BCUM = 298 * MiB;
constexpr size_t WS_MERGED = 686 * MiB, WS_XN2 = 210 * MiB, WS_H1 = 274 * MiB, WS_SSQ = 402 * MiB, WS_TOPE = 404 * MiB, WS_TOPW = 404 * MiB + 512 * KiB;
constexpr size_t WS_ROWTOK = 405 * MiB, WS_ROWSLOT = 406 * MiB, WS_TILEE = 407 * MiB, WS_A2 = 408 * MiB, WS_YS = 680 * MiB;
constexpr int CW_CNT = 64, CW_FILL = 128, CW_NTILES = 192, CW_BAR = 4096;

constexpr int RING_BYTES = 131072, GOFF_LDS = RING_BYTES, MISC_OFF = RING_BYTES + 16384 + 256, LDS_BYTES = 155648;


__device__ __forceinline__ float bf2f(unsigned b) { return __builtin_bit_cast(float, b << 16); }

typedef __bf16 bf16x2_t __attribute__((ext_vector_type(2)));
__device__ __forceinline__ unsigned cvt_pk_bf16(float lo, float hi) { const bf16x2_t v = __builtin_convertvector((f32x2){lo, hi}, bf16x2_t); return __builtin_bit_cast(unsigned, v); }
__device__ __forceinline__ unsigned f2bf(float f) { const __bf16 h = (__bf16)f; return (unsigned)__builtin_bit_cast(unsigned short, h); }
__device__ __forceinline__ unsigned pk2(float lo, float hi) { return cvt_pk_bf16(lo, hi); }
__device__ __forceinline__ unsigned pk4_fp8(float a, float b, float c, float d) {
    a = __builtin_amdgcn_fmed3f(a, -448.f, 448.f); b = __builtin_amdgcn_fmed3f(b, -448.f, 448.f); c = __builtin_amdgcn_fmed3f(c, -448.f, 448.f); d = __builtin_amdgcn_fmed3f(d, -448.f, 448.f);
    int w = 0; w = __builtin_amdgcn_cvt_pk_fp8_f32(a, b, w, false); w = __builtin_amdgcn_cvt_pk_fp8_f32(c, d, w, true); return (unsigned)w; }
__device__ __forceinline__ unsigned pk4_fp8_nc(float a, float b, float c, float d) { int w = 0; w = __builtin_amdgcn_cvt_pk_fp8_f32(a, b, w, false); w = __builtin_amdgcn_cvt_pk_fp8_f32(c, d, w, true); return (unsigned)w; }
__device__ __forceinline__ unsigned pk4_u8(float a, float b, float c, float d) {
    return (unsigned)(a * 255.f + 0.5f) | ((unsigned)(b * 255.f + 0.5f) << 8) | ((unsigned)(c * 255.f + 0.5f) << 16) | ((unsigned)(d * 255.f + 0.5f) << 24); }
__device__ __forceinline__ float sigmoidf_(float x) { return __builtin_amdgcn_rcpf(1.0f + __builtin_amdgcn_exp2f(x * -1.4426950408889634f)); }
__device__ __forceinline__ float wave_sum(float v) {
#pragma unroll
    for (int o = 1; o < 64; o <<= 1) v += __shfl_xor(v, o);
    return v;
}
#define LDS_WAIT() asm volatile("s_waitcnt lgkmcnt(0)" ::: "memory")
#define VM_WAIT() asm volatile("s_waitcnt vmcnt(0)" ::: "memory")

#define XB_TMO      128
#define XB_XCNT(j)  (256  + 64 * (j))
#define XB_XSUB(j)  (1280 + 64 * (j))
#define XB_XGEN(j)  (2304 + 64 * (j))
#define XB_TOP      3328
#define XB_TOPGEN   3392
#define XCD_BAR_WORDS 3456
#define XB_SPIN_CAP (1u << 22)
__device__ __forceinline__ unsigned xb_ld(unsigned* p)              { return __hip_atomic_load(p, __ATOMIC_RELAXED, __HIP_MEMORY_SCOPE_AGENT); }
__device__ __forceinline__ unsigned xb_add(unsigned* p, unsigned v) { return __hip_atomic_fetch_add(p, v, __ATOMIC_RELAXED, __HIP_MEMORY_SCOPE_AGENT); }
__device__ __forceinline__ unsigned xb_xcc_id() { return (unsigned)__builtin_amdgcn_s_getreg((3 << 11) | 20) & 0xFu; }
#define XB_SPIN(cond, bar) do { unsigned _sp = 0; while (cond) { __builtin_amdgcn_s_sleep(1); \
    if ((++_sp & 255u) == 0u) { if (xb_ld(&(bar)[XB_TMO])) break; if (_sp > XB_SPIN_CAP) { atomicAdd(&(bar)[XB_TMO], 1u); break; } } } } while (0)
struct XcdBarrier { unsigned* bar; unsigned x; volatile LAS unsigned* st; };
__device__ __forceinline__ XcdBarrier xcd_barrier_post(unsigned* bar, volatile LAS unsigned* st) {
    XcdBarrier b; b.bar = bar; b.x = xb_xcc_id(); b.st = st;
    if (threadIdx.x == 0) (void)xb_add(&bar[XB_XCNT(b.x)], 1u);
    return b;
}
__device__ __forceinline__ void xcd_barrier_complete(unsigned* bar, unsigned x, unsigned& nloc, unsigned& nx) {
    const unsigned G = gridDim.x * gridDim.y * gridDim.z;
    unsigned sum, cnt, mine, sp = 0u;
    for (;;) {
        sum = 0u; cnt = 0u; mine = 0u;
#pragma unroll
        for (unsigned j = 0; j < 16; ++j) { const unsigned c = xb_ld(&bar[XB_XCNT(j)]); sum += c; cnt += (c > 0u) ? 1u : 0u; mine = (j == x) ? c : mine; }
        if (sum == G) break;
        __builtin_amdgcn_s_sleep(1);
        if ((++sp & 255u) == 0u) { if (xb_ld(&bar[XB_TMO])) break; if (sp > XB_SPIN_CAP) { atomicAdd(&bar[XB_TMO], 1u); break; } }
    }
    nloc = mine > 0u ? mine : 1u; nx = cnt > 0u ? cnt : 1u;
}
__device__ __forceinline__ void xcd_barrier(const XcdBarrier& b) {
    asm volatile("s_waitcnt vmcnt(0)" ::: "memory");
    __syncthreads();
    if (threadIdx.x == 0) {
        unsigned* bar = b.bar;
        __builtin_amdgcn_s_waitcnt(0);
        unsigned nloc = b.st[0], nx = b.st[1];
        if (nloc == 0u) { xcd_barrier_complete(bar, b.x, nloc, nx); b.st[0] = nloc; b.st[1] = nx; }
        const unsigned old = xb_add(&bar[XB_XSUB(b.x)], 1u);
        const unsigned gen = old / nloc;
        if (old + 1u == (gen + 1u) * nloc) {
            __builtin_amdgcn_fence(__ATOMIC_RELEASE, "agent");
            asm volatile("s_waitcnt vmcnt(0)" ::: "memory");
            const unsigned og = xb_add(&bar[XB_TOP], 1u);
            const unsigned tg = og / nx;
            if (og + 1u == (tg + 1u) * nx) xb_add(&bar[XB_TOPGEN], 1u);
            else XB_SPIN(xb_ld(&bar[XB_TOPGEN]) == tg, bar);
            __builtin_amdgcn_fence(__ATOMIC_ACQUIRE, "agent");
            xb_add(&bar[XB_XGEN(b.x)], 1u);
            asm volatile("s_waitcnt vmcnt(0)" ::: "memory");
        } else {
            XB_SPIN(xb_ld(&bar[XB_XGEN(b.x)]) == gen, bar);
            __builtin_amdgcn_fence(__ATOMIC_ACQUIRE, "agent");
            asm volatile("s_waitcnt vmcnt(0)" ::: "memory");
        }
    }
    __syncthreads();
}

namespace pg8 {
constexpr int BM = 256, BK = 64, HALF = 128, HTB = HALF * BK * 2, STAGE_BYTES = 8 * HTB, NXCD = 8, WGM = 8;
__device__ __forceinline__ int lds_byte(int r, int c) { const int st = (r >> 4) * 2 + (c >> 5), rr = r & 15, cc = c & 31, ob = rr * 64 + cc * 2; return st * 1024 + (ob ^ (((ob >> 9) & 1) << 5)); }
__device__ __forceinline__ void stage_rc(int b, int& R, int& C) { const int st = b / 1024, sb = b % 1024, swz = sb ^ (((sb >> 9) & 1) << 5); R = (st >> 1) * 16 + swz / 64; C = (st & 1) * 32 + (swz % 64) / 2; }
__device__ __forceinline__ int perm32(int rho) { const int n = rho >> 4, i = rho & 15; return 8 * (i >> 2) + 4 * n + (i & 3); }

struct Unit { int pm, pn, aux; const char* a; const char* b; };

__device__ __forceinline__ bool static_tile(int L, int nM, int nN, int& pm, int& pn) {
    const int nwg = nM * nN; if (L >= nwg) return false;
    int wgid = L; { const int q = nwg / NXCD, r = nwg % NXCD, xcd = wgid % NXCD, off = wgid / NXCD; wgid = (xcd < r ? xcd * (q + 1) : r * (q + 1) + (xcd - r) * q) + off; }
    const int nig = WGM * nN, gid = wgid / nig, fm = gid * WGM, gsz = (nM - fm) < WGM ? (nM - fm) : WGM;
    pm = fm + ((wgid % nig) % gsz); pn = (wgid % nig) / gsz; return true;
}

constexpr int F8_WSH = 6;
template <class Epi, class Sched, bool GATHER, bool F8 = false>
__device__ __forceinline__ void gemm_phase(LAS unsigned char* lds, const int K, const int lda, const int ldb, const Sched& S, const Epi& E, const int* __restrict__ rowidx, const int pv = 0) {
    const int tid = threadIdx.x, wid = __builtin_amdgcn_readfirstlane(tid >> 6), lane = tid & 63, wr = wid >> 2, wc = wid & 3, fr = lane & 15, fq = lane >> 4;
    constexpr int ES = F8 ? 1 : 2;
    const int nt = K / (F8 ? 128 : BK);
#define PG8_SW(r) ((((r) >> 1) & 7) ^ (((((r) >> 2) ^ ((r) >> 3)) & 1) * (F8 ? 2 : 1)))
    unsigned voffA[2], voffB[2]; int gR[2], gC[2];
#pragma unroll
    for (int i = 0; i < 2; ++i) { const int q = tid * 16 + i * 8192, r = (q >> 7) & 15; const int R = (q >> 11) * 16 + r, C = (((q >> 4) & 7) ^ PG8_SW(r)) * 16;
        const int Rb = Epi::PERM ? ((R & ~31) + perm32(R & 31)) : R;
        voffA[i] = (unsigned)(R * lda * ES + C); voffB[i] = (unsigned)(Rb * ldb * ES + C); gR[i] = R; gC[i] = C; }
    const size_t kstep = (size_t)(BK * 2);
    const size_t hstepA = (size_t)HALF * lda * ES, hstepB = (size_t)HALF * ldb * ES;
    const unsigned ldsw = (unsigned)wid * 1024u;
    const int sx = PG8_SW(fr), ck0 = F8 ? 2 * fq : fq, ck1 = F8 ? 2 * fq + 1 : 4 + fq;
    const int aoff0 = wr * 8192 + fr * 128 + 16 * (ck0 ^ sx), aoff1 = wr * 8192 + fr * 128 + 16 * (ck1 ^ sx), boff0 = wc * 4096 + fr * 128 + 16 * (ck0 ^ sx), boff1 = wc * 4096 + fr * 128 + 16 * (ck1 ^ sx);
#define PG8_SA(b, h) (((b) * 2 + (h)) * HTB)
#define PG8_SB(b, h) ((4 + (b) * 2 + (h)) * HTB)
#define PG8_GLDS(src, dstoff) do { if (!(pv & 32)) __builtin_amdgcn_global_load_lds((const unsigned*)(src), (LAS unsigned*)(lds + (dstoff)), 16, 0, 0); } while (0)
#define PG8_STAGEB(bufoff, gbase) do { PG8_GLDS((const char*)(gbase) + voffB[0], (bufoff) + ldsw); PG8_GLDS((const char*)(gbase) + voffB[1], (bufoff) + ldsw + 8192); } while (0)
#define PG8_STAGEA(bufoff, gbase, h, SET) do { if constexpr (GATHER) { const u32x2 o_ = *(const LAS u32x2*)(lds + GOFF_LDS + ((SET) * 2 + (h)) * 4096 + tid * 8); \
        PG8_GLDS((const char*)(gbase) + o_.x, (bufoff) + ldsw); PG8_GLDS((const char*)(gbase) + o_.y, (bufoff) + ldsw + 8192); } \
        else { PG8_GLDS((const char*)(gbase) + (h) * hstepA + voffA[0], (bufoff) + ldsw); PG8_GLDS((const char*)(gbase) + (h) * hstepA + voffA[1], (bufoff) + ldsw + 8192); } } while (0)
#define PG8_LDA(dst, b, h) do { _Pragma("unroll") for (int m = 0; m < 4; ++m) { dst[m][0] = *(const LAS bf16x8*)(lds + PG8_SA(b, h) + aoff0 + m * 2048); dst[m][1] = *(const LAS bf16x8*)(lds + PG8_SA(b, h) + aoff1 + m * 2048); } } while (0)
#define PG8_LDB(dst, b, h) do { _Pragma("unroll") for (int n = 0; n < 2; ++n) { dst[n][0] = *(const LAS bf16x8*)(lds + PG8_SB(b, h) + boff0 + n * 2048); dst[n][1] = *(const LAS bf16x8*)(lds + PG8_SB(b, h) + boff1 + n * 2048); } } while (0)
#define PG8_CAT(lo, hi) __builtin_shufflevector(__builtin_bit_cast(i32x4, lo), __builtin_bit_cast(i32x4, hi), 0, 1, 2, 3, 4, 5, 6, 7)
#define PG8_MMA(ai, bj, At, Bt) do { if (pv & 16) { asm volatile("" :: "v"(At[0][0]), "v"(At[1][0]), "v"(At[2][0]), "v"(At[3][0]), "v"(At[0][1]), "v"(At[1][1]), "v"(At[2][1]), "v"(At[3][1]), "v"(Bt[0][0]), "v"(Bt[0][1]), "v"(Bt[1][0]), "v"(Bt[1][1])); break; } __builtin_amdgcn_s_setprio(1); _Pragma("unroll") for (int m = 0; m < 4; ++m) _Pragma("unroll") for (int n = 0; n < 2; ++n) { \
        if constexpr (F8) { const i32x8 b8_ = PG8_CAT(Bt[n][0], Bt[n][1]), a8_ = PG8_CAT(At[m][0], At[m][1]); \
            asm volatile("v_mfma_scale_f32_16x16x128_f8f6f4 %0, %1, %2, %0, %3, %4 op_sel_hi:[0,0,0]" : "+v"(acc[ai][bj][m][n]) : "v"(b8_), "v"(a8_), "v"(sc_w), "v"(sc_x)); } \
        else { _Pragma("unroll") for (int k = 0; k < 2; ++k) acc[ai][bj][m][n] = __builtin_amdgcn_mfma_f32_16x16x32_bf16(Bt[n][k], At[m][k], acc[ai][bj][m][n], 0, 0, 0); } } __builtin_amdgcn_s_setprio(0); } while (0)
#define PG8_WAIT_V(n) asm volatile("s_waitcnt vmcnt(" #n ")" ::: "memory")
#define PG8_WAIT_L(n) asm volatile("s_waitcnt lgkmcnt(" #n ")" ::: "memory")
#define PG8_BAR __builtin_amdgcn_s_barrier()
#define PG8_SCHED __builtin_amdgcn_sched_barrier(0)
#define PG8_GOFFS(SET, U) do { if constexpr (GATHER) { _Pragma("unroll") for (int h_ = 0; h_ < 2; ++h_) { u32x2 o_; \
        o_.x = (unsigned)rowidx[(U).aux + h_ * HALF + gR[0]] * (unsigned)(lda * ES) + (unsigned)gC[0]; o_.y = (unsigned)rowidx[(U).aux + h_ * HALF + gR[1]] * (unsigned)(lda * ES) + (unsigned)gC[1]; \
        *(LAS u32x2*)(lds + GOFF_LDS + ((SET) * 2 + h_) * 4096 + tid * 8) = o_; } } } while (0)
    const int sc_w = 127 - F8_WSH, sc_x = 127; (void)sc_w; (void)sc_x;
    Unit cur, nxt; int ui = 0;
    if (!S.next(0, cur)) return;
    f32x4 acc[2][2][4][2];
#pragma unroll
    for (int a = 0; a < 2; ++a)
#pragma unroll
        for (int b = 0; b < 2; ++b)
#pragma unroll
            for (int m = 0; m < 4; ++m)
#pragma unroll
                for (int n = 0; n < 2; ++n) acc[a][b][m][n] = (f32x4){0.f, 0.f, 0.f, 0.f};
    bf16x8 At[4][2], B0[2][2], B1[2][2];
    PG8_GOFFS(0, cur);
    const char* cA = cur.a; const char* cB = cur.b;
    PG8_STAGEB(PG8_SB(0, 0), cB); PG8_STAGEB(PG8_SB(0, 1), cB + hstepB); PG8_STAGEA(PG8_SA(0, 0), cA, 0, 0); PG8_STAGEA(PG8_SA(0, 1), cA, 1, 0);
    if (wr == 1) PG8_BAR;
    PG8_WAIT_V(2); PG8_BAR;
    PG8_STAGEB(PG8_SB(1, 0), cB + kstep); PG8_STAGEA(PG8_SA(1, 0), cA + kstep, 0, 0); PG8_STAGEB(PG8_SB(1, 1), cB + hstepB + kstep);
    PG8_WAIT_V(6); PG8_BAR;
    for (;;) {
        const bool has_next = S.next(ui + 1, nxt);
        const int cs = ui & 1; if (has_next) PG8_GOFFS(cs ^ 1, nxt);
        const char* nA = has_next ? nxt.a : cA; const char* nB = has_next ? nxt.b : cB;
#pragma unroll 1
        for (int t = 0; t < nt; t += 2) {
            const bool last = (t == nt - 2);
            const char* a1 = cA + (size_t)(t + 1) * kstep;
            const char* a2 = last ? nA : cA + (size_t)(t + 2) * kstep; const char* b2 = last ? nB : cB + (size_t)(t + 2) * kstep;
            const char* a3 = a2 + kstep; const char* b3 = b2 + kstep;
            const int s2 = (last && has_next) ? (cs ^ 1) : cs;
            PG8_LDB(B0, 0, 0); PG8_LDB(B1, 0, 1); PG8_SCHED; PG8_LDA(At, 0, 0); PG8_STAGEA(PG8_SA(1, 1), a1, 1, cs);
            PG8_WAIT_V(8); PG8_WAIT_L(0); PG8_BAR; PG8_MMA(0, 0, At, B0); PG8_MMA(0, 1, At, B1); PG8_BAR; PG8_SCHED;
            PG8_LDA(At, 0, 1); PG8_STAGEB(PG8_SB(0, 0), b2); PG8_STAGEB(PG8_SB(0, 1), b2 + hstepB); PG8_STAGEA(PG8_SA(0, 0), a2, 0, s2);
            PG8_WAIT_V(8); PG8_WAIT_L(0); PG8_BAR; PG8_MMA(1, 0, At, B0); PG8_MMA(1, 1, At, B1); PG8_BAR; PG8_SCHED;
            PG8_LDB(B0, 1, 0); PG8_LDB(B1, 1, 1); PG8_SCHED; PG8_LDA(At, 1, 0); PG8_STAGEA(PG8_SA(0, 1), a2, 1, s2);
            PG8_WAIT_V(8); PG8_WAIT_L(0); PG8_BAR; PG8_MMA(0, 0, At, B0); PG8_MMA(0, 1, At, B1); PG8_BAR; PG8_SCHED;
            PG8_LDA(At, 1, 1); PG8_STAGEB(PG8_SB(1, 0), b3); PG8_STAGEB(PG8_SB(1, 1), b3 + hstepB); PG8_STAGEA(PG8_SA(1, 0), a3, 0, s2);
            PG8_WAIT_V(8); PG8_WAIT_L(0); PG8_BAR; PG8_MMA(1, 0, At, B0); PG8_MMA(1, 1, At, B1); PG8_BAR; PG8_SCHED;
        }
        if constexpr (F8) {
            asm volatile("s_nop 15\n\ts_nop 15" : "+v"(acc[0][0][0][0]), "+v"(acc[0][0][0][1]), "+v"(acc[0][0][1][0]), "+v"(acc[0][0][1][1]), "+v"(acc[0][0][2][0]), "+v"(acc[0][0][2][1]), "+v"(acc[0][0][3][0]), "+v"(acc[0][0][3][1]),
                         "+v"(acc[0][1][0][0]), "+v"(acc[0][1][0][1]), "+v"(acc[0][1][1][0]), "+v"(acc[0][1][1][1]), "+v"(acc[0][1][2][0]), "+v"(acc[0][1][2][1]), "+v"(acc[0][1][3][0]), "+v"(acc[0][1][3][1]) :: "memory");
            asm volatile("" : "+v"(acc[1][0][0][0]), "+v"(acc[1][0][0][1]), "+v"(acc[1][0][1][0]), "+v"(acc[1][0][1][1]), "+v"(acc[1][0][2][0]), "+v"(acc[1][0][2][1]), "+v"(acc[1][0][3][0]), "+v"(acc[1][0][3][1]),
                         "+v"(acc[1][1][0][0]), "+v"(acc[1][1][0][1]), "+v"(acc[1][1][1][0]), "+v"(acc[1][1][1][1]), "+v"(acc[1][1][2][0]), "+v"(acc[1][1][2][1]), "+v"(acc[1][1][3][0]), "+v"(acc[1][1][3][1]) :: "memory"); }
        if (wr == 0) PG8_BAR;
        int fr_e = fr, fq_e = fq; asm volatile("" : "+v"(fr_e), "+v"(fq_e));
        const bool keep = E(acc, cur, wr, wc, fr_e, fq_e);
        if (!has_next) break;
        if (!keep) {
#pragma unroll
            for (int a = 0; a < 2; ++a)
#pragma unroll
                for (int b = 0; b < 2; ++b)
#pragma unroll
                    for (int m = 0; m < 4; ++m)
#pragma unroll
                        for (int n = 0; n < 2; ++n) acc[a][b][m][n] = (f32x4){0.f, 0.f, 0.f, 0.f};
        }
        cur = nxt; cA = nA; cB = nB; ++ui;
        if (wr == 1) PG8_BAR;
    }
    PG8_WAIT_V(0);
    PG8_BAR;
#undef PG8_SW
#undef PG8_SA
#undef PG8_SB
#undef PG8_GLDS
#undef PG8_STAGEA
#undef PG8_STAGEB
#undef PG8_LDA
#undef PG8_LDB
#undef PG8_MMA
#undef PG8_CAT
#undef PG8_WAIT_V
#undef PG8_WAIT_L
#undef PG8_BAR
#undef PG8_SCHED
#undef PG8_GOFFS
}
}
using pg8::Unit;

struct Frame {
    LAS unsigned char* lds; volatile LAS unsigned* MISC; unsigned* ctl; unsigned char* ws;
    int tid, lane, wave, vcu, G, bx;
    const float* in[26]; float* out;
};
enum { I_X = 0, I_META, I_N1G, I_WIN, I_LRE, I_LIM, I_LDT, I_BRE, I_BIM, I_CRE, I_CIM, I_SD, I_WGLU, I_LBL, I_HNG, I_WBS, I_WBH, I_WOUT, I_N2G, I_WR, I_BR, I_WGU, I_BGU, I_WD, I_BD, I_FNG };

struct SchedStatic {
    const char* A; const char* B; int nM, nN, G, c; size_t ta, tb; int var = 0, pn_off = 0;
    __device__ __forceinline__ bool next(int i, Unit& u) const { int pm, pn; if (!pg8::static_tile(i * G + c, nM, nN, pm, pn)) return false; u.pm = pm; u.pn = pn + pn_off; u.aux = 0; u.a = A + (size_t)pm * ta; u.b = B + (size_t)pn * tb; if (var & 8) { u.a = A; u.b = B; } return true; }
};
struct SchedS5E {
    const char* UA; const char* WE; int c;
    __device__ __forceinline__ bool next(int i, Unit& u) const { if (i > 0 || c >= 64) return false; const int x = c & 7, r = c >> 3, g = x * 4 + (r >> 1), pm = r & 1; u.pm = pm; u.pn = 0; u.aux = g;
        u.a = UA + ((size_t)g * 512 + pm * 256) * UAK * 2; u.b = WE + (size_t)g * 256 * 1024 * 2; return true; }
};
struct SchedS5Y {
    const char* UA; const char* TZ; int c, G;
    __device__ __forceinline__ bool next(int i, Unit& u) const { if (i > 0 || G != 256) { const int L = i * G + c; if (G == 256 || L >= 256) return false; const int g = L >> 3; u.pm = (L >> 2) & 1; u.pn = L & 3; u.aux = g;
            u.a = UA + ((size_t)g * 512 + u.pm * 256) * UAK * 2; u.b = TZ + ((size_t)g * 1024 + u.pn * 256) * UAK * 2; return true; }
        const int x = c & 7, r = c >> 3, g = x + 8 * (r >> 3), pm = (r >> 2) & 1, pn = r & 3; u.pm = pm; u.pn = pn; u.aux = g;
        u.a = UA + ((size_t)g * 512 + pm * 256) * UAK * 2; u.b = TZ + ((size_t)g * 1024 + pn * 256) * UAK * 2; return true; }
};
struct SchedBranch {
    const char* A0; const char* A1; const char* B0; const char* B1; int G, c;
    __device__ __forceinline__ bool next(int i, Unit& u) const { int pm, pn; if (!pg8::static_tile((i >> 1) * G + c, T / 256, 4, pm, pn)) return false; const int part = i & 1; u.pm = pm; u.pn = pn; u.aux = part;
        u.a = (part ? A1 : A0) + (size_t)pm * 256 * HW * 2; u.b = (part ? B1 : B0) + (size_t)pn * 256 * HW * 2; return true; }
};
struct SchedMoe {
    const char* A; const char* W; const int* tile_e; int ntiles, NN, G, c; size_t wexp, wtile; bool gather; int var;
    __device__ __forceinline__ bool next(int i, Unit& u) const { int ti, pn;
        if ((G & 7) == 0) { const int x = c & 7, j = i * (G >> 3) + (c >> 3), ml = j / NN; pn = j - ml * NN; ti = ml * 8 + x; }
        else { const int L = i * G + c; ti = L / NN; pn = L - ti * NN; }
        if (ti >= ntiles) return false; const int e = tile_e[ti];
        u.pm = ti; u.pn = pn; u.aux = gather ? ti * 256 : e; u.a = gather ? A : A + (size_t)ti * 256 * DF; u.b = W + (size_t)e * wexp + (size_t)pn * wtile;
        if (var & 8) { u.a = A; u.b = W; if (gather) u.aux = 0; } return true; }
};

__device__ __forceinline__ u32x4 pack8(const f32x4& v0, const f32x4& v1) { u32x4 w; w.x = cvt_pk_bf16(v0[0], v0[1]); w.y = cvt_pk_bf16(v0[2], v0[3]); w.z = cvt_pk_bf16(v1[0], v1[1]); w.w = cvt_pk_bf16(v1[2], v1[3]); return w; }

struct EpiInProj {
    static constexpr bool PERM = true;
    bf16_t *UA, *Q, *V, *GS, *GATES; _Float16* LOGF; const float* LBV; int var = 0;
    __device__ __forceinline__ bool operator()(f32x4 (&acc)[2][2][4][2], const Unit& u, int wr, int wc, int fr, int fq) const {
        const int kind = u.pn >> 1;
#pragma unroll
        for (int ai = 0; ai < 2; ++ai)
#pragma unroll
            for (int m = 0; m < 4; ++m) { const int tok = u.pm * 256 + ai * 128 + wr * 64 + m * 16 + fr;
                if (var & 4) { asm volatile("" :: "v"(acc[ai][0][m][0]), "v"(acc[ai][0][m][1]), "v"(acc[ai][1][m][0]), "v"(acc[ai][1][m][1])); continue; }
#pragma unroll
                for (int bj = 0; bj < 2; ++bj) { const int col = u.pn * 256 + bj * 128 + wc * 32 + 8 * fq; f32x4 v0 = acc[ai][bj][m][0], v1 = acc[ai][bj][m][1];
                    if (kind == 0) { const int g = col >> 4, hh = col & 15; *(u32x4*)(UA + ((size_t)(g * 512 + (tok >> 6)) * UAK + (tok & 63) * 16 + hh)) = pack8(v0, v1); }
                    else if (kind == 1) {
#pragma unroll
                        for (int j = 0; j < 4; ++j) { v0[j] = v0[j] * sigmoidf_(v0[j]); v1[j] = v1[j] * sigmoidf_(v1[j]); }
                        *(u32x4*)(Q + (size_t)tok * HW + (col - 512)) = pack8(v0, v1); }
                    else if (kind == 2) { const int c2 = col - 1024; const f32x4 l0 = *(const f32x4*)(LBV + c2), l1 = *(const f32x4*)(LBV + c2 + 4);
#pragma unroll
                        for (int j = 0; j < 4; ++j) { v0[j] = __logf(l0[j] + (1.f - l0[j]) * sigmoidf_(v0[j])); v1[j] = __logf(l1[j] + (1.f - l1[j]) * sigmoidf_(v1[j])); }
                        typedef _Float16 h16x8 __attribute__((ext_vector_type(8))); h16x8 hv; hv[0] = (_Float16)v0[0]; hv[1] = (_Float16)v0[1]; hv[2] = (_Float16)v0[2]; hv[3] = (_Float16)v0[3]; hv[4] = (_Float16)v1[0]; hv[5] = (_Float16)v1[1]; hv[6] = (_Float16)v1[2]; hv[7] = (_Float16)v1[3];
                        *(h16x8*)(LOGF + (size_t)tok * HW + c2) = hv; }
                    else if (kind == 3) { *(u32x4*)(V + (size_t)tok * HW + (col - 1536)) = pack8(v0, v1); }
                    else if (kind == 4) {
#pragma unroll
                        for (int j = 0; j < 4; ++j) { v0[j] = v0[j] * sigmoidf_(v0[j]); v1[j] = v1[j] * sigmoidf_(v1[j]); }
                        *(u32x4*)(GS + (size_t)tok * HW + (col - 2048)) = pack8(v0, v1); }
                    else if (MK_GSTORE_F8) { u32x2 q8; q8.x = 0u; q8.y = 0u;
#pragma unroll
                        for (int j = 0; j < 4; ++j) { const float a = __builtin_amdgcn_rcpf(__builtin_fmaf(__builtin_amdgcn_exp2f(v0[j] * -1.4426950408889634f), 1.0f / 255.0f, 1.0f / 255.0f)), b = __builtin_amdgcn_rcpf(__builtin_fmaf(__builtin_amdgcn_exp2f(v1[j] * -1.4426950408889634f), 1.0f / 255.0f, 1.0f / 255.0f));
                            q8.x = __builtin_amdgcn_cvt_pk_u8_f32(a, j, q8.x); q8.y = __builtin_amdgcn_cvt_pk_u8_f32(b, j, q8.y); }
                        *(u32x2*)((unsigned char*)GATES + (size_t)tok * 2048 + (col - 2560)) = q8; }
                    else {
#pragma unroll
                        for (int j = 0; j < 4; ++j) { v0[j] = sigmoidf_(v0[j]); v1[j] = sigmoidf_(v1[j]); }
                        if (MK_GSTORE_F8) { u32x2 q8; q8.x = pk4_u8(v0[0], v0[1], v0[2], v0[3]); q8.y = pk4_u8(v1[0], v1[1], v1[2], v1[3]); *(u32x2*)((unsigned char*)GATES + (size_t)tok * 2048 + (col - 2560)) = q8; }
                        else *(u32x4*)(GATES + (size_t)tok * 2048 + (col - 2560)) = pack8(v0, v1); }
                } }
        return false;
    }
};
struct EpiS5E {
    static constexpr bool PERM = false;
    float* SE;
    __device__ __forceinline__ bool operator()(f32x4 (&acc)[2][2][4][2], const Unit& u, int wr, int wc, int fr, int fq) const {
#pragma unroll
        for (int ai = 0; ai < 2; ++ai)
#pragma unroll
            for (int m = 0; m < 4; ++m) { const int r = u.pm * 256 + ai * 128 + wr * 64 + m * 16 + fr; float* rowp = SE + ((size_t)u.aux * 512 + r) * 128 + wc * 32 + 4 * fq;
#pragma unroll
                for (int n = 0; n < 2; ++n) *(f32x4*)(rowp + n * 16) = acc[ai][0][m][n]; }
        return false;
    }
};
struct EpiS5Y {
    static constexpr bool PERM = true;
    const bf16_t* UA; const float* SD; bf16_t* Y1;
    __device__ __forceinline__ bool operator()(f32x4 (&acc)[2][2][4][2], const Unit& u, int wr, int wc, int fr, int fq) const {
        const int g = u.aux;
#pragma unroll
        for (int ai = 0; ai < 2; ++ai)
#pragma unroll
            for (int m = 0; m < 4; ++m) { const int r = u.pm * 256 + ai * 128 + wr * 64 + m * 16 + fr; const int b = r >> 7, c = r & 127;
#pragma unroll
                for (int bj = 0; bj < 2; ++bj) { const int col = u.pn * 256 + bj * 128 + wc * 32 + 8 * fq; const int t = col >> 4, hh = col & 15;
                    const u32x4 uu = *(const u32x4*)(UA + ((size_t)(g * 512 + r) * UAK + col));
                    const f32x4 d0 = *(const f32x4*)(SD + g * 16 + hh), d1 = *(const f32x4*)(SD + g * 16 + hh + 4);
                    f32x4 v0 = acc[ai][bj][m][0], v1 = acc[ai][bj][m][1];
                    v0[0] += d0[0] * bf2f(uu.x & 0xffffu); v0[1] += d0[1] * bf2f(uu.x >> 16); v0[2] += d0[2] * bf2f(uu.y & 0xffffu); v0[3] += d0[3] * bf2f(uu.y >> 16);
                    v1[0] += d1[0] * bf2f(uu.z & 0xffffu); v1[1] += d1[1] * bf2f(uu.z >> 16); v1[2] += d1[2] * bf2f(uu.w & 0xffffu); v1[3] += d1[3] * bf2f(uu.w >> 16);
#pragma unroll
                    for (int j = 0; j < 4; ++j) { float x = v0[j]; v0[j] = x * sigmoidf_(1.5957691216f * (x + 0.044715f * x * x * x)); x = v1[j]; v1[j] = x * sigmoidf_(1.5957691216f * (x + 0.044715f * x * x * x)); }
                    const int tok = b * SEQ + c * 64 + t;
                    *(u32x4*)(Y1 + (size_t)tok * HW + g * 16 + hh) = pack8(v0, v1); } }
        return false;
    }
};
struct EpiGlu {
    static constexpr bool PERM = true;
    const bf16_t* Y1; bf16_t* YS5;
    __device__ __forceinline__ bool operator()(f32x4 (&acc)[2][2][4][2], const Unit& u, int wr, int wc, int fr, int fq) const {
#pragma unroll
        for (int ai = 0; ai < 2; ++ai)
#pragma unroll
            for (int m = 0; m < 4; ++m) { const int row = u.pm * 256 + ai * 128 + wr * 64 + m * 16 + fr;
#pragma unroll
                for (int bj = 0; bj < 2; ++bj) { const int col = u.pn * 256 + bj * 128 + wc * 32 + 8 * fq; const u32x4 y = *(const u32x4*)(Y1 + (size_t)row * HW + col);
                    f32x4 v0 = acc[ai][bj][m][0], v1 = acc[ai][bj][m][1];
                    v0[0] = bf2f(y.x & 0xffffu) * sigmoidf_(v0[0]); v0[1] = bf2f(y.x >> 16) * sigmoidf_(v0[1]); v0[2] = bf2f(y.y & 0xffffu) * sigmoidf_(v0[2]); v0[3] = bf2f(y.y >> 16) * sigmoidf_(v0[3]);
                    v1[0] = bf2f(y.z & 0xffffu) * sigmoidf_(v1[0]); v1[1] = bf2f(y.z >> 16) * sigmoidf_(v1[1]); v1[2] = bf2f(y.w & 0xffffu) * sigmoidf_(v1[2]); v1[3] = bf2f(y.w >> 16) * sigmoidf_(v1[3]);
                    *(u32x4*)(YS5 + (size_t)row * HW + col) = pack8(v0, v1); } }
        return false;
    }
};
struct EpiBranch {
    static constexpr bool PERM = true;
    const bf16_t* GATES; bf16_t* MERGED;
    __device__ __forceinline__ bool operator()(f32x4 (&acc)[2][2][4][2], const Unit& u, int wr, int wc, int fr, int fq) const {
        const int part = u.aux;
#pragma unroll
        for (int ai = 0; ai < 2; ++ai)
#pragma unroll
            for (int m = 0; m < 4; ++m) { const int row = u.pm * 256 + ai * 128 + wr * 64 + m * 16 + fr;
#pragma unroll
                for (int bj = 0; bj < 2; ++bj) { const int col = u.pn * 256 + bj * 128 + wc * 32 + 8 * fq;
                    float h[8], s[8];
                    if (MK_GSTORE_F8) { const u32x2 g2 = *(const u32x2*)((const unsigned char*)GATES + (size_t)row * 2048 + 1024 + col); const float i255 = 1.0f / 255.0f;
#pragma unroll
                        for (int j = 0; j < 4; ++j) { h[j] = fmaxf((float)((g2.x >> (8 * j)) & 0xffu), 0.5f) * i255; h[4 + j] = fmaxf((float)((g2.y >> (8 * j)) & 0xffu), 0.5f) * i255; }
                        if (part == 0) { const u32x2 g1 = *(const u32x2*)((const unsigned char*)GATES + (size_t)row * 2048 + col);
#pragma unroll
                            for (int j = 0; j < 4; ++j) { s[j] = (float)((g1.x >> (8 * j)) & 0xffu) * i255; s[4 + j] = (float)((g1.y >> (8 * j)) & 0xffu) * i255; } } }
                    else { const u32x4 g2 = *(const u32x4*)(GATES + (size_t)row * 2048 + 1024 + col);
                        h[0] = bf2f(g2.x & 0xffffu); h[1] = bf2f(g2.x >> 16); h[2] = bf2f(g2.y & 0xffffu); h[3] = bf2f(g2.y >> 16); h[4] = bf2f(g2.z & 0xffffu); h[5] = bf2f(g2.z >> 16); h[6] = bf2f(g2.w & 0xffffu); h[7] = bf2f(g2.w >> 16);
                        if (part == 0) { const u32x4 g1 = *(const u32x4*)(GATES + (size_t)row * 2048 + col);
                            s[0] = bf2f(g1.x & 0xffffu); s[1] = bf2f(g1.x >> 16); s[2] = bf2f(g1.y & 0xffffu); s[3] = bf2f(g1.y >> 16); s[4] = bf2f(g1.z & 0xffffu); s[5] = bf2f(g1.z >> 16); s[6] = bf2f(g1.w & 0xffffu); s[7] = bf2f(g1.w >> 16); } }
#pragma unroll
                    for (int j = 0; j < 8; ++j) h[j] = fmaxf(h[j], 1e-30f);
                    if (part == 0) {
#pragma unroll
                        for (int j = 0; j < 4; ++j) { acc[ai][bj][m][0][j] *= s[j] * __builtin_amdgcn_rcpf(h[j]); acc[ai][bj][m][1][j] *= s[4 + j] * __builtin_amdgcn_rcpf(h[4 + j]); } }
                    else { f32x4 v0 = acc[ai][bj][m][0], v1 = acc[ai][bj][m][1];
#pragma unroll
                        for (int j = 0; j < 4; ++j) { v0[j] *= h[j]; v1[j] *= h[4 + j]; }
                        *(u32x4*)(MERGED + (size_t)row * D + col) = pack8(v0, v1); } } }
        return part == 0;
    }
};
struct EpiOut {
    static constexpr bool PERM = true;
    const float* X; bf16_t* H1; float* SSQ; int var = 0;
    __device__ __forceinline__ bool operator()(f32x4 (&acc)[2][2][4][2], const Unit& u, int wr, int wc, int fr, int fq) const {
#pragma unroll
        for (int ai = 0; ai < 2; ++ai)
#pragma unroll
            for (int m = 0; m < 4; ++m) { const int row = u.pm * 256 + ai * 128 + wr * 64 + m * 16 + fr; const size_t off = (size_t)row * D + u.pn * 256 + wc * 32 + 8 * fq; float ss = 0.f;
                if (var & 4) { asm volatile("" :: "v"(acc[ai][0][m][0]), "v"(acc[ai][0][m][1]), "v"(acc[ai][1][m][0]), "v"(acc[ai][1][m][1])); continue; }
#pragma unroll
                for (int bj = 0; bj < 2; ++bj) { const f32x4 o0 = *(const f32x4*)(X + off + bj * 128) + acc[ai][bj][m][0], o1 = *(const f32x4*)(X + off + bj * 128 + 4) + acc[ai][bj][m][1];
                    *(u32x4*)(H1 + off + bj * 128) = pack8(o0, o1); ss += ((o0[0] * o0[0] + o0[1] * o0[1]) + (o0[2] * o0[2] + o0[3] * o0[3])) + ((o1[0] * o1[0] + o1[1] * o1[1]) + (o1[2] * o1[2] + o1[3] * o1[3])); }
                ss += __shfl_xor(ss, 16); ss += __shfl_xor(ss, 32);
                if (fq == 0) SSQ[(size_t)row * 16 + u.pn * 4 + wc] = ss; }
        return false;
    }
};
struct EpiMoe1 {
    static constexpr bool PERM = true;
    const float* BGU; const int* tile_e; unsigned char* A2; int var;
    __device__ __forceinline__ bool operator()(f32x4 (&acc)[2][2][4][2], const Unit& u, int wr, int wc, int fr, int fq) const {
        const int e = tile_e[u.pm]; const int hid = u.pn * 128 + wc * 32 + 8 * fq; const float* bp = BGU + (size_t)e * 2048 + 2 * hid;
        const f32x4 b0 = *(const f32x4*)(bp), b1 = *(const f32x4*)(bp + 4), b2 = *(const f32x4*)(bp + 8), b3 = *(const f32x4*)(bp + 12);
        const float bg[8] = {b0[0], b0[2], b1[0], b1[2], b2[0], b2[2], b3[0], b3[2]}, bu[8] = {b0[1], b0[3], b1[1], b1[3], b2[1], b2[3], b3[1], b3[3]};
#pragma unroll
        for (int ai = 0; ai < 2; ++ai)
#pragma unroll
            for (int m = 0; m < 4; ++m) { const int prow = u.pm * 256 + ai * 128 + wr * 64 + m * 16 + fr; f32x4 o0, o1;
                if (var & 4) { asm volatile("" :: "v"(acc[ai][0][m][0]), "v"(acc[ai][0][m][1]), "v"(acc[ai][1][m][0]), "v"(acc[ai][1][m][1])); continue; }
#pragma unroll
                for (int j = 0; j < 4; ++j) {
                    float gt = fminf(acc[ai][0][m][0][j] + bg[j], 7.0f), up = fminf(fmaxf(acc[ai][1][m][0][j] + bu[j], -7.0f), 7.0f); o0[j] = (up + 1.0f) * gt * __builtin_amdgcn_rcpf(1.0f + __builtin_amdgcn_exp2f(gt * -2.4554669595930156f));
                    gt = fminf(acc[ai][0][m][1][j] + bg[4 + j], 7.0f); up = fminf(fmaxf(acc[ai][1][m][1][j] + bu[4 + j], -7.0f), 7.0f); o1[j] = (up + 1.0f) * gt * __builtin_amdgcn_rcpf(1.0f + __builtin_amdgcn_exp2f(gt * -2.4554669595930156f)); }
                u32x2 q8; q8.x = pk4_fp8_nc(o0[0], o0[1], o0[2], o0[3]); q8.y = pk4_fp8_nc(o1[0], o1[1], o1[2], o1[3]);
                if (var & 1) asm volatile("" :: "v"(q8)); else *(u32x2*)(A2 + (size_t)prow * DF + hid) = q8; }
        return false;
    }
};
struct EpiMoe2 {
    static constexpr bool PERM = true;
    const float* BD; const int* tile_e; const int* rowslot; unsigned char* YS; int var;
    __device__ __forceinline__ bool operator()(f32x4 (&acc)[2][2][4][2], const Unit& u, int wr, int wc, int fr, int fq) const {
        const int e = tile_e[u.pm];
#pragma unroll
        for (int ai = 0; ai < 2; ++ai)
#pragma unroll
            for (int m = 0; m < 4; ++m) { const int prow = u.pm * 256 + ai * 128 + wr * 64 + m * 16 + fr; const int slot = rowslot[prow];
                if (var & 4) { asm volatile("" :: "v"(acc[ai][0][m][0]), "v"(acc[ai][0][m][1]), "v"(acc[ai][1][m][0]), "v"(acc[ai][1][m][1])); continue; }
                if (var & 1) { const f32x4 c0 = *(const f32x4*)(BD + (size_t)e * D + u.pn * 256 + wc * 32 + 8 * fq); const f32x4 t0 = acc[ai][0][m][0] + c0, t1 = acc[ai][1][m][1] + c0; asm volatile("" :: "v"(t0), "v"(t1), "v"(slot)); continue; }
                if (slot >= 0) {
#pragma unroll
                    for (int bj = 0; bj < 2; ++bj) { const int col = u.pn * 256 + bj * 128 + wc * 32 + 8 * fq; const f32x4 c0 = *(const f32x4*)(BD + (size_t)e * D + col), c1 = *(const f32x4*)(BD + (size_t)e * D + col + 4);
                        const f32x4 y0 = acc[ai][bj][m][0] + c0, y1 = acc[ai][bj][m][1] + c1; u32x2 q8; q8.x = pk4_fp8(y0[0], y0[1], y0[2], y0[3]); q8.y = pk4_fp8(y1[0], y1[1], y1[2], y1[3]);
                        *(u32x2*)(YS + (size_t)slot * D + col) = q8; } } }
        return false;
    }
};

struct TDesc { const float* W; unsigned char* WT; int K, N, k0, n0, mode, out8; };
__device__ __forceinline__ TDesc p0_decode(const Frame& F, int t) {
    TDesc d; unsigned char* ws = F.ws;
    if (t < 16384) { const int e = t >> 9, r = t & 511; d.W = F.in[I_WGU] + (size_t)e * D * 2048; d.WT = ws + WS_WGU + (size_t)e * 2048 * D; d.K = D; d.N = 2048; d.k0 = (r >> 5) * 64; d.n0 = (r & 31) * 64; d.mode = 1; d.out8 = 1; return d; }
    t -= 16384;
    if (t < 8192) { const int e = t >> 8, r = t & 255; d.W = F.in[I_WD] + (size_t)e * DF * D; d.WT = ws + WS_WD + (size_t)e * D * DF; d.K = DF; d.N = D; d.k0 = (r >> 4) * 64; d.n0 = (r & 15) * 64; d.mode = 0; d.out8 = 1; return d; }
    t -= 8192; d.mode = 0; d.out8 = 0;
    if (t < 1152) { d.W = F.in[I_WIN]; d.WT = ws + WS_WIN; d.K = D; d.N = INW; d.k0 = (t / 72) * 64; d.n0 = (t % 72) * 64; d.out8 = MK_P1_F8; if (MK_GATES_F8 && d.n0 >= 2560) { d.out8 = 1; d.WT = ws + WS_WIN8 - (size_t)2560 * D; } return d; }
    t -= 1152;
    if (t < 64) { d.W = F.in[I_WGLU]; d.WT = ws + WS_WGLU; d.K = HW; d.N = HW; d.k0 = (t >> 3) * 64; d.n0 = (t & 7) * 64; return d; }
    t -= 64;
    if (t < 128) { d.W = F.in[I_WBS]; d.WT = ws + WS_WBS; d.K = HW; d.N = D; d.k0 = (t >> 4) * 64; d.n0 = (t & 15) * 64; return d; }
    t -= 128;
    if (t < 128) { d.W = F.in[I_WBH]; d.WT = ws + WS_WBH; d.K = HW; d.N = D; d.k0 = (t >> 4) * 64; d.n0 = (t & 15) * 64; return d; }
    t -= 128;
    d.W = F.in[I_WOUT]; d.WT = ws + WS_WOUT; d.K = D; d.N = D; d.k0 = (t >> 4) * 64; d.n0 = (t & 15) * 64; return d;
}
constexpr int P0_NTILES = 16384 + 8192 + 1152 + 64 + 128 + 128 + 256;
__device__ __forceinline__ void p0_tile_load(const TDesc& d, f32x4 (&r)[16], int lane) {
    const float* p = d.W + (size_t)(d.k0 + (lane >> 4)) * d.N + d.n0 + (lane & 15) * 4;
#pragma unroll
    for (int i = 0; i < 16; ++i) r[i] = *(const f32x4*)(p + (size_t)(4 * i) * d.N);
}
__device__ __forceinline__ void p0_tile_to_lds(LAS float* scr, const f32x4 (&r)[16], int lane) {
#pragma unroll
    for (int i = 0; i < 16; ++i) { const int k = (lane >> 4) + 4 * i; *(LAS f32x4*)(scr + k * 64 + (((lane & 15) * 4) ^ (4 * ((k >> 3) & 7)))) = r[i]; }
}
__device__ __forceinline__ void p0_tile_store(const TDesc& d, const LAS float* scr, int lane) {
    if (d.out8) { const int c = lane & 3; const float sc = (float)(1 << pg8::F8_WSH);
#pragma unroll
        for (int j = 0; j < 4; ++j) { const int n = (lane >> 2) + 16 * j; float v[16];
#pragma unroll
            for (int t = 0; t < 16; ++t) { const int k = 16 * c + t; v[t] = scr[k * 64 + (n ^ (4 * ((k >> 3) & 7)))] * sc; }
            u32x4 o;
            { int w = 0; w = __builtin_amdgcn_cvt_pk_fp8_f32(v[0], v[1], w, false); w = __builtin_amdgcn_cvt_pk_fp8_f32(v[2], v[3], w, true); o.x = (unsigned)w; }
            { int w = 0; w = __builtin_amdgcn_cvt_pk_fp8_f32(v[4], v[5], w, false); w = __builtin_amdgcn_cvt_pk_fp8_f32(v[6], v[7], w, true); o.y = (unsigned)w; }
            { int w = 0; w = __builtin_amdgcn_cvt_pk_fp8_f32(v[8], v[9], w, false); w = __builtin_amdgcn_cvt_pk_fp8_f32(v[10], v[11], w, true); o.z = (unsigned)w; }
            { int w = 0; w = __builtin_amdgcn_cvt_pk_fp8_f32(v[12], v[13], w, false); w = __builtin_amdgcn_cvt_pk_fp8_f32(v[14], v[15], w, true); o.w = (unsigned)w; }
            int nn = d.n0 + n; if (d.mode == 1) { const int hid = nn >> 1, part = nn & 1; nn = 256 * (hid >> 7) + 128 * part + (hid & 127); }
            *(u32x4*)(d.WT + (size_t)nn * d.K + d.k0 + 16 * c) = o; } }
    else { const int c = lane & 7;
#pragma unroll
        for (int j = 0; j < 8; ++j) { const int n = (lane >> 3) + 8 * j; float v[8];
#pragma unroll
            for (int t = 0; t < 8; ++t) { const int k = 8 * c + t; v[t] = scr[k * 64 + (n ^ (4 * (c & 7)))]; }
            u32x4 o; o.x = cvt_pk_bf16(v[0], v[1]); o.y = cvt_pk_bf16(v[2], v[3]); o.z = cvt_pk_bf16(v[4], v[5]); o.w = cvt_pk_bf16(v[6], v[7]);
            *(u32x4*)((bf16_t*)d.WT + (size_t)(d.n0 + n) * d.K + d.k0 + 8 * c) = o; } }
}
struct C2 { double re, im; };
__device__ __forceinline__ C2 cmul(C2 a, C2 b) { return C2{a.re * b.re - a.im * b.im, a.re * b.im + a.im * b.re}; }
__device__ __forceinline__ C2 s5_pow(const Frame& F, int g, int p, int k) {
    const double lre = (double)F.in[I_LRE][g * SP + p], lim = (double)F.in[I_LIM][g * SP + p], dt = exp((double)F.in[I_LDT][g]);
    const double mag = exp((double)k * lre * dt); double s, c; sincos((double)k * lim * dt, &s, &c); return C2{mag * c, mag * s};
}
__device__ __forceinline__ C2 s5_coef(const Frame& F, int g, int p) {
    const double lre = (double)F.in[I_LRE][g * SP + p], lim = (double)F.in[I_LIM][g * SP + p]; const C2 lb = s5_pow(F, g, p, 1);
    const double nr = lb.re - 1.0, ni = lb.im, den = lre * lre + lim * lim; return C2{(nr * lre + ni * lim) / den, (ni * lre - nr * lim) / den};
}

struct C2f { float re, im; };
__device__ __forceinline__ C2f cmulf(C2f a, C2f b) { return C2f{a.re * b.re - a.im * b.im, a.re * b.im + a.im * b.re}; }
__device__ __forceinline__ void s5_fast(const Frame& F, int g, int p, C2f& lb, C2f& cf) {
    const float lre = F.in[I_LRE][g * SP + p], lim = F.in[I_LIM][g * SP + p], dt = __expf(F.in[I_LDT][g]); const float a = lre * dt, th = lim * dt;
    const float sn = __sinf(th), cs = __cosf(th), ea = __expf(a); lb = C2f{ea * cs, ea * sn};
    const float sh = __sinf(0.5f * th); const float em1 = (fabsf(a) < 0.125f) ? a * (1.0f + a * (0.5f + a * (0.16666667f + a * 0.041666668f))) : ea - 1.0f;
    const float nr = em1 * cs - 2.0f * sh * sh, ni = ea * sn, den = lre * lre + lim * lim;
    cf = C2f{(nr * lre + ni * lim) / den, (ni * lre - nr * lim) / den};
}
__device__ __forceinline__ C2f cpowf_(C2f b, int k) { C2f r{1.f, 0.f};
#pragma unroll
    for (int i = 0; i < 7; ++i) { if (k & 1) r = cmulf(r, b); b = cmulf(b, b); k >>= 1; } return r; }
__device__ __forceinline__ void p0_prologue(Frame& F, const int var = 0) {
    LAS float* scr = (LAS float*)(F.lds + F.wave * 16384);
    const int gw = F.vcu * 8 + F.wave, NGW = F.G * 8, lane = F.lane;
    unsigned char* ws = F.ws;
    { f32x4 rr[16]; int t = gw;
      if (t < P0_NTILES && !(var & 256)) { TDesc dc = p0_decode(F, t); p0_tile_load(dc, rr, lane);
        for (;;) { p0_tile_to_lds(scr, rr, lane);
            const int tn = t + NGW; TDesc dn = dc; const bool more = tn < P0_NTILES;
            if (more) { dn = p0_decode(F, tn); p0_tile_load(dn, rr, lane); }
            LDS_WAIT(); asm volatile("" ::: "memory");
            p0_tile_store(dc, scr, lane);
            LDS_WAIT(); asm volatile("" ::: "memory");
            if (!more) break; dc = dn; t = tn; } } }
    constexpr int R6 = 0;
    constexpr int R7 = R6 + 2048  , R8 = R7 + 2048  , R9 = R8 + 2048  , R10 = R9 + 32  , R11 = R10 + 384  , R12 = R11 + 16  , R13 = R12 + 1  ;
    constexpr int R14 = R13 + 2048  ;
    for (int it = gw; it < ((var & 512) ? 0 : R14); it += NGW) {
        if ((var & 2048) && it >= R9 && it < R10) continue; if ((var & 4096) && it < R9) continue; if ((var & 8192) && it >= R10 && it < R11) continue; if ((var & 16384) && it >= R11) continue;
        if (it < R7) {
            const int q = it - R6, g = q >> 6, k = q & 63, p = lane;
            C2f lb, cf; s5_fast(F, g, p, lb, cf); const C2f pw = cpowf_(lb, k);
            LAS float* CLre = scr; LAS float* CLim = scr + 1024; LAS float* BBre = scr + 2048; LAS float* BBim = scr + 3072;
            { const f32x4* br = (const f32x4*)(F.in[I_BRE] + (size_t)(g * SP + p) * 16); const f32x4* bi = (const f32x4*)(F.in[I_BIM] + (size_t)(g * SP + p) * 16);
#pragma unroll
              for (int h4 = 0; h4 < 4; ++h4) { const f32x4 r4 = br[h4], i4 = bi[h4];
#pragma unroll
                  for (int j = 0; j < 4; ++j) { const C2f bb = cmulf(cf, C2f{r4[j], i4[j]}); BBre[p * 16 + h4 * 4 + j] = bb.re; BBim[p * 16 + h4 * 4 + j] = -bb.im; } } }
#pragma unroll 4
            for (int h = 0; h < 16; ++h) { const C2f cc = cmulf(C2f{F.in[I_CRE][(g * 16 + h) * SP + p], F.in[I_CIM][(g * 16 + h) * SP + p]}, pw); CLre[h * 64 + p] = cc.re; CLim[h * 64 + p] = cc.im; }
            LDS_WAIT(); asm volatile("" ::: "memory");
            f32x4 kacc = (f32x4){0.f, 0.f, 0.f, 0.f};
#pragma unroll
            for (int sblk = 0; sblk < 16; ++sblk) { const int pp = 4 * sblk + (lane >> 4);
                kacc = __builtin_amdgcn_mfma_f32_16x16x4f32(CLre[(lane & 15) * 64 + pp], BBre[pp * 16 + (lane & 15)], kacc, 0, 0, 0);
                kacc = __builtin_amdgcn_mfma_f32_16x16x4f32(CLim[(lane & 15) * 64 + pp], BBim[pp * 16 + (lane & 15)], kacc, 0, 0, 0); }
            bf16_t* ko = (bf16_t*)(ws + WS_KCONV) + (size_t)q * 256;
#pragma unroll
            for (int r = 0; r < 4; ++r) ko[(4 * (lane >> 4) + r) * 16 + (lane & 15)] = (bf16_t)f2bf(kacc[r]);
            LDS_WAIT(); asm volatile("" ::: "memory");
        }
        else if (it < R8) {
            const int q = it - R7, g = q >> 6, s = q & 63, p = lane; C2f lb, cf; s5_fast(F, g, p, lb, cf); const C2f pw = cmulf(cpowf_(lb, 63 - s), cf);
            float re[16], im[16];
#pragma unroll
            for (int h4 = 0; h4 < 4; ++h4) { const f32x4 r4 = ((const f32x4*)(F.in[I_BRE] + (size_t)(g * SP + p) * 16))[h4], i4 = ((const f32x4*)(F.in[I_BIM] + (size_t)(g * SP + p) * 16))[h4];
#pragma unroll
                for (int j = 0; j < 4; ++j) { const C2f w = cmulf(pw, C2f{r4[j], i4[j]}); re[h4 * 4 + j] = w.re; im[h4 * 4 + j] = w.im; } }
            bf16_t* o0 = (bf16_t*)(ws + WS_WE) + ((size_t)(g * 256 + p) * 1024 + s * 16); bf16_t* o1 = o0 + (size_t)64 * 1024;
            u32x4 a, b; a.x = pk2(re[0], re[1]); a.y = pk2(re[2], re[3]); a.z = pk2(re[4], re[5]); a.w = pk2(re[6], re[7]); b.x = pk2(re[8], re[9]); b.y = pk2(re[10], re[11]); b.z = pk2(re[12], re[13]); b.w = pk2(re[14], re[15]);
            *(u32x4*)o0 = a; *(u32x4*)(o0 + 8) = b;
            a.x = pk2(im[0], im[1]); a.y = pk2(im[2], im[3]); a.z = pk2(im[4], im[5]); a.w = pk2(im[6], im[7]); b.x = pk2(im[8], im[9]); b.y = pk2(im[10], im[11]); b.z = pk2(im[12], im[13]); b.w = pk2(im[14], im[15]);
            *(u32x4*)o1 = a; *(u32x4*)(o1 + 8) = b;
        }
        else if (it < R9) {
            const int q = it - R8, g = q >> 6, t = q & 63, p = lane; C2f lb, cf; s5_fast(F, g, p, lb, cf); const C2f pw = cpowf_(lb, t + 1);
            for (int h = 0; h < 16; ++h) { const C2f cc = cmulf(C2f{F.in[I_CRE][(g * 16 + h) * SP + p], F.in[I_CIM][(g * 16 + h) * SP + p]}, pw);
                bf16_t* o = (bf16_t*)(ws + WS_TZ) + ((size_t)(g * 1024 + t * 16 + h) * UAK + 1024 + p); o[0] = (bf16_t)f2bf(cc.re); o[64] = (bf16_t)f2bf(-cc.im); }
        }
        else if (it < R10) {
            const int g = it - R9, p = lane; const C2 l1 = s5_pow(F, g, p, 1), cf = s5_coef(F, g, p); C2 l64 = l1;
#pragma unroll
            for (int q2 = 0; q2 < 6; ++q2) l64 = cmul(l64, l64);
            ((f32x2*)(ws + WS_LAMB))[g * SP + p] = (f32x2){(float)l1.re, (float)l1.im}; ((f32x2*)(ws + WS_LAMC))[g * SP + p] = (f32x2){(float)l64.re, (float)l64.im};
            for (int h = 0; h < 16; ++h) { const C2 bb = cmul(cf, C2{(double)F.in[I_BRE][(g * SP + p) * 16 + h], (double)F.in[I_BIM][(g * SP + p) * 16 + h]}); ((f32x2*)(ws + WS_BBAR))[(g * SP + p) * 16 + h] = (f32x2){(float)bb.re, (float)bb.im}; }
        }
        else if (it < R11) {
            const int q = it - R10, cg = q >> 4, kq = q & 15; const int wcol = (cg < 8 ? cg * 64 : (cg < 16 ? 1024 + (cg - 8) * 64 : 1536 + (cg - 16) * 64)) + lane;
            const float* meta = F.in[I_META]; const float* g1 = F.in[I_N1G];
            { const int k = kq * 64 + lane; const float gk = g1[k];
#pragma unroll
              for (int r = 0; r < 16; ++r) scr[lane * 16 + r] = meta[r * D + k] * gk; }
            LDS_WAIT(); asm volatile("" ::: "memory");
            float a[16];
#pragma unroll
            for (int r = 0; r < 16; ++r) a[r] = 0.f;
            const float* wp = F.in[I_WIN] + (size_t)(kq * 64) * INW + wcol;
#pragma unroll 16
            for (int kk = 0; kk < 64; ++kk) { const float w = wp[(size_t)kk * INW]; const LAS f32x4* xs = (const LAS f32x4*)(scr + kk * 16);
                const f32x4 x0 = xs[0], x1 = xs[1], x2 = xs[2], x3 = xs[3];
                a[0] += w * x0[0]; a[1] += w * x0[1]; a[2] += w * x0[2]; a[3] += w * x0[3]; a[4] += w * x1[0]; a[5] += w * x1[1]; a[6] += w * x1[2]; a[7] += w * x1[3];
                a[8] += w * x2[0]; a[9] += w * x2[1]; a[10] += w * x2[2]; a[11] += w * x2[3]; a[12] += w * x3[0]; a[13] += w * x3[1]; a[14] += w * x3[2]; a[15] += w * x3[3]; }
            float* pm = (float*)(ws + WS_PMETA);
#pragma unroll
            for (int r = 0; r < 16; ++r) pm[(size_t)(kq * 16 + r) * 1536 + cg * 64 + lane] = a[r];
            LDS_WAIT(); asm volatile("" ::: "memory");
        }
        else if (it < R12) {
            const int k = (it - R11) * 64 + lane; bf16_t* hi = (bf16_t*)(ws + WS_WRT); bf16_t* lo = hi + NE * D;
            for (int e = 0; e < NE; ++e) { const float w = F.in[I_WR][k * NE + e]; const unsigned h = f2bf(w); hi[e * D + k] = (bf16_t)h; lo[e * D + k] = (bf16_t)f2bf(w - bf2f(h)); }
        }
        else if (it < R13) {
            for (int d = lane; d < HW; d += 64) ((float*)(ws + WS_LBV))[d] = sigmoidf_(F.in[I_LBL][d] - F.in[I_LBL][HW + d]);
        }
        else {
            const int q = it - R13, g = q >> 6, r0 = 128 + (q & 63) * 2; u32x4* o = (u32x4*)((bf16_t*)(ws + WS_WE) + (size_t)(g * 256 + r0) * 1024);
#pragma unroll
            for (int j = 0; j < 4; ++j) o[lane + 64 * j] = (u32x4){0u, 0u, 0u, 0u};
        }
    }
    const float* g1 = F.in[I_N1G];
    for (int m = gw; m < ((var & 1024) ? 0 : T); m += 2 * NGW) {
        const int m2 = m + NGW; const bool two = m2 < T;
        const f32x4* xr = (const f32x4*)(F.in[I_X] + (size_t)m * D) + lane; const f32x4* xr2 = (const f32x4*)(F.in[I_X] + (size_t)(two ? m2 : m) * D) + lane; f32x4 v[4], w2[4]; float s = 0.f, s2 = 0.f;
#pragma unroll
        for (int j = 0; j < 4; ++j) { v[j] = xr[64 * j]; w2[j] = xr2[64 * j]; }
#pragma unroll
        for (int j = 0; j < 4; ++j) { s += (v[j].x * v[j].x + v[j].y * v[j].y) + (v[j].z * v[j].z + v[j].w * v[j].w); s2 += (w2[j].x * w2[j].x + w2[j].y * w2[j].y) + (w2[j].z * w2[j].z + w2[j].w * w2[j].w); }
        const float rstd = 1.0f / sqrtf(wave_sum(s) * (1.0f / D) + EPS), rstd2 = 1.0f / sqrtf(wave_sum(s2) * (1.0f / D) + EPS);
        if (MK_GATES_F8 && !MK_P1_F8) { unsigned* o4 = (unsigned*)(ws + WS_XN8 + (size_t)m * D) + lane; unsigned* o42 = (unsigned*)(ws + WS_XN8 + (size_t)m2 * D) + lane;
#pragma unroll
            for (int j = 0; j < 4; ++j) { const f32x4 gg = ((const f32x4*)g1)[lane + 64 * j]; o4[64 * j] = pk4_fp8(v[j].x * rstd * gg.x, v[j].y * rstd * gg.y, v[j].z * rstd * gg.z, v[j].w * rstd * gg.w);
                if (two) o42[64 * j] = pk4_fp8(w2[j].x * rstd2 * gg.x, w2[j].y * rstd2 * gg.y, w2[j].z * rstd2 * gg.z, w2[j].w * rstd2 * gg.w); } }
        if (MK_P1_F8) { unsigned* o4 = (unsigned*)(ws + WS_XN + (size_t)m * D) + lane; unsigned* o42 = (unsigned*)(ws + WS_XN + (size_t)m2 * D) + lane;
#pragma unroll
            for (int j = 0; j < 4; ++j) { const f32x4 gg = ((const f32x4*)g1)[lane + 64 * j]; o4[64 * j] = pk4_fp8(v[j].x * rstd * gg.x, v[j].y * rstd * gg.y, v[j].z * rstd * gg.z, v[j].w * rstd * gg.w);
                if (two) o42[64 * j] = pk4_fp8(w2[j].x * rstd2 * gg.x, w2[j].y * rstd2 * gg.y, w2[j].z * rstd2 * gg.z, w2[j].w * rstd2 * gg.w); } }
        else {
        u32x2* o8 = (u32x2*)((bf16_t*)(ws + WS_XN) + (size_t)m * D) + lane; u32x2* o82 = (u32x2*)((bf16_t*)(ws + WS_XN) + (size_t)m2 * D) + lane;
#pragma unroll
        for (int j = 0; j < 4; ++j) { const f32x4 gg = ((const f32x4*)g1)[lane + 64 * j]; u32x2 w; w.x = pk2(v[j].x * rstd * gg.x, v[j].y * rstd * gg.y); w.y = pk2(v[j].z * rstd * gg.z, v[j].w * rstd * gg.w); o8[64 * j] = w;
            if (two) { w.x = pk2(w2[j].x * rstd2 * gg.x, w2[j].y * rstd2 * gg.y); w.y = pk2(w2[j].z * rstd2 * gg.z, w2[j].w * rstd2 * gg.w); o82[64 * j] = w; } }
        }
    }
}
__device__ __forceinline__ void p1_toeplitz(Frame& F) {
    { const float* pm = (const float*)(F.ws + WS_PMETA); float* pr = (float*)(F.ws + WS_PMR);
      LAS float* rs = (LAS float*)F.lds;
      for (int r = F.wave; r < 16; r += 8) { float sq = 0.f;
#pragma unroll
          for (int j = 0; j < 16; ++j) { const float v = F.in[I_META][r * D + F.lane + 64 * j]; sq += v * v; }
          sq = wave_sum(sq); if (F.lane == 0) rs[r] = 1.0f / sqrtf(sq * (1.0f / D) + EPS); }
      __syncthreads();
      for (int i = F.vcu * 512 + F.tid; i < 16 * 1536; i += F.G * 512) { float sm = 0.f;
#pragma unroll
          for (int kq = 0; kq < 16; ++kq) sm += pm[(size_t)kq * 16 * 1536 + i]; pr[i] = sm * rs[i / 1536]; }
      __syncthreads(); }
}
__device__ __forceinline__ void tz_load32(const Frame& F, int row0, u32x4 (&v)[8]) {
    const bf16_t* kc = (const bf16_t*)(F.ws + WS_KCONV);
#pragma unroll
    for (int i = 0; i < 8; ++i) { const int pc = F.tid + 512 * i, row = row0 + (pc >> 7), q = pc & 127, s = q >> 1, half = q & 1, g = row >> 10, t = (row >> 4) & 63, h = row & 15; v[i] = (u32x4){0u, 0u, 0u, 0u};
        if (s <= t) v[i] = *(const u32x4*)(kc + ((size_t)((g * 64 + (t - s)) * 16 + h) * 16 + half * 8)); }
}
__device__ __forceinline__ void tz_store32(const Frame& F, int row0, const u32x4 (&v)[8]) {
    bf16_t* tz = (bf16_t*)(F.ws + WS_TZ);
#pragma unroll
    for (int i = 0; i < 8; ++i) { const int pc = F.tid + 512 * i, row = row0 + (pc >> 7), q = pc & 127; *(u32x4*)(tz + (size_t)row * UAK + (q >> 1) * 16 + (q & 1) * 8) = v[i]; }
}

constexpr int ST64 = 144, ST128 = 272;
template <int K> __device__ __forceinline__ void mma_nt32k(f32x16& acc, const LAS unsigned char* A, int sa, const LAS unsigned char* B, int sb, int lane) {
    const LAS unsigned char* pa = A + (lane & 31) * sa + (lane >> 5) * 16; const LAS unsigned char* pb = B + (lane & 31) * sb + (lane >> 5) * 16;
#pragma unroll
    for (int k = 0; k < K; k += 16) { const bf16x8 a = *(const LAS bf16x8*)(pa + k * 2), b = *(const LAS bf16x8*)(pb + k * 2); acc = __builtin_amdgcn_mfma_f32_32x32x16_bf16(a, b, acc, 0, 0, 0); }
}
__device__ __forceinline__ void hga_load(Frame& F, int unit, float (&lf)[16], u32x4 (&vv)[2]) {
    const int tid = F.tid; const int bh = unit >> 7, c = unit & 127, tok0 = (bh >> 2) * SEQ + c * CH, hcol = (bh & 3) * HD; const int d = tid & 127, seg = tid >> 7;
    const _Float16* lg = (const _Float16*)(F.ws + WS_LOGF) + (size_t)(tok0 + seg * 16) * HW + hcol + d;
#pragma unroll
    for (int j = 0; j < 16; ++j) lf[j] = (float)lg[(size_t)j * HW];
#pragma unroll
    for (int i = 0; i < 2; ++i) vv[i] = *(const u32x4*)((const bf16_t*)(F.ws + WS_V) + (size_t)(tok0 + (tid & 63)) * HW + hcol + ((tid >> 6) + 8 * i) * 8);
}
__device__ __forceinline__ void hgrn_a_phase(Frame& F, int first, int stride, int count) {
    const int tid = F.tid, lane = F.lane, wave = F.wave; int tzi = 0;
    LAS unsigned char* KT = F.lds; LAS unsigned char* VT = F.lds + 128 * ST64; LAS float* segtot = (LAS float*)(F.lds + 2 * 128 * ST64); LAS unsigned char* OT = (LAS unsigned char*)(segtot + 512);
    const int d = tid & 127, seg = tid >> 7;
    int unit = first; if (unit >= 16 * NCH) return;
    float lf[16]; u32x4 vv[2]; hga_load(F, unit, lf, vv);
    for (;;) {
        const int bh = unit >> 7, c = unit & 127, b = bh >> 2, h = bh & 3, tok0 = b * SEQ + c * CH, hcol = h * HD;
        float cs[16]; float run = 0.f;
#pragma unroll
        for (int j = 0; j < 16; ++j) { run += lf[j]; cs[j] = run; }
        segtot[seg * 128 + d] = run;
#pragma unroll
        for (int i = 0; i < 2; ++i) { const int e0 = ((tid >> 6) + 8 * i) * 8; LAS bf16_t* o = (LAS bf16_t*)(VT + e0 * ST64 + (tid & 63) * 2); const u32x4 v = vv[i];
            o[0 * (ST64 / 2)] = (bf16_t)(v.x & 0xffffu); o[1 * (ST64 / 2)] = (bf16_t)(v.x >> 16); o[2 * (ST64 / 2)] = (bf16_t)(v.y & 0xffffu); o[3 * (ST64 / 2)] = (bf16_t)(v.y >> 16);
            o[4 * (ST64 / 2)] = (bf16_t)(v.z & 0xffffu); o[5 * (ST64 / 2)] = (bf16_t)(v.z >> 16); o[6 * (ST64 / 2)] = (bf16_t)(v.w & 0xffffu); o[7 * (ST64 / 2)] = (bf16_t)(v.w >> 16); }
        __syncthreads();
        const float t0 = segtot[d], t1 = segtot[128 + d], t2 = segtot[256 + d], t3 = segtot[384 + d];
        const float pre = seg == 0 ? 0.f : (seg == 1 ? t0 : (seg == 2 ? t0 + t1 : t0 + t1 + t2)); const float total = (t0 + t1) + (t2 + t3);
        float kk[16];
#pragma unroll
        for (int j = 0; j < 16; ++j) { cs[j] += pre; kk[j] = (1.0f - __expf(lf[j])) * __expf(total - cs[j]); }
        u32x4 w0, w1; w0.x = cvt_pk_bf16(kk[0], kk[1]); w0.y = cvt_pk_bf16(kk[2], kk[3]); w0.z = cvt_pk_bf16(kk[4], kk[5]); w0.w = cvt_pk_bf16(kk[6], kk[7]); w1.x = cvt_pk_bf16(kk[8], kk[9]); w1.y = cvt_pk_bf16(kk[10], kk[11]); w1.z = cvt_pk_bf16(kk[12], kk[13]); w1.w = cvt_pk_bf16(kk[14], kk[15]);
        *(LAS u32x4*)(KT + d * ST64 + seg * 32) = w0; *(LAS u32x4*)(KT + d * ST64 + seg * 32 + 16) = w1;
        if (seg == 0) ((float*)(F.ws + WS_DEC))[(size_t)unit * HD + d] = __expf(total);
        { float* bc = (float*)(F.ws + WS_BCUM) + (size_t)(tok0 + seg * 16) * HW + hcol + d;
#pragma unroll
          for (int j = 0; j < 16; ++j) bc[(size_t)j * HW] = cs[j]; }
        const int un = unit + stride; const bool more = (un < 16 * NCH) && (--count > 0);
        if (more) hga_load(F, un, lf, vv);
        u32x4 tzv[8]; const bool dotz = tzi < 4 && F.G == 256; if (dotz) tz_load32(F, 128 * F.bx + 32 * tzi, tzv);
        __syncthreads();
#pragma unroll
        for (int i = 0; i < 2; ++i) { const int tile = wave * 2 + i, et = tile >> 2, dt = tile & 3; f32x16 acc;
#pragma unroll
            for (int r = 0; r < 16; ++r) acc[r] = 0.f;
            mma_nt32k<64>(acc, VT + et * 32 * ST64, ST64, KT + dt * 32 * ST64, ST64, lane);
#pragma unroll
            for (int r = 0; r < 16; ++r) { const int e = et * 32 + (r & 3) + 8 * (r >> 2) + 4 * (lane >> 5); ((LAS bf16_t*)(OT + e * ST128))[dt * 32 + (lane & 31)] = (bf16_t)f2bf(acc[r]); } }
        __syncthreads();
        { bf16_t* kvt = (bf16_t*)(F.ws + WS_KVT) + (size_t)unit * HD * HD;
#pragma unroll
          for (int i = 0; i < 4; ++i) { const int p = tid + 512 * i, e = p >> 4, d0 = (p & 15) * 8; *(u32x4*)(kvt + (size_t)e * HD + d0) = *(const LAS u32x4*)(OT + e * ST128 + d0 * 2); } }
        if (dotz) { tz_store32(F, 128 * F.bx + 32 * tzi, tzv); ++tzi; }
        if (!more) break;
        unit = un;
    }
    __syncthreads();
}
struct HgPre { u32x4 q[2]; f32x4 bj[2][2], bp[2][2], bm[2]; u32x4 v[2], sp[4]; };
__device__ __forceinline__ void hgc_load(Frame& F, int unit, HgPre& P) {
    const int tid = F.tid; const int bh = unit >> 7, c = unit & 127, b = bh >> 2, h = bh & 3, tok0 = b * SEQ + c * CH, hcol = h * HD;
    const bf16_t* qg = (const bf16_t*)(F.ws + WS_Q); const float* bc = (const float*)(F.ws + WS_BCUM); const bf16_t* vg = (const bf16_t*)(F.ws + WS_V); const bf16_t* sp = (const bf16_t*)(F.ws + WS_SPREV) + (size_t)unit * HD * HD;
    const int d0 = (tid & 15) * 8;
#pragma unroll
    for (int i = 0; i < 2; ++i) { const int j = (tid >> 4) + 32 * i; const size_t o = (size_t)(tok0 + j) * HW + hcol + d0;
        P.q[i] = *(const u32x4*)(qg + o); P.bj[i][0] = *(const f32x4*)(bc + o); P.bj[i][1] = *(const f32x4*)(bc + o + 4);
        if (j > 0) { P.bp[i][0] = *(const f32x4*)(bc + o - HW); P.bp[i][1] = *(const f32x4*)(bc + o - HW + 4); } else { P.bp[i][0] = (f32x4){0.f, 0.f, 0.f, 0.f}; P.bp[i][1] = (f32x4){0.f, 0.f, 0.f, 0.f}; }
        const int e0 = ((tid >> 6) + 8 * i) * 8; P.v[i] = *(const u32x4*)(vg + (size_t)(tok0 + (tid & 63)) * HW + hcol + e0); }
    { const size_t o = (size_t)(tok0 + 31) * HW + hcol + d0; P.bm[0] = *(const f32x4*)(bc + o); P.bm[1] = *(const f32x4*)(bc + o + 4); }
#pragma unroll
    for (int i = 0; i < 4; ++i) { const int p = tid + 512 * i; P.sp[i] = *(const u32x4*)(sp + (size_t)(p >> 4) * HD + (p & 15) * 8); }
}
__device__ __forceinline__ void hgrn_c_phase(Frame& F) {
    const int tid = F.tid, lane = F.lane, wave = F.wave;
    LAS unsigned char* Q1 = F.lds; LAS unsigned char* K1 = Q1 + 64 * ST128; LAS unsigned char* Q2 = K1 + 64 * ST128; LAS unsigned char* VT = Q2 + 64 * ST128;
    LAS unsigned char* PP = VT + 128 * ST64; LAS unsigned char* SPL = PP + 64 * ST64; LAS float* RS = (LAS float*)(SPL + 128 * ST128); LAS unsigned char* OL = Q1;
    int unit = F.bx; if (unit >= 16 * NCH) return;
    HgPre P; hgc_load(F, unit, P);
    u32x4 gsv[2];
    { const int bh = unit >> 7, c = unit & 127, tok0 = (bh >> 2) * SEQ + c * CH, hcol = (bh & 3) * HD;
#pragma unroll
      for (int i = 0; i < 2; ++i) gsv[i] = *(const u32x4*)((const bf16_t*)(F.ws + WS_GS) + (size_t)(tok0 + (tid >> 4) + 32 * i) * HW + hcol + (tid & 15) * 8); }
    for (;;) {
        const int bh = unit >> 7, c = unit & 127, b = bh >> 2, h = bh & 3, tok0 = b * SEQ + c * CH, hcol = h * HD;
        { const int d0 = (tid & 15) * 8;
#pragma unroll
          for (int i = 0; i < 2; ++i) { const int j = (tid >> 4) + 32 * i; float q1[8], k1[8], q2[8];
              const unsigned qw[4] = {P.q[i].x, P.q[i].y, P.q[i].z, P.q[i].w};
#pragma unroll
              for (int k = 0; k < 8; ++k) { const float bb = P.bj[i][k >> 2][k & 3], bm = P.bm[k >> 2][k & 3], lf = bb - P.bp[i][k >> 2][k & 3]; const float q = bf2f((qw[k >> 1] >> ((k & 1) * 16)) & 0xffffu);
                  const float kx = 1.0f - __expf(lf), ed = __expf(bb - bm); q1[k] = q * ed; k1[k] = kx * __expf(bm - bb); q2[k] = q * __expf(bb); }
              u32x4 w; w.x = cvt_pk_bf16(q1[0], q1[1]); w.y = cvt_pk_bf16(q1[2], q1[3]); w.z = cvt_pk_bf16(q1[4], q1[5]); w.w = cvt_pk_bf16(q1[6], q1[7]); *(LAS u32x4*)(Q1 + j * ST128 + d0 * 2) = w;
              w.x = cvt_pk_bf16(k1[0], k1[1]); w.y = cvt_pk_bf16(k1[2], k1[3]); w.z = cvt_pk_bf16(k1[4], k1[5]); w.w = cvt_pk_bf16(k1[6], k1[7]); *(LAS u32x4*)(K1 + j * ST128 + d0 * 2) = w;
              w.x = cvt_pk_bf16(q2[0], q2[1]); w.y = cvt_pk_bf16(q2[2], q2[3]); w.z = cvt_pk_bf16(q2[4], q2[5]); w.w = cvt_pk_bf16(q2[6], q2[7]); *(LAS u32x4*)(Q2 + j * ST128 + d0 * 2) = w;
              const int e0 = ((tid >> 6) + 8 * i) * 8; LAS bf16_t* o = (LAS bf16_t*)(VT + e0 * ST64 + (tid & 63) * 2); const u32x4 v = P.v[i];
              o[0 * (ST64 / 2)] = (bf16_t)(v.x & 0xffffu); o[1 * (ST64 / 2)] = (bf16_t)(v.x >> 16); o[2 * (ST64 / 2)] = (bf16_t)(v.y & 0xffffu); o[3 * (ST64 / 2)] = (bf16_t)(v.y >> 16);
              o[4 * (ST64 / 2)] = (bf16_t)(v.z & 0xffffu); o[5 * (ST64 / 2)] = (bf16_t)(v.z >> 16); o[6 * (ST64 / 2)] = (bf16_t)(v.w & 0xffffu); o[7 * (ST64 / 2)] = (bf16_t)(v.w >> 16); }
#pragma unroll
          for (int i = 0; i < 4; ++i) { const int p = tid + 512 * i; *(LAS u32x4*)(SPL + (p >> 4) * ST128 + (p & 15) * 16) = P.sp[i]; } }
        const int un = unit + F.G; const bool more = un < 16 * NCH;
        if (more) hgc_load(F, un, P);
        __syncthreads();
        const int it = wave >> 2, et = wave & 3; f32x16 acc;
#pragma unroll
        for (int r = 0; r < 16; ++r) acc[r] = 0.f;
        mma_nt32k<128>(acc, Q2 + it * 32 * ST128, ST128, SPL + et * 32 * ST128, ST128, lane);
        if (wave < 3) { const int si = wave ? 1 : 0, sj = wave == 2 ? 1 : 0; f32x16 sc;
#pragma unroll
            for (int r = 0; r < 16; ++r) sc[r] = 0.f;
            mma_nt32k<128>(sc, Q1 + si * 32 * ST128, ST128, K1 + sj * 32 * ST128, ST128, lane);
#pragma unroll
            for (int r = 0; r < 16; ++r) { const int i = si * 32 + (r & 3) + 8 * (r >> 2) + 4 * (lane >> 5), j = sj * 32 + (lane & 31); ((LAS bf16_t*)(PP + i * ST64))[j] = (bf16_t)f2bf(j <= i ? sc[r] : 0.f); } }
        else if (wave == 3) {
#pragma unroll
            for (int r = 0; r < 16; ++r) { const int i = (r & 3) + 8 * (r >> 2) + 4 * (lane >> 5); ((LAS bf16_t*)(PP + i * ST64))[32 + (lane & 31)] = (bf16_t)0; } }
        __syncthreads();
        mma_nt32k<64>(acc, PP + it * 32 * ST64, ST64, VT + et * 32 * ST64, ST64, lane);
#pragma unroll
        for (int r = 0; r < 16; ++r) { const int i = it * 32 + (r & 3) + 8 * (r >> 2) + 4 * (lane >> 5); ((LAS bf16_t*)(OL + i * ST128))[et * 32 + (lane & 31)] = (bf16_t)f2bf(acc[r]); }
        __syncthreads();
        { const int eo = (tid & 15) * 8; const f32x4 g0 = *(const f32x4*)(F.in[I_HNG] + hcol + eo), g1 = *(const f32x4*)(F.in[I_HNG] + hcol + eo + 4); bf16_t* yo = (bf16_t*)(F.ws + WS_YHG);
#pragma unroll
          for (int i = 0; i < 2; ++i) { const int row = (tid >> 4) + 32 * i; const u32x4 o = *(const LAS u32x4*)(OL + row * ST128 + eo * 2); const u32x4 gq = gsv[i];
              const float x[8] = {bf2f(o.x & 0xffffu), bf2f(o.x >> 16), bf2f(o.y & 0xffffu), bf2f(o.y >> 16), bf2f(o.z & 0xffffu), bf2f(o.z >> 16), bf2f(o.w & 0xffffu), bf2f(o.w >> 16)};
              float ss = ((x[0] * x[0] + x[1] * x[1]) + (x[2] * x[2] + x[3] * x[3])) + ((x[4] * x[4] + x[5] * x[5]) + (x[6] * x[6] + x[7] * x[7]));
              ss += __shfl_xor(ss, 1); ss += __shfl_xor(ss, 2); ss += __shfl_xor(ss, 4); ss += __shfl_xor(ss, 8);
              const float rstd = 1.0f / sqrtf(ss * (1.0f / HD) + EPS);
              f32x4 y0, y1; y0[0] = x[0] * rstd * g0[0] * bf2f(gq.x & 0xffffu); y0[1] = x[1] * rstd * g0[1] * bf2f(gq.x >> 16); y0[2] = x[2] * rstd * g0[2] * bf2f(gq.y & 0xffffu); y0[3] = x[3] * rstd * g0[3] * bf2f(gq.y >> 16);
              y1[0] = x[4] * rstd * g1[0] * bf2f(gq.z & 0xffffu); y1[1] = x[5] * rstd * g1[1] * bf2f(gq.z >> 16); y1[2] = x[6] * rstd * g1[2] * bf2f(gq.w & 0xffffu); y1[3] = x[7] * rstd * g1[3] * bf2f(gq.w >> 16);
              *(u32x4*)(yo + (size_t)(tok0 + row) * HW + hcol + eo) = pack8(y0, y1); } }
        if (!more) break;
        unit = un;
        { const int bh2 = unit >> 7, c2 = unit & 127, tk = (bh2 >> 2) * SEQ + c2 * CH, hc = (bh2 & 3) * HD;
#pragma unroll
          for (int i = 0; i < 2; ++i) gsv[i] = *(const u32x4*)((const bf16_t*)(F.ws + WS_GS) + (size_t)(tk + (tid >> 4) + 32 * i) * HW + hc + (tid & 15) * 8); }
        __syncthreads();
    }
    __syncthreads();
}

__device__ __forceinline__ void stagger(const Frame& F, int units) {
    const unsigned long long t0 = __builtin_amdgcn_s_memrealtime(), dt = (unsigned long long)(((F.bx >> 3) & 3) * units);
    while (__builtin_amdgcn_s_memrealtime() - t0 < dt) __builtin_amdgcn_s_sleep(8);
}
__device__ __forceinline__ void phase0(Frame& F, const int var) {
    unsigned char* ws = F.ws; (void)ws;
    p0_prologue(F, var);
}
__device__ __forceinline__ void phase1(Frame& F, const int var) {
    unsigned char* ws = F.ws; (void)ws;
        if (!(var & 64)) p1_toeplitz(F);
        EpiInProj E{(bf16_t*)(ws + WS_UA), (bf16_t*)(ws + WS_Q), (bf16_t*)(ws + WS_V), (bf16_t*)(ws + WS_GS), (bf16_t*)(ws + WS_GATES), (_Float16*)(ws + WS_LOGF), (const float*)(ws + WS_LBV), var};
        if (MK_GATES_F8 && !MK_P1_F8) {
            { SchedStatic S{(const char*)(ws + WS_XN), (const char*)(ws + WS_WIN), T / 256, 10, F.G, F.bx, (size_t)256 * D * 2, (size_t)256 * D * 2, var};
              pg8::gemm_phase<EpiInProj, SchedStatic, false, false>(F.lds, D, D, D, S, E, nullptr, var); }
            { SchedStatic S{(const char*)(ws + WS_XN8), (const char*)(ws + WS_WIN8), T / 256, 8, F.G, F.bx, (size_t)256 * D, (size_t)256 * D, var, 10};
              pg8::gemm_phase<EpiInProj, SchedStatic, false, true>(F.lds, D, D, D, S, E, nullptr, var); }
        } else {
            SchedStatic S{(const char*)(ws + WS_XN), (const char*)(ws + WS_WIN), T / 256, INW / 256, F.G, F.bx, (size_t)256 * D * (MK_P1_F8 ? 1 : 2), (size_t)256 * D * (MK_P1_F8 ? 1 : 2)};
            pg8::gemm_phase<EpiInProj, SchedStatic, false, MK_P1_F8 != 0>(F.lds, D, D, D, S, E, nullptr);
        }
}
__device__ __forceinline__ void phase2(Frame& F, const int var) {
    unsigned char* ws = F.ws; (void)ws;
        { SchedS5E S{(const char*)(ws + WS_UA), (const char*)(ws + WS_WE), F.bx}; EpiS5E E{(float*)(ws + WS_SE)};
          pg8::gemm_phase<EpiS5E, SchedS5E, false>(F.lds, 1024, UAK, 1024, S, E, nullptr); }
        __syncthreads();
        const float* pm = (const float*)(ws + WS_PMR);
        if (F.bx >= 64 && F.bx < 68) {
            const int g = (F.bx - 64) * 8 + (F.tid >> 6), p = F.tid & 63; const f32x2 lb = ((const f32x2*)(ws + WS_LAMB))[g * SP + p]; float xr = 0.f, xi = 0.f;
            for (int s = 0; s < NMETA; ++s) { float ar = 0.f, ai = 0.f;
#pragma unroll
                for (int h = 0; h < 16; ++h) { const int col = g * 16 + h; const float uu = pm[(size_t)s * 1536 + col];
                    const f32x2 bb = ((const f32x2*)(ws + WS_BBAR))[(g * SP + p) * 16 + h]; ar += bb.x * uu; ai += bb.y * uu; }
                const float nr = lb.x * xr - lb.y * xi + ar, ni = lb.x * xi + lb.y * xr + ai; xr = nr; xi = ni; }
            float* xm = (float*)(ws + WS_XMETA); xm[g * 128 + p] = xr; xm[g * 128 + 64 + p] = xi;
        }
        if (F.bx >= 68 && F.bx < 196) {
            const int idx = (F.bx - 68) * 512 + F.tid, h = idx >> 14, e = (idx >> 7) & 127, d = idx & 127; const float lbv = ((const float*)(ws + WS_LBV))[h * HD + d]; float S = 0.f;
            for (int s = 0; s < NMETA; ++s) { const int cf = 512 + h * HD + d, cv = 1024 + h * HD + e;
                const float fp = pm[(size_t)s * 1536 + cf];
                const float vv = pm[(size_t)s * 1536 + cv];
                const float f = lbv + (1.0f - lbv) * sigmoidf_(fp); S = f * S + (1.0f - f) * vv; }
            ((float*)(ws + WS_SMETA))[idx] = S;
        }
        if (F.bx < 64) hgrn_a_phase(F, 4 * F.bx, 1, 4); else hgrn_a_phase(F, 256 + (F.bx - 64), F.G - 64, 1 << 20);
}
__device__ __forceinline__ void phase3(Frame& F, const int var) {
    unsigned char* ws = F.ws; (void)ws;
        {
            const int bh = F.bx >> 4, e = (F.bx & 15) * 8 + (F.tid >> 6), d = (F.tid & 63) * 2, h = bh & 3;
            f32x2 S = *(const f32x2*)((const float*)(ws + WS_SMETA) + (size_t)(h * HD + e) * HD + d);
            const unsigned* kv = (const unsigned*)((const bf16_t*)(ws + WS_KVT) + (size_t)bh * NCH * HD * HD + (size_t)e * HD + d); const float* dc = (const float*)(ws + WS_DEC) + (size_t)bh * NCH * HD + d;
            unsigned* sp = (unsigned*)((bf16_t*)(ws + WS_SPREV) + (size_t)bh * NCH * HD * HD + (size_t)e * HD + d);
            for (int c0 = 0; c0 < NCH; c0 += 16) { unsigned kq[16]; f32x2 dv[16];
#pragma unroll
                for (int j = 0; j < 16; ++j) { kq[j] = kv[(size_t)(c0 + j) * (HD * HD / 2)]; dv[j] = *(const f32x2*)(dc + (size_t)(c0 + j) * HD); }
#pragma unroll
                for (int j = 0; j < 16; ++j) { sp[(size_t)(c0 + j) * (HD * HD / 2)] = pk2(S.x, S.y); S.x = S.x * dv[j].x + bf2f(kq[j] & 0xffffu); S.y = S.y * dv[j].y + bf2f(kq[j] >> 16); } }
        }
        if (F.bx < 16) {
            const int b = F.bx >> 2, g = (F.bx & 3) * 8 + (F.tid >> 6), p = F.tid & 63; const f32x2 lc = ((const f32x2*)(ws + WS_LAMC))[g * SP + p];
            const float* xm = (const float*)(ws + WS_XMETA); float xr = xm[g * 128 + p], xi = xm[g * 128 + 64 + p];
            const float* se = (const float*)(ws + WS_SE) + ((size_t)g * 512 + b * 128) * 128 + p; bf16_t* ua = (bf16_t*)(ws + WS_UA) + ((size_t)g * 512 + b * 128) * UAK + 1024 + p;
            for (int c0 = 0; c0 < NCH; c0 += 8) { float er[8], ei[8];
#pragma unroll
                for (int j = 0; j < 8; ++j) { er[j] = se[(size_t)(c0 + j) * 128]; ei[j] = se[(size_t)(c0 + j) * 128 + 64]; }
#pragma unroll
                for (int j = 0; j < 8; ++j) { bf16_t* o = ua + (size_t)(c0 + j) * UAK; o[0] = (bf16_t)f2bf(xr); o[64] = (bf16_t)f2bf(xi);
                    const float nr = lc.x * xr - lc.y * xi + er[j], ni = lc.x * xi + lc.y * xr + ei[j]; xr = nr; xi = ni; } }
        }
}
__device__ __forceinline__ void phase4(Frame& F, const int var) {
    unsigned char* ws = F.ws; (void)ws;
        if (!(var & 64)) { SchedS5Y S{(const char*)(ws + WS_UA), (const char*)(ws + WS_TZ), F.bx, F.G}; EpiS5Y E{(const bf16_t*)(ws + WS_UA), F.in[I_SD], (bf16_t*)(ws + WS_Y1)};
          pg8::gemm_phase<EpiS5Y, SchedS5Y, false>(F.lds, UAK, UAK, UAK, S, E, nullptr); }
        __syncthreads();
        if (!(var & 128)) hgrn_c_phase(F);
}
__device__ __forceinline__ void phase5(Frame& F, const int var) {
    unsigned char* ws = F.ws; (void)ws;
        SchedStatic S{(const char*)(ws + WS_Y1), (const char*)(ws + WS_WGLU), T / 256, HW / 256, F.G, F.bx, (size_t)256 * HW * 2, (size_t)256 * HW * 2};
        EpiGlu E{(const bf16_t*)(ws + WS_Y1), (bf16_t*)(ws + WS_YS5)};
        pg8::gemm_phase<EpiGlu, SchedStatic, false>(F.lds, HW, HW, HW, S, E, nullptr);
}
__device__ __forceinline__ void phase6(Frame& F, const int var) {
    unsigned char* ws = F.ws; (void)ws;
        SchedBranch S{(const char*)(ws + WS_YS5), (const char*)(ws + WS_YHG), (const char*)(ws + WS_WBS), (const char*)(ws + WS_WBH), F.G, F.bx};
        EpiBranch E{(const bf16_t*)(ws + WS_GATES), (bf16_t*)(ws + WS_MERGED)};
        pg8::gemm_phase<EpiBranch, SchedBranch, false>(F.lds, HW, HW, HW, S, E, nullptr);
}
__device__ __forceinline__ void phase7(Frame& F, const int var) {
    unsigned char* ws = F.ws; (void)ws;
        SchedStatic S{(const char*)(ws + WS_MERGED), (const char*)(ws + WS_WOUT), T / 256, D / 256, F.G, F.bx, (size_t)256 * D * 2, (size_t)256 * D * 2, var};
        EpiOut E{F.in[I_X], (bf16_t*)(ws + WS_H1), (float*)(ws + WS_SSQ), var};
        pg8::gemm_phase<EpiOut, SchedStatic, false>(F.lds, D, D, D, S, E, nullptr, var);
}
__device__ __forceinline__ void phase8(Frame& F, const int var) {
    unsigned char* ws = F.ws; (void)ws;
        volatile LAS unsigned* hist = F.MISC + 16;
        if (F.tid < 32) hist[F.tid] = 0u;
        __syncthreads();
        const int lane = F.lane, tl = lane & 15, kg = lane >> 4; const float* g2 = F.in[I_N2G];
        { const u32x4* src = (const u32x4*)(ws + WS_WRT); LAS u32x4* dst = (LAS u32x4*)F.lds;
          for (int i = F.tid; i < 2 * NE * D / 8; i += 512) { const int row = i >> 7, ch = i & 127; *(LAS u32x4*)((LAS unsigned char*)dst + row * 2064 + ch * 16) = src[i]; } }
        __syncthreads();
        const LAS unsigned char* wh = F.lds; const LAS unsigned char* wl = F.lds + NE * 2064;
        for (int tile = F.vcu * 8 + F.wave; tile < T / 16; tile += F.G * 8) {
            const int tok = tile * 16 + tl; const bf16_t* hrow = (const bf16_t*)(ws + WS_H1) + (size_t)tok * D; const f32x4* sq = (const f32x4*)((const float*)(ws + WS_SSQ) + (size_t)tok * 16);
            const f32x4 s0 = sq[0], s1 = sq[1], s2 = sq[2], s3 = sq[3];
            const float ss = ((s0[0] + s0[1]) + (s0[2] + s0[3])) + ((s1[0] + s1[1]) + (s1[2] + s1[3])) + ((s2[0] + s2[1]) + (s2[2] + s2[3])) + ((s3[0] + s3[1]) + (s3[2] + s3[3]));
            const float rstd = 1.0f / sqrtf(ss * (1.0f / D) + EPS);
            f32x4 a0 = (f32x4){0.f, 0.f, 0.f, 0.f}, a1 = a0; unsigned char* xo = (unsigned char*)(ws + WS_XN2) + (size_t)tok * D;
#pragma unroll 1
            for (int kb = 0; kb < 32; kb += 8) { u32x4 hv[8];
#pragma unroll
                for (int u8 = 0; u8 < 8; ++u8) hv[u8] = *(const u32x4*)(hrow + (kb + u8) * 32 + kg * 8);
#pragma unroll
                for (int u8 = 0; u8 < 8; ++u8) { const int k = (kb + u8) * 32 + kg * 8; const f32x4 ga = *(const f32x4*)(g2 + k), gb = *(const f32x4*)(g2 + k + 4); const u32x4 hq = hv[u8];
                    float x[8] = {bf2f(hq.x & 0xffffu) * rstd * ga[0], bf2f(hq.x >> 16) * rstd * ga[1], bf2f(hq.y & 0xffffu) * rstd * ga[2], bf2f(hq.y >> 16) * rstd * ga[3], bf2f(hq.z & 0xffffu) * rstd * gb[0], bf2f(hq.z >> 16) * rstd * gb[1], bf2f(hq.w & 0xffffu) * rstd * gb[2], bf2f(hq.w >> 16) * rstd * gb[3]};
                    unsigned hb[8]; float lr[8];
#pragma unroll
                    for (int j = 0; j < 8; ++j) { hb[j] = f2bf(x[j]); lr[j] = x[j] - bf2f(hb[j]); }
                    u32x4 hi4; hi4.x = hb[0] | (hb[1] << 16); hi4.y = hb[2] | (hb[3] << 16); hi4.z = hb[4] | (hb[5] << 16); hi4.w = hb[6] | (hb[7] << 16);
                    u32x4 lo4; lo4.x = pk2(lr[0], lr[1]); lo4.y = pk2(lr[2], lr[3]); lo4.z = pk2(lr[4], lr[5]); lo4.w = pk2(lr[6], lr[7]);
                    { u32x2 q8; q8.x = pk4_fp8(x[0], x[1], x[2], x[3]); q8.y = pk4_fp8(x[4], x[5], x[6], x[7]); *(u32x2*)(xo + k) = q8; }
                    const bf16x8 xh = __builtin_bit_cast(bf16x8, hi4), xl = __builtin_bit_cast(bf16x8, lo4);
                    const bf16x8 wh0 = *(const LAS bf16x8*)(wh + tl * 2064 + k * 2), wh1 = *(const LAS bf16x8*)(wh + (16 + tl) * 2064 + k * 2), wl0 = *(const LAS bf16x8*)(wl + tl * 2064 + k * 2), wl1 = *(const LAS bf16x8*)(wl + (16 + tl) * 2064 + k * 2);
                    a0 = __builtin_amdgcn_mfma_f32_16x16x32_bf16(wh0, xh, a0, 0, 0, 0); a0 = __builtin_amdgcn_mfma_f32_16x16x32_bf16(wh0, xl, a0, 0, 0, 0); a0 = __builtin_amdgcn_mfma_f32_16x16x32_bf16(wl0, xh, a0, 0, 0, 0);
                    a1 = __builtin_amdgcn_mfma_f32_16x16x32_bf16(wh1, xh, a1, 0, 0, 0); a1 = __builtin_amdgcn_mfma_f32_16x16x32_bf16(wh1, xl, a1, 0, 0, 0); a1 = __builtin_amdgcn_mfma_f32_16x16x32_bf16(wl1, xh, a1, 0, 0, 0); } }
            float lg[8]; int le[8]; const float* br = F.in[I_BR];
#pragma unroll
            for (int j = 0; j < 4; ++j) { le[j] = 4 * kg + j; le[4 + j] = 16 + 4 * kg + j; lg[j] = a0[j] + br[le[j]]; lg[4 + j] = a1[j] + br[le[4 + j]]; }
            float tv[4]; int te[4];
#pragma unroll
            for (int r = 0; r < 4; ++r) { float bv = -3.0e38f; int be = 1 << 20;
#pragma unroll
                for (int j = 0; j < 8; ++j) if (lg[j] > bv || (lg[j] == bv && le[j] < be)) { bv = lg[j]; be = le[j]; }
#pragma unroll
                for (int o = 16; o <= 32; o <<= 1) { const float ov = __shfl_xor(bv, o); const int oe = __shfl_xor(be, o); if (ov > bv || (ov == bv && oe < be)) { bv = ov; be = oe; } }
                tv[r] = bv; te[r] = be;
#pragma unroll
                for (int j = 0; j < 8; ++j) if (le[j] == be) lg[j] = -3.0e38f; }
            if (kg == 0) { const float e1 = __expf(tv[1] - tv[0]), e2 = __expf(tv[2] - tv[0]), e3 = __expf(tv[3] - tv[0]); const float inv = 1.0f / (1.0f + e1 + e2 + e3);
                *(f32x4*)((float*)(ws + WS_TOPW) + (size_t)tok * 4) = (f32x4){inv, e1 * inv, e2 * inv, e3 * inv};
                int* tp = (int*)(ws + WS_TOPE) + (size_t)tok * 4; tp[0] = te[0]; tp[1] = te[1]; tp[2] = te[2]; tp[3] = te[3];
#pragma unroll
                for (int r = 0; r < 4; ++r) __hip_atomic_fetch_add((LAS unsigned*)(hist + te[r]), 1u, __ATOMIC_RELAXED, __HIP_MEMORY_SCOPE_WORKGROUP); }
        }
        __syncthreads();
        if (F.tid < 32) __hip_atomic_fetch_add(F.ctl + CW_CNT + F.tid, hist[F.tid], __ATOMIC_RELAXED, __HIP_MEMORY_SCOPE_AGENT);
}
__device__ __forceinline__ void phase9(Frame& F, const int var) {
    unsigned char* ws = F.ws; (void)ws;
        volatile LAS unsigned* sb = F.MISC + 16;
        LAS unsigned* base = (LAS unsigned*)F.lds; LAS unsigned* lcnt = base + 64; LAS unsigned* gb = base + 128; (void)sb;
        if (F.tid < 32) { lcnt[F.tid] = 0u; }
        if (F.tid == 0) { unsigned run = 0; for (int e = 0; e < NE; ++e) { const unsigned c = __hip_atomic_load(F.ctl + CW_CNT + e, __ATOMIC_RELAXED, __HIP_MEMORY_SCOPE_AGENT); base[e] = run * 256u; base[32 + e] = c; run += (c + 255u) >> 8; }
            base[96] = run; if (F.bx == 0) F.ctl[CW_NTILES] = run; }
        __syncthreads();
        if (F.bx == 0) { for (int e = 0; e < NE; ++e) { const unsigned t0 = base[e] >> 8, nt_ = (base[32 + e] + 255u) >> 8; for (unsigned t = F.tid; t < nt_; t += 512) ((int*)(ws + WS_TILEE))[t0 + t] = e; } }
        if (F.bx < NE) { const int e = F.bx; const unsigned c = base[32 + e], pe = ((c + 255u) >> 8) << 8; for (unsigned r = c + F.tid; r < pe; r += 512) { ((int*)(ws + WS_ROWTOK))[base[e] + r] = 0; ((int*)(ws + WS_ROWSLOT))[base[e] + r] = -1; } }
        for (int vb = F.bx; vb < T / 128; vb += F.G) {
            const int tok = vb * 128 + (F.tid >> 2), k = F.tid & 3; const int e = ((const int*)(ws + WS_TOPE))[(size_t)tok * 4 + k];
            const unsigned lr = __hip_atomic_fetch_add(lcnt + e, 1u, __ATOMIC_RELAXED, __HIP_MEMORY_SCOPE_WORKGROUP);
            __syncthreads();
            if (F.tid < 32) { gb[F.tid] = __hip_atomic_fetch_add(F.ctl + CW_FILL + F.tid, lcnt[F.tid], __ATOMIC_RELAXED, __HIP_MEMORY_SCOPE_AGENT); lcnt[F.tid] = 0u; }
            __syncthreads();
            const unsigned prow = base[e] + gb[e] + lr; ((int*)(ws + WS_ROWTOK))[prow] = tok; ((int*)(ws + WS_ROWSLOT))[prow] = tok * 4 + k;
            __syncthreads();
        }
}
__device__ __forceinline__ void phase10(Frame& F, const int var) {
    unsigned char* ws = F.ws; (void)ws;
        const int ntiles = (int)__hip_atomic_load(F.ctl + CW_NTILES, __ATOMIC_RELAXED, __HIP_MEMORY_SCOPE_AGENT);
        SchedMoe S{(const char*)(ws + WS_XN2), (const char*)(ws + WS_WGU), (const int*)(ws + WS_TILEE), ntiles, 8, F.G, F.bx, (size_t)2048 * D, (size_t)256 * D, true, var};
        EpiMoe1 E{F.in[I_BGU], (const int*)(ws + WS_TILEE), (unsigned char*)(ws + WS_A2), var};
        if (MK_STAGGER) stagger(F, MK_STAGGER * 10);
        pg8::gemm_phase<EpiMoe1, SchedMoe, true, true>(F.lds, D, D, D, S, E, (const int*)(ws + WS_ROWTOK));
}
__device__ __forceinline__ void phase11(Frame& F, const int var) {
    unsigned char* ws = F.ws; (void)ws;
        const int ntiles = (int)__hip_atomic_load(F.ctl + CW_NTILES, __ATOMIC_RELAXED, __HIP_MEMORY_SCOPE_AGENT);
        SchedMoe S{(const char*)(ws + WS_A2), (const char*)(ws + WS_WD), (const int*)(ws + WS_TILEE), ntiles, 4, F.G, F.bx, (size_t)D * DF, (size_t)256 * DF, false, var};
        EpiMoe2 E{F.in[I_BD], (const int*)(ws + WS_TILEE), (const int*)(ws + WS_ROWSLOT), (unsigned char*)(ws + WS_YS), var};
        pg8::gemm_phase<EpiMoe2, SchedMoe, false, true>(F.lds, DF, DF, DF, S, E, nullptr, var);
}
__device__ __forceinline__ void phase12(Frame& F, const int var) {
    unsigned char* ws = F.ws; (void)ws;
        const int lane = F.lane; const float* fg = F.in[I_FNG];
        float pe = 0.f; if (MK_STAMP >= 0) { const float dt = __builtin_bit_cast(float, __hip_atomic_load(F.ctl + 200, __ATOMIC_RELAXED, __HIP_MEMORY_SCOPE_AGENT)); pe = sqrtf(dt * MK_STAMP_SCALE); if (lane & 1) pe = -pe; }
        const int NW = F.G * 8; int tok = F.vcu * 8 + F.wave;
        u32x2 hq[4]; unsigned yq[4][4]; f32x4 wq;
#define P12_LOAD(t_) do { wq = *(const f32x4*)((const float*)(ws + WS_TOPW) + (size_t)(t_) * 4); _Pragma("unroll") for (int j = 0; j < 4; ++j) { hq[j] = *((const u32x2*)((const bf16_t*)(ws + WS_H1) + (size_t)(t_) * D) + lane + 64 * j); \
            _Pragma("unroll") for (int k = 0; k < 4; ++k) yq[j][k] = *((const unsigned*)((const unsigned char*)(ws + WS_YS) + ((size_t)(t_) * 4 + k) * D) + lane + 64 * j); } } while (0)
        if (tok < T) P12_LOAD(tok);
        for (; tok < T; tok += NW) {
            const float wk[4] = {wq[0], wq[1], wq[2], wq[3]}; f32x4 v[4]; float s = 0.f;
#pragma unroll
            for (int j = 0; j < 4; ++j) { v[j] = (f32x4){bf2f(hq[j].x & 0xffffu), bf2f(hq[j].x >> 16), bf2f(hq[j].y & 0xffffu), bf2f(hq[j].y >> 16)};
#pragma unroll
                for (int k = 0; k < 4; ++k) { const unsigned y = yq[j][k]; const f32x2 lo = __builtin_amdgcn_cvt_pk_f32_fp8((int)y, false), hi = __builtin_amdgcn_cvt_pk_f32_fp8((int)y, true);
                    v[j].x += wk[k] * lo.x; v[j].y += wk[k] * lo.y; v[j].z += wk[k] * hi.x; v[j].w += wk[k] * hi.y; }
                s += (v[j].x * v[j].x + v[j].y * v[j].y) + (v[j].z * v[j].z + v[j].w * v[j].w); }
            if (tok + NW < T) P12_LOAD(tok + NW);
            const float rstd = 1.0f / sqrtf(wave_sum(s) * (1.0f / D) + EPS);
            f32x4* o = (f32x4*)(F.out + (size_t)tok * D) + lane;
#pragma unroll
            for (int j = 0; j < 4; ++j) { const f32x4 gg = ((const f32x4*)fg)[lane + 64 * j]; o[64 * j] = (f32x4){v[j].x * rstd * gg.x * (1.f + pe), v[j].y * rstd * gg.y * (1.f - pe), v[j].z * rstd * gg.z * (1.f + pe), v[j].w * rstd * gg.w * (1.f - pe)}; }
        }
#undef P12_LOAD
}
struct Args { const float* in[26]; float* out; unsigned char* ws; int ph_lo, ph_hi; };
constexpr int NPHASE = 13;

__global__ void __launch_bounds__(512, 2) mk_fwd(Args args) {
    extern __shared__ __attribute__((aligned(16))) unsigned char lds[];
    Frame F;
    F.lds = (LAS unsigned char*)lds; F.MISC = (volatile LAS unsigned*)(F.lds + MISC_OFF);
    F.tid = threadIdx.x; F.lane = F.tid & 63; F.wave = __builtin_amdgcn_readfirstlane(F.tid >> 6);
    F.G = gridDim.x; F.bx = blockIdx.x; F.vcu = (F.G % 8 == 0) ? (F.bx % 8) * (F.G / 8) + F.bx / 8 : F.bx;
    F.ws = args.ws; F.ctl = (unsigned*)(args.ws + WS_CTL); F.out = args.out;
#pragma unroll
    for (int i = 0; i < 26; ++i) F.in[i] = args.in[i];
    for (int u = F.tid; u < 64; u += 512) F.MISC[u] = 0u;
    __syncthreads();
    unsigned char* ws = F.ws;
    XcdBarrier bar; bar.bar = F.ctl + CW_BAR; bar.x = 0; bar.st = nullptr;
    if (!MK_PER_PHASE) bar = xcd_barrier_post(F.ctl + CW_BAR, F.MISC + 8);
    const int lo = args.ph_lo, hi = args.ph_hi;
    unsigned long long ts_a = 0ull, ts_b = 0ull; (void)ts_a; (void)ts_b;
#define STAMP(k) do { if (MK_STAMP >= 0 && F.bx == 0 && F.tid == 0) { if ((k) == MK_STAMP) ts_a = __builtin_amdgcn_s_memrealtime(); if ((k) == MK_STAMP + 1) { ts_b = __builtin_amdgcn_s_memrealtime(); \
        __hip_atomic_store(F.ctl + 200, __builtin_bit_cast(unsigned, (float)(ts_b - ts_a) * 0.01f), __ATOMIC_RELAXED, __HIP_MEMORY_SCOPE_AGENT); } } } while (0)
#define IN(k) (lo <= (k) && (k) < hi)
#define SEAM(k) do { if (IN(k) && IN((k) + 1)) xcd_barrier(bar); } while (0)

    STAMP(0);
    if (IN(0)) { phase0(F, 0); if ((MK_REP_MASK >> 0) & 1) { xcd_barrier(bar); phase0(F, MK_VARIANT); } }
    SEAM(0);
    STAMP(1);
    if (IN(1)) { phase1(F, 0); if ((MK_REP_MASK >> 1) & 1) { xcd_barrier(bar); phase1(F, MK_VARIANT); } }
    SEAM(1);
    STAMP(2);
    if (IN(2)) { phase2(F, 0); if ((MK_REP_MASK >> 2) & 1) { xcd_barrier(bar); phase2(F, MK_VARIANT); } }
    SEAM(2);
    STAMP(3);
    if (IN(3)) { phase3(F, 0); if ((MK_REP_MASK >> 3) & 1) { xcd_barrier(bar); phase3(F, MK_VARIANT); } }
    SEAM(3);
    STAMP(4);
    if (IN(4)) { phase4(F, 0); if ((MK_REP_MASK >> 4) & 1) { xcd_barrier(bar); phase4(F, MK_VARIANT); } }
    SEAM(4);
    STAMP(5);
    if (IN(5)) { phase5(F, 0); if ((MK_REP_MASK >> 5) & 1) { xcd_barrier(bar); phase5(F, MK_VARIANT); } }
    SEAM(5);
    STAMP(6);
    if (IN(6)) { phase6(F, 0); if ((MK_REP_MASK >> 6) & 1) { xcd_barrier(bar); phase6(F, MK_VARIANT); } }
    SEAM(6);
    STAMP(7);
    if (IN(7)) { phase7(F, 0); if ((MK_REP_MASK >> 7) & 1) { xcd_barrier(bar); phase7(F, MK_VARIANT); } }
    SEAM(7);
    STAMP(8);
    if (IN(8)) { phase8(F, 0); if ((MK_REP_MASK >> 8) & 1) { xcd_barrier(bar); phase8(F, MK_VARIANT); } }
    SEAM(8);
    STAMP(9);
    if (IN(9)) { phase9(F, 0); if ((MK_REP_MASK >> 9) & 1) { xcd_barrier(bar); phase9(F, MK_VARIANT); } }
    SEAM(9);
    STAMP(10);
    if (IN(10)) { phase10(F, 0); if ((MK_REP_MASK >> 10) & 1) { xcd_barrier(bar); phase10(F, MK_VARIANT); } }
    SEAM(10);
    STAMP(11);
    if (IN(11)) { phase11(F, 0); if ((MK_REP_MASK >> 11) & 1) { xcd_barrier(bar); phase11(F, MK_VARIANT); } }
    SEAM(11);
    STAMP(12);
    if (IN(12)) { phase12(F, 0); if ((MK_REP_MASK >> 12) & 1) { xcd_barrier(bar); phase12(F, MK_VARIANT); } }
#undef IN
#undef SEAM
}

extern "C" void kernel_launch(void* const* d_in, const int* in_sizes, int n_in, void* d_out, int out_size, void* d_ws, size_t ws_size, hipStream_t stream) {
    static int grid = 0;
    if (grid == 0) {
        if (n_in != 26 || in_sizes[0] != T * D || out_size != T * D || ws_size < WS_END) { fprintf(stderr, "kernel_launch: unexpected shapes (n_in %d, in0 %d, out %d, ws %zu < %zu)\n", n_in, n_in > 0 ? in_sizes[0] : -1, out_size, ws_size, (size_t)WS_END); grid = -1; return; }
        int dev = 0, cus = 0, per_cu = 0;
        if (hipGetDevice(&dev) != hipSuccess || hipDeviceGetAttribute(&cus, hipDeviceAttributeMultiprocessorCount, dev) != hipSuccess) { grid = -1; return; }
        if (hipFuncSetAttribute((const void*)mk_fwd, hipFuncAttributeMaxDynamicSharedMemorySize, LDS_BYTES) != hipSuccess) { fprintf(stderr, "kernel_launch: hipFuncSetAttribute failed\n"); grid = -1; return; }
        if (hipOccupancyMaxActiveBlocksPerMultiprocessor(&per_cu, (const void*)mk_fwd, 512, LDS_BYTES) != hipSuccess || per_cu < 1) fprintf(stderr, "kernel_launch: occupancy query reports %d\n", per_cu);
        (void)hipGetLastError();
        grid = cus;
        if (grid != 256) fprintf(stderr, "kernel_launch: %d CUs (built for 256)\n", grid);
    }
    if (grid < 0) return;
    (void)hipMemsetAsync((char*)d_ws + WS_CTL, 0, 1 * MiB, stream);
    Args a{};
    for (int i = 0; i < 26; ++i) a.in[i] = (const float*)d_in[i];
    a.out = (float*)d_out; a.ws = (unsigned char*)d_ws;
#if MK_PER_PHASE
    for (int p = 0; p < NPHASE; ++p) { a.ph_lo = p; a.ph_hi = p + 1; hipLaunchKernelGGL(mk_fwd, dim3(grid), dim3(512), LDS_BYTES, stream, a); }
#else
    a.ph_lo = 0; a.ph_hi = NPHASE; hipLaunchKernelGGL(mk_fwd, dim3(grid), dim3(512), LDS_BYTES, stream, a);
#endif
}
```

```cpp
#include <hip/hip_runtime.h>
#include <cstdio>
#include <cstdint>

#ifndef MK_PER_PHASE
#define MK_PER_PHASE 0
#endif

#ifndef MK_REP_MASK
#define MK_REP_MASK 0
#endif

#ifndef MK_P1_F8
#define MK_P1_F8 0
#endif
#ifndef MK_BGW
#define MK_BGW (!MK_PER_PHASE)
#endif
#ifndef MK_PERG_F64
#define MK_PERG_F64 1
#endif
#ifndef MK_P7_F8
#define MK_P7_F8 1
#endif
#ifndef MK_P7_XSH
#define MK_P7_XSH 3
#endif
#ifndef MK_GATES_F8
#define MK_GATES_F8 1
#endif
#ifndef MK_GSTORE_F8
#define MK_GSTORE_F8 1
#endif
#ifndef MK_STAGGER
#define MK_STAGGER 0
#endif
#ifndef MK_STAMP
#define MK_STAMP -1
#endif
#define MK_STAMP_SCALE 1e-5f
#ifndef MK_VARIANT
#define MK_VARIANT 0
#endif

#define LAS __attribute__((address_space(3)))
#define GAS __attribute__((address_space(1)))
typedef unsigned short bf16_t;
typedef short bf16x8 __attribute__((ext_vector_type(8)));
typedef float f32x4 __attribute__((ext_vector_type(4)));
typedef float f32x2 __attribute__((ext_vector_type(2)));
typedef float f32x16 __attribute__((ext_vector_type(16)));
typedef unsigned u32x4 __attribute__((ext_vector_type(4)));
typedef unsigned u32x2 __attribute__((ext_vector_type(2)));
typedef int i32x4 __attribute__((ext_vector_type(4)));
typedef int i32x8 __attribute__((ext_vector_type(8)));

constexpr int T = 32768, D = 1024, NB = 4, SEQ = 8192, NCH = 128, CH = 64, NMETA = 16, INW = 4608;
constexpr int SG = 32, SH = 16, SP = 64;
constexpr int HH = 4, HD = 128, HW = 512;
constexpr int NE = 32, TOPK = 4, DF = 1024;
constexpr int UAK = 1152, UA0 = 128;
constexpr float EPS = 1e-6f;
constexpr int MAXTILES = 544;

constexpr size_t MiB = 1u << 20, KiB = 1024;
constexpr size_t WS_CTL = 0;
constexpr size_t WS_LBV = 1 * MiB, WS_LAMB = 1 * MiB + 4 * KiB, WS_LAMC = 1 * MiB + 20 * KiB, WS_XMETA = 1 * MiB + 36 * KiB;
constexpr size_t WS_BBAR = 1 * MiB + 64 * KiB, WS_WRT = 1 * MiB + 320 * KiB, WS_PMR = 1 * MiB + 512 * KiB  ;
constexpr size_t WS_KCONV = 2 * MiB, WS_SMETA = 3 * MiB;
constexpr size_t WS_WIN = 4 * MiB, WS_WGLU = 13 * MiB, WS_WBS = 14 * MiB, WS_WBH = 15 * MiB, WS_WOUT = 16 * MiB, WS_WGU = 18 * MiB, WS_WD = 146 * MiB;
constexpr size_t WS_TZ = 210 * MiB, WS_WE = 282 * MiB, WS_XN = 298 * MiB, WS_UA = 362 * MiB, WS_Q = 398 * MiB, WS_LOGF = 430 * MiB, WS_V = 494 * MiB;
constexpr size_t WS_GS = 526 * MiB, WS_GATES = 558 * MiB, WS_KVT = 686 * MiB, WS_SPREV = 814 * MiB, WS_SE = 878 * MiB, WS_DEC = 886 * MiB;
constexpr size_t WS_Y1 = 888 * MiB, WS_YHG = 920 * MiB, WS_YS5 = 952 * MiB, WS_PMETA = 814 * MiB  , WS_XN8 = 986 * MiB  , WS_END = 1018 * MiB;
constexpr size_t WS_WIN8 = WS_WIN + 5 * MiB;
constexpr size_t WS_BCUM = 622 * MiB;
constexpr size_t WS_RMS = 1 * MiB + 640 * KiB;
constexpr size_t WS_MERGED = 686 * MiB, WS_XN2 = 210 * MiB, WS_H1 = 558 * MiB  , WS_SSQ = 402 * MiB, WS_TOPE = 404 * MiB, WS_TOPW = 404 * MiB + 512 * KiB;
constexpr size_t WS_LIST = 398 * MiB;
constexpr int MT_BASE = 64, MT_CNT = 96, MT_NT = 128, MT_TILEE = 160;
constexpr size_t WS_ROWTOK = 405 * MiB, WS_ROWSLOT = 406 * MiB, WS_TILEE = 407 * MiB, WS_A2 = 408 * MiB, WS_YS = 680 * MiB;
constexpr int CW_WQ = 512  , P0_MOE_TILES = 16384 + 8192, BGW_PER_SHARD = P0_MOE_TILES / 8;
constexpr int CW_CNT = 64, CW_FILL = 128, CW_NTILES = 192, CW_HGQ = 256  , CW_BAR = 4096;

constexpr int RING_BYTES = 131072, GOFF_LDS = RING_BYTES, MISC_OFF = RING_BYTES + 16384 + 256, LDS_BYTES = 155648;


__device__ __forceinline__ float bf2f(unsigned b) { return __builtin_bit_cast(float, b << 16); }

typedef __bf16 bf16x2_t __attribute__((ext_vector_type(2)));
__device__ __forceinline__ unsigned cvt_pk_bf16(float lo, float hi) { const bf16x2_t v = __builtin_convertvector((f32x2){lo, hi}, bf16x2_t); return __builtin_bit_cast(unsigned, v); }
__device__ __forceinline__ unsigned f2bf(float f) { const __bf16 h = (__bf16)f; return (unsigned)__builtin_bit_cast(unsigned short, h); }
__device__ __forceinline__ unsigned pk2(float lo, float hi) { return cvt_pk_bf16(lo, hi); }
__device__ __forceinline__ unsigned pk4_fp8(float a, float b, float c, float d) {
    a = __builtin_amdgcn_fmed3f(a, -448.f, 448.f); b = __builtin_amdgcn_fmed3f(b, -448.f, 448.f); c = __builtin_amdgcn_fmed3f(c, -448.f, 448.f); d = __builtin_amdgcn_fmed3f(d, -448.f, 448.f);
    int w = 0; w = __builtin_amdgcn_cvt_pk_fp8_f32(a, b, w, false); w = __builtin_amdgcn_cvt_pk_fp8_f32(c, d, w, true); return (unsigned)w; }
__device__ __forceinline__ unsigned pk4_fp8_nc(float a, float b, float c, float d) { int w = 0; w = __builtin_amdgcn_cvt_pk_fp8_f32(a, b, w, false); w = __builtin_amdgcn_cvt_pk_fp8_f32(c, d, w, true); return (unsigned)w; }
__device__ __forceinline__ unsigned pk4_u8(float a, float b, float c, float d) {
    return (unsigned)(a * 255.f + 0.5f) | ((unsigned)(b * 255.f + 0.5f) << 8) | ((unsigned)(c * 255.f + 0.5f) << 16) | ((unsigned)(d * 255.f + 0.5f) << 24); }
__device__ __forceinline__ float sigmoidf_(float x) { return __builtin_amdgcn_rcpf(1.0f + __builtin_amdgcn_exp2f(x * -1.4426950408889634f)); }
__device__ __forceinline__ float wave_sum(float v) {
#pragma unroll
    for (int o = 1; o < 64; o <<= 1) v += __shfl_xor(v, o);
    return v;
}
#define LDS_WAIT() asm volatile("s_waitcnt lgkmcnt(0)" ::: "memory")
#define VM_WAIT() asm volatile("s_waitcnt vmcnt(0)" ::: "memory")

#define XB_TMO      128
#define XB_XCNT(j)  (256  + 64 * (j))
#define XB_XSUB(j)  (1280 + 64 * (j))
#define XB_XGEN(j)  (2304 + 64 * (j))
#define XB_TOP      3328
#define XB_TOPGEN   3392
#define XCD_BAR_WORDS 3456
#define XB_SPIN_CAP (1u << 22)
__device__ __forceinline__ unsigned xb_ld(unsigned* p)              { return __hip_atomic_load(p, __ATOMIC_RELAXED, __HIP_MEMORY_SCOPE_AGENT); }
__device__ __forceinline__ unsigned xb_add(unsigned* p, unsigned v) { return __hip_atomic_fetch_add(p, v, __ATOMIC_RELAXED, __HIP_MEMORY_SCOPE_AGENT); }
__device__ __forceinline__ unsigned xb_xcc_id() { return (unsigned)__builtin_amdgcn_s_getreg((3 << 11) | 20) & 0xFu; }
#define XB_SPIN(cond, bar) do { unsigned _sp = 0; while (cond) { __builtin_amdgcn_s_sleep(1); \
    if ((++_sp & 255u) == 0u) { if (xb_ld(&(bar)[XB_TMO])) break; if (_sp > XB_SPIN_CAP) { atomicAdd(&(bar)[XB_TMO], 1u); break; } } } } while (0)
struct XcdBarrier { unsigned* bar; unsigned x; volatile LAS unsigned* st; };
__device__ __forceinline__ XcdBarrier xcd_barrier_post(unsigned* bar, volatile LAS unsigned* st) {
    XcdBarrier b; b.bar = bar; b.x = xb_xcc_id(); b.st = st;
    if (threadIdx.x == 0) (void)xb_add(&bar[XB_XCNT(b.x)], 1u);
    return b;
}
__device__ __forceinline__ void xcd_barrier_complete(unsigned* bar, unsigned x, unsigned& nloc, unsigned& nx) {
    const unsigned G = gridDim.x * gridDim.y * gridDim.z;
    unsigned sum, cnt, mine, sp = 0u;
    for (;;) {
        sum = 0u; cnt = 0u; mine = 0u;
#pragma unroll
        for (unsigned j = 0; j < 16; ++j) { const unsigned c = xb_ld(&bar[XB_XCNT(j)]); sum += c; cnt += (c > 0u) ? 1u : 0u; mine = (j == x) ? c : mine; }
        if (sum == G) break;
        __builtin_amdgcn_s_sleep(1);
        if ((++sp & 255u) == 0u) { if (xb_ld(&bar[XB_TMO])) break; if (sp > XB_SPIN_CAP) { atomicAdd(&bar[XB_TMO], 1u); break; } }
    }
    nloc = mine > 0u ? mine : 1u; nx = cnt > 0u ? cnt : 1u;
}
__device__ __forceinline__ void xcd_barrier(const XcdBarrier& b) {
    asm volatile("s_waitcnt vmcnt(0)" ::: "memory");
    __syncthreads();
    if (threadIdx.x == 0) {
        unsigned* bar = b.bar;
        __builtin_amdgcn_s_waitcnt(0);
        unsigned nloc = b.st[0], nx = b.st[1];
        if (nloc == 0u) { xcd_barrier_complete(bar, b.x, nloc, nx); b.st[0] = nloc; b.st[1] = nx; }
        const unsigned old = xb_add(&bar[XB_XSUB(b.x)], 1u);
        const unsigned gen = old / nloc;
        if (old + 1u == (gen + 1u) * nloc) {
            __builtin_amdgcn_fence(__ATOMIC_RELEASE, "agent");
            asm volatile("s_waitcnt vmcnt(0)" ::: "memory");
            const unsigned og = xb_add(&bar[XB_TOP], 1u);
            const unsigned tg = og / nx;
            if (og + 1u == (tg + 1u) * nx) xb_add(&bar[XB_TOPGEN], 1u);
            else XB_SPIN(xb_ld(&bar[XB_TOPGEN]) == tg, bar);
            __builtin_amdgcn_fence(__ATOMIC_ACQUIRE, "agent");
            xb_add(&bar[XB_XGEN(b.x)], 1u);
            asm volatile("s_waitcnt vmcnt(0)" ::: "memory");
        } else {
            XB_SPIN(xb_ld(&bar[XB_XGEN(b.x)]) == gen, bar);
            __builtin_amdgcn_fence(__ATOMIC_ACQUIRE, "agent");
            asm volatile("s_waitcnt vmcnt(0)" ::: "memory");
        }
    }
    __syncthreads();
}

struct XbWait { unsigned mode, key; };
__device__ __forceinline__ XbWait xcd_arrive(const XcdBarrier& b) {
    unsigned* bar = b.bar; XbWait w; w.mode = 0u; w.key = 0u;
    __builtin_amdgcn_s_waitcnt(0);
    unsigned nloc = b.st[0], nx = b.st[1];
    if (nloc == 0u) { xcd_barrier_complete(bar, b.x, nloc, nx); b.st[0] = nloc; b.st[1] = nx; }
    const unsigned old = xb_add(&bar[XB_XSUB(b.x)], 1u);
    const unsigned gen = old / nloc;
    if (old + 1u == (gen + 1u) * nloc) {
        __builtin_amdgcn_fence(__ATOMIC_RELEASE, "agent");
        asm volatile("s_waitcnt vmcnt(0)" ::: "memory");
        const unsigned og = xb_add(&bar[XB_TOP], 1u);
        const unsigned tg = og / nx;
        if (og + 1u == (tg + 1u) * nx) { xb_add(&bar[XB_TOPGEN], 1u);
            __builtin_amdgcn_fence(__ATOMIC_ACQUIRE, "agent");
            xb_add(&bar[XB_XGEN(b.x)], 1u);
            asm volatile("s_waitcnt vmcnt(0)" ::: "memory");
            return w; }
        w.mode = 2u; w.key = tg; return w; }
    w.mode = 1u; w.key = gen; return w;
}
__device__ __forceinline__ bool xcd_poll(const XcdBarrier& b, XbWait& w) {
    unsigned* bar = b.bar;
    if (w.mode == 1u) { if (xb_ld(&bar[XB_XGEN(b.x)]) == w.key) return false;
        __builtin_amdgcn_fence(__ATOMIC_ACQUIRE, "agent"); asm volatile("s_waitcnt vmcnt(0)" ::: "memory"); w.mode = 0u; return true; }
    if (w.mode == 2u) { if (xb_ld(&bar[XB_TOPGEN]) == w.key) return false;
        (void)xb_add(&bar[XB_XGEN(b.x)], 1u);
        __builtin_amdgcn_fence(__ATOMIC_ACQUIRE, "agent"); asm volatile("s_waitcnt vmcnt(0)" ::: "memory"); w.mode = 0u; return true; }
    return true;
}

namespace pg8 {
constexpr int BM = 256, BK = 64, HALF = 128, HTB = HALF * BK * 2, STAGE_BYTES = 8 * HTB, NXCD = 8, WGM = 2;
__device__ __forceinline__ int lds_byte(int r, int c) { const int st = (r >> 4) * 2 + (c >> 5), rr = r & 15, cc = c & 31, ob = rr * 64 + cc * 2; return st * 1024 + (ob ^ (((ob >> 9) & 1) << 5)); }
__device__ __forceinline__ void stage_rc(int b, int& R, int& C) { const int st = b / 1024, sb = b % 1024, swz = sb ^ (((sb >> 9) & 1) << 5); R = (st >> 1) * 16 + swz / 64; C = (st & 1) * 32 + (swz % 64) / 2; }
__device__ __forceinline__ int perm32(int rho) { const int n = rho >> 4, i = rho & 15; return 8 * (i >> 2) + 4 * n + (i & 3); }

struct Unit { int pm, pn, aux, kt; const char* a; const char* b; int lim; };

__device__ __forceinline__ bool static_tile(int L, int nM, int nN, int& pm, int& pn) {
    const int nwg = nM * nN; if (L >= nwg) return false;
    int wgid = L; { const int q = nwg / NXCD, r = nwg % NXCD, xcd = wgid % NXCD, off = wgid / NXCD; wgid = (xcd < r ? xcd * (q + 1) : r * (q + 1) + (xcd - r) * q) + off; }
    const int nig = WGM * nN, gid = wgid / nig, fm = gid * WGM, gsz = (nM - fm) < WGM ? (nM - fm) : WGM;
    pm = fm + ((wgid % nig) % gsz); pn = (wgid % nig) / gsz; return true;
}

constexpr int F8_WSH = 6;
template <class E, class = void> struct EpiXsh { static constexpr int v = 0; };
template <class E> struct EpiXsh<E, decltype((void)E::XSH)> { static constexpr int v = E::XSH; };
template <class Epi, class Sched, bool GATHER, bool F8 = false>
__device__ __forceinline__ void gemm_phase(LAS unsigned char* lds, const int K, const int lda, const int ldb, const Sched& S, const Epi& E, const int* __restrict__ rowidx, const int pv = 0) {
    const int tid = threadIdx.x, wid = __builtin_amdgcn_readfirstlane(tid >> 6), lane = tid & 63, wr = wid >> 2, wc = wid & 3, fr = lane & 15, fq = lane >> 4;
    constexpr int ES = F8 ? 1 : 2;
    const int nt0 = K / (F8 ? 128 : BK);
#define PG8_SW(r) ((((r) >> 1) & 7) ^ (((((r) >> 2) ^ ((r) >> 3)) & 1) * (F8 ? 2 : 1)))
    unsigned voffA[2], voffB[2], voffB16[2][2]; int gR[2], gC[2];
#pragma unroll
    for (int i = 0; i < 2; ++i) { const int q = tid * 16 + i * 8192, r = (q >> 7) & 15; const int R = (q >> 11) * 16 + r, C = (((q >> 4) & 7) ^ PG8_SW(r)) * 16;
        const int Rb = Epi::PERM ? ((R & ~31) + perm32(R & 31)) : R;
        voffA[i] = (unsigned)(R * lda * ES + C); voffB[i] = (unsigned)(Rb * ldb * ES + C); gR[i] = R; gC[i] = C;
#pragma unroll
        for (int h = 0; h < 2; ++h) { const int rho = R & 31, n_ = rho >> 4, i_ = rho & 15; voffB16[h][i] = (unsigned)((64 * (R >> 5) + 16 * (i_ >> 2) + 8 * h + 4 * n_ + (i_ & 3)) * ldb * ES + C); } }
    const size_t kstep = (size_t)(BK * 2);
    const size_t hstepA = (size_t)HALF * lda * ES, hstepB = (size_t)HALF * ldb * ES;
    const unsigned ldsw = (unsigned)wid * 1024u;
    const int sx = PG8_SW(fr), ck0 = F8 ? 2 * fq : fq, ck1 = F8 ? 2 * fq + 1 : 4 + fq;
    const int aoff0 = wr * 8192 + fr * 128 + 16 * (ck0 ^ sx), aoff1 = wr * 8192 + fr * 128 + 16 * (ck1 ^ sx), boff0 = wc * 4096 + fr * 128 + 16 * (ck0 ^ sx), boff1 = wc * 4096 + fr * 128 + 16 * (ck1 ^ sx);
#define PG8_SA(b, h) (((b) * 2 + (h)) * HTB)
#define PG8_SB(b, h) ((4 + (b) * 2 + (h)) * HTB)
#define PG8_GLDS(src, dstoff) do { if (!(pv & 32)) __builtin_amdgcn_global_load_lds((const unsigned*)(src), (LAS unsigned*)(lds + (dstoff)), 16, 0, 0); } while (0)
#define PG8_STAGEB(bufoff, gbase, h) do { if constexpr (Epi::P16) { PG8_GLDS((const char*)(gbase) + voffB16[h][0], (bufoff) + ldsw); PG8_GLDS((const char*)(gbase) + voffB16[h][1], (bufoff) + ldsw + 8192); } \
        else { PG8_GLDS((const char*)(gbase) + (h) * hstepB + voffB[0], (bufoff) + ldsw); PG8_GLDS((const char*)(gbase) + (h) * hstepB + voffB[1], (bufoff) + ldsw + 8192); } } while (0)
#define PG8_STAGEA(bufoff, gbase, h, SET) do { if constexpr (GATHER) { const u32x2 o_ = *(const LAS u32x2*)(lds + GOFF_LDS + ((SET) * 2 + (h)) * 4096 + tid * 8); \
        PG8_GLDS((const char*)(gbase) + o_.x, (bufoff) + ldsw); PG8_GLDS((const char*)(gbase) + o_.y, (bufoff) + ldsw + 8192); } \
        else { PG8_GLDS((const char*)(gbase) + (h) * hstepA + voffA[0], (bufoff) + ldsw); PG8_GLDS((const char*)(gbase) + (h) * hstepA + voffA[1], (bufoff) + ldsw + 8192); } } while (0)
#define PG8_LDA(dst, b, h) do { _Pragma("unroll") for (int m = 0; m < 4; ++m) { dst[m][0] = *(const LAS bf16x8*)(lds + PG8_SA(b, h) + aoff0 + m * 2048); dst[m][1] = *(const LAS bf16x8*)(lds + PG8_SA(b, h) + aoff1 + m * 2048); } } while (0)
#define PG8_LDB(dst, b, h) do { _Pragma("unroll") for (int n = 0; n < 2; ++n) { dst[n][0] = *(const LAS bf16x8*)(lds + PG8_SB(b, h) + boff0 + n * 2048); dst[n][1] = *(const LAS bf16x8*)(lds + PG8_SB(b, h) + boff1 + n * 2048); } } while (0)
#define PG8_CAT(lo, hi) __builtin_shufflevector(__builtin_bit_cast(i32x4, lo), __builtin_bit_cast(i32x4, hi), 0, 1, 2, 3, 4, 5, 6, 7)
#define PG8_MMA(ai, bj, At, Bt) do { if (pv & 16) { asm volatile("" :: "v"(At[0][0]), "v"(At[1][0]), "v"(At[2][0]), "v"(At[3][0]), "v"(At[0][1]), "v"(At[1][1]), "v"(At[2][1]), "v"(At[3][1]), "v"(Bt[0][0]), "v"(Bt[0][1]), "v"(Bt[1][0]), "v"(Bt[1][1])); break; } __builtin_amdgcn_s_setprio(1); _Pragma("unroll") for (int m = 0; m < 4; ++m) _Pragma("unroll") for (int n = 0; n < 2; ++n) { \
        if constexpr (F8) { const i32x8 b8_ = PG8_CAT(Bt[n][0], Bt[n][1]), a8_ = PG8_CAT(At[m][0], At[m][1]); \
            asm volatile("v_mfma_scale_f32_16x16x128_f8f6f4 %0, %1, %2, %0, %3, %4 op_sel_hi:[0,0,0]" : "+v"(acc[ai][bj][m][n]) : "v"(b8_), "v"(a8_), "v"(sc_w), "v"(sc_x)); } \
        else { _Pragma("unroll") for (int k = 0; k < 2; ++k) acc[ai][bj][m][n] = __builtin_amdgcn_mfma_f32_16x16x32_bf16(Bt[n][k], At[m][k], acc[ai][bj][m][n], 0, 0, 0); } } __builtin_amdgcn_s_setprio(0); } while (0)
#define PG8_WAIT_V(n) asm volatile("s_waitcnt vmcnt(" #n ")" ::: "memory")
#define PG8_WAIT_L(n) asm volatile("s_waitcnt lgkmcnt(" #n ")" ::: "memory")
#define PG8_BAR __builtin_amdgcn_s_barrier()
#define PG8_SCHED __builtin_amdgcn_sched_barrier(0)
#define PG8_GOFFS(SET, U) do { if constexpr (GATHER) { _Pragma("unroll") for (int h_ = 0; h_ < 2; ++h_) { u32x2 o_; \
        const int i0_ = (U).aux + h_ * HALF + gR[0], i1_ = (U).aux + h_ * HALF + gR[1]; const unsigned t0_ = i0_ < (U).lim ? (unsigned)rowidx[i0_] : 0u, t1_ = i1_ < (U).lim ? (unsigned)rowidx[i1_] : 0u;     \
        o_.x = t0_ * (unsigned)(lda * ES) + (unsigned)gC[0]; o_.y = t1_ * (unsigned)(lda * ES) + (unsigned)gC[1]; \
        *(LAS u32x2*)(lds + GOFF_LDS + ((SET) * 2 + h_) * 4096 + tid * 8) = o_; } } } while (0)
    const int sc_w = 127 - F8_WSH, sc_x = 127 - EpiXsh<Epi>::v; (void)sc_w; (void)sc_x;
    Unit cur, nxt; int ui = 0;
    if (!S.next(0, cur)) return;
    int nt = cur.kt ? cur.kt : nt0;
    f32x4 acc[2][2][4][2];
    typename Epi::Pre pre_;
    E.pre(pre_, cur, wc, fq); E.init(acc, pre_);
    bf16x8 At[4][2], B0[2][2], B1[2][2];
    PG8_GOFFS(0, cur);
    const char* cA = cur.a; const char* cB = cur.b;
    PG8_STAGEB(PG8_SB(0, 0), cB, 0); PG8_STAGEB(PG8_SB(0, 1), cB, 1); PG8_STAGEA(PG8_SA(0, 0), cA, 0, 0); PG8_STAGEA(PG8_SA(0, 1), cA, 1, 0);
    if (wr == 1) PG8_BAR;
    PG8_WAIT_V(2); PG8_BAR;
    PG8_STAGEB(PG8_SB(1, 0), cB + kstep, 0); PG8_STAGEA(PG8_SA(1, 0), cA + kstep, 0, 0); PG8_STAGEB(PG8_SB(1, 1), cB + kstep, 1);
    PG8_WAIT_V(6); PG8_BAR;
    for (;;) {
        const bool has_next = S.next(ui + 1, nxt);
        const int cs = ui & 1; if (has_next) PG8_GOFFS(cs ^ 1, nxt);
        const char* nA = has_next ? nxt.a : cA; const char* nB = has_next ? nxt.b : cB;
#pragma unroll 1
        for (int t = 0; t < nt; t += 2) {
            const bool last = (t == nt - 2);
            const char* a1 = cA + (size_t)(t + 1) * kstep;
            const char* a2 = last ? nA : cA + (size_t)(t + 2) * kstep; const char* b2 = last ? nB : cB + (size_t)(t + 2) * kstep;
            const char* a3 = a2 + kstep; const char* b3 = b2 + kstep;
            const int s2 = (last && has_next) ? (cs ^ 1) : cs;
            if (last && has_next) E.pre(pre_, nxt, wc, fq);
            PG8_LDB(B0, 0, 0); PG8_LDB(B1, 0, 1); PG8_SCHED; PG8_LDA(At, 0, 0); PG8_STAGEA(PG8_SA(1, 1), a1, 1, cs);
            PG8_WAIT_V(8); PG8_WAIT_L(0); PG8_BAR; PG8_MMA(0, 0, At, B0); PG8_MMA(0, 1, At, B1); PG8_BAR; PG8_SCHED;
            PG8_LDA(At, 0, 1); PG8_STAGEB(PG8_SB(0, 0), b2, 0); PG8_STAGEB(PG8_SB(0, 1), b2, 1); PG8_STAGEA(PG8_SA(0, 0), a2, 0, s2);
            PG8_WAIT_V(8); PG8_WAIT_L(0); PG8_BAR; PG8_MMA(1, 0, At, B0); PG8_MMA(1, 1, At, B1); PG8_BAR; PG8_SCHED;
            PG8_LDB(B0, 1, 0); PG8_LDB(B1, 1, 1); PG8_SCHED; PG8_LDA(At, 1, 0); PG8_STAGEA(PG8_SA(0, 1), a2, 1, s2);
            PG8_WAIT_V(8); PG8_WAIT_L(0); PG8_BAR; PG8_MMA(0, 0, At, B0); PG8_MMA(0, 1, At, B1); PG8_BAR; PG8_SCHED;
            PG8_LDA(At, 1, 1); PG8_STAGEB(PG8_SB(1, 0), b3, 0); PG8_STAGEB(PG8_SB(1, 1), b3, 1); PG8_STAGEA(PG8_SA(1, 0), a3, 0, s2);
            PG8_WAIT_V(8); PG8_WAIT_L(0); PG8_BAR; PG8_MMA(1, 0, At, B0); PG8_MMA(1, 1, At, B1); PG8_BAR; PG8_SCHED;
        }
        if constexpr (F8) {
            asm volatile("s_nop 15\n\ts_nop 15" : "+v"(acc[0][0][0][0]), "+v"(acc[0][0][0][1]), "+v"(acc[0][0][1][0]), "+v"(acc[0][0][1][1]), "+v"(acc[0][0][2][0]), "+v"(acc[0][0][2][1]), "+v"(acc[0][0][3][0]), "+v"(acc[0][0][3][1]),
                         "+v"(acc[0][1][0][0]), "+v"(acc[0][1][0][1]), "+v"(acc[0][1][1][0]), "+v"(acc[0][1][1][1]), "+v"(acc[0][1][2][0]), "+v"(acc[0][1][2][1]), "+v"(acc[0][1][3][0]), "+v"(acc[0][1][3][1]) :: "memory");
            asm volatile("" : "+v"(acc[1][0][0][0]), "+v"(acc[1][0][0][1]), "+v"(acc[1][0][1][0]), "+v"(acc[1][0][1][1]), "+v"(acc[1][0][2][0]), "+v"(acc[1][0][2][1]), "+v"(acc[1][0][3][0]), "+v"(acc[1][0][3][1]),
                         "+v"(acc[1][1][0][0]), "+v"(acc[1][1][0][1]), "+v"(acc[1][1][1][0]), "+v"(acc[1][1][1][1]), "+v"(acc[1][1][2][0]), "+v"(acc[1][1][2][1]), "+v"(acc[1][1][3][0]), "+v"(acc[1][1][3][1]) :: "memory"); }
        if (wr == 0) PG8_BAR;
        int fr_e = fr, fq_e = fq; asm volatile("" : "+v"(fr_e), "+v"(fq_e));
        const bool keep = E(acc, cur, wr, wc, fr_e, fq_e);
        if (!has_next) break;
        if (!keep) E.init(acc, pre_);
        cur = nxt; cA = nA; cB = nB; ++ui; nt = cur.kt ? cur.kt : nt0;
        if (wr == 1) PG8_BAR;
    }
    PG8_WAIT_V(0);
    PG8_BAR;
#undef PG8_SW
#undef PG8_SA
#undef PG8_SB
#undef PG8_GLDS
#undef PG8_STAGEA
#undef PG8_STAGEB
#undef PG8_LDA
#undef PG8_LDB
#undef PG8_MMA
#undef PG8_CAT
#undef PG8_WAIT_V
#undef PG8_WAIT_L
#undef PG8_BAR
#undef PG8_SCHED
#undef PG8_GOFFS
}
}
using pg8::Unit;

struct Frame {
    LAS unsigned char* lds; volatile LAS unsigned* MISC; unsigned* ctl; unsigned char* ws;
    int tid, lane, wave, vcu, G, bx;
    const float* in[26]; float* out;
};
enum { I_X = 0, I_META, I_N1G, I_WIN, I_LRE, I_LIM, I_LDT, I_BRE, I_BIM, I_CRE, I_CIM, I_SD, I_WGLU, I_LBL, I_HNG, I_WBS, I_WBH, I_WOUT, I_N2G, I_WR, I_BR, I_WGU, I_BGU, I_WD, I_BD, I_FNG };

struct SchedStatic {
    const char* A; const char* B; int nM, nN, G, c; size_t ta, tb; int var = 0, pn_off = 0;
    __device__ __forceinline__ bool next(int i, Unit& u) const { int pm, pn; if (!pg8::static_tile(i * G + c, nM, nN, pm, pn)) return false; u.pm = pm; u.pn = pn + pn_off; u.aux = 0; u.kt = 0; u.a = A + (size_t)pm * ta; u.b = B + (size_t)pn * tb; if (var & 8) { u.a = A; u.b = B; } return true; }
};
struct SchedS5E {
    const char* UA; const char* WE; int c;
    __device__ __forceinline__ bool next(int i, Unit& u) const { if (i > 0 || c >= 64) return false; const int x = c & 7, r = c >> 3, g = x * 4 + (r >> 1), pm = r & 1; u.pm = pm; u.pn = 0; u.aux = g; u.kt = 0;
        u.a = UA + (((size_t)g * 512 + pm * 256) * UAK + UA0) * 2; u.b = WE + (size_t)g * 256 * 1024 * 2; return true; }
};
struct SchedS5Y {
    const char* UA; const char* TZ; int c, G;
    __device__ __forceinline__ bool next(int i, Unit& u) const { if (i > 0 || G != 256) { const int L = i * G + c; if (G == 256 || L >= 256) return false; const int g = L >> 3; u.pm = (L >> 2) & 1; u.pn = L & 3; u.aux = g; u.kt = 6 + 4 * u.pn;
            u.a = UA + ((size_t)g * 512 + u.pm * 256) * UAK * 2; u.b = TZ + ((size_t)g * 1024 + u.pn * 256) * UAK * 2; return true; }
        const int x = c & 7, r = c >> 3, g = x + 8 * (r >> 3), pm = (r >> 2) & 1, pn = r & 3; u.pm = pm; u.pn = pn; u.aux = g; u.kt = 6 + 4 * pn;
        u.a = UA + ((size_t)g * 512 + pm * 256) * UAK * 2; u.b = TZ + ((size_t)g * 1024 + pn * 256) * UAK * 2; return true; }
};
struct SchedBranch {
    const char* A0; const char* A1; const char* B0; const char* B1; int G, c;
    __device__ __forceinline__ bool next(int i, Unit& u) const { int pm, pn; if (!pg8::static_tile((i >> 1) * G + c, T / 256, 4, pm, pn)) return false; const int part = i & 1; u.pm = pm; u.pn = pn; u.aux = part; u.kt = 0;
        u.a = (part ? A1 : A0) + (size_t)pm * 256 * HW * 2; u.b = (part ? B1 : B0) + (size_t)pn * 256 * HW * 2; return true; }
};
struct SchedMoe {
    const char* A; const char* W; volatile LAS unsigned* M; int ntiles, NN, G, c; size_t wexp, wtile; bool gather; int var;
    __device__ __forceinline__ bool next(int i, Unit& u) const { int ti, pn;
        if ((G & 7) == 0) { const int x = c & 7, j = i * (G >> 3) + (c >> 3), ml = j / NN, C = (ntiles + 7) >> 3; pn = j - ml * NN; ti = x * C + ml; if (ml >= C) return false; }
        else { const int L = i * G + c; ti = L / NN; pn = L - ti * NN; }
        if (ti >= ntiles) return false; const int e = __builtin_amdgcn_readfirstlane((int)M[MT_TILEE + ti]);
        u.pm = ti; u.pn = pn; u.kt = 0; u.lim = 0;
        if (gather) { const int t0 = __builtin_amdgcn_readfirstlane((int)M[MT_BASE + e]) >> 8, cn = __builtin_amdgcn_readfirstlane((int)M[MT_CNT + e]); u.aux = e * T + (ti - t0) * 256; u.lim = e * T + cn; u.a = A; }
        else { u.aux = e; u.a = A + (size_t)ti * 256 * DF; }
        u.b = W + (size_t)e * wexp + (size_t)pn * wtile;
        if (var & 8) { u.a = A; u.b = W; if (gather) { u.aux = 0; u.lim = 256; } } return true; }
};

struct NoPre {};
#define EPI_ZERO_INIT static constexpr bool P16 = false; struct Pre {}; __device__ __forceinline__ void pre(Pre&, const Unit&, int, int) const {} \
    __device__ __forceinline__ void init(f32x4 (&acc)[2][2][4][2], const Pre&) const { _Pragma("unroll") for (int a = 0; a < 2; ++a) _Pragma("unroll") for (int b = 0; b < 2; ++b) _Pragma("unroll") for (int m = 0; m < 4; ++m) _Pragma("unroll") for (int n = 0; n < 2; ++n) acc[a][b][m][n] = (f32x4){0.f, 0.f, 0.f, 0.f}; }
__device__ __forceinline__ u32x4 pack8(const f32x4& v0, const f32x4& v1) { u32x4 w; w.x = cvt_pk_bf16(v0[0], v0[1]); w.y = cvt_pk_bf16(v0[2], v0[3]); w.z = cvt_pk_bf16(v1[0], v1[1]); w.w = cvt_pk_bf16(v1[2], v1[3]); return w; }

template <bool G16> struct EpiInProjT {
    static constexpr bool PERM = true; static constexpr bool P16 = G16; struct Pre {}; __device__ __forceinline__ void pre(Pre&, const Unit&, int, int) const {}
    __device__ __forceinline__ void init(f32x4 (&acc)[2][2][4][2], const Pre&) const { _Pragma("unroll") for (int a = 0; a < 2; ++a) _Pragma("unroll") for (int b = 0; b < 2; ++b) _Pragma("unroll") for (int m = 0; m < 4; ++m) _Pragma("unroll") for (int n = 0; n < 2; ++n) acc[a][b][m][n] = (f32x4){0.f, 0.f, 0.f, 0.f}; }
    bf16_t *UA, *Q, *V, *GS, *GATES; _Float16* LOGF; const float* LBV; int var = 0;
    __device__ __forceinline__ bool operator()(f32x4 (&acc)[2][2][4][2], const Unit& u, int wr, int wc, int fr, int fq) const {
        const int kind = u.pn >> 1;
#pragma unroll
        for (int ai = 0; ai < 2; ++ai)
#pragma unroll
            for (int m = 0; m < 4; ++m) { const int tok = u.pm * 256 + ai * 128 + wr * 64 + m * 16 + fr;
                if (var & 4) { asm volatile("" :: "v"(acc[ai][0][m][0]), "v"(acc[ai][0][m][1]), "v"(acc[ai][1][m][0]), "v"(acc[ai][1][m][1])); continue; }
                if constexpr (G16) { u32x4 q = (u32x4){0u, 0u, 0u, 0u}; unsigned qw[4] = {0u, 0u, 0u, 0u};
#pragma unroll
                    for (int bj = 0; bj < 2; ++bj)
#pragma unroll
                        for (int n = 0; n < 2; ++n)
#pragma unroll
                            for (int j = 0; j < 4; ++j) { const float a = __builtin_amdgcn_rcpf(__builtin_fmaf(__builtin_amdgcn_exp2f(acc[ai][bj][m][n][j] * -1.4426950408889634f), 1.0f / 255.0f, 1.0f / 255.0f)); qw[bj * 2 + n] = __builtin_amdgcn_cvt_pk_u8_f32(a, j, qw[bj * 2 + n]); }
                    q.x = qw[0]; q.y = qw[1]; q.z = qw[2]; q.w = qw[3];
                    *(u32x4*)((unsigned char*)GATES + (size_t)tok * 2048 + (u.pn - 10) * 256 + wc * 64 + fq * 16) = q; continue; }
#pragma unroll
                for (int bj = 0; bj < 2; ++bj) { const int col = u.pn * 256 + bj * 128 + wc * 32 + 8 * fq; f32x4 v0 = acc[ai][bj][m][0], v1 = acc[ai][bj][m][1];
                    if (kind == 0) { const int g = col >> 4, hh = col & 15; *(u32x4*)(UA + ((size_t)(g * 512 + (tok >> 6)) * UAK + UA0 + (tok & 63) * 16 + hh)) = pack8(v0, v1); }
                    else if (kind == 1) {
#pragma unroll
                        for (int j = 0; j < 4; ++j) { v0[j] = v0[j] * sigmoidf_(v0[j]); v1[j] = v1[j] * sigmoidf_(v1[j]); }
                        *(u32x4*)(Q + (size_t)tok * HW + (col - 512)) = pack8(v0, v1); }
                    else if (kind == 2) { const int c2 = col - 1024; const f32x4 l0 = *(const f32x4*)(LBV + c2), l1 = *(const f32x4*)(LBV + c2 + 4);
#pragma unroll
                        for (int j = 0; j < 4; ++j) { v0[j] = __logf(l0[j] + (1.f - l0[j]) * sigmoidf_(v0[j])); v1[j] = __logf(l1[j] + (1.f - l1[j]) * sigmoidf_(v1[j])); }
                        typedef _Float16 h16x8 __attribute__((ext_vector_type(8))); h16x8 hv; hv[0] = (_Float16)v0[0]; hv[1] = (_Float16)v0[1]; hv[2] = (_Float16)v0[2]; hv[3] = (_Float16)v0[3]; hv[4] = (_Float16)v1[0]; hv[5] = (_Float16)v1[1]; hv[6] = (_Float16)v1[2]; hv[7] = (_Float16)v1[3];
                        *(h16x8*)(LOGF + (size_t)tok * HW + c2) = hv; }
                    else if (kind == 3) { *(u32x4*)(V + (size_t)tok * HW + (col - 1536)) = pack8(v0, v1); }
                    else if (kind == 4) {
#pragma unroll
                        for (int j = 0; j < 4; ++j) { v0[j] = v0[j] * sigmoidf_(v0[j]); v1[j] = v1[j] * sigmoidf_(v1[j]); }
                        *(u32x4*)(GS + (size_t)tok * HW + (col - 2048)) = pack8(v0, v1); }
                    else if (MK_GSTORE_F8) { u32x2 q8; q8.x = 0u; q8.y = 0u;
#pragma unroll
                        for (int j = 0; j < 4; ++j) { const float a = __builtin_amdgcn_rcpf(__builtin_fmaf(__builtin_amdgcn_exp2f(v0[j] * -1.4426950408889634f), 1.0f / 255.0f, 1.0f / 255.0f)), b = __builtin_amdgcn_rcpf(__builtin_fmaf(__builtin_amdgcn_exp2f(v1[j] * -1.4426950408889634f), 1.0f / 255.0f, 1.0f / 255.0f));
                            q8.x = __builtin_amdgcn_cvt_pk_u8_f32(a, j, q8.x); q8.y = __builtin_amdgcn_cvt_pk_u8_f32(b, j, q8.y); }
                        *(u32x2*)((unsigned char*)GATES + (size_t)tok * 2048 + (col - 2560)) = q8; }
                    else {
#pragma unroll
                        for (int j = 0; j < 4; ++j) { v0[j] = sigmoidf_(v0[j]); v1[j] = sigmoidf_(v1[j]); }
                        if (MK_GSTORE_F8) { u32x2 q8; q8.x = pk4_u8(v0[0], v0[1], v0[2], v0[3]); q8.y = pk4_u8(v1[0], v1[1], v1[2], v1[3]); *(u32x2*)((unsigned char*)GATES + (size_t)tok * 2048 + (col - 2560)) = q8; }
                        else *(u32x4*)(GATES + (size_t)tok * 2048 + (col - 2560)) = pack8(v0, v1); }
                } }
        return false;
    }
};
struct EpiS5E {
    static constexpr bool PERM = false; EPI_ZERO_INIT
    float* SE;
    __device__ __forceinline__ bool operator()(f32x4 (&acc)[2][2][4][2], const Unit& u, int wr, int wc, int fr, int fq) const {
#pragma unroll
        for (int ai = 0; ai < 2; ++ai)
#pragma unroll
            for (int m = 0; m < 4; ++m) { const int r = u.pm * 256 + ai * 128 + wr * 64 + m * 16 + fr; float* rowp = SE + ((size_t)u.aux * 512 + r) * 128 + wc * 32 + 4 * fq;
#pragma unroll
                for (int n = 0; n < 2; ++n) *(f32x4*)(rowp + n * 16) = acc[ai][0][m][n]; }
        return false;
    }
};
struct EpiS5Y {
    static constexpr bool PERM = true; EPI_ZERO_INIT
    const bf16_t* UA; const float* SD; bf16_t* Y1;
    __device__ __forceinline__ bool operator()(f32x4 (&acc)[2][2][4][2], const Unit& u, int wr, int wc, int fr, int fq) const {
        const int g = u.aux;
#pragma unroll
        for (int ai = 0; ai < 2; ++ai)
#pragma unroll
            for (int m = 0; m < 4; ++m) { const int r = u.pm * 256 + ai * 128 + wr * 64 + m * 16 + fr; const int b = r >> 7, c = r & 127;
#pragma unroll
                for (int bj = 0; bj < 2; ++bj) { const int col = u.pn * 256 + bj * 128 + wc * 32 + 8 * fq; const int t = col >> 4, hh = col & 15;
                    const u32x4 uu = *(const u32x4*)(UA + ((size_t)(g * 512 + r) * UAK + UA0 + col));
                    const f32x4 d0 = *(const f32x4*)(SD + g * 16 + hh), d1 = *(const f32x4*)(SD + g * 16 + hh + 4);
                    f32x4 v0 = acc[ai][bj][m][0], v1 = acc[ai][bj][m][1];
                    v0[0] += d0[0] * bf2f(uu.x & 0xffffu); v0[1] += d0[1] * bf2f(uu.x >> 16); v0[2] += d0[2] * bf2f(uu.y & 0xffffu); v0[3] += d0[3] * bf2f(uu.y >> 16);
                    v1[0] += d1[0] * bf2f(uu.z & 0xffffu); v1[1] += d1[1] * bf2f(uu.z >> 16); v1[2] += d1[2] * bf2f(uu.w & 0xffffu); v1[3] += d1[3] * bf2f(uu.w >> 16);
#pragma unroll
                    for (int j = 0; j < 4; ++j) { float x = v0[j]; v0[j] = x * sigmoidf_(1.5957691216f * (x + 0.044715f * x * x * x)); x = v1[j]; v1[j] = x * sigmoidf_(1.5957691216f * (x + 0.044715f * x * x * x)); }
                    const int tok = b * SEQ + c * 64 + t;
                    *(u32x4*)(Y1 + (size_t)tok * HW + g * 16 + hh) = pack8(v0, v1); } }
        return false;
    }
};
struct EpiGlu {
    static constexpr bool PERM = true; EPI_ZERO_INIT
    const bf16_t* Y1; bf16_t* YS5;
    __device__ __forceinline__ bool operator()(f32x4 (&acc)[2][2][4][2], const Unit& u, int wr, int wc, int fr, int fq) const {
#pragma unroll
        for (int ai = 0; ai < 2; ++ai)
#pragma unroll
            for (int m = 0; m < 4; ++m) { const int row = u.pm * 256 + ai * 128 + wr * 64 + m * 16 + fr;
#pragma unroll
                for (int bj = 0; bj < 2; ++bj) { const int col = u.pn * 256 + bj * 128 + wc * 32 + 8 * fq; const u32x4 y = *(const u32x4*)(Y1 + (size_t)row * HW + col);
                    f32x4 v0 = acc[ai][bj][m][0], v1 = acc[ai][bj][m][1];
                    v0[0] = bf2f(y.x & 0xffffu) * sigmoidf_(v0[0]); v0[1] = bf2f(y.x >> 16) * sigmoidf_(v0[1]); v0[2] = bf2f(y.y & 0xffffu) * sigmoidf_(v0[2]); v0[3] = bf2f(y.y >> 16) * sigmoidf_(v0[3]);
                    v1[0] = bf2f(y.z & 0xffffu) * sigmoidf_(v1[0]); v1[1] = bf2f(y.z >> 16) * sigmoidf_(v1[1]); v1[2] = bf2f(y.w & 0xffffu) * sigmoidf_(v1[2]); v1[3] = bf2f(y.w >> 16) * sigmoidf_(v1[3]);
                    *(u32x4*)(YS5 + (size_t)row * HW + col) = pack8(v0, v1); } }
        return false;
    }
};
struct EpiBranch {
    static constexpr bool PERM = true, P16 = true;
    struct Pre {}; __device__ __forceinline__ void pre(Pre&, const Unit&, int, int) const {}
    __device__ __forceinline__ void init(f32x4 (&acc)[2][2][4][2], const Pre&) const {
#pragma unroll
        for (int a = 0; a < 2; ++a)
#pragma unroll
            for (int b = 0; b < 2; ++b)
#pragma unroll
                for (int m = 0; m < 4; ++m)
#pragma unroll
                    for (int n = 0; n < 2; ++n) acc[a][b][m][n] = (f32x4){0.f, 0.f, 0.f, 0.f}; }
    const bf16_t* GATES; bf16_t* MERGED;
    __device__ __forceinline__ bool operator()(f32x4 (&acc)[2][2][4][2], const Unit& u, int wr, int wc, int fr, int fq) const {
        const int part = u.aux; const float i255 = (MK_P7_F8 ? (float)(1 << MK_P7_XSH) : 1.0f) / 255.0f;
#pragma unroll
        for (int ai = 0; ai < 2; ++ai)
#pragma unroll
            for (int m = 0; m < 4; ++m) { const int row = u.pm * 256 + ai * 128 + wr * 64 + m * 16 + fr; const int col = u.pn * 256 + wc * 64 + fq * 16;
                const u32x4 g2 = *(const u32x4*)((const unsigned char*)GATES + (size_t)row * 2048 + 1024 + col); const unsigned g2w[4] = {g2.x, g2.y, g2.z, g2.w};
                if (part == 0) { const u32x4 g1 = *(const u32x4*)((const unsigned char*)GATES + (size_t)row * 2048 + col); const unsigned g1w[4] = {g1.x, g1.y, g1.z, g1.w};
#pragma unroll
                    for (int bj = 0; bj < 2; ++bj)
#pragma unroll
                        for (int n = 0; n < 2; ++n)
#pragma unroll
                            for (int j = 0; j < 4; ++j) { const float h = fmaxf((float)((g2w[bj * 2 + n] >> (8 * j)) & 0xffu), 0.5f), sv = (float)((g1w[bj * 2 + n] >> (8 * j)) & 0xffu); acc[ai][bj][m][n][j] *= sv * __builtin_amdgcn_rcpf(h); } }
                else { f32x4 v[2][2];
#pragma unroll
                    for (int bj = 0; bj < 2; ++bj)
#pragma unroll
                        for (int n = 0; n < 2; ++n)
#pragma unroll
                            for (int j = 0; j < 4; ++j) v[bj][n][j] = acc[ai][bj][m][n][j] * (fmaxf((float)((g2w[bj * 2 + n] >> (8 * j)) & 0xffu), 0.5f) * i255);
                    if (MK_P7_F8) { u32x4 q; q.x = pk4_fp8(v[0][0][0], v[0][0][1], v[0][0][2], v[0][0][3]); q.y = pk4_fp8(v[0][1][0], v[0][1][1], v[0][1][2], v[0][1][3]); q.z = pk4_fp8(v[1][0][0], v[1][0][1], v[1][0][2], v[1][0][3]); q.w = pk4_fp8(v[1][1][0], v[1][1][1], v[1][1][2], v[1][1][3]);
                        *(u32x4*)((unsigned char*)MERGED + (size_t)row * D + col) = q; }
                    else { *(u32x4*)(MERGED + (size_t)row * D + col) = pack8(v[0][0], v[0][1]); *(u32x4*)(MERGED + (size_t)row * D + col + 8) = pack8(v[1][0], v[1][1]); } } }
        return part == 0;
    }
};
struct EpiOut {
    static constexpr bool PERM = true; EPI_ZERO_INIT
    static constexpr int XSH = MK_P7_F8 ? MK_P7_XSH : 0;
    const bf16_t* XN; const float* RMS; bf16_t* H1; float* SSQ; int var = 0;
    __device__ __forceinline__ bool operator()(f32x4 (&acc)[2][2][4][2], const Unit& u, int wr, int wc, int fr, int fq) const {
#pragma unroll
        for (int ai = 0; ai < 2; ++ai)
#pragma unroll
            for (int m = 0; m < 4; ++m) { const int row = u.pm * 256 + ai * 128 + wr * 64 + m * 16 + fr; const size_t off = (size_t)row * D + u.pn * 256 + wc * 32 + 8 * fq; float ss = 0.f; const float rms = RMS[row];
                if (var & 4) { asm volatile("" :: "v"(acc[ai][0][m][0]), "v"(acc[ai][0][m][1]), "v"(acc[ai][1][m][0]), "v"(acc[ai][1][m][1])); continue; }
#pragma unroll
                for (int bj = 0; bj < 2; ++bj) { const u32x4 xq = *(const u32x4*)(XN + off + bj * 128);
                    const f32x4 o0 = (f32x4){bf2f(xq.x & 0xffffu), bf2f(xq.x >> 16), bf2f(xq.y & 0xffffu), bf2f(xq.y >> 16)} * rms + acc[ai][bj][m][0], o1 = (f32x4){bf2f(xq.z & 0xffffu), bf2f(xq.z >> 16), bf2f(xq.w & 0xffffu), bf2f(xq.w >> 16)} * rms + acc[ai][bj][m][1];
                    *(u32x4*)(H1 + off + bj * 128) = pack8(o0, o1); ss += ((o0[0] * o0[0] + o0[1] * o0[1]) + (o0[2] * o0[2] + o0[3] * o0[3])) + ((o1[0] * o1[0] + o1[1] * o1[1]) + (o1[2] * o1[2] + o1[3] * o1[3])); }
                ss += __shfl_xor(ss, 16); ss += __shfl_xor(ss, 32);
                if (fq == 0) SSQ[(size_t)row * 16 + u.pn * 4 + wc] = ss; }
        return false;
    }
};
struct EpiMoe1 {
    static constexpr bool PERM = true;
    const float* BGU; volatile LAS unsigned* M; unsigned char* A2; int var; static constexpr bool P16 = false;
    struct Pre { f32x4 b0, b1, b2, b3; };
    __device__ __forceinline__ void pre(Pre& p, const Unit& u, int wc, int fq) const { const int e = __builtin_amdgcn_readfirstlane((int)M[MT_TILEE + u.pm]); const float* bp = BGU + (size_t)e * 2048 + 2 * (u.pn * 128 + wc * 32 + 8 * fq);
        p.b0 = *(const f32x4*)(bp); p.b1 = *(const f32x4*)(bp + 4); p.b2 = *(const f32x4*)(bp + 8); p.b3 = *(const f32x4*)(bp + 12); }
    __device__ __forceinline__ void init(f32x4 (&acc)[2][2][4][2], const Pre& p) const {
        const f32x4 g0 = (f32x4){p.b0[0], p.b0[2], p.b1[0], p.b1[2]}, g1 = (f32x4){p.b2[0], p.b2[2], p.b3[0], p.b3[2]}, u0 = (f32x4){p.b0[1], p.b0[3], p.b1[1], p.b1[3]} + 1.0f, u1 = (f32x4){p.b2[1], p.b2[3], p.b3[1], p.b3[3]} + 1.0f;
#pragma unroll
        for (int ai = 0; ai < 2; ++ai)
#pragma unroll
            for (int m = 0; m < 4; ++m) { acc[ai][0][m][0] = g0; acc[ai][0][m][1] = g1; acc[ai][1][m][0] = u0; acc[ai][1][m][1] = u1; } }
    __device__ __forceinline__ bool operator()(f32x4 (&acc)[2][2][4][2], const Unit& u, int wr, int wc, int fr, int fq) const {
        const int hid = u.pn * 128 + wc * 32 + 8 * fq;
#pragma unroll
        for (int ai = 0; ai < 2; ++ai)
#pragma unroll
            for (int m = 0; m < 4; ++m) { const int prow = u.pm * 256 + ai * 128 + wr * 64 + m * 16 + fr; f32x4 o0, o1;
                if (var & 4) { asm volatile("" :: "v"(acc[ai][0][m][0]), "v"(acc[ai][0][m][1]), "v"(acc[ai][1][m][0]), "v"(acc[ai][1][m][1])); continue; }
#pragma unroll
                for (int j = 0; j < 4; ++j) {
                    float gt = fminf(acc[ai][0][m][0][j], 7.0f), up = __builtin_amdgcn_fmed3f(acc[ai][1][m][0][j], -6.0f, 8.0f); o0[j] = up * gt * __builtin_amdgcn_rcpf(1.0f + __builtin_amdgcn_exp2f(gt * -2.4554669595930156f));
                    gt = fminf(acc[ai][0][m][1][j], 7.0f); up = __builtin_amdgcn_fmed3f(acc[ai][1][m][1][j], -6.0f, 8.0f); o1[j] = up * gt * __builtin_amdgcn_rcpf(1.0f + __builtin_amdgcn_exp2f(gt * -2.4554669595930156f)); }
                u32x2 q8; q8.x = pk4_fp8_nc(o0[0], o0[1], o0[2], o0[3]); q8.y = pk4_fp8_nc(o1[0], o1[1], o1[2], o1[3]);
                if (var & 1) asm volatile("" :: "v"(q8)); else *(u32x2*)(A2 + (size_t)prow * DF + hid) = q8; }
        return false;
    }
};
struct EpiMoe2 {
    static constexpr bool PERM = true, P16 = true;
    const float* BD; volatile LAS unsigned* M; unsigned char* YS; int var;
    struct Pre { f32x4 c[2][2]; };
    __device__ __forceinline__ void pre(Pre& p, const Unit& u, int wc, int fq) const { const int e = __builtin_amdgcn_readfirstlane((int)M[MT_TILEE + u.pm]); const float* bp = BD + (size_t)e * D + u.pn * 256 + wc * 64 + fq * 16;
#pragma unroll
        for (int bj = 0; bj < 2; ++bj) { p.c[bj][0] = *(const f32x4*)(bp + bj * 8); p.c[bj][1] = *(const f32x4*)(bp + bj * 8 + 4); } }
    __device__ __forceinline__ void init(f32x4 (&acc)[2][2][4][2], const Pre& p) const {
#pragma unroll
        for (int ai = 0; ai < 2; ++ai)
#pragma unroll
            for (int bj = 0; bj < 2; ++bj)
#pragma unroll
                for (int m = 0; m < 4; ++m) { acc[ai][bj][m][0] = p.c[bj][0]; acc[ai][bj][m][1] = p.c[bj][1]; } }
    __device__ __forceinline__ bool operator()(f32x4 (&acc)[2][2][4][2], const Unit& u, int wr, int wc, int fr, int fq) const {
#pragma unroll
        for (int ai = 0; ai < 2; ++ai)
#pragma unroll
            for (int m = 0; m < 4; ++m) { const int prow = u.pm * 256 + ai * 128 + wr * 64 + m * 16 + fr;
                if (var & 4) { asm volatile("" :: "v"(acc[ai][0][m][0]), "v"(acc[ai][0][m][1]), "v"(acc[ai][1][m][0]), "v"(acc[ai][1][m][1])); continue; }
                if (var & 1) { asm volatile("" :: "v"(acc[ai][0][m][0]), "v"(acc[ai][1][m][1])); continue; }
                u32x4 q; { const f32x4 a0 = acc[ai][0][m][0], a1 = acc[ai][0][m][1], b0 = acc[ai][1][m][0], b1 = acc[ai][1][m][1];
                    q.x = pk4_fp8(a0[0], a0[1], a0[2], a0[3]); q.y = pk4_fp8(a1[0], a1[1], a1[2], a1[3]); q.z = pk4_fp8(b0[0], b0[1], b0[2], b0[3]); q.w = pk4_fp8(b1[0], b1[1], b1[2], b1[3]); }
                *(u32x4*)(YS + (size_t)prow * D + u.pn * 256 + wc * 64 + fq * 16) = q; }
        return false;
    }
};

struct TDesc { const float* W; unsigned char* WT; const float* rs; int K, N, k0, n0, mode, out8; };
__device__ __forceinline__ TDesc p0_decode(const Frame& F, int t) {
    TDesc d; unsigned char* ws = F.ws; d.rs = nullptr;
    if (t < 16384) { const int e = t >> 9, r = t & 511; d.W = F.in[I_WGU] + (size_t)e * D * 2048; d.WT = ws + WS_WGU + (size_t)e * 2048 * D; d.K = D; d.N = 2048; d.k0 = (r >> 5) * 64; d.n0 = (r & 31) * 64; d.mode = 1; d.out8 = 1; return d; }
    t -= 16384;
    if (t < 8192) { const int e = t >> 8, r = t & 255; d.W = F.in[I_WD] + (size_t)e * DF * D; d.WT = ws + WS_WD + (size_t)e * D * DF; d.K = DF; d.N = D; d.k0 = (r >> 4) * 64; d.n0 = (r & 15) * 64; d.mode = 0; d.out8 = 1; return d; }
    t -= 8192; d.mode = 0; d.out8 = 0;
    if (t < 1152) { d.W = F.in[I_WIN]; d.WT = ws + WS_WIN; d.K = D; d.N = INW; d.k0 = (t / 72) * 64; d.n0 = (t % 72) * 64; d.out8 = MK_P1_F8; d.rs = F.in[I_N1G] + d.k0; if (MK_GATES_F8 && d.n0 >= 2560) { d.out8 = 1; d.WT = ws + WS_WIN8 - (size_t)2560 * D; } return d; }
    t -= 1152;
    if (t < 64) { d.W = F.in[I_WGLU]; d.WT = ws + WS_WGLU; d.K = HW; d.N = HW; d.k0 = (t >> 3) * 64; d.n0 = (t & 7) * 64; return d; }
    t -= 64;
    if (t < 128) { d.W = F.in[I_WBS]; d.WT = ws + WS_WBS; d.K = HW; d.N = D; d.k0 = (t >> 4) * 64; d.n0 = (t & 15) * 64; return d; }
    t -= 128;
    if (t < 128) { d.W = F.in[I_WBH]; d.WT = ws + WS_WBH; d.K = HW; d.N = D; d.k0 = (t >> 4) * 64; d.n0 = (t & 15) * 64; return d; }
    t -= 128;
    d.out8 = MK_P7_F8; d.W = F.in[I_WOUT]; d.WT = ws + WS_WOUT; d.K = D; d.N = D; d.k0 = (t >> 4) * 64; d.n0 = (t & 15) * 64; return d;
}
constexpr int P0_NTILES = 16384 + 8192 + 1152 + 64 + 128 + 128 + 256;
__device__ __forceinline__ void p0_tile_load(const TDesc& d, f32x4 (&r)[16], int lane) {
    const float* p = d.W + (size_t)(d.k0 + (lane >> 4)) * d.N + d.n0 + (lane & 15) * 4;
#pragma unroll
    for (int i = 0; i < 16; ++i) r[i] = __builtin_nontemporal_load((const f32x4*)(p + (size_t)(4 * i) * d.N));
}
__device__ __forceinline__ void p0_tile_to_lds(LAS float* scr, const f32x4 (&r)[16], int lane, const float* rs) {
    if (rs) {
#pragma unroll
        for (int i = 0; i < 16; ++i) { const int k = (lane >> 4) + 4 * i; const float g = rs[k]; *(LAS f32x4*)(scr + k * 64 + (((lane & 15) * 4) ^ (4 * ((k >> 3) & 7)))) = r[i] * g; }
        return; }
#pragma unroll
    for (int i = 0; i < 16; ++i) { const int k = (lane >> 4) + 4 * i; *(LAS f32x4*)(scr + k * 64 + (((lane & 15) * 4) ^ (4 * ((k >> 3) & 7)))) = r[i]; }
}
__device__ __forceinline__ void p0_tile_store(const TDesc& d, const LAS float* scr, int lane) {
    if (d.out8) { const int c = lane & 3; const float sc = (float)(1 << pg8::F8_WSH);
#pragma unroll
        for (int j = 0; j < 4; ++j) { const int n = (lane >> 2) + 16 * j; float v[16];
#pragma unroll
            for (int t = 0; t < 16; ++t) { const int k = 16 * c + t; v[t] = scr[k * 64 + (n ^ (4 * ((k >> 3) & 7)))] * sc; }
            u32x4 o;
            { int w = 0; w = __builtin_amdgcn_cvt_pk_fp8_f32(v[0], v[1], w, false); w = __builtin_amdgcn_cvt_pk_fp8_f32(v[2], v[3], w, true); o.x = (unsigned)w; }
            { int w = 0; w = __builtin_amdgcn_cvt_pk_fp8_f32(v[4], v[5], w, false); w = __builtin_amdgcn_cvt_pk_fp8_f32(v[6], v[7], w, true); o.y = (unsigned)w; }
            { int w = 0; w = __builtin_amdgcn_cvt_pk_fp8_f32(v[8], v[9], w, false); w = __builtin_amdgcn_cvt_pk_fp8_f32(v[10], v[11], w, true); o.z = (unsigned)w; }
            { int w = 0; w = __builtin_amdgcn_cvt_pk_fp8_f32(v[12], v[13], w, false); w = __builtin_amdgcn_cvt_pk_fp8_f32(v[14], v[15], w, true); o.w = (unsigned)w; }
            int nn = d.n0 + n; if (d.mode == 1) { const int hid = nn >> 1, part = nn & 1; nn = 256 * (hid >> 7) + 128 * part + (hid & 127); }
            *(u32x4*)(d.WT + (size_t)nn * d.K + d.k0 + 16 * c) = o; } }
    else { const int c = lane & 7;
#pragma unroll
        for (int j = 0; j < 8; ++j) { const int n = (lane >> 3) + 8 * j; float v[8];
#pragma unroll
            for (int t = 0; t < 8; ++t) { const int k = 8 * c + t; v[t] = scr[k * 64 + (n ^ (4 * (c & 7)))]; }
            u32x4 o; o.x = cvt_pk_bf16(v[0], v[1]); o.y = cvt_pk_bf16(v[2], v[3]); o.z = cvt_pk_bf16(v[4], v[5]); o.w = cvt_pk_bf16(v[6], v[7]);
            *(u32x4*)((bf16_t*)d.WT + (size_t)(d.n0 + n) * d.K + d.k0 + 8 * c) = o; } }
}
struct C2 { double re, im; };
__device__ __forceinline__ C2 cmul(C2 a, C2 b) { return C2{a.re * b.re - a.im * b.im, a.re * b.im + a.im * b.re}; }
__device__ __forceinline__ C2 s5_pow(const Frame& F, int g, int p, int k) {
    const double lre = (double)F.in[I_LRE][g * SP + p], lim = (double)F.in[I_LIM][g * SP + p], dt = exp((double)F.in[I_LDT][g]);
    const double mag = exp((double)k * lre * dt); double s, c; sincos((double)k * lim * dt, &s, &c); return C2{mag * c, mag * s};
}
__device__ __forceinline__ C2 s5_coef(const Frame& F, int g, int p) {
    const double lre = (double)F.in[I_LRE][g * SP + p], lim = (double)F.in[I_LIM][g * SP + p]; const C2 lb = s5_pow(F, g, p, 1);
    const double nr = lb.re - 1.0, ni = lb.im, den = lre * lre + lim * lim; return C2{(nr * lre + ni * lim) / den, (ni * lre - nr * lim) / den};
}

struct C2f { float re, im; };
__device__ __forceinline__ C2f cmulf(C2f a, C2f b) { return C2f{a.re * b.re - a.im * b.im, a.re * b.im + a.im * b.re}; }
__device__ __forceinline__ void s5_fast(const Frame& F, int g, int p, C2f& lb, C2f& cf) {
    const float lre = F.in[I_LRE][g * SP + p], lim = F.in[I_LIM][g * SP + p], dt = __expf(F.in[I_LDT][g]); const float a = lre * dt, th = lim * dt;
    const float sn = __sinf(th), cs = __cosf(th), ea = __expf(a); lb = C2f{ea * cs, ea * sn};
    const float sh = __sinf(0.5f * th); const float em1 = (fabsf(a) < 0.125f) ? a * (1.0f + a * (0.5f + a * (0.16666667f + a * 0.041666668f))) : ea - 1.0f;
    const float nr = em1 * cs - 2.0f * sh * sh, ni = ea * sn, den = lre * lre + lim * lim;
    cf = C2f{(nr * lre + ni * lim) / den, (ni * lre - nr * lim) / den};
}
__device__ __forceinline__ C2f cpowf_(C2f b, int k) { C2f r{1.f, 0.f};
#pragma unroll
    for (int i = 0; i < 7; ++i) { if (k & 1) r = cmulf(r, b); b = cmulf(b, b); k >>= 1; } return r; }
constexpr int R6 = 0;
constexpr int R7 = R6 + 2048  , R8 = R7 + 2048  , R9 = R8 + 2048  , R10 = R9 + 32  , R11 = R10 + 1536  , R12 = R11 + 16  , R13 = R12 + 1  ;
constexpr int R14 = R13 + 2048  ;
constexpr int P0_NITEMS = R14;
__device__ __forceinline__ void p0_table_item(Frame& F, const int it, LAS float* scr, const int lane) {
    unsigned char* ws = F.ws;
        if (it >= R7 && it < R9) return;
        if (it < R7) {
            const int q = it - R6, g = q >> 6, k = q & 63, p = lane;
            C2f lb, cf; s5_fast(F, g, p, lb, cf); const C2f pw = cpowf_(lb, k), pwe = cmulf(cpowf_(lb, 63 - k), cf), pvc = cmulf(pw, lb);
            LAS float* CLre = scr; LAS float* CLim = scr + 1024; LAS float* BBre = scr + 2048; LAS float* BBim = scr + 3072;
            { const f32x4* br = (const f32x4*)(F.in[I_BRE] + (size_t)(g * SP + p) * 16); const f32x4* bi = (const f32x4*)(F.in[I_BIM] + (size_t)(g * SP + p) * 16);
              bf16_t* o0 = (bf16_t*)(ws + WS_WE) + ((size_t)(g * 256 + p) * 1024 + k * 16); bf16_t* o1 = o0 + (size_t)64 * 1024;
#pragma unroll
              for (int h4 = 0; h4 < 4; ++h4) { const f32x4 r4 = br[h4], i4 = bi[h4]; float re[4], im[4];
#pragma unroll
                  for (int j = 0; j < 4; ++j) { const C2f bb = cmulf(cf, C2f{r4[j], i4[j]}); BBre[p * 16 + h4 * 4 + j] = bb.re; BBim[p * 16 + h4 * 4 + j] = -bb.im;
                      const C2f w = cmulf(pwe, C2f{r4[j], i4[j]}); re[j] = w.re; im[j] = w.im; }
                  *(u32x2*)(o0 + h4 * 4) = (u32x2){pk2(re[0], re[1]), pk2(re[2], re[3])}; *(u32x2*)(o1 + h4 * 4) = (u32x2){pk2(im[0], im[1]), pk2(im[2], im[3])}; } }
#pragma unroll 4
            for (int h = 0; h < 16; ++h) { const C2f c0 = C2f{F.in[I_CRE][(g * 16 + h) * SP + p], F.in[I_CIM][(g * 16 + h) * SP + p]}; const C2f cc = cmulf(c0, pw), cv = cmulf(c0, pvc); CLre[h * 64 + p] = cc.re; CLim[h * 64 + p] = cc.im;
                bf16_t* o = (bf16_t*)(ws + WS_TZ) + ((size_t)(g * 1024 + k * 16 + h) * UAK + p); o[0] = (bf16_t)f2bf(cv.re); o[64] = (bf16_t)f2bf(-cv.im); }
            LDS_WAIT(); asm volatile("" ::: "memory");
            f32x4 kacc = (f32x4){0.f, 0.f, 0.f, 0.f};
#pragma unroll
            for (int sblk = 0; sblk < 16; ++sblk) { const int pp = 4 * sblk + (lane >> 4);
                kacc = __builtin_amdgcn_mfma_f32_16x16x4f32(CLre[(lane & 15) * 64 + pp], BBre[pp * 16 + (lane & 15)], kacc, 0, 0, 0);
                kacc = __builtin_amdgcn_mfma_f32_16x16x4f32(CLim[(lane & 15) * 64 + pp], BBim[pp * 16 + (lane & 15)], kacc, 0, 0, 0); }
            bf16_t* ko = (bf16_t*)(ws + WS_KCONV) + (size_t)q * 256;
#pragma unroll
            for (int r = 0; r < 4; ++r) ko[(4 * (lane >> 4) + r) * 16 + (lane & 15)] = (bf16_t)f2bf(kacc[r]);
            LDS_WAIT(); asm volatile("" ::: "memory");
        }
        else if (it < R8) {
            const int q = it - R7, g = q >> 6, s = q & 63, p = lane; C2f lb, cf; s5_fast(F, g, p, lb, cf); const C2f pw = cmulf(cpowf_(lb, 63 - s), cf);
            float re[16], im[16];
#pragma unroll
            for (int h4 = 0; h4 < 4; ++h4) { const f32x4 r4 = ((const f32x4*)(F.in[I_BRE] + (size_t)(g * SP + p) * 16))[h4], i4 = ((const f32x4*)(F.in[I_BIM] + (size_t)(g * SP + p) * 16))[h4];
#pragma unroll
                for (int j = 0; j < 4; ++j) { const C2f w = cmulf(pw, C2f{r4[j], i4[j]}); re[h4 * 4 + j] = w.re; im[h4 * 4 + j] = w.im; } }
            bf16_t* o0 = (bf16_t*)(ws + WS_WE) + ((size_t)(g * 256 + p) * 1024 + s * 16); bf16_t* o1 = o0 + (size_t)64 * 1024;
            u32x4 a, b; a.x = pk2(re[0], re[1]); a.y = pk2(re[2], re[3]); a.z = pk2(re[4], re[5]); a.w = pk2(re[6], re[7]); b.x = pk2(re[8], re[9]); b.y = pk2(re[10], re[11]); b.z = pk2(re[12], re[13]); b.w = pk2(re[14], re[15]);
            *(u32x4*)o0 = a; *(u32x4*)(o0 + 8) = b;
            a.x = pk2(im[0], im[1]); a.y = pk2(im[2], im[3]); a.z = pk2(im[4], im[5]); a.w = pk2(im[6], im[7]); b.x = pk2(im[8], im[9]); b.y = pk2(im[10], im[11]); b.z = pk2(im[12], im[13]); b.w = pk2(im[14], im[15]);
            *(u32x4*)o1 = a; *(u32x4*)(o1 + 8) = b;
        }
        else if (it < R9) {
            const int q = it - R8, g = q >> 6, t = q & 63, p = lane; C2f lb, cf; s5_fast(F, g, p, lb, cf); const C2f pw = cpowf_(lb, t + 1);
            for (int h = 0; h < 16; ++h) { const C2f cc = cmulf(C2f{F.in[I_CRE][(g * 16 + h) * SP + p], F.in[I_CIM][(g * 16 + h) * SP + p]}, pw);
                bf16_t* o = (bf16_t*)(ws + WS_TZ) + ((size_t)(g * 1024 + t * 16 + h) * UAK + p); o[0] = (bf16_t)f2bf(cc.re); o[64] = (bf16_t)f2bf(-cc.im); }
        }
        else if (it < R10) {
            const int g = it - R9, p = lane;
#if MK_PERG_F64
            const C2 l1 = s5_pow(F, g, p, 1), cf = s5_coef(F, g, p); C2 l64 = l1;
#pragma unroll
            for (int q2 = 0; q2 < 6; ++q2) l64 = cmul(l64, l64);
            ((f32x2*)(ws + WS_LAMB))[g * SP + p] = (f32x2){(float)l1.re, (float)l1.im}; ((f32x2*)(ws + WS_LAMC))[g * SP + p] = (f32x2){(float)l64.re, (float)l64.im};
            for (int h = 0; h < 16; ++h) { const C2 bb = cmul(cf, C2{(double)F.in[I_BRE][(g * SP + p) * 16 + h], (double)F.in[I_BIM][(g * SP + p) * 16 + h]}); ((f32x2*)(ws + WS_BBAR))[(g * SP + p) * 16 + h] = (f32x2){(float)bb.re, (float)bb.im}; }
#else
            C2f l1, cf; s5_fast(F, g, p, l1, cf); C2f l64 = l1;
#pragma unroll
            for (int q2 = 0; q2 < 6; ++q2) l64 = cmulf(l64, l64);
            ((f32x2*)(ws + WS_LAMB))[g * SP + p] = (f32x2){l1.re, l1.im}; ((f32x2*)(ws + WS_LAMC))[g * SP + p] = (f32x2){l64.re, l64.im};
#pragma unroll
            for (int h4 = 0; h4 < 4; ++h4) { const f32x4 r4 = ((const f32x4*)(F.in[I_BRE] + (size_t)(g * SP + p) * 16))[h4], i4 = ((const f32x4*)(F.in[I_BIM] + (size_t)(g * SP + p) * 16))[h4];
#pragma unroll
                for (int j = 0; j < 4; ++j) { const C2f bb = cmulf(cf, C2f{r4[j], i4[j]}); ((f32x2*)(ws + WS_BBAR))[(g * SP + p) * 16 + h4 * 4 + j] = (f32x2){bb.re, bb.im}; } }
#endif
        }
        else if (it < R11) {
            const int q = it - R10, cg = q >> 6, kq = q & 63; const int wcol = (cg < 8 ? cg * 64 : (cg < 16 ? 1024 + (cg - 8) * 64 : 1536 + (cg - 16) * 64)) + lane;
            const float* meta = F.in[I_META]; const float* g1 = F.in[I_N1G];
            if (lane < 16) { const int k = kq * 16 + lane; const float gk = g1[k];
#pragma unroll
              for (int r = 0; r < 16; ++r) scr[lane * 16 + r] = meta[r * D + k] * gk; }
            LDS_WAIT(); asm volatile("" ::: "memory");
            float a[16];
#pragma unroll
            for (int r = 0; r < 16; ++r) a[r] = 0.f;
            const float* wp = F.in[I_WIN] + (size_t)(kq * 16) * INW + wcol;
#pragma unroll 16
            for (int kk = 0; kk < 16; ++kk) { const float w = wp[(size_t)kk * INW]; const LAS f32x4* xs = (const LAS f32x4*)(scr + kk * 16);
                const f32x4 x0 = xs[0], x1 = xs[1], x2 = xs[2], x3 = xs[3];
                a[0] += w * x0[0]; a[1] += w * x0[1]; a[2] += w * x0[2]; a[3] += w * x0[3]; a[4] += w * x1[0]; a[5] += w * x1[1]; a[6] += w * x1[2]; a[7] += w * x1[3];
                a[8] += w * x2[0]; a[9] += w * x2[1]; a[10] += w * x2[2]; a[11] += w * x2[3]; a[12] += w * x3[0]; a[13] += w * x3[1]; a[14] += w * x3[2]; a[15] += w * x3[3]; }
            float* pm = (float*)(ws + WS_PMETA);
#pragma unroll
            for (int r = 0; r < 16; ++r) pm[(size_t)(kq * 16 + r) * 1536 + cg * 64 + lane] = a[r];
            LDS_WAIT(); asm volatile("" ::: "memory");
        }
        else if (it < R12) {
            const int k = (it - R11) * 64 + lane; bf16_t* hi = (bf16_t*)(ws + WS_WRT); bf16_t* lo = hi + NE * D;
            for (int e = 0; e < NE; ++e) { const float w = F.in[I_WR][k * NE + e]; const unsigned h = f2bf(w); hi[e * D + k] = (bf16_t)h; lo[e * D + k] = (bf16_t)f2bf(w - bf2f(h)); }
        }
        else if (it < R13) {
            for (int d = lane; d < HW; d += 64) ((float*)(ws + WS_LBV))[d] = sigmoidf_(F.in[I_LBL][d] - F.in[I_LBL][HW + d]);
        }
        else {
            const int q = it - R13, g = q >> 6, r0 = 128 + (q & 63) * 2; u32x4* o = (u32x4*)((bf16_t*)(ws + WS_WE) + (size_t)(g * 256 + r0) * 1024);
#pragma unroll
            for (int j = 0; j < 4; ++j) o[lane + 64 * j] = (u32x4){0u, 0u, 0u, 0u};
        }
}
__device__ __forceinline__ void p0_prologue(Frame& F, const int var = 0) {
    LAS float* scr = (LAS float*)(F.lds + F.wave * 16384);
    const int gw = F.vcu * 8 + F.wave, NGW = F.G * 8, lane = F.lane;
    unsigned char* ws = F.ws;
    int it = gw;
    { f32x4 rr[16]; int t = (MK_BGW ? P0_MOE_TILES : 0) + gw, step = 0;
      if (t < P0_NTILES && !(var & 256)) { TDesc dc = p0_decode(F, t); p0_tile_load(dc, rr, lane);
        for (;;) { p0_tile_to_lds(scr, rr, lane, dc.rs);
            const int tn = t + NGW; TDesc dn = dc; const bool more = tn < P0_NTILES;
            if (more) { dn = p0_decode(F, tn); p0_tile_load(dn, rr, lane); }
            LDS_WAIT(); asm volatile("" ::: "memory");
            p0_tile_store(dc, scr, lane);
            LDS_WAIT(); asm volatile("" ::: "memory");
            if (!MK_BGW && (++step % 3) == 0 && it < P0_NITEMS && !(var & 512)) { p0_table_item(F, it, scr, lane); it += NGW; }
            if (!more) break; dc = dn; t = tn; } }
      if (!MK_BGW && !(var & 512)) for (; it < P0_NITEMS; it += NGW) p0_table_item(F, it, scr, lane); }
    f32x4 v[4], w2[4];
#define P0_XLOAD(M_) do { const int m2_ = (M_) + NGW; const f32x4* xr = (const f32x4*)(F.in[I_X] + (size_t)(M_) * D) + lane; const f32x4* xr2 = (const f32x4*)(F.in[I_X] + (size_t)(m2_ < T ? m2_ : (M_)) * D) + lane; \
        _Pragma("unroll") for (int j = 0; j < 4; ++j) { v[j] = __builtin_nontemporal_load(xr + 64 * j); w2[j] = __builtin_nontemporal_load(xr2 + 64 * j); } } while (0)
    const int TX = (var & 1024) ? 0 : T;
    if (gw < TX) P0_XLOAD(gw);
    for (int m = gw; m < TX; m += 2 * NGW) {
        const int m2 = m + NGW; const bool two = m2 < T; float s = 0.f, s2 = 0.f;
#pragma unroll
        for (int j = 0; j < 4; ++j) { s += (v[j].x * v[j].x + v[j].y * v[j].y) + (v[j].z * v[j].z + v[j].w * v[j].w); s2 += (w2[j].x * w2[j].x + w2[j].y * w2[j].y) + (w2[j].z * w2[j].z + w2[j].w * w2[j].w); }
        const float ms = wave_sum(s) * (1.0f / D) + EPS, ms2 = wave_sum(s2) * (1.0f / D) + EPS;
        const float rstd = __builtin_amdgcn_rsqf(ms), rstd2 = __builtin_amdgcn_rsqf(ms2);
        if (lane == 0) { ((float*)(ws + WS_RMS))[m] = ms * rstd; if (two) ((float*)(ws + WS_RMS))[m2] = ms2 * rstd2; }
        if (MK_GATES_F8 && !MK_P1_F8) { unsigned* o4 = (unsigned*)(ws + WS_XN8 + (size_t)m * D) + lane; unsigned* o42 = (unsigned*)(ws + WS_XN8 + (size_t)m2 * D) + lane;
#pragma unroll
            for (int j = 0; j < 4; ++j) { o4[64 * j] = pk4_fp8_nc(v[j].x * rstd, v[j].y * rstd, v[j].z * rstd, v[j].w * rstd);
                if (two) o42[64 * j] = pk4_fp8_nc(w2[j].x * rstd2, w2[j].y * rstd2, w2[j].z * rstd2, w2[j].w * rstd2); } }
        if (MK_P1_F8) { unsigned* o4 = (unsigned*)(ws + WS_XN + (size_t)m * D) + lane; unsigned* o42 = (unsigned*)(ws + WS_XN + (size_t)m2 * D) + lane;
#pragma unroll
            for (int j = 0; j < 4; ++j) { o4[64 * j] = pk4_fp8(v[j].x * rstd, v[j].y * rstd, v[j].z * rstd, v[j].w * rstd);
                if (two) o42[64 * j] = pk4_fp8(w2[j].x * rstd2, w2[j].y * rstd2, w2[j].z * rstd2, w2[j].w * rstd2); } }
        else {
        u32x2* o8 = (u32x2*)((bf16_t*)(ws + WS_XN) + (size_t)m * D) + lane; u32x2* o82 = (u32x2*)((bf16_t*)(ws + WS_XN) + (size_t)m2 * D) + lane;
#pragma unroll
        for (int j = 0; j < 4; ++j) { u32x2 w; w.x = pk2(v[j].x * rstd, v[j].y * rstd); w.y = pk2(v[j].z * rstd, v[j].w * rstd); o8[64 * j] = w;
            if (two) { w.x = pk2(w2[j].x * rstd2, w2[j].y * rstd2); w.y = pk2(w2[j].z * rstd2, w2[j].w * rstd2); o82[64 * j] = w; } }
        }
        asm volatile("" ::: "memory");
        if (m + 2 * NGW < TX) P0_XLOAD(m + 2 * NGW);
        asm volatile("" ::: "memory");
        if (MK_BGW && it < P0_NITEMS && !(var & 512)) { if (!((var & 2048) && it >= R9 && it < R13)) p0_table_item(F, it, scr, lane); it += NGW; }
    }
#undef P0_XLOAD
    if (MK_BGW && !(var & 512)) for (; it < P0_NITEMS; it += NGW) { if ((var & 2048) && it >= R9 && it < R13) continue; p0_table_item(F, it, scr, lane); }
}
__device__ __forceinline__ void p1_toeplitz(Frame& F) {
    { const float* pm = (const float*)(F.ws + WS_PMETA); float* pr = (float*)(F.ws + WS_PMR);
      LAS float* rs = (LAS float*)F.lds;
      for (int r = F.wave; r < 16; r += 8) { float sq = 0.f;
#pragma unroll
          for (int j = 0; j < 16; ++j) { const float v = F.in[I_META][r * D + F.lane + 64 * j]; sq += v * v; }
          sq = wave_sum(sq); if (F.lane == 0) rs[r] = __builtin_amdgcn_rsqf(sq * (1.0f / D) + EPS); }
      __syncthreads();
      for (int i = F.vcu * 512 + F.tid; i < 16 * 1536; i += F.G * 512) { float sm = 0.f;
#pragma unroll
          for (int kq = 0; kq < 64; ++kq) sm += pm[(size_t)kq * 16 * 1536 + i]; pr[i] = sm * rs[i / 1536]; }
      __syncthreads(); }
}
__device__ __forceinline__ void tz_load32(const Frame& F, int row0, u32x4 (&v)[8]) {
    const bf16_t* kc = (const bf16_t*)(F.ws + WS_KCONV);
#pragma unroll
    for (int i = 0; i < 8; ++i) { const int pc = F.tid + 512 * i, row = row0 + (pc >> 7), q = pc & 127, s = q >> 1, half = q & 1, g = row >> 10, t = (row >> 4) & 63, h = row & 15; v[i] = (u32x4){0u, 0u, 0u, 0u};
        if (s <= t) v[i] = *(const u32x4*)(kc + ((size_t)((g * 64 + (t - s)) * 16 + h) * 16 + half * 8)); }
}
__device__ __forceinline__ void tz_store32(const Frame& F, int row0, const u32x4 (&v)[8]) {
    bf16_t* tz = (bf16_t*)(F.ws + WS_TZ);
#pragma unroll
    for (int i = 0; i < 8; ++i) { const int pc = F.tid + 512 * i, row = row0 + (pc >> 7), q = pc & 127; if ((q >> 5) <= ((row >> 8) & 3)) *(u32x4*)(tz + (size_t)row * UAK + UA0 + (q >> 1) * 16 + (q & 1) * 8) = v[i]; }
}

constexpr int ST64 = 144, ST128 = 272;
template <int K> __device__ __forceinline__ void mma_nt32k(f32x16& acc, const LAS unsigned char* A, int sa, const LAS unsigned char* B, int sb, int lane) {
    const LAS unsigned char* pa = A + (lane & 31) * sa + (lane >> 5) * 16; const LAS unsigned char* pb = B + (lane & 31) * sb + (lane >> 5) * 16;
#pragma unroll
    for (int k = 0; k < K; k += 16) { const bf16x8 a = *(const LAS bf16x8*)(pa + k * 2), b = *(const LAS bf16x8*)(pb + k * 2); acc = __builtin_amdgcn_mfma_f32_32x32x16_bf16(a, b, acc, 0, 0, 0); }
}
__device__ __forceinline__ void hga_load(Frame& F, int unit, float (&lf)[16], u32x4 (&vv)[2]) {
    const int tid = F.tid; const int bh = unit >> 7, c = unit & 127, tok0 = (bh >> 2) * SEQ + c * CH, hcol = (bh & 3) * HD; const int d = tid & 127, seg = tid >> 7;
    const _Float16* lg = (const _Float16*)(F.ws + WS_LOGF) + (size_t)(tok0 + seg * 16) * HW + hcol + d;
#pragma unroll
    for (int j = 0; j < 16; ++j) lf[j] = (float)lg[(size_t)j * HW];
#pragma unroll
    for (int i = 0; i < 2; ++i) vv[i] = *(const u32x4*)((const bf16_t*)(F.ws + WS_V) + (size_t)(tok0 + (tid & 63)) * HW + hcol + ((tid >> 6) + 8 * i) * 8);
}
__device__ __forceinline__ void hgrn_a_phase(Frame& F, int first, int stride, int count) {
    const int tid = F.tid, lane = F.lane, wave = F.wave; int tzi = 0;
    LAS unsigned char* KT = F.lds; LAS unsigned char* VT = F.lds + 128 * ST64; LAS float* segtot = (LAS float*)(F.lds + 2 * 128 * ST64); LAS unsigned char* OT = (LAS unsigned char*)(segtot + 512);
    const int d = tid & 127, seg = tid >> 7;
    int unit = first; if (unit >= 16 * NCH) return;
    float lf[16]; u32x4 vv[2]; hga_load(F, unit, lf, vv);
    for (;;) {
        const int bh = unit >> 7, c = unit & 127, b = bh >> 2, h = bh & 3, tok0 = b * SEQ + c * CH, hcol = h * HD;
        float cs[16]; float run = 0.f;
#pragma unroll
        for (int j = 0; j < 16; ++j) { run += lf[j]; cs[j] = run; }
        segtot[seg * 128 + d] = run;
#pragma unroll
        for (int i = 0; i < 2; ++i) { const int e0 = ((tid >> 6) + 8 * i) * 8; LAS bf16_t* o = (LAS bf16_t*)(VT + e0 * ST64 + (tid & 63) * 2); const u32x4 v = vv[i];
            o[0 * (ST64 / 2)] = (bf16_t)(v.x & 0xffffu); o[1 * (ST64 / 2)] = (bf16_t)(v.x >> 16); o[2 * (ST64 / 2)] = (bf16_t)(v.y & 0xffffu); o[3 * (ST64 / 2)] = (bf16_t)(v.y >> 16);
            o[4 * (ST64 / 2)] = (bf16_t)(v.z & 0xffffu); o[5 * (ST64 / 2)] = (bf16_t)(v.z >> 16); o[6 * (ST64 / 2)] = (bf16_t)(v.w & 0xffffu); o[7 * (ST64 / 2)] = (bf16_t)(v.w >> 16); }
        __syncthreads();
        const float t0 = segtot[d], t1 = segtot[128 + d], t2 = segtot[256 + d], t3 = segtot[384 + d];
        const float pre = seg == 0 ? 0.f : (seg == 1 ? t0 : (seg == 2 ? t0 + t1 : t0 + t1 + t2)); const float total = (t0 + t1) + (t2 + t3);
        float kk[16];
#pragma unroll
        for (int j = 0; j < 16; ++j) { cs[j] += pre; kk[j] = (1.0f - __expf(lf[j])) * __expf(total - cs[j]); }
        u32x4 w0, w1; w0.x = cvt_pk_bf16(kk[0], kk[1]); w0.y = cvt_pk_bf16(kk[2], kk[3]); w0.z = cvt_pk_bf16(kk[4], kk[5]); w0.w = cvt_pk_bf16(kk[6], kk[7]); w1.x = cvt_pk_bf16(kk[8], kk[9]); w1.y = cvt_pk_bf16(kk[10], kk[11]); w1.z = cvt_pk_bf16(kk[12], kk[13]); w1.w = cvt_pk_bf16(kk[14], kk[15]);
        *(LAS u32x4*)(KT + d * ST64 + seg * 32) = w0; *(LAS u32x4*)(KT + d * ST64 + seg * 32 + 16) = w1;
        if (seg == 0) ((float*)(F.ws + WS_DEC))[(size_t)unit * HD + d] = __expf(total);
        { float* bc = (float*)(F.ws + WS_BCUM) + (size_t)(tok0 + seg * 16) * HW + hcol + d;
#pragma unroll
          for (int j = 0; j < 16; ++j) bc[(size_t)j * HW] = cs[j]; }
        const int un = unit + stride; const bool more = (un < 16 * NCH) && (--count > 0);
        if (more) hga_load(F, un, lf, vv);
        u32x4 tzv[8]; const bool dotz = tzi < 4 && F.G == 256; if (dotz) tz_load32(F, 128 * F.bx + 32 * tzi, tzv);
        __syncthreads();
#pragma unroll
        for (int i = 0; i < 2; ++i) { const int tile = wave * 2 + i, et = tile >> 2, dt = tile & 3; f32x16 acc;
#pragma unroll
            for (int r = 0; r < 16; ++r) acc[r] = 0.f;
            mma_nt32k<64>(acc, VT + et * 32 * ST64, ST64, KT + dt * 32 * ST64, ST64, lane);
#pragma unroll
            for (int r = 0; r < 16; ++r) { const int e = et * 32 + (r & 3) + 8 * (r >> 2) + 4 * (lane >> 5); ((LAS bf16_t*)(OT + e * ST128))[dt * 32 + (lane & 31)] = (bf16_t)f2bf(acc[r]); } }
        __syncthreads();
        { bf16_t* kvt = (bf16_t*)(F.ws + WS_KVT) + (size_t)unit * HD * HD;
#pragma unroll
          for (int i = 0; i < 4; ++i) { const int p = tid + 512 * i, e = p >> 4, d0 = (p & 15) * 8; *(u32x4*)(kvt + (size_t)e * HD + d0) = *(const LAS u32x4*)(OT + e * ST128 + d0 * 2); } }
        if (dotz) { tz_store32(F, 128 * F.bx + 32 * tzi, tzv); ++tzi; }
        if (!more) break;
        unit = un;
    }
    __syncthreads();
}
struct HgPre { u32x4 q[2]; f32x4 bj[2][2], bp[2][2], bm[2]; u32x4 v[2], sp[4]; };
__device__ __forceinline__ void hgc_load(Frame& F, int unit, HgPre& P) {
    const int tid = F.tid; const int bh = unit >> 7, c = unit & 127, b = bh >> 2, h = bh & 3, tok0 = b * SEQ + c * CH, hcol = h * HD;
    const bf16_t* qg = (const bf16_t*)(F.ws + WS_Q); const float* bc = (const float*)(F.ws + WS_BCUM); const bf16_t* vg = (const bf16_t*)(F.ws + WS_V); const bf16_t* sp = (const bf16_t*)(F.ws + WS_SPREV) + (size_t)unit * HD * HD;
    const int d0 = (tid & 15) * 8;
#pragma unroll
    for (int i = 0; i < 2; ++i) { const int j = (tid >> 4) + 32 * i; const size_t o = (size_t)(tok0 + j) * HW + hcol + d0;
        P.q[i] = __builtin_nontemporal_load((const u32x4*)(qg + o)); P.bj[i][0] = *(const f32x4*)(bc + o); P.bj[i][1] = *(const f32x4*)(bc + o + 4);
        if (j > 0) { P.bp[i][0] = *(const f32x4*)(bc + o - HW); P.bp[i][1] = *(const f32x4*)(bc + o - HW + 4); } else { P.bp[i][0] = (f32x4){0.f, 0.f, 0.f, 0.f}; P.bp[i][1] = (f32x4){0.f, 0.f, 0.f, 0.f}; }
        const int e0 = ((tid >> 6) + 8 * i) * 8; P.v[i] = __builtin_nontemporal_load((const u32x4*)(vg + (size_t)(tok0 + (tid & 63)) * HW + hcol + e0)); }
    { const size_t o = (size_t)(tok0 + 31) * HW + hcol + d0; P.bm[0] = *(const f32x4*)(bc + o); P.bm[1] = *(const f32x4*)(bc + o + 4); }
#pragma unroll
    for (int i = 0; i < 4; ++i) { const int p = tid + 512 * i; P.sp[i] = __builtin_nontemporal_load((const u32x4*)(sp + (size_t)(p >> 4) * HD + (p & 15) * 8)); }
}
__device__ __forceinline__ void hgrn_c_phase(Frame& F) {
    const int tid = F.tid, lane = F.lane, wave = F.wave;
    LAS unsigned char* Q1 = F.lds; LAS unsigned char* K1 = Q1 + 64 * ST128; LAS unsigned char* Q2 = K1 + 64 * ST128; LAS unsigned char* VT = Q2 + 64 * ST128;
    LAS unsigned char* PP = VT + 128 * ST64; LAS unsigned char* SPL = PP + 64 * ST64; LAS float* RS = (LAS float*)(SPL + 128 * ST128); LAS unsigned char* OL = Q1;
    volatile LAS int* qid = (volatile LAS int*)(F.MISC + 48);
    if (tid == 0) { qid[0] = (int)__hip_atomic_fetch_add(F.ctl + CW_HGQ, 1u, __ATOMIC_RELAXED, __HIP_MEMORY_SCOPE_AGENT); qid[1] = (int)__hip_atomic_fetch_add(F.ctl + CW_HGQ, 1u, __ATOMIC_RELAXED, __HIP_MEMORY_SCOPE_AGENT); }
    __syncthreads();
    int unit = qid[0], un = qid[1]; if (unit >= 16 * NCH) return;
    __syncthreads();
    HgPre P; hgc_load(F, unit, P);
    u32x4 gsv[2];
    { const int bh = unit >> 7, c = unit & 127, tok0 = (bh >> 2) * SEQ + c * CH, hcol = (bh & 3) * HD;
#pragma unroll
      for (int i = 0; i < 2; ++i) gsv[i] = *(const u32x4*)((const bf16_t*)(F.ws + WS_GS) + (size_t)(tok0 + (tid >> 4) + 32 * i) * HW + hcol + (tid & 15) * 8); }
    for (;;) {
        const int bh = unit >> 7, c = unit & 127, b = bh >> 2, h = bh & 3, tok0 = b * SEQ + c * CH, hcol = h * HD;
        { const int d0 = (tid & 15) * 8;
#pragma unroll
          for (int i = 0; i < 2; ++i) { const int j = (tid >> 4) + 32 * i; float q1[8], k1[8], q2[8];
              const unsigned qw[4] = {P.q[i].x, P.q[i].y, P.q[i].z, P.q[i].w};
#pragma unroll
              for (int k = 0; k < 8; ++k) { const float bb = P.bj[i][k >> 2][k & 3], bm = P.bm[k >> 2][k & 3], lf = bb - P.bp[i][k >> 2][k & 3]; const float q = bf2f((qw[k >> 1] >> ((k & 1) * 16)) & 0xffffu);
                  const float kx = 1.0f - __expf(lf), ed = __expf(bb - bm); q1[k] = q * ed; k1[k] = kx * __expf(bm - bb); q2[k] = q * __expf(bb); }
              u32x4 w; w.x = cvt_pk_bf16(q1[0], q1[1]); w.y = cvt_pk_bf16(q1[2], q1[3]); w.z = cvt_pk_bf16(q1[4], q1[5]); w.w = cvt_pk_bf16(q1[6], q1[7]); *(LAS u32x4*)(Q1 + j * ST128 + d0 * 2) = w;
              w.x = cvt_pk_bf16(k1[0], k1[1]); w.y = cvt_pk_bf16(k1[2], k1[3]); w.z = cvt_pk_bf16(k1[4], k1[5]); w.w = cvt_pk_bf16(k1[6], k1[7]); *(LAS u32x4*)(K1 + j * ST128 + d0 * 2) = w;
              w.x = cvt_pk_bf16(q2[0], q2[1]); w.y = cvt_pk_bf16(q2[2], q2[3]); w.z = cvt_pk_bf16(q2[4], q2[5]); w.w = cvt_pk_bf16(q2[6], q2[7]); *(LAS u32x4*)(Q2 + j * ST128 + d0 * 2) = w;
              const int e0 = ((tid >> 6) + 8 * i) * 8; LAS bf16_t* o = (LAS bf16_t*)(VT + e0 * ST64 + (tid & 63) * 2); const u32x4 v = P.v[i];
              o[0 * (ST64 / 2)] = (bf16_t)(v.x & 0xffffu); o[1 * (ST64 / 2)] = (bf16_t)(v.x >> 16); o[2 * (ST64 / 2)] = (bf16_t)(v.y & 0xffffu); o[3 * (ST64 / 2)] = (bf16_t)(v.y >> 16);
              o[4 * (ST64 / 2)] = (bf16_t)(v.z & 0xffffu); o[5 * (ST64 / 2)] = (bf16_t)(v.z >> 16); o[6 * (ST64 / 2)] = (bf16_t)(v.w & 0xffffu); o[7 * (ST64 / 2)] = (bf16_t)(v.w >> 16); }
#pragma unroll
          for (int i = 0; i < 4; ++i) { const int p = tid + 512 * i; *(LAS u32x4*)(SPL + (p >> 4) * ST128 + (p & 15) * 16) = P.sp[i]; } }
        const bool more = un < 16 * NCH;
        if (more) hgc_load(F, un, P);
        if (tid == 0) qid[0] = more ? (int)__hip_atomic_fetch_add(F.ctl + CW_HGQ, 1u, __ATOMIC_RELAXED, __HIP_MEMORY_SCOPE_AGENT) : 16 * NCH;
        __syncthreads();
        const int it = wave >> 2, et = wave & 3; f32x16 acc;
#pragma unroll
        for (int r = 0; r < 16; ++r) acc[r] = 0.f;
        mma_nt32k<128>(acc, Q2 + it * 32 * ST128, ST128, SPL + et * 32 * ST128, ST128, lane);
        if (wave < 3) { const int si = wave ? 1 : 0, sj = wave == 2 ? 1 : 0; f32x16 sc;
#pragma unroll
            for (int r = 0; r < 16; ++r) sc[r] = 0.f;
            mma_nt32k<128>(sc, Q1 + si * 32 * ST128, ST128, K1 + sj * 32 * ST128, ST128, lane);
#pragma unroll
            for (int r = 0; r < 16; ++r) { const int i = si * 32 + (r & 3) + 8 * (r >> 2) + 4 * (lane >> 5), j = sj * 32 + (lane & 31); ((LAS bf16_t*)(PP + i * ST64))[j] = (bf16_t)f2bf(j <= i ? sc[r] : 0.f); } }
        else if (wave == 3) {
#pragma unroll
            for (int r = 0; r < 16; ++r) { const int i = (r & 3) + 8 * (r >> 2) + 4 * (lane >> 5); ((LAS bf16_t*)(PP + i * ST64))[32 + (lane & 31)] = (bf16_t)0; } }
        __syncthreads();
        mma_nt32k<64>(acc, PP + it * 32 * ST64, ST64, VT + et * 32 * ST64, ST64, lane);
#pragma unroll
        for (int r = 0; r < 16; ++r) { const int i = it * 32 + (r & 3) + 8 * (r >> 2) + 4 * (lane >> 5); ((LAS bf16_t*)(OL + i * ST128))[et * 32 + (lane & 31)] = (bf16_t)f2bf(acc[r]); }
        __syncthreads();
        { const int eo = (tid & 15) * 8; const f32x4 g0 = *(const f32x4*)(F.in[I_HNG] + hcol + eo), g1 = *(const f32x4*)(F.in[I_HNG] + hcol + eo + 4); bf16_t* yo = (bf16_t*)(F.ws + WS_YHG);
#pragma unroll
          for (int i = 0; i < 2; ++i) { const int row = (tid >> 4) + 32 * i; const u32x4 o = *(const LAS u32x4*)(OL + row * ST128 + eo * 2); const u32x4 gq = gsv[i];
              const float x[8] = {bf2f(o.x & 0xffffu), bf2f(o.x >> 16), bf2f(o.y & 0xffffu), bf2f(o.y >> 16), bf2f(o.z & 0xffffu), bf2f(o.z >> 16), bf2f(o.w & 0xffffu), bf2f(o.w >> 16)};
              float ss = ((x[0] * x[0] + x[1] * x[1]) + (x[2] * x[2] + x[3] * x[3])) + ((x[4] * x[4] + x[5] * x[5]) + (x[6] * x[6] + x[7] * x[7]));
              ss += __shfl_xor(ss, 1); ss += __shfl_xor(ss, 2); ss += __shfl_xor(ss, 4); ss += __shfl_xor(ss, 8);
              const float rstd = __builtin_amdgcn_rsqf(ss * (1.0f / HD) + EPS);
              f32x4 y0, y1; y0[0] = x[0] * rstd * g0[0] * bf2f(gq.x & 0xffffu); y0[1] = x[1] * rstd * g0[1] * bf2f(gq.x >> 16); y0[2] = x[2] * rstd * g0[2] * bf2f(gq.y & 0xffffu); y0[3] = x[3] * rstd * g0[3] * bf2f(gq.y >> 16);
              y1[0] = x[4] * rstd * g1[0] * bf2f(gq.z & 0xffffu); y1[1] = x[5] * rstd * g1[1] * bf2f(gq.z >> 16); y1[2] = x[6] * rstd * g1[2] * bf2f(gq.w & 0xffffu); y1[3] = x[7] * rstd * g1[3] * bf2f(gq.w >> 16);
              *(u32x4*)(yo + (size_t)(tok0 + row) * HW + hcol + eo) = pack8(y0, y1); } }
        if (!more) break;
        unit = un; un = qid[0];
        { const int bh2 = unit >> 7, c2 = unit & 127, tk = (bh2 >> 2) * SEQ + c2 * CH, hc = (bh2 & 3) * HD;
#pragma unroll
          for (int i = 0; i < 2; ++i) gsv[i] = *(const u32x4*)((const bf16_t*)(F.ws + WS_GS) + (size_t)(tk + (tid >> 4) + 32 * i) * HW + hc + (tid & 15) * 8); }
        __syncthreads();
    }
    __syncthreads();
}

__device__ __forceinline__ void stagger(const Frame& F, int units) {
    const unsigned long long t0 = __builtin_amdgcn_s_memrealtime(), dt = (unsigned long long)(((F.bx >> 3) & 3) * units);
    while (__builtin_amdgcn_s_memrealtime() - t0 < dt) __builtin_amdgcn_s_sleep(8);
}
__device__ __forceinline__ void phase0(Frame& F, const int var) {
    unsigned char* ws = F.ws; (void)ws;
    p0_prologue(F, var);
}
__device__ __forceinline__ void phase1(Frame& F, const int var) {
    unsigned char* ws = F.ws; (void)ws;
        if (!(var & 64)) p1_toeplitz(F);
        typedef EpiInProjT<false> EpiInProj; EpiInProj E{(bf16_t*)(ws + WS_UA), (bf16_t*)(ws + WS_Q), (bf16_t*)(ws + WS_V), (bf16_t*)(ws + WS_GS), (bf16_t*)(ws + WS_GATES), (_Float16*)(ws + WS_LOGF), (const float*)(ws + WS_LBV), var};
        EpiInProjT<true> E8{(bf16_t*)(ws + WS_UA), (bf16_t*)(ws + WS_Q), (bf16_t*)(ws + WS_V), (bf16_t*)(ws + WS_GS), (bf16_t*)(ws + WS_GATES), (_Float16*)(ws + WS_LOGF), (const float*)(ws + WS_LBV), var};
        if (MK_GATES_F8 && !MK_P1_F8) {
            { SchedStatic S{(const char*)(ws + WS_XN), (const char*)(ws + WS_WIN), T / 256, 10, F.G, F.bx, (size_t)256 * D * 2, (size_t)256 * D * 2, var};
              pg8::gemm_phase<EpiInProj, SchedStatic, false, false>(F.lds, D, D, D, S, E, nullptr, var); }
            { SchedStatic S{(const char*)(ws + WS_XN8), (const char*)(ws + WS_WIN8), T / 256, 8, F.G, F.bx, (size_t)256 * D, (size_t)256 * D, var, 10};
              pg8::gemm_phase<EpiInProjT<true>, SchedStatic, false, true>(F.lds, D, D, D, S, E8, nullptr, var); }
        } else {
            SchedStatic S{(const char*)(ws + WS_XN), (const char*)(ws + WS_WIN), T / 256, INW / 256, F.G, F.bx, (size_t)256 * D * (MK_P1_F8 ? 1 : 2), (size_t)256 * D * (MK_P1_F8 ? 1 : 2)};
            pg8::gemm_phase<EpiInProj, SchedStatic, false, MK_P1_F8 != 0>(F.lds, D, D, D, S, E, nullptr);
        }
}
__device__ __forceinline__ void phase2(Frame& F, const int var) {
    unsigned char* ws = F.ws; (void)ws;
        { SchedS5E S{(const char*)(ws + WS_UA), (const char*)(ws + WS_WE), F.bx}; EpiS5E E{(float*)(ws + WS_SE)};
          pg8::gemm_phase<EpiS5E, SchedS5E, false>(F.lds, 1024, UAK, 1024, S, E, nullptr); }
        __syncthreads();
        const float* pm = (const float*)(ws + WS_PMR);
        if (F.bx >= 64 && F.bx < 68) {
            const int g = (F.bx - 64) * 8 + (F.tid >> 6), p = F.tid & 63; const f32x2 lb = ((const f32x2*)(ws + WS_LAMB))[g * SP + p]; float xr = 0.f, xi = 0.f;
            for (int s = 0; s < NMETA; ++s) { float ar = 0.f, ai = 0.f;
#pragma unroll
                for (int h = 0; h < 16; ++h) { const int col = g * 16 + h; const float uu = pm[(size_t)s * 1536 + col];
                    const f32x2 bb = ((const f32x2*)(ws + WS_BBAR))[(g * SP + p) * 16 + h]; ar += bb.x * uu; ai += bb.y * uu; }
                const float nr = lb.x * xr - lb.y * xi + ar, ni = lb.x * xi + lb.y * xr + ai; xr = nr; xi = ni; }
            float* xm = (float*)(ws + WS_XMETA); xm[g * 128 + p] = xr; xm[g * 128 + 64 + p] = xi;
        }
        if (F.bx >= 68 && F.bx < 196) {
            const int idx = (F.bx - 68) * 512 + F.tid, h = idx >> 14, e = (idx >> 7) & 127, d = idx & 127; const float lbv = ((const float*)(ws + WS_LBV))[h * HD + d]; float S = 0.f;
            for (int s = 0; s < NMETA; ++s) { const int cf = 512 + h * HD + d, cv = 1024 + h * HD + e;
                const float fp = pm[(size_t)s * 1536 + cf];
                const float vv = pm[(size_t)s * 1536 + cv];
                const float f = lbv + (1.0f - lbv) * sigmoidf_(fp); S = f * S + (1.0f - f) * vv; }
            ((float*)(ws + WS_SMETA))[idx] = S;
        }
        if (F.bx < 64) hgrn_a_phase(F, 5 * F.bx, 1, 5); else hgrn_a_phase(F, 320 + (F.bx - 64), F.G - 64, 1 << 20);
}
__device__ __forceinline__ void phase3(Frame& F, const int var) {
    unsigned char* ws = F.ws; (void)ws;
        {
            const int bh = F.bx >> 4, e = (F.bx & 15) * 8 + (F.tid >> 6), d = (F.tid & 63) * 2, h = bh & 3;
            f32x2 S = *(const f32x2*)((const float*)(ws + WS_SMETA) + (size_t)(h * HD + e) * HD + d);
            const unsigned* kv = (const unsigned*)((const bf16_t*)(ws + WS_KVT) + (size_t)bh * NCH * HD * HD + (size_t)e * HD + d); const float* dc = (const float*)(ws + WS_DEC) + (size_t)bh * NCH * HD + d;
            unsigned* sp = (unsigned*)((bf16_t*)(ws + WS_SPREV) + (size_t)bh * NCH * HD * HD + (size_t)e * HD + d);
            for (int c0 = 0; c0 < NCH; c0 += 16) { unsigned kq[16]; f32x2 dv[16];
#pragma unroll
                for (int j = 0; j < 16; ++j) { kq[j] = __builtin_nontemporal_load(kv + (size_t)(c0 + j) * (HD * HD / 2)); dv[j] = *(const f32x2*)(dc + (size_t)(c0 + j) * HD); }
#pragma unroll
                for (int j = 0; j < 16; ++j) { sp[(size_t)(c0 + j) * (HD * HD / 2)] = pk2(S.x, S.y); S.x = S.x * dv[j].x + bf2f(kq[j] & 0xffffu); S.y = S.y * dv[j].y + bf2f(kq[j] >> 16); } }
        }
        if (F.bx < 16) {
            const int b = F.bx >> 2, g = (F.bx & 3) * 8 + (F.tid >> 6), p = F.tid & 63; const f32x2 lc = ((const f32x2*)(ws + WS_LAMC))[g * SP + p];
            const float* xm = (const float*)(ws + WS_XMETA); float xr = xm[g * 128 + p], xi = xm[g * 128 + 64 + p];
            const float* se = (const float*)(ws + WS_SE) + ((size_t)g * 512 + b * 128) * 128 + p; bf16_t* ua = (bf16_t*)(ws + WS_UA) + ((size_t)g * 512 + b * 128) * UAK + p;
            for (int c0 = 0; c0 < NCH; c0 += 8) { float er[8], ei[8];
#pragma unroll
                for (int j = 0; j < 8; ++j) { er[j] = se[(size_t)(c0 + j) * 128]; ei[j] = se[(size_t)(c0 + j) * 128 + 64]; }
#pragma unroll
                for (int j = 0; j < 8; ++j) { bf16_t* o = ua + (size_t)(c0 + j) * UAK; o[0] = (bf16_t)f2bf(xr); o[64] = (bf16_t)f2bf(xi);
                    const float nr = lc.x * xr - lc.y * xi + er[j], ni = lc.x * xi + lc.y * xr + ei[j]; xr = nr; xi = ni; } }
        }
}
__device__ __forceinline__ void phase4(Frame& F, const int var) {
    unsigned char* ws = F.ws; (void)ws;
        if (!(var & 64)) { SchedS5Y S{(const char*)(ws + WS_UA), (const char*)(ws + WS_TZ), F.bx, F.G}; EpiS5Y E{(const bf16_t*)(ws + WS_UA), F.in[I_SD], (bf16_t*)(ws + WS_Y1)};
          pg8::gemm_phase<EpiS5Y, SchedS5Y, false>(F.lds, UAK, UAK, UAK, S, E, nullptr); }
        __syncthreads();
        if (!(var & 128)) hgrn_c_phase(F);
}
__device__ __forceinline__ void phase5(Frame& F, const int var) {
    unsigned char* ws = F.ws; (void)ws;
        SchedStatic S{(const char*)(ws + WS_Y1), (const char*)(ws + WS_WGLU), T / 256, HW / 256, F.G, F.bx, (size_t)256 * HW * 2, (size_t)256 * HW * 2};
        EpiGlu E{(const bf16_t*)(ws + WS_Y1), (bf16_t*)(ws + WS_YS5)};
        pg8::gemm_phase<EpiGlu, SchedStatic, false>(F.lds, HW, HW, HW, S, E, nullptr);
}
__device__ __forceinline__ void phase6(Frame& F, const int var) {
    unsigned char* ws = F.ws; (void)ws;
        SchedBranch S{(const char*)(ws + WS_YS5), (const char*)(ws + WS_YHG), (const char*)(ws + WS_WBS), (const char*)(ws + WS_WBH), F.G, F.bx};
        EpiBranch E{(const bf16_t*)(ws + WS_GATES), (bf16_t*)(ws + WS_MERGED)};
        pg8::gemm_phase<EpiBranch, SchedBranch, false>(F.lds, HW, HW, HW, S, E, nullptr);
}
__device__ __forceinline__ void phase7(Frame& F, const int var) {
    unsigned char* ws = F.ws; (void)ws;
        SchedStatic S{(const char*)(ws + WS_MERGED), (const char*)(ws + WS_WOUT), T / 256, D / 256, F.G, F.bx, (size_t)256 * D * (MK_P7_F8 ? 1 : 2), (size_t)256 * D * (MK_P7_F8 ? 1 : 2), var};
        EpiOut E{(const bf16_t*)(ws + WS_XN), (const float*)(ws + WS_RMS), (bf16_t*)(ws + WS_H1), (float*)(ws + WS_SSQ), var};
        pg8::gemm_phase<EpiOut, SchedStatic, false, MK_P7_F8 != 0>(F.lds, D, D, D, S, E, nullptr, var);
}
__device__ __forceinline__ void phase8(Frame& F, const int var) {
    unsigned char* ws = F.ws; (void)ws;
        volatile LAS unsigned* hist = F.MISC + 16;
        volatile LAS unsigned* gb = F.MISC + 64;
        const int lane = F.lane, tl = lane & 15, kg = lane >> 4; const float* g2 = F.in[I_N2G];
        { const u32x4* src = (const u32x4*)(ws + WS_WRT); LAS u32x4* dst = (LAS u32x4*)F.lds;
          for (int i = F.tid; i < 2 * NE * D / 8; i += 512) { const int row = i >> 7, ch = i & 127; *(LAS u32x4*)((LAS unsigned char*)dst + row * 2064 + ch * 16) = src[i]; } }
        __syncthreads();
        const LAS unsigned char* wh = F.lds; const LAS unsigned char* wl = F.lds + NE * 2064;
        const int rounds = (T / 16 + F.G * 8 - 1) / (F.G * 8);
        for (int rd = 0; rd < rounds; ++rd) {
            const int tile = (rd * F.G + F.vcu) * 8 + F.wave; const bool act = tile < T / 16;
            if (F.tid < 32) hist[F.tid] = 0u;
            __syncthreads();
            int te[4] = {0, 0, 0, 0}; unsigned lr[4] = {0u, 0u, 0u, 0u}; const int tok = (act ? tile : 0) * 16 + tl;
            if (act) {
            const bf16_t* hrow = (const bf16_t*)(ws + WS_H1) + (size_t)tok * D; const f32x4* sq = (const f32x4*)((const float*)(ws + WS_SSQ) + (size_t)tok * 16);
            const f32x4 s0 = sq[0], s1 = sq[1], s2 = sq[2], s3 = sq[3];
            const float ss = ((s0[0] + s0[1]) + (s0[2] + s0[3])) + ((s1[0] + s1[1]) + (s1[2] + s1[3])) + ((s2[0] + s2[1]) + (s2[2] + s2[3])) + ((s3[0] + s3[1]) + (s3[2] + s3[3]));
            const float rstd = __builtin_amdgcn_rsqf(ss * (1.0f / D) + EPS);
            f32x4 a0 = (f32x4){0.f, 0.f, 0.f, 0.f}, a1 = a0; unsigned char* xo = (unsigned char*)(ws + WS_XN2) + (size_t)tok * D;
#pragma unroll 1
            for (int kb = 0; kb < 32; kb += 16) { u32x4 hv[16];
#pragma unroll
                for (int u8 = 0; u8 < 16; ++u8) hv[u8] = __builtin_nontemporal_load((const u32x4*)(hrow + ((kb + u8) >> 1) * 64 + kg * 16 + (u8 & 1) * 8));
                u32x2 qprev = (u32x2){0u, 0u};
#pragma unroll
                for (int u8 = 0; u8 < 16; ++u8) { const int k = ((kb + u8) >> 1) * 64 + kg * 16 + (u8 & 1) * 8; const f32x4 ga = *(const f32x4*)(g2 + k), gb = *(const f32x4*)(g2 + k + 4); const u32x4 hq = hv[u8];
                    float x[8] = {bf2f(hq.x & 0xffffu) * rstd * ga[0], bf2f(hq.x >> 16) * rstd * ga[1], bf2f(hq.y & 0xffffu) * rstd * ga[2], bf2f(hq.y >> 16) * rstd * ga[3], bf2f(hq.z & 0xffffu) * rstd * gb[0], bf2f(hq.z >> 16) * rstd * gb[1], bf2f(hq.w & 0xffffu) * rstd * gb[2], bf2f(hq.w >> 16) * rstd * gb[3]};
                    u32x4 hi4; hi4.x = cvt_pk_bf16(x[0], x[1]); hi4.y = cvt_pk_bf16(x[2], x[3]); hi4.z = cvt_pk_bf16(x[4], x[5]); hi4.w = cvt_pk_bf16(x[6], x[7]);
                    { u32x2 q8; q8.x = pk4_fp8_nc(x[0], x[1], x[2], x[3]); q8.y = pk4_fp8_nc(x[4], x[5], x[6], x[7]);
                      if (u8 & 1) *(u32x4*)(xo + k - 8) = (u32x4){qprev.x, qprev.y, q8.x, q8.y}; else qprev = q8; }
                    const bf16x8 xh = __builtin_bit_cast(bf16x8, hi4);
                    const bf16x8 wh0 = *(const LAS bf16x8*)(wh + tl * 2064 + k * 2), wh1 = *(const LAS bf16x8*)(wh + (16 + tl) * 2064 + k * 2), wl0 = *(const LAS bf16x8*)(wl + tl * 2064 + k * 2), wl1 = *(const LAS bf16x8*)(wl + (16 + tl) * 2064 + k * 2);
                    a0 = __builtin_amdgcn_mfma_f32_16x16x32_bf16(wh0, xh, a0, 0, 0, 0); a0 = __builtin_amdgcn_mfma_f32_16x16x32_bf16(wl0, xh, a0, 0, 0, 0);
                    a1 = __builtin_amdgcn_mfma_f32_16x16x32_bf16(wh1, xh, a1, 0, 0, 0); a1 = __builtin_amdgcn_mfma_f32_16x16x32_bf16(wl1, xh, a1, 0, 0, 0); } }
            float lg[8]; int le[8]; const float* br = F.in[I_BR];
#pragma unroll
            for (int j = 0; j < 4; ++j) { le[j] = 4 * kg + j; le[4 + j] = 16 + 4 * kg + j; lg[j] = a0[j] + br[le[j]]; lg[4 + j] = a1[j] + br[le[4 + j]]; }
            float tv[4];
#pragma unroll
            for (int r = 0; r < 4; ++r) { float bv = -3.0e38f; int be = 1 << 20;
#pragma unroll
                for (int j = 0; j < 8; ++j) if (lg[j] > bv || (lg[j] == bv && le[j] < be)) { bv = lg[j]; be = le[j]; }
#pragma unroll
                for (int o = 16; o <= 32; o <<= 1) { const float ov = __shfl_xor(bv, o); const int oe = __shfl_xor(be, o); if (ov > bv || (ov == bv && oe < be)) { bv = ov; be = oe; } }
                tv[r] = bv; te[r] = be;
#pragma unroll
                for (int j = 0; j < 8; ++j) if (le[j] == be) lg[j] = -3.0e38f; }
            if (kg == 0) { const float e1 = __expf(tv[1] - tv[0]), e2 = __expf(tv[2] - tv[0]), e3 = __expf(tv[3] - tv[0]); const float inv = 1.0f / (1.0f + e1 + e2 + e3);
                *(f32x4*)((float*)(ws + WS_TOPW) + (size_t)tok * 4) = (f32x4){inv, e1 * inv, e2 * inv, e3 * inv};
#pragma unroll
                for (int r = 0; r < 4; ++r) lr[r] = __hip_atomic_fetch_add((LAS unsigned*)(hist + te[r]), 1u, __ATOMIC_RELAXED, __HIP_MEMORY_SCOPE_WORKGROUP); }
            }
            __syncthreads();
            if (F.tid < 32) gb[F.tid] = __hip_atomic_fetch_add(F.ctl + CW_CNT + F.tid, hist[F.tid], __ATOMIC_RELAXED, __HIP_MEMORY_SCOPE_AGENT);
            __syncthreads();
            if (act && kg == 0) { i32x4 sl;
#pragma unroll
                for (int r = 0; r < 4; ++r) { const unsigned rank = gb[te[r]] + lr[r]; ((int*)(ws + WS_LIST))[(size_t)te[r] * T + rank] = tok; sl[r] = (int)(((unsigned)te[r] << 24) | rank); }
                *(i32x4*)((int*)(ws + WS_ROWSLOT) + (size_t)tok * 4) = sl; }
        }
}
__device__ __forceinline__ void moe_tables(Frame& F) {
    volatile LAS unsigned* M = F.MISC;
    if (F.tid < 64) { const int e = F.tid & 31; const unsigned c = __hip_atomic_load(F.ctl + CW_CNT + e, __ATOMIC_RELAXED, __HIP_MEMORY_SCOPE_AGENT), nt = (c + 255u) >> 8; unsigned incl = nt;
#pragma unroll
        for (int o = 1; o < 32; o <<= 1) { const unsigned v = __shfl_up(incl, o, 32); if (e >= o) incl += v; }
        if (F.tid < 32) { M[MT_BASE + e] = (incl - nt) * 256u; M[MT_CNT + e] = c; if (e == 31) M[MT_NT] = incl;
            for (unsigned t = incl - nt; t < incl; ++t) M[MT_TILEE + t] = (unsigned)e; } }
    __syncthreads();
}
__device__ __forceinline__ void phase9(Frame& F, const int var) { (void)F; (void)var; }
__device__ __forceinline__ void phase10(Frame& F, const int var) {
    unsigned char* ws = F.ws; (void)ws;
        moe_tables(F);
        const int ntiles = __builtin_amdgcn_readfirstlane((int)F.MISC[MT_NT]);
        SchedMoe S{(const char*)(ws + WS_XN2), (const char*)(ws + WS_WGU), F.MISC, ntiles, 8, F.G, F.bx, (size_t)2048 * D, (size_t)256 * D, true, var};
        EpiMoe1 E{F.in[I_BGU], F.MISC, (unsigned char*)(ws + WS_A2), var};
        pg8::gemm_phase<EpiMoe1, SchedMoe, true, true>(F.lds, D, D, D, S, E, (const int*)(ws + WS_LIST));
}
__device__ __forceinline__ void phase11(Frame& F, const int var) {
    unsigned char* ws = F.ws; (void)ws;
        if (MK_PER_PHASE) moe_tables(F);
        const int ntiles = __builtin_amdgcn_readfirstlane((int)F.MISC[MT_NT]);
        SchedMoe S{(const char*)(ws + WS_A2), (const char*)(ws + WS_WD), F.MISC, ntiles, 4, F.G, F.bx, (size_t)D * DF, (size_t)256 * DF, false, var};
        EpiMoe2 E{F.in[I_BD], F.MISC, (unsigned char*)(ws + WS_YS), var};
        if (MK_STAGGER) { const unsigned long long t0 = __builtin_amdgcn_s_memrealtime(), dt = (unsigned long long)(((F.bx >> 3) & 3) * (MK_STAGGER / 2)); while (__builtin_amdgcn_s_memrealtime() - t0 < dt) __builtin_amdgcn_s_sleep(8); }
        pg8::gemm_phase<EpiMoe2, SchedMoe, false, true>(F.lds, DF, DF, DF, S, E, nullptr, var);
}
__device__ __forceinline__ i32x4 p12_rows(volatile LAS unsigned* M, const int* slot) {
    const i32x4 s = *(const i32x4*)slot; i32x4 r;
#pragma unroll
    for (int k = 0; k < 4; ++k) r[k] = (int)(M[MT_BASE + ((unsigned)s[k] >> 24)] + ((unsigned)s[k] & 0xffffffu));
    return r;
}
__device__ __forceinline__ void phase12(Frame& F, const int var) {
    unsigned char* ws = F.ws; (void)ws;
        const int lane = F.lane; const float* fg = F.in[I_FNG];
        float pe = 0.f; if (MK_STAMP >= 0) { const float dt = __builtin_bit_cast(float, __hip_atomic_load(F.ctl + 200, __ATOMIC_RELAXED, __HIP_MEMORY_SCOPE_AGENT)); pe = sqrtf(dt * MK_STAMP_SCALE); if (lane & 1) pe = -pe; }
        const int NW = F.G * 8; int tok = F.vcu * 8 + F.wave;
        u32x2 hq[4]; unsigned yq[4][4]; f32x4 wq; i32x4 sr, srn;
        if (MK_PER_PHASE) moe_tables(F);
        volatile LAS unsigned* MT = F.MISC;
#define P12_ROWS(t_) p12_rows(MT, (const int*)(ws + WS_ROWSLOT) + (size_t)(t_) * 4)
#define P12_LOAD(t_, R_) do { wq = *(const f32x4*)((const float*)(ws + WS_TOPW) + (size_t)(t_) * 4); _Pragma("unroll") for (int j = 0; j < 4; ++j) { hq[j] = __builtin_nontemporal_load((const u32x2*)((const bf16_t*)(ws + WS_H1) + (size_t)(t_) * D) + lane + 64 * j); \
            _Pragma("unroll") for (int k = 0; k < 4; ++k) yq[j][k] = __builtin_nontemporal_load((const unsigned*)((const unsigned char*)(ws + WS_YS) + (size_t)(R_)[k] * D) + lane + 64 * j); } } while (0)
        sr = (i32x4){0, 0, 0, 0}; srn = sr;
        if (tok < T) { sr = P12_ROWS(tok); if (tok + NW < T) srn = P12_ROWS(tok + NW); P12_LOAD(tok, sr); }
        for (; tok < T; tok += NW) {
            const float wk[4] = {wq[0], wq[1], wq[2], wq[3]}; f32x4 v[4]; float s = 0.f;
#pragma unroll
            for (int j = 0; j < 4; ++j) { v[j] = (f32x4){bf2f(hq[j].x & 0xffffu), bf2f(hq[j].x >> 16), bf2f(hq[j].y & 0xffffu), bf2f(hq[j].y >> 16)};
#pragma unroll
                for (int k = 0; k < 4; ++k) { const unsigned y = yq[j][k]; const f32x2 lo = __builtin_amdgcn_cvt_pk_f32_fp8((int)y, false), hi = __builtin_amdgcn_cvt_pk_f32_fp8((int)y, true);
                    v[j].x += wk[k] * lo.x; v[j].y += wk[k] * lo.y; v[j].z += wk[k] * hi.x; v[j].w += wk[k] * hi.y; }
                s += (v[j].x * v[j].x + v[j].y * v[j].y) + (v[j].z * v[j].z + v[j].w * v[j].w); }
            if (tok + NW < T) { sr = srn; P12_LOAD(tok + NW, sr); if (tok + 2 * NW < T) srn = P12_ROWS(tok + 2 * NW); }
            const float rstd = __builtin_amdgcn_rsqf(wave_sum(s) * (1.0f / D) + EPS);
            f32x4* o = (f32x4*)(F.out + (size_t)tok * D) + lane;
#pragma unroll
            for (int j = 0; j < 4; ++j) { const f32x4 gg = ((const f32x4*)fg)[lane + 64 * j]; o[64 * j] = (f32x4){v[j].x * rstd * gg.x * (1.f + pe), v[j].y * rstd * gg.y * (1.f - pe), v[j].z * rstd * gg.z * (1.f + pe), v[j].w * rstd * gg.w * (1.f - pe)}; }
        }
#undef P12_ROWS
#undef P12_LOAD
}
__device__ __forceinline__ void bgw_tile(Frame& F, int t) {
    LAS float* scr = (LAS float*)(F.lds + F.wave * 16384); f32x4 rr[16];
    const TDesc dc = p0_decode(F, t); p0_tile_load(dc, rr, F.lane); p0_tile_to_lds(scr, rr, F.lane, dc.rs);
    LDS_WAIT(); asm volatile("" ::: "memory");
    p0_tile_store(dc, scr, F.lane);
    LDS_WAIT(); asm volatile("" ::: "memory");
}
__device__ __forceinline__ void seam_bg(Frame& F, const XcdBarrier& b, const unsigned need) {
    volatile LAS unsigned* M = F.MISC; const int x = F.bx & 7;
    if (need) {
        for (int s_ = 0; s_ < 8; ++s_) { const int xs = (x + s_) & 7;
            for (;;) { if (F.tid == 0) { unsigned cl = 0xffffffffu; if (xb_ld(F.ctl + CW_WQ + 64 * xs) < need) cl = xb_add(F.ctl + CW_WQ + 64 * xs, 8u); M[57] = cl; }
                __syncthreads();
                const unsigned base = M[57];
                __syncthreads();
                if (base >= (unsigned)BGW_PER_SHARD) break;
                const unsigned local = base + (unsigned)F.wave; if (local < (unsigned)BGW_PER_SHARD) bgw_tile(F, (int)local * 8 + xs); } } }
    asm volatile("s_waitcnt vmcnt(0)" ::: "memory");
    __syncthreads();
    XbWait w; w.mode = 0u; w.key = 0u; bool dry = need >= (unsigned)BGW_PER_SHARD;
    if (F.tid == 0) w = xcd_arrive(b);
    for (;;) {
        if (F.tid == 0) { const bool xfull = (w.mode == 1u) && (xb_ld(&b.bar[XB_XSUB(b.x)]) >= (w.key + 1u) * b.st[0]);
            if (dry || w.mode == 2u || xfull) { while (!xcd_poll(b, w)) __builtin_amdgcn_s_sleep(1); }
            const bool done = xcd_poll(b, w); unsigned cl = 0xffffffffu;
            if (!done && !dry) { cl = xb_add(F.ctl + CW_WQ + 64 * x, 8u); if (cl >= (unsigned)BGW_PER_SHARD) dry = true; }
            M[56] = done ? 1u : 0u; M[57] = cl; }
        __syncthreads();
        const unsigned done = M[56], base = M[57];
        __syncthreads();
        if (done) break;
        if (base < (unsigned)BGW_PER_SHARD) { const unsigned local = base + (unsigned)F.wave; if (local < (unsigned)BGW_PER_SHARD) bgw_tile(F, (int)local * 8 + x); }
        else __builtin_amdgcn_s_sleep(4);
    }
}
struct Args { const float* in[26]; float* out; unsigned char* ws; int ph_lo, ph_hi; };
constexpr int NPHASE = 13;

__global__ void __launch_bounds__(512, 2) mk_fwd(Args args) {
    extern __shared__ __attribute__((aligned(16))) unsigned char lds[];
    Frame F;
    F.lds = (LAS unsigned char*)lds; F.MISC = (volatile LAS unsigned*)(F.lds + MISC_OFF);
    F.tid = threadIdx.x; F.lane = F.tid & 63; F.wave = __builtin_amdgcn_readfirstlane(F.tid >> 6);
    F.G = gridDim.x; F.bx = blockIdx.x; F.vcu = (F.G % 8 == 0) ? (F.bx % 8) * (F.G / 8) + F.bx / 8 : F.bx;
    F.ws = args.ws; F.ctl = (unsigned*)(args.ws + WS_CTL); F.out = args.out;
#pragma unroll
    for (int i = 0; i < 26; ++i) F.in[i] = args.in[i];
    for (int u = F.tid; u < 64; u += 512) F.MISC[u] = 0u;
    __syncthreads();
    unsigned char* ws = F.ws;
    XcdBarrier bar; bar.bar = F.ctl + CW_BAR; bar.x = 0; bar.st = nullptr;
    if (!MK_PER_PHASE) bar = xcd_barrier_post(F.ctl + CW_BAR, F.MISC + 8);
    const int lo = args.ph_lo, hi = args.ph_hi;
    unsigned long long ts_a = 0ull, ts_b = 0ull; (void)ts_a; (void)ts_b;
#define STAMP(k) do { if (MK_STAMP >= 0 && F.bx == 0 && F.tid == 0) { if ((k) == MK_STAMP) ts_a = __builtin_amdgcn_s_memrealtime(); if ((k) == MK_STAMP + 1) { ts_b = __builtin_amdgcn_s_memrealtime(); \
        __hip_atomic_store(F.ctl + 200, __builtin_bit_cast(unsigned, (float)(ts_b - ts_a) * 0.01f), __ATOMIC_RELAXED, __HIP_MEMORY_SCOPE_AGENT); } } } while (0)
#define IN(k) (lo <= (k) && (k) < hi)
#define SEAM(k) do { if (IN(k) && IN((k) + 1)) { if (MK_BGW && (k) <= 10) seam_bg(F, bar, (k) == 8 ? (unsigned)(16384 / 8 < BGW_PER_SHARD ? 16384 / 8 : BGW_PER_SHARD) : ((k) == 10 ? (unsigned)BGW_PER_SHARD : 0u)); else xcd_barrier(bar); } } while (0)

    STAMP(0);
    if (IN(0)) { phase0(F, 0); if ((MK_REP_MASK >> 0) & 1) { xcd_barrier(bar); phase0(F, MK_VARIANT); } }
    SEAM(0);
    STAMP(1);
    if (IN(1)) { phase1(F, 0); if ((MK_REP_MASK >> 1) & 1) { xcd_barrier(bar); phase1(F, MK_VARIANT); } }
    SEAM(1);
    STAMP(2);
    if (IN(2)) { phase2(F, 0); if ((MK_REP_MASK >> 2) & 1) { xcd_barrier(bar); phase2(F, MK_VARIANT); } }
    SEAM(2);
    STAMP(3);
    if (IN(3)) { phase3(F, 0); if ((MK_REP_MASK >> 3) & 1) { xcd_barrier(bar); phase3(F, MK_VARIANT); } }
    SEAM(3);
    STAMP(4);
    if (IN(4)) { phase4(F, 0); if ((MK_REP_MASK >> 4) & 1) { xcd_barrier(bar); phase4(F, MK_VARIANT); } }
    SEAM(4);
    STAMP(5);
    if (IN(5)) { phase5(F, 0); if ((MK_REP_MASK >> 5) & 1) { xcd_barrier(bar); phase5(F, MK_VARIANT); } }
    SEAM(5);
    STAMP(6);
    if (IN(6)) { phase6(F, 0); if ((MK_REP_MASK >> 6) & 1) { xcd_barrier(bar); phase6(F, MK_VARIANT); } }
    SEAM(6);
    STAMP(7);
    if (IN(7)) { phase7(F, 0); if ((MK_REP_MASK >> 7) & 1) { xcd_barrier(bar); phase7(F, MK_VARIANT); } }
    SEAM(7);
    STAMP(8);
    if (IN(8)) { phase8(F, 0); if ((MK_REP_MASK >> 8) & 1) { xcd_barrier(bar); phase8(F, MK_VARIANT); } }
    SEAM(8);
    STAMP(9);
    STAMP(10);
    if (IN(10)) { phase10(F, 0); if ((MK_REP_MASK >> 10) & 1) { xcd_barrier(bar); phase10(F, MK_VARIANT); } }
    SEAM(10);
    STAMP(11);
    if (IN(11)) { phase11(F, 0); if ((MK_REP_MASK >> 11) & 1) { xcd_barrier(bar); phase11(F, MK_VARIANT); } }
    SEAM(11);
    STAMP(12);
    if (IN(12)) { phase12(F, 0); if ((MK_REP_MASK >> 12) & 1) { xcd_barrier(bar); phase12(F, MK_VARIANT); } }
#undef IN
#undef SEAM
}

extern "C" void kernel_launch(void* const* d_in, const int* in_sizes, int n_in, void* d_out, int out_size, void* d_ws, size_t ws_size, hipStream_t stream) {
    static int grid = 0;
    if (grid == 0) {
        if (n_in != 26 || in_sizes[0] != T * D || out_size != T * D || ws_size < WS_END) { fprintf(stderr, "kernel_launch: unexpected shapes (n_in %d, in0 %d, out %d, ws %zu < %zu)\n", n_in, n_in > 0 ? in_sizes[0] : -1, out_size, ws_size, (size_t)WS_END); grid = -1; return; }
        int dev = 0, cus = 0, per_cu = 0;
        if (hipGetDevice(&dev) != hipSuccess || hipDeviceGetAttribute(&cus, hipDeviceAttributeMultiprocessorCount, dev) != hipSuccess) { grid = -1; return; }
        if (hipFuncSetAttribute((const void*)mk_fwd, hipFuncAttributeMaxDynamicSharedMemorySize, LDS_BYTES) != hipSuccess) { fprintf(stderr, "kernel_launch: hipFuncSetAttribute failed\n"); grid = -1; return; }
        if (hipOccupancyMaxActiveBlocksPerMultiprocessor(&per_cu, (const void*)mk_fwd, 512, LDS_BYTES) != hipSuccess || per_cu < 1) fprintf(stderr, "kernel_launch: occupancy query reports %d\n", per_cu);
        (void)hipGetLastError();
        grid = cus;
        if (grid != 256) fprintf(stderr, "kernel_launch: %d CUs (built for 256)\n", grid);
    }
    if (grid < 0) return;
    (void)hipMemsetAsync((char*)d_ws + WS_CTL, 0, 32 * KiB, stream);
    Args a{};
    for (int i = 0; i < 26; ++i) a.in[i] = (const float*)d_in[i];
    a.out = (float*)d_out; a.ws = (unsigned char*)d_ws;
#if MK_PER_PHASE
    for (int p = 0; p < NPHASE; ++p) { a.ph_lo = p; a.ph_hi = p + 1; hipLaunchKernelGGL(mk_fwd, dim3(grid), dim3(512), LDS_BYTES, stream, a); }
#else
    a.ph_lo = 0; a.ph_hi = NPHASE; hipLaunchKernelGGL(mk_fwd, dim3(grid), dim3(512), LDS_BYTES, stream, a);
#endif
}
```
